# Optimizing an MI355X kernel written in HIP

```python
import jax, jax.numpy as jnp
from jax import lax
import numpy as np


D_MODEL = 1024
BATCH = 2
SEQ = 8192
DEPTH = 1

PLE_DIM = 256
D_MIX = D_MODEL
GDN_HEADS = 4
GDN_DK = 128
GDN_DV = 128
GDN_QK_W = GDN_HEADS * GDN_DK
GDN_V_W = GDN_HEADS * GDN_DV
GDN_CONV = 4
GDN_CHUNK = 64
CONF_CH = D_MIX - GDN_V_W
CONF_WIDTH = 31
N_GROUPS = 8
EXPERTS_PER_GROUP = 8
N_EXPERTS = N_GROUPS * EXPERTS_PER_GROUP
TOP_K = 2
D_EXPERT = 256
MOE_BLOCK = 128
EPS = 1e-6
IN_COLS = 2 * GDN_QK_W + 2 * GDN_V_W + 2 * GDN_HEADS + 2 * CONF_CH

kernel_name = 'hybrid_gdn_conformer_hmoe_block'


def _rmsnorm(x, g):
    xf = x.astype(jnp.float32)
    y = xf * lax.rsqrt(jnp.mean(xf * xf, axis=-1, keepdims=True) + EPS)
    return (y * g.astype(jnp.float32)).astype(x.dtype)


def _layernorm(x, g, b):
    xf = x.astype(jnp.float32)
    mu = jnp.mean(xf, axis=-1, keepdims=True)
    var = jnp.mean(jnp.square(xf - mu), axis=-1, keepdims=True)
    y = (xf - mu) * lax.rsqrt(var + EPS)
    return (y * g.astype(jnp.float32) + b.astype(jnp.float32)).astype(x.dtype)


def _l2norm(x):
    return x * lax.rsqrt(jnp.sum(x * x, axis=-1, keepdims=True) + EPS)


def _causal_depthwise_conv(x, w):
    K, C = w.shape
    return lax.conv_general_dilated(
        x, w[:, None, :].astype(x.dtype), window_strides=(1,), padding=[(K - 1, 0)],
        dimension_numbers=('NWC', 'WIO', 'NWC'), feature_group_count=C)


def _gated_delta_rule_chunked(q, k, v, g, beta):
    B, T, H, DK = q.shape
    DV = v.shape[-1]
    C = GDN_CHUNK
    NC = T // C

    def chunks(t):
        return jnp.moveaxis(t.reshape((B, NC, C, H) + t.shape[3:]), 3, 1)

    q, k, v, g, beta = chunks(q), chunks(k), chunks(v), chunks(g), chunks(beta)
    gc = jnp.cumsum(g, axis=-1)
    causal = jnp.tril(jnp.ones((C, C), dtype=bool))
    strict = jnp.tril(jnp.ones((C, C), dtype=bool), -1)
    decay = jnp.exp(jnp.where(causal, gc[..., :, None] - gc[..., None, :], -jnp.inf))
    k_beta = k * beta[..., None]
    v_beta = v * beta[..., None]
    L = jnp.where(strict, jnp.einsum('bhncd,bhnsd->bhncs', k_beta, k) * decay, 0.0)
    eye = jnp.broadcast_to(jnp.eye(C, dtype=L.dtype), L.shape)
    Tm = lax.linalg.triangular_solve(L + eye, eye, left_side=True, lower=True, unit_diagonal=True)
    u = jnp.einsum('bhncs,bhnse->bhnce', Tm, v_beta)
    w = jnp.einsum('bhncs,bhnsd->bhncd', Tm, k_beta * jnp.exp(gc)[..., None])
    qk = jnp.einsum('bhncd,bhnsd->bhncs', q, k) * decay
    q_dec = q * jnp.exp(gc)[..., None]
    k_dec = k * jnp.exp(gc[..., -1:] - gc)[..., None]
    g_tot = jnp.exp(gc[..., -1])
    xs = tuple(jnp.moveaxis(t, 2, 0) for t in (u, w, qk, q_dec, k_dec, g_tot))

    def step(S, xs_n):
        u_n, w_n, qk_n, qd_n, kd_n, gt_n = xs_n
        v_new = u_n - jnp.einsum('bhcd,bhde->bhce', w_n, S)
        o_n = jnp.einsum('bhcd,bhde->bhce', qd_n, S) + jnp.einsum('bhcs,bhse->bhce', qk_n, v_new)
        S = S * gt_n[..., None, None] + jnp.einsum('bhcd,bhce->bhde', kd_n, v_new)
        return S, o_n

    S0 = jnp.zeros((B, H, DK, DV), jnp.float32)
    _, o = lax.scan(step, S0, xs)
    return o.transpose(1, 0, 3, 2, 4).reshape(B, T, H, DV)


def _mixers(n1, w_in, w_conv_qkv, a_log, dt_bias, g_gdn_out, b_glu, w_conv_dw, b_conv_dw,
            ln_conv_g, ln_conv_b):
    B, T, _ = n1.shape
    proj = n1 @ w_in
    o1 = 2 * GDN_QK_W + GDN_V_W
    o2 = o1 + GDN_V_W
    o3 = o2 + GDN_HEADS
    o4 = o3 + GDN_HEADS
    qkv, z, b_raw, a_raw, glu_in = jnp.split(proj, [o1, o2, o3, o4], axis=-1)

    qkv = jax.nn.silu(_causal_depthwise_conv(qkv, w_conv_qkv)).astype(jnp.float32)
    q, k, v = jnp.split(qkv, [GDN_QK_W, 2 * GDN_QK_W], axis=-1)
    q = _l2norm(q.reshape(B, T, GDN_HEADS, GDN_DK)) * (GDN_DK ** -0.5)
    k = _l2norm(k.reshape(B, T, GDN_HEADS, GDN_DK))
    v = v.reshape(B, T, GDN_HEADS, GDN_DV)
    beta = jax.nn.sigmoid(b_raw.astype(jnp.float32))
    g = -jnp.exp(a_log.astype(jnp.float32)) * jax.nn.softplus(
        a_raw.astype(jnp.float32) + dt_bias.astype(jnp.float32))
    o = _gated_delta_rule_chunked(q, k, v, g, beta)
    o = (o * lax.rsqrt(jnp.mean(o * o, axis=-1, keepdims=True) + EPS) * g_gdn_out.astype(jnp.float32)
         * jax.nn.silu(z.astype(jnp.float32).reshape(B, T, GDN_HEADS, GDN_DV)))
    y_gdn = o.reshape(B, T, GDN_V_W).astype(n1.dtype)

    u = glu_in + b_glu
    u = u[..., :CONF_CH] * jax.nn.sigmoid(u[..., CONF_CH:])
    c = _causal_depthwise_conv(u, w_conv_dw) + b_conv_dw
    y_conv = jax.nn.silu(_layernorm(c, ln_conv_g, ln_conv_b))

    return jnp.concatenate([y_gdn, y_conv], axis=-1)


def _hierarchical_moe(xn, w_group_router, w_expert_router, w_up, w_down):
    B, T, D = xn.shape
    N = B * T
    xf = xn.reshape(N, D)
    group_p = jax.nn.softmax((xf @ w_group_router).astype(jnp.float32), axis=-1)
    g_w, g_idx = lax.top_k(group_p, 1)
    e_logits = (xf @ w_expert_router).astype(jnp.float32).reshape(N, N_GROUPS, EXPERTS_PER_GROUP)
    in_group = jnp.take_along_axis(e_logits, g_idx[:, :, None], axis=1)[:, 0]
    e_w, e_idx = lax.top_k(jax.nn.softmax(in_group, axis=-1), TOP_K)
    gate = g_w * (e_w / jnp.sum(e_w, axis=-1, keepdims=True))
    expert = g_idx * EXPERTS_PER_GROUP + e_idx

    NK = N * TOP_K
    flat_e = expert.reshape(-1)
    flat_tok = jnp.repeat(jnp.arange(N, dtype=jnp.int32), TOP_K)
    flat_w = gate.reshape(-1)
    order = jnp.argsort(flat_e)
    se, st, sw = flat_e[order], flat_tok[order], flat_w[order]
    counts = jnp.bincount(flat_e, length=N_EXPERTS)
    starts = jnp.cumsum(counts) - counts
    padded = (counts + MOE_BLOCK - 1) // MOE_BLOCK * MOE_BLOCK
    pend = jnp.cumsum(padded)
    pstart = pend - padded
    pos = pstart[se] + jnp.arange(NK, dtype=jnp.int32) - starts[se]
    nb = -(-NK // MOE_BLOCK) + N_EXPERTS
    P = nb * MOE_BLOCK
    buf_tok = jnp.zeros((P,), jnp.int32).at[pos].set(st)
    buf_w = jnp.zeros((P,), jnp.float32).at[pos].set(sw)
    block_expert = jnp.minimum(
        jnp.searchsorted(pend, jnp.arange(nb, dtype=jnp.int32) * MOE_BLOCK, side='right'), N_EXPERTS - 1)
    xb = xf[buf_tok].reshape(nb, MOE_BLOCK, D)

    def expert_block(args):
        x_blk, e = args
        a, b = jnp.split(x_blk @ w_up[e], 2, axis=-1)
        return (jax.nn.silu(a) * b) @ w_down[e]

    yb = lax.map(expert_block, (xb, block_expert)).reshape(P, D)
    y = jax.ops.segment_sum(yb * buf_w[:, None].astype(yb.dtype), buf_tok, num_segments=N)
    return y.reshape(B, T, D)


def setup_inputs(seed: int = 0) -> dict:
    key = jax.random.key(seed)
    ks = jax.random.split(key, 24)
    f32 = jnp.float32

    def nrm(k, shape, scale):
        return jax.random.normal(k, shape, f32) * scale

    def gain(k, shape):
        return 1.0 + 0.05 * jax.random.normal(k, shape, f32)

    dt = jnp.exp(jax.random.uniform(ks[5], (DEPTH, GDN_HEADS), f32, np.log(1e-3), np.log(1e-1)))
    return {
        'x': nrm(ks[0], (BATCH, SEQ, D_MODEL), 1.0),
        'p': nrm(ks[1], (DEPTH, BATCH, SEQ, PLE_DIM), 1.0),
        'g_mix': gain(ks[2], (DEPTH, D_MODEL)),
        'w_in': nrm(ks[3], (DEPTH, D_MODEL, IN_COLS), D_MODEL ** -0.5),
        'w_conv_qkv': nrm(ks[4], (DEPTH, GDN_CONV, 2 * GDN_QK_W + GDN_V_W), GDN_CONV ** -0.5),
        'a_log': jnp.log(jax.random.uniform(ks[6], (DEPTH, GDN_HEADS), f32, 1.0, 16.0)),
        'dt_bias': dt + jnp.log(-jnp.expm1(-dt)),
        'g_gdn_out': gain(ks[7], (DEPTH, GDN_DV)),
        'b_glu': nrm(ks[8], (DEPTH, 2 * CONF_CH), 0.02),
        'w_conv_dw': nrm(ks[9], (DEPTH, CONF_WIDTH, CONF_CH), CONF_WIDTH ** -0.5),
        'b_conv_dw': nrm(ks[10], (DEPTH, CONF_CH), 0.02),
        'ln_conv_g': gain(ks[11], (DEPTH, CONF_CH)),
        'ln_conv_b': nrm(ks[12], (DEPTH, CONF_CH), 0.02),
        'w_out': nrm(ks[13], (DEPTH, D_MIX, D_MODEL), D_MIX ** -0.5),
        'g_moe': gain(ks[14], (DEPTH, D_MODEL)),
        'w_group_router': nrm(ks[15], (DEPTH, D_MODEL, N_GROUPS), D_MODEL ** -0.5),
        'w_expert_router': nrm(ks[16], (DEPTH, D_MODEL, N_EXPERTS), D_MODEL ** -0.5),
        'w_up': nrm(ks[17], (DEPTH, N_EXPERTS, D_MODEL, 2 * D_EXPERT), D_MODEL ** -0.5),
        'w_down': nrm(ks[18], (DEPTH, N_EXPERTS, D_EXPERT, D_MODEL), D_EXPERT ** -0.5),
        'g_ple': gain(ks[19], (DEPTH, D_MODEL)),
        'w_ple_gate': nrm(ks[20], (DEPTH, D_MODEL, D_MODEL), D_MODEL ** -0.5),
        'w_ple_proj': nrm(ks[21], (DEPTH, PLE_DIM, D_MODEL), PLE_DIM ** -0.5),
        'g_final': gain(ks[22], (D_MODEL,)),
    }


def reference(x, p, g_mix, w_in, w_conv_qkv, a_log, dt_bias, g_gdn_out, b_glu, w_conv_dw,
              b_conv_dw, ln_conv_g, ln_conv_b, w_out, g_moe, w_group_router, w_expert_router,
              w_up, w_down, g_ple, w_ple_gate, w_ple_proj, g_final):
    h = x
    for i in range(DEPTH):
        n1 = _rmsnorm(h, g_mix[i])
        mix = _mixers(n1, w_in[i], w_conv_qkv[i], a_log[i], dt_bias[i], g_gdn_out[i], b_glu[i],
                      w_conv_dw[i], b_conv_dw[i], ln_conv_g[i], ln_conv_b[i])
        h = h + mix @ w_out[i]
        h = h + _hierarchical_moe(_rmsnorm(h, g_moe[i]), w_group_router[i], w_expert_router[i],
                                  w_up[i], w_down[i])
        ple_gate = jax.nn.sigmoid(_rmsnorm(h, g_ple[i]) @ w_ple_gate[i])
        h = h + ple_gate * (p[i] @ w_ple_proj[i])
    return _rmsnorm(h, g_final)
```

```cpp
#include <hip/hip_runtime.h>
#include <cstdio>
#include <cstdint>

constexpr int DM = 1024, NB = 2, SEQ = 8192, M = NB * SEQ, PLE = 256;
constexpr int NH = 4, DK = 128, DV = 128, QKW = 512, VW = 512, CCH = 512, CWID = 31;
constexpr int NGRP = 8, EPG = 8, NEXP = 64, DEXP = 256, INC = 3080;
constexpr int O1 = 1536, O2 = 2048, O3 = 2052, O4 = 2056;
constexpr float EPS = 1e-6f;

#define HYB 6
namespace nv {
__device__ __forceinline__ float wave_sum(float v) {
#pragma unroll
    for (int o = 1; o < 64; o <<= 1) v += __shfl_xor(v, o);
    return v;
}
__device__ __forceinline__ float sigmoidf_(float x) { return 1.f / (1.f + __expf(-x)); }
__device__ __forceinline__ float siluf_(float x) { return x / (1.f + __expf(-x)); }

__global__ void __launch_bounds__(256) k_rmsnorm(const float* __restrict__ x, const float* __restrict__ g, float* __restrict__ out) {
    __shared__ float red[4];
    const int row = blockIdx.x, tid = threadIdx.x;
    const float4 v = ((const float4*)(x + (size_t)row * DM))[tid];
    float s = v.x * v.x + v.y * v.y + v.z * v.z + v.w * v.w;
    s = wave_sum(s);
    if ((tid & 63) == 0) red[tid >> 6] = s;
    __syncthreads();
    const float tot = red[0] + red[1] + red[2] + red[3];
    const float r = rsqrtf(tot * (1.f / DM) + EPS);
    const float4 gg = ((const float4*)g)[tid];
    float4 o; o.x = v.x * r * gg.x; o.y = v.y * r * gg.y; o.z = v.z * r * gg.z; o.w = v.w * r * gg.w;
    ((float4*)(out + (size_t)row * DM))[tid] = o;
}

__global__ void __launch_bounds__(256) k_gemm(const float* __restrict__ A, int lda, const float* __restrict__ B, int ldb, float* __restrict__ C, int ldc,
                                              int Mr, int N, int K, const int* __restrict__ rowidx, const int* __restrict__ tile_e, size_t bstride) {
    __shared__ float As[16][65];
    __shared__ float Bs[16][65];
    const int tid = threadIdx.x, tx = tid & 15, ty = tid >> 4;
    const int m0 = blockIdx.y * 64, n0 = blockIdx.x * 64;
    if (tile_e) { const int e = tile_e[blockIdx.y]; if (e < 0) return; B += (size_t)e * bstride; }
    float acc[4][4] = {};
    const int ar = tid >> 2, ak = (tid & 3) * 4;
    int arow = m0 + ar; bool avalid = arow < Mr;
    if (avalid && rowidx) { arow = rowidx[arow]; avalid = arow >= 0; }
    const float* ap = A + (size_t)(avalid ? arow : 0) * lda + ak;
    const int bk = tid >> 4, bn = (tid & 15) * 4;
    for (int k0 = 0; k0 < K; k0 += 16) {
        float4 av = avalid ? *(const float4*)(ap + k0) : make_float4(0.f, 0.f, 0.f, 0.f);
        As[ak + 0][ar] = av.x; As[ak + 1][ar] = av.y; As[ak + 2][ar] = av.z; As[ak + 3][ar] = av.w;
        const float* bp = B + (size_t)(k0 + bk) * ldb + n0 + bn;
#pragma unroll
        for (int j = 0; j < 4; ++j) Bs[bk][bn + j] = (n0 + bn + j < N) ? bp[j] : 0.f;
        __syncthreads();
#pragma unroll
        for (int kk = 0; kk < 16; ++kk) {
            float a[4], b[4];
#pragma unroll
            for (int i = 0; i < 4; ++i) { a[i] = As[kk][ty * 4 + i]; b[i] = Bs[kk][tx * 4 + i]; }
#pragma unroll
            for (int i = 0; i < 4; ++i)
#pragma unroll
                for (int j = 0; j < 4; ++j) acc[i][j] = fmaf(a[i], b[j], acc[i][j]);
        }
        __syncthreads();
    }
#pragma unroll
    for (int i = 0; i < 4; ++i) { const int m = m0 + ty * 4 + i; if (m >= Mr) continue;
#pragma unroll
        for (int j = 0; j < 4; ++j) { const int n = n0 + tx * 4 + j; if (n < N) C[(size_t)m * ldc + n] = acc[i][j]; } }
}

__global__ void __launch_bounds__(256) k_conv4(const float* __restrict__ proj, int ldp, const float* __restrict__ w, float* __restrict__ out) {
    const size_t i = (size_t)blockIdx.x * 256 + threadIdx.x;
    if (i >= (size_t)M * O1) return;
    const int m = (int)(i / O1), c = (int)(i % O1), t = m % SEQ;
    float s = 0.f;
#pragma unroll
    for (int k = 0; k < 4; ++k) { const int tt = t - 3 + k; if (tt >= 0) s = fmaf(w[k * O1 + c], proj[(size_t)(m - 3 + k) * ldp + c], s); }
    out[i] = siluf_(s);
}
__global__ void __launch_bounds__(256) k_l2norm(float* __restrict__ qkv) {
    const int gw = blockIdx.x * 4 + (threadIdx.x >> 6), lane = threadIdx.x & 63;
    if (gw >= M * 8) return;
    const int m = gw >> 3, j = gw & 7;
    float* p = qkv + (size_t)m * O1 + j * 128;
    float a = p[lane], b = p[lane + 64];
    const float s = wave_sum(a * a + b * b);
    float r = rsqrtf(s + EPS); if (j < 4) r *= 0.08838834764831845f;
    p[lane] = a * r; p[lane + 64] = b * r;
}
__global__ void __launch_bounds__(256) k_gbeta(const float* __restrict__ proj, int ldp, const float* __restrict__ a_log, const float* __restrict__ dt_bias, float* __restrict__ gb) {
    const int i = blockIdx.x * 256 + threadIdx.x; if (i >= M * NH) return;
    const int m = i >> 2, h = i & 3;
    const float braw = proj[(size_t)m * ldp + O2 + h], araw = proj[(size_t)m * ldp + O3 + h];
    const float x = araw + dt_bias[h];
    const float sp = (x > 20.f) ? x : log1pf(expf(x));
    gb[(size_t)m * 8 + h] = -expf(a_log[h]) * sp;
    gb[(size_t)m * 8 + 4 + h] = 1.f / (1.f + expf(-braw));
}
__global__ void __launch_bounds__(128) k_scan(const float* __restrict__ qkv, const float* __restrict__ gb, float* __restrict__ o) {
    __shared__ float kq[2][256];
    const int bh = blockIdx.x, b = bh >> 2, h = bh & 3, e = threadIdx.x;
    float S[DK];
#pragma unroll
    for (int d = 0; d < DK; ++d) S[d] = 0.f;
    for (int t = 0; t < SEQ; ++t) {
        const size_t m = (size_t)b * SEQ + t;
        const float* row = qkv + m * O1;
        kq[t & 1][e] = row[QKW + h * 128 + e];
        kq[t & 1][128 + e] = row[h * 128 + e];
        const float v = row[2 * QKW + h * 128 + e];
        const float g = gb[m * 8 + h], beta = gb[m * 8 + 4 + h];
        const float eg = expf(g);
        __syncthreads();
        const float* kk = kq[t & 1]; const float* qq = kq[t & 1] + 128;
        float dot = 0.f;
#pragma unroll
        for (int d = 0; d < DK; ++d) dot = fmaf(kk[d], S[d], dot);
        const float r = beta * (v - eg * dot);
        float oo = 0.f;
#pragma unroll
        for (int d = 0; d < DK; ++d) { S[d] = fmaf(kk[d], r, eg * S[d]); oo = fmaf(qq[d], S[d], oo); }
        o[m * VW + h * 128 + e] = oo;
    }
}
__global__ void __launch_bounds__(256) k_gatednorm(const float* __restrict__ o, const float* __restrict__ proj, int ldp, const float* __restrict__ gg, float* __restrict__ mix) {
    const int gw = blockIdx.x * 4 + (threadIdx.x >> 6), lane = threadIdx.x & 63;
    if (gw >= M * NH) return;
    const int m = gw >> 2, h = gw & 3;
    const float* op = o + (size_t)m * VW + h * 128;
    const float a = op[lane], b = op[lane + 64];
    const float r = rsqrtf(wave_sum(a * a + b * b) * (1.f / DV) + EPS);
    const float* zp = proj + (size_t)m * ldp + O1 + h * 128;
    float* mp = mix + (size_t)m * DM + h * 128;
    mp[lane] = a * r * gg[lane] * siluf_(zp[lane]);
    mp[lane + 64] = b * r * gg[lane + 64] * siluf_(zp[lane + 64]);
}
__global__ void __launch_bounds__(256) k_glu(const float* __restrict__ proj, const float* __restrict__ b_glu, float* __restrict__ u) {
    const size_t i = (size_t)blockIdx.x * 256 + threadIdx.x; if (i >= (size_t)M * CCH) return;
    const int m = (int)(i / CCH), c = (int)(i % CCH);
    const float a = proj[(size_t)m * INC + O4 + c] + b_glu[c], g = proj[(size_t)m * INC + O4 + CCH + c] + b_glu[CCH + c];
    u[i] = a * sigmoidf_(g);
}
__global__ void __launch_bounds__(256) k_conf(const float* __restrict__ u, const float* __restrict__ w, const float* __restrict__ bdw, const float* __restrict__ lg, const float* __restrict__ lb, float* __restrict__ mix) {
    __shared__ float red[8];
    const int m = blockIdx.x, t = m % SEQ, tid = threadIdx.x;
    float c[2];
#pragma unroll
    for (int j = 0; j < 2; ++j) { const int ch = tid + 256 * j; float s = bdw[ch];
        for (int k = 0; k < CWID; ++k) { const int tt = t - (CWID - 1) + k; if (tt >= 0) s = fmaf(w[k * CCH + ch], u[(size_t)(m - (CWID - 1) + k) * CCH + ch], s); }
        c[j] = s; }
    float s1 = wave_sum(c[0] + c[1]);
    if ((tid & 63) == 0) red[tid >> 6] = s1;
    __syncthreads();
    const float mu = (red[0] + red[1] + red[2] + red[3]) * (1.f / CCH);
    const float d0 = c[0] - mu, d1 = c[1] - mu;
    float s2 = wave_sum(d0 * d0 + d1 * d1);
    if ((tid & 63) == 0) red[4 + (tid >> 6)] = s2;
    __syncthreads();
    const float r = rsqrtf((red[4] + red[5] + red[6] + red[7]) * (1.f / CCH) + EPS);
#pragma unroll
    for (int j = 0; j < 2; ++j) { const int ch = tid + 256 * j; const float y = (c[j] - mu) * r * lg[ch] + lb[ch]; mix[(size_t)m * DM + 512 + ch] = siluf_(y); }
}
__global__ void __launch_bounds__(256) k_addx(float* __restrict__ h, const float* __restrict__ x) {
    const size_t i = (size_t)blockIdx.x * 256 + threadIdx.x; if (i >= (size_t)M * DM / 4) return;
    float4 a = ((float4*)h)[i]; const float4 b = ((const float4*)x)[i]; a.x += b.x; a.y += b.y; a.z += b.z; a.w += b.w; ((float4*)h)[i] = a;
}
__global__ void __launch_bounds__(256) k_route(const float* __restrict__ logits, int* __restrict__ te, float* __restrict__ tw, int* __restrict__ counts) {
    const int m = blockIdx.x * 256 + threadIdx.x; if (m >= M) return;
    const float* lg = logits + (size_t)m * 72;
    float mx = lg[0]; int gi = 0;
#pragma unroll
    for (int j = 1; j < NGRP; ++j) if (lg[j] > mx) { mx = lg[j]; gi = j; }
    float den = 0.f;
#pragma unroll
    for (int j = 0; j < NGRP; ++j) den += expf(lg[j] - mx);
    const float gw = 1.f / den;
    const float* el = lg + 8 + gi * EPG;
    float m1 = -INFINITY, m2 = -INFINITY; int i1 = 0, i2 = 0;
#pragma unroll
    for (int j = 0; j < EPG; ++j) { const float v = el[j]; if (v > m1) { m2 = m1; i2 = i1; m1 = v; i1 = j; } else if (v > m2) { m2 = v; i2 = j; } }
    const float p2 = expf(m2 - m1);
    const float w1 = 1.f / (1.f + p2), w2 = p2 / (1.f + p2);
    const int e1 = gi * EPG + i1, e2 = gi * EPG + i2;
    te[m * 2] = e1; te[m * 2 + 1] = e2; tw[m * 2] = gw * w1; tw[m * 2 + 1] = gw * w2;
    atomicAdd(&counts[e1], 1); atomicAdd(&counts[e2], 1);
}
__global__ void __launch_bounds__(64) k_offsets(const int* __restrict__ counts, int* __restrict__ pstart, int* __restrict__ cursor, int* __restrict__ tile_e, int ntile_max) {
    __shared__ int ps[NEXP + 1];
    if (threadIdx.x == 0) { int acc = 0; for (int e = 0; e < NEXP; ++e) { ps[e] = acc; acc += (counts[e] + 63) / 64 * 64; } ps[NEXP] = acc; }
    __syncthreads();
    const int e = threadIdx.x; pstart[e] = ps[e]; cursor[e] = 0;
    for (int i = threadIdx.x; i < ntile_max; i += 64) { const int r = i * 64; int ee = -1; if (r < ps[NEXP]) { for (int q = 0; q < NEXP; ++q) if (r >= ps[q] && r < ps[q + 1]) ee = q; } tile_e[i] = ee; }
}
__global__ void __launch_bounds__(256) k_scatter(const int* __restrict__ te, const int* __restrict__ pstart, int* __restrict__ cursor, int* __restrict__ rowidx, int* __restrict__ tpos) {
    const int i = blockIdx.x * 256 + threadIdx.x; if (i >= M * 2) return;
    const int e = te[i]; const int pos = pstart[e] + atomicAdd(&cursor[e], 1);
    rowidx[pos] = i >> 1; tpos[i] = pos;
}
__global__ void __launch_bounds__(256) k_act(const float* __restrict__ up, float* __restrict__ act, int rows) {
    const size_t i = (size_t)blockIdx.x * 256 + threadIdx.x; if (i >= (size_t)rows * DEXP) return;
    const size_t r = i / DEXP; const int j = (int)(i % DEXP);
    act[i] = siluf_(up[r * 512 + j]) * up[r * 512 + 256 + j];
}
__global__ void __launch_bounds__(256) k_combine(float* __restrict__ h, const float* __restrict__ Y, const int* __restrict__ tpos, const float* __restrict__ tw) {
    const int m = blockIdx.x, tid = threadIdx.x;
    const int p0 = tpos[m * 2], p1 = tpos[m * 2 + 1]; const float w0 = tw[m * 2], w1 = tw[m * 2 + 1];
    float4 a = ((float4*)(h + (size_t)m * DM))[tid];
    const float4 y0 = ((const float4*)(Y + (size_t)p0 * DM))[tid], y1 = ((const float4*)(Y + (size_t)p1 * DM))[tid];
    a.x += w0 * y0.x + w1 * y1.x; a.y += w0 * y0.y + w1 * y1.y; a.z += w0 * y0.z + w1 * y1.z; a.w += w0 * y0.w + w1 * y1.w;
    ((float4*)(h + (size_t)m * DM))[tid] = a;
}
__global__ void __launch_bounds__(256) k_final(const float* __restrict__ h2, const float* __restrict__ G, const float* __restrict__ PP, const float* __restrict__ g, float* __restrict__ out) {
    __shared__ float red[4];
    const int row = blockIdx.x, tid = threadIdx.x;
    const float4 a = ((const float4*)(h2 + (size_t)row * DM))[tid], gg = ((const float4*)(G + (size_t)row * DM))[tid], pp = ((const float4*)(PP + (size_t)row * DM))[tid];
    float4 v; v.x = a.x + sigmoidf_(gg.x) * pp.x; v.y = a.y + sigmoidf_(gg.y) * pp.y; v.z = a.z + sigmoidf_(gg.z) * pp.z; v.w = a.w + sigmoidf_(gg.w) * pp.w;
    float s = wave_sum(v.x * v.x + v.y * v.y + v.z * v.z + v.w * v.w);
    if ((tid & 63) == 0) red[tid >> 6] = s;
    __syncthreads();
    const float r = rsqrtf((red[0] + red[1] + red[2] + red[3]) * (1.f / DM) + EPS);
    const float4 gf = ((const float4*)g)[tid];
    float4 o; o.x = v.x * r * gf.x; o.y = v.y * r * gf.y; o.z = v.z * r * gf.z; o.w = v.w * r * gf.w;
    ((float4*)(out + (size_t)row * DM))[tid] = o;
}
}
namespace pg8 {
#define PG8_LAS __attribute__((address_space(3)))
typedef unsigned short bf16_t;
typedef short bf16x8 __attribute__((ext_vector_type(8)));
typedef float f32x4 __attribute__((ext_vector_type(4)));
typedef unsigned u32x4 __attribute__((ext_vector_type(4)));
constexpr int BM = 256, BK = 64, HALF = 128, HTB = HALF * BK * 2  , STAGE_BYTES = 8 * HTB, NXCD = 8, WGM = 8;

__host__ __device__ __forceinline__ int lds_byte(int r, int c) { const int st = (r >> 4) * 2 + (c >> 5), rr = r & 15, cc = c & 31, ob = rr * 64 + cc * 2; return st * 1024 + (ob ^ (((ob >> 9) & 1) << 5)); }
__host__ __device__ __forceinline__ void stage_rc(int b, int& R, int& C) { const int st = b / 1024, sb = b % 1024, swz = sb ^ (((sb >> 9) & 1) << 5); R = (st >> 1) * 16 + swz / 64; C = (st & 1) * 32 + (swz % 64) / 2; }
__host__ __device__ __forceinline__ int perm32(int rho) { const int n = rho >> 4, i = rho & 15; return 8 * (i >> 2) + 4 * n + (i & 3); }

struct Unit { int pm, pn, be; };
struct Gemm { const bf16_t* A; const bf16_t* Bt; int M, N, K; size_t bstride; };

struct StaticOrder {
    int nM, nN, nwg, G, c;
    __host__ __device__ void init(int M, int N, int G_, int c_) { nM = M / BM; nN = N / BM; nwg = nM * nN; G = G_; c = c_; }
    __host__ __device__ bool next(int i, Unit& u) const {
        const long L = (long)i * G + c; if (L >= nwg) return false;
        int wgid = (int)L; { const int q = nwg / NXCD, r = nwg % NXCD, xcd = wgid % NXCD, off = wgid / NXCD; wgid = (xcd < r ? xcd * (q + 1) : r * (q + 1) + (xcd - r) * q) + off; }
        const int nig = WGM * nN, gid = wgid / nig, fm = gid * WGM, gsz = (nM - fm) < WGM ? (nM - fm) : WGM;
        u.pm = fm + ((wgid % nig) % gsz); u.pn = (wgid % nig) / gsz; u.be = 0; return true;
    }
    __device__ __forceinline__ void a_ready(const Unit&) const {}
    __device__ __forceinline__ void done(const Unit&) const {}
};

__device__ __forceinline__ unsigned cvt_pk_bf16(float lo, float hi) { unsigned r; asm volatile("v_cvt_pk_bf16_f32 %0, %1, %2" : "=v"(r) : "v"(lo), "v"(hi)); return r; }
typedef float f32x2 __attribute__((ext_vector_type(2)));
__device__ __forceinline__ f32x2 gelu_pk(f32x2 v) {
    const f32x2 av = __builtin_elementwise_abs(v), d = av * 0.2316418882f + 1.0f;
    f32x2 t; t.x = __builtin_amdgcn_rcpf(d.x); t.y = __builtin_amdgcn_rcpf(d.y);
    f32x2 q = t * 0.5307027145f + (-0.7265760135f); q = q * t + 0.7107068705f; q = q * t + (-0.142248368f); q = q * t + 0.127414796f; q = q * t;
    const f32x2 s = (v * v) * (-0.72134752044f);
    f32x2 e; e.x = __builtin_amdgcn_exp2f(s.x); e.y = __builtin_amdgcn_exp2f(s.y);
    const f32x2 m = v * (q * e), r = v - m;
    f32x2 o; o.x = v.x < 0.f ? m.x : r.x; o.y = v.y < 0.f ? m.y : r.y; return o;
}

template <int ACT  > struct EpiBf16 {
    static constexpr bool PERM = true, AFTER_DRAIN = false; static_assert(ACT == 0 || ACT == 1, "EpiBf16: ACT is 0 (none) or 1 (gelu_pk)");
    bf16_t* O; int ldc; const float* bias; int split_cols; size_t split_stride; float scale0;
    __device__ __forceinline__ void operator()(const f32x4 (&acc)[2][2][4][2], const Unit& u, int wr, int wc, int fr, int fq) const {
        const int row0 = u.pm * BM + wr * 64 + fr; int colt = u.pn * BM; bf16_t* base = O;
        float sc = 1.f; if (split_cols) { const int t = colt / split_cols; base += (size_t)t * split_stride; colt -= t * split_cols; if (t == 0) sc = scale0; }
        const int col0 = colt + wc * 32 + 8 * fq, bcol0 = u.pn * BM + wc * 32 + 8 * fq;
        f32x4 bv[2][2];
#pragma unroll
        for (int bj = 0; bj < 2; ++bj)
#pragma unroll
            for (int n = 0; n < 2; ++n) bv[bj][n] = bias ? *(const f32x4*)(bias + bcol0 + bj * HALF + 4 * n) : (f32x4){0.f, 0.f, 0.f, 0.f};
#pragma unroll
        for (int ai = 0; ai < 2; ++ai)
#pragma unroll
            for (int m = 0; m < 4; ++m) { bf16_t* rowp = base + (size_t)(row0 + ai * HALF + m * 16) * ldc + col0;
#pragma unroll
                for (int bj = 0; bj < 2; ++bj) { f32x4 v0 = acc[ai][bj][m][0] + bv[bj][0], v1 = acc[ai][bj][m][1] + bv[bj][1];
                    if (ACT == 1) { f32x2 a = gelu_pk((f32x2){v0[0], v0[1]}), b = gelu_pk((f32x2){v0[2], v0[3]}), c = gelu_pk((f32x2){v1[0], v1[1]}), d = gelu_pk((f32x2){v1[2], v1[3]});
                        v0 = (f32x4){a.x, a.y, b.x, b.y}; v1 = (f32x4){c.x, c.y, d.x, d.y}; }
                    v0 = v0 * sc; v1 = v1 * sc; u32x4 w; w.x = cvt_pk_bf16(v0[0], v0[1]); w.y = cvt_pk_bf16(v0[2], v0[3]); w.z = cvt_pk_bf16(v1[0], v1[1]); w.w = cvt_pk_bf16(v1[2], v1[3]);
                    *(u32x4*)(rowp + bj * HALF) = w; } }
    }
};

struct PanelStats {
    unsigned* xbuf;
    unsigned* cnt;
    unsigned* tmo;
    int ntn; float eps;
    unsigned code;
    __device__ __forceinline__ bool run(const f32x4 (&v)[2][2][4][2], const Unit& u, int wr, int wc, int fr, int fq, PG8_LAS unsigned char* lds, int wid, int lane) const {
        typedef float f32x2v __attribute__((ext_vector_type(2)));
        PG8_LAS f32x2v* P = (PG8_LAS f32x2v*)lds;
        PG8_LAS f32x2v* S = (PG8_LAS f32x2v*)(lds + 8192);
        PG8_LAS unsigned* flag = (PG8_LAS unsigned*)(lds + 8192 + 2048);
#pragma unroll
        for (int ai = 0; ai < 2; ++ai)
#pragma unroll
            for (int m = 0; m < 4; ++m) {
                float s = 0.f;
#pragma unroll
                for (int bj = 0; bj < 2; ++bj)
#pragma unroll
                    for (int n = 0; n < 2; ++n) { const f32x4 x = v[ai][bj][m][n]; s += (x[0] + x[1]) + (x[2] + x[3]); }
                s += __shfl_xor(s, 16); s += __shfl_xor(s, 32);
                const float mw = s * (1.0f / 64.0f); float q = 0.f;
#pragma unroll
                for (int bj = 0; bj < 2; ++bj)
#pragma unroll
                    for (int n = 0; n < 2; ++n) { const f32x4 d = v[ai][bj][m][n] - mw; q += (d[0] * d[0] + d[1] * d[1]) + (d[2] * d[2] + d[3] * d[3]); }
                q += __shfl_xor(q, 16); q += __shfl_xor(q, 32);
                if (fq == 0) P[(ai * HALF + wr * 64 + m * 16 + fr) * 4 + wc] = (f32x2v){mw, q};
            }
        asm volatile("s_waitcnt lgkmcnt(0)" ::: "memory"); __builtin_amdgcn_s_barrier(); asm volatile("" ::: "memory");
#if defined(BROKEN_EXCHANGE_NO_WAIT)
#warning BROKEN CONTROL BUILD: the row-statistics exchange does not wait; results are wrong by design
        if (blockIdx.x >= 64) { const long long t0_ = clock64(); while (clock64() - t0_ < 60000) __builtin_amdgcn_s_sleep(8); }
#endif
        const int row = wid * 32 + (lane & 31);
        if (lane < 32) {
            const f32x2v a = P[row * 4 + 0], b = P[row * 4 + 1], c = P[row * 4 + 2], d = P[row * 4 + 3];
            const float mt = (a.x + b.x + c.x + d.x) * 0.25f;
            const float da = a.x - mt, db = b.x - mt, dc = c.x - mt, dd = d.x - mt;
            const float m2 = (a.y + b.y) + (c.y + d.y) + 64.0f * ((da * da + db * db) + (dc * dc + dd * dd));
            unsigned long long* slot = (unsigned long long*)xbuf + ((size_t)(u.pm * BM + row) * 4 + u.pn);
            __hip_atomic_store(slot, ((unsigned long long)__float_as_uint(m2) << 32) | __float_as_uint(mt), __ATOMIC_RELAXED, __HIP_MEMORY_SCOPE_AGENT);
        }
        asm volatile("s_waitcnt vmcnt(0)" ::: "memory");
        if (lane == 0) __hip_atomic_fetch_add(cnt + 64 * u.pm, 1u, __ATOMIC_RELAXED, __HIP_MEMORY_SCOPE_AGENT);
        if (wid == 0) {
            bool dead = false; const unsigned long long t0 = __builtin_amdgcn_s_memrealtime(); const unsigned want = 8u * (unsigned)ntn;
            for (;;) {
#if defined(BROKEN_EXCHANGE_NO_WAIT)
                break;
#endif
                if ((unsigned)__builtin_amdgcn_readfirstlane(__hip_atomic_load(cnt + 64 * u.pm, __ATOMIC_RELAXED, __HIP_MEMORY_SCOPE_AGENT)) >= want) break;
                if (__builtin_amdgcn_s_memrealtime() - t0 > 2000000ull) {
                    if (lane == 0) { unsigned expect = 0u; __hip_atomic_compare_exchange_strong(tmo + 1, &expect, code | (unsigned)(u.pm & 0xff), __ATOMIC_RELAXED, __ATOMIC_RELAXED, __HIP_MEMORY_SCOPE_AGENT);
                                     __hip_atomic_store(tmo, 1u, __ATOMIC_RELAXED, __HIP_MEMORY_SCOPE_AGENT); }
                    dead = true; break; }
                __builtin_amdgcn_s_sleep(2);
            }
            __builtin_amdgcn_fence(__ATOMIC_ACQUIRE, "agent");
            if (lane == 0) flag[0] = dead ? 1u : 0u;
        }
        asm volatile("s_waitcnt vmcnt(0) lgkmcnt(0)" ::: "memory"); __builtin_amdgcn_s_barrier(); asm volatile("" ::: "memory");
        const bool bad = flag[0] != 0u;
        if (lane < 32) {
            const unsigned long long* slot = (const unsigned long long*)xbuf + (size_t)(u.pm * BM + row) * 4; float mt[4], m2[4]; float ms = 0.f;
#pragma unroll
            for (int t = 0; t < 4; ++t) { if (t < ntn) { const unsigned long long w = __hip_atomic_load(slot + t, __ATOMIC_RELAXED, __HIP_MEMORY_SCOPE_AGENT); mt[t] = __uint_as_float((unsigned)w); m2[t] = __uint_as_float((unsigned)(w >> 32)); } else { mt[t] = 0.f; m2[t] = 0.f; } ms += mt[t]; }
            const float mean = ms / (float)ntn; float q = 0.f;
#pragma unroll
            for (int t = 0; t < 4; ++t) if (t < ntn) { const float dm = mt[t] - mean; q += m2[t] + 256.0f * dm * dm; }
            S[row] = (f32x2v){mean, 1.0f / sqrtf(q / (256.0f * (float)ntn) + eps)};
        }
        asm volatile("s_waitcnt lgkmcnt(0)" ::: "memory"); __builtin_amdgcn_s_barrier(); asm volatile("" ::: "memory");
        return bad;
    }
};
struct EpiLnRes {
    static constexpr bool PERM = false, AFTER_DRAIN = true;
    const float* base; float* out; int ldc; const float* bias; PanelStats st; unsigned poison;
    __device__ __forceinline__ void fused(f32x4 (&acc)[2][2][4][2], const Unit& u, int wr, int wc, int fr, int fq, PG8_LAS unsigned char* lds, int wid, int lane) const {
        typedef float f32x2v __attribute__((ext_vector_type(2)));
        const PG8_LAS f32x2v* S = (const PG8_LAS f32x2v*)(lds + 8192);
        const int col0 = u.pn * BM + wc * 32 + 4 * fq;
#pragma unroll
        for (int bj = 0; bj < 2; ++bj)
#pragma unroll
            for (int n = 0; n < 2; ++n) { const f32x4 bv = bias ? *(const f32x4*)(bias + col0 + bj * HALF + n * 16) : (f32x4){0.f, 0.f, 0.f, 0.f};
#pragma unroll
                for (int ai = 0; ai < 2; ++ai)
#pragma unroll
                    for (int m = 0; m < 4; ++m) acc[ai][bj][m][n] += bv; }
        f32x4 pre[4][2][2];
#pragma unroll
        for (int m = 0; m < 4; ++m) { const size_t off = (size_t)(u.pm * BM + wr * 64 + m * 16 + fr) * ldc + col0;
#pragma unroll
            for (int bj = 0; bj < 2; ++bj)
#pragma unroll
                for (int n = 0; n < 2; ++n) pre[m][bj][n] = *(const f32x4*)(base + off + bj * HALF + n * 16); }
        const bool bad = st.run(acc, u, wr, wc, fr, fq, lds, wid, lane) || poison != 0u;
        const float qnan = __builtin_nanf("");
#pragma unroll
        for (int ai = 0; ai < 2; ++ai)
#pragma unroll
            for (int m = 0; m < 4; ++m) { const int r = ai * HALF + wr * 64 + m * 16 + fr; const f32x2v sr = S[r]; const size_t off = (size_t)(u.pm * BM + r) * ldc + col0;
#pragma unroll
                for (int bj = 0; bj < 2; ++bj)
#pragma unroll
                    for (int n = 0; n < 2; ++n) { const f32x4 bs = ai == 0 ? pre[m][bj][n] : *(const f32x4*)(base + off + bj * HALF + n * 16); f32x4 o = bs + (acc[ai][bj][m][n] - sr.x) * sr.y;
                        if (bad) o = (f32x4){qnan, qnan, qnan, qnan}; *(f32x4*)(out + off + bj * HALF + n * 16) = o; }
                if (m & 1) asm volatile("" ::: "memory"); }
    }
};
struct EpiLnResLn {
    static constexpr bool PERM = false, AFTER_DRAIN = true;
    const float* base; float* out; bf16_t* xn; int ldc; const float* bias; PanelStats st1, st2; unsigned poison;
    __device__ __forceinline__ void fused(f32x4 (&acc)[2][2][4][2], const Unit& u, int wr, int wc, int fr, int fq, PG8_LAS unsigned char* lds, int wid, int lane) const {
        typedef float f32x2v __attribute__((ext_vector_type(2))); typedef unsigned u32x2v __attribute__((ext_vector_type(2)));
        const PG8_LAS f32x2v* S = (const PG8_LAS f32x2v*)(lds + 8192);
        const int col0 = u.pn * BM + wc * 32 + 4 * fq;
#pragma unroll
        for (int bj = 0; bj < 2; ++bj)
#pragma unroll
            for (int n = 0; n < 2; ++n) { const f32x4 bv = bias ? *(const f32x4*)(bias + col0 + bj * HALF + n * 16) : (f32x4){0.f, 0.f, 0.f, 0.f};
#pragma unroll
                for (int ai = 0; ai < 2; ++ai)
#pragma unroll
                    for (int m = 0; m < 4; ++m) acc[ai][bj][m][n] += bv; }
        bool bad = st1.run(acc, u, wr, wc, fr, fq, lds, wid, lane) || poison != 0u;
        const float qnan = __builtin_nanf("");
#pragma unroll
        for (int ai = 0; ai < 2; ++ai)
#pragma unroll
            for (int m = 0; m < 4; ++m) { const int r = ai * HALF + wr * 64 + m * 16 + fr; const f32x2v sr = S[r]; const size_t off = (size_t)(u.pm * BM + r) * ldc + col0;
#pragma unroll
                for (int bj = 0; bj < 2; ++bj)
#pragma unroll
                    for (int n = 0; n < 2; ++n) { const f32x4 bs = *(const f32x4*)(base + off + bj * HALF + n * 16); acc[ai][bj][m][n] = bs + (acc[ai][bj][m][n] - sr.x) * sr.y; }
                asm volatile("" : "+v"(acc[ai][0][m][0]), "+v"(acc[ai][0][m][1]), "+v"(acc[ai][1][m][0]), "+v"(acc[ai][1][m][1]));
                if (m & 1) asm volatile("" ::: "memory"); }
        const bool bad1 = bad;
        bad = st2.run(acc, u, wr, wc, fr, fq, lds, wid, lane) || bad;
#pragma unroll
        for (int ai = 0; ai < 2; ++ai)
#pragma unroll
            for (int m = 0; m < 4; ++m) { const int r = ai * HALF + wr * 64 + m * 16 + fr; const f32x2v sr = S[r]; const size_t off = (size_t)(u.pm * BM + r) * ldc + col0;
#pragma unroll
                for (int bj = 0; bj < 2; ++bj)
#pragma unroll
                    for (int n = 0; n < 2; ++n) { const f32x4 x1 = acc[ai][bj][m][n]; *(f32x4*)(out + off + bj * HALF + n * 16) = bad1 ? (f32x4){qnan, qnan, qnan, qnan} : x1;
                        const f32x4 o = (x1 - sr.x) * sr.y; u32x2v w; w.x = cvt_pk_bf16(o[0], o[1]); w.y = cvt_pk_bf16(o[2], o[3]);
                        if (bad) { w.x = 0x7fc07fc0u; w.y = 0x7fc07fc0u; } *(u32x2v*)(xn + off + bj * HALF + n * 16) = w; }
                asm volatile("" ::: "memory"); }
    }
};

template <class Epi, class Sched, bool ALIGN_EPI = false, bool SP2 = false>
__device__ __forceinline__ void gemm_phase(PG8_LAS unsigned char* lds, const Gemm g, const Sched& S, const Epi& E, const int wid  ) {
    int lane; asm volatile("v_mbcnt_lo_u32_b32 %0, -1, 0\n\tv_mbcnt_hi_u32_b32 %0, -1, %0" : "=v"(lane));
    const int tid = wid * 64 + lane, wr = wid >> 2, wc = wid & 3, fr = lane & 15, fq = lane >> 4;
    const int K = g.K, nt = K / BK;
    unsigned voffA[2], voffB[2];
#pragma unroll
    for (int i = 0; i < 2; ++i) { int R, C; stage_rc(tid * 16 + i * 8192, R, C); const int Rb = Epi::PERM ? ((R & ~31) + perm32(R & 31)) : R;
        voffA[i] = (unsigned)(R * K + C) * 2u; voffB[i] = (unsigned)(Rb * K + C) * 2u; }
    const size_t kstep = (size_t)(BK * 2);
    const size_t hstep = (size_t)HALF * K * 2;
    const size_t tstep = 2 * hstep;
    const unsigned ldsw = (unsigned)wid * 1024u;
    const int aoff = lds_byte(wr * 64 + fr, fq * 8), boff = lds_byte(wc * 32 + fr, fq * 8);
#define PG8_SA(b, h) (((b) * 2 + (h)) * HTB)
#define PG8_SB(b, h) ((4 + (b) * 2 + (h)) * HTB)
#define PG8_STAGE(bufoff, gbase, voff) do { _Pragma("unroll") for (int _i = 0; _i < 2; ++_i) \
        __builtin_amdgcn_global_load_lds((const unsigned*)((const char*)(gbase) + (voff)[_i]), (PG8_LAS unsigned*)(lds + (bufoff) + ldsw + _i * 8192), 16, 0, 0); } while (0)
#define PG8_LDA(dst, b, h) do { _Pragma("unroll") for (int m = 0; m < 4; ++m) _Pragma("unroll") for (int k = 0; k < 2; ++k) dst[m][k] = *(const PG8_LAS bf16x8*)(lds + PG8_SA(b, h) + aoff + m * 2048 + k * 1024); } while (0)
#define PG8_LDB(dst, b, h) do { _Pragma("unroll") for (int n = 0; n < 2; ++n) _Pragma("unroll") for (int k = 0; k < 2; ++k) dst[n][k] = *(const PG8_LAS bf16x8*)(lds + PG8_SB(b, h) + boff + n * 2048 + k * 1024); } while (0)
#define PG8_MMA(ai, bj, At, Bt) do { __builtin_amdgcn_s_setprio(1); _Pragma("unroll") for (int m = 0; m < 4; ++m) _Pragma("unroll") for (int n = 0; n < 2; ++n) _Pragma("unroll") for (int k = 0; k < 2; ++k) \
        acc[ai][bj][m][n] = __builtin_amdgcn_mfma_f32_16x16x32_bf16(Bt[n][k], At[m][k], acc[ai][bj][m][n], 0, 0, 0); __builtin_amdgcn_s_setprio(0); } while (0)
#define PG8_WAIT_V(n) asm volatile("s_waitcnt vmcnt(" #n ")" ::: "memory")
#define PG8_WAIT_L(n) asm volatile("s_waitcnt lgkmcnt(" #n ")" ::: "memory")
#define PG8_BAR __builtin_amdgcn_s_barrier()
#define PG8_SCHED __builtin_amdgcn_sched_barrier(0)
    Unit cur, nxt; int ui = 0;
    if (!S.next(0, cur)) return;
    f32x4 acc[2][2][4][2];
#pragma unroll
    for (int a = 0; a < 2; ++a)
#pragma unroll
        for (int b = 0; b < 2; ++b)
#pragma unroll
            for (int m = 0; m < 4; ++m)
#pragma unroll
                for (int n = 0; n < 2; ++n) acc[a][b][m][n] = (f32x4){0.f, 0.f, 0.f, 0.f};
    bf16x8 At[4][2], B0[2][2], B1[2][2];
    const char* cA = (const char*)g.A + (size_t)cur.pm * tstep; const char* cB = (const char*)g.Bt + (size_t)cur.pn * tstep + (size_t)cur.be * g.bstride;
    S.a_ready(cur);
    if constexpr (SP2) {
        PG8_STAGE(PG8_SB(0, 0), cB, voffB); PG8_STAGE(PG8_SB(0, 1), cB + hstep, voffB); PG8_STAGE(PG8_SA(0, 0), cA, voffA); PG8_STAGE(PG8_SA(0, 1), cA + hstep, voffA);
        if (wr == 1) PG8_BAR;
        PG8_WAIT_V(2); PG8_BAR;
        PG8_STAGE(PG8_SB(1, 0), cB + kstep, voffB); PG8_STAGE(PG8_SA(1, 0), cA + kstep, voffA); PG8_STAGE(PG8_SB(1, 1), cB + hstep + kstep, voffB);
        PG8_WAIT_V(6); PG8_BAR;
    } else {
        PG8_STAGE(PG8_SB(0, 0), cB, voffB); PG8_STAGE(PG8_SA(0, 0), cA, voffA); PG8_STAGE(PG8_SB(0, 1), cB + hstep, voffB); PG8_STAGE(PG8_SA(0, 1), cA + hstep, voffA);
        if (wr == 1) PG8_BAR;
        PG8_WAIT_V(4); PG8_BAR;
        PG8_STAGE(PG8_SB(1, 0), cB + kstep, voffB); PG8_STAGE(PG8_SA(1, 0), cA + kstep, voffA); PG8_STAGE(PG8_SB(1, 1), cB + hstep + kstep, voffB);
        PG8_WAIT_V(6); PG8_BAR;
    }
    for (;;) {
        const bool has_next = S.next(ui + 1, nxt);
        const char* nA = has_next ? (const char*)g.A + (size_t)nxt.pm * tstep : cA; const char* nB = has_next ? (const char*)g.Bt + (size_t)nxt.pn * tstep + (size_t)nxt.be * g.bstride : cB;
        for (int t = 0; t < nt; t += 2) {
            const bool last = (t == nt - 2);
            const char* a1 = cA + (size_t)(t + 1) * kstep;
            const char* a2 = last ? nA : cA + (size_t)(t + 2) * kstep; const char* b2 = last ? nB : cB + (size_t)(t + 2) * kstep;
            const char* a3 = a2 + kstep; const char* b3 = b2 + kstep;
            if (last && has_next) S.a_ready(nxt);
            if constexpr (SP2) {
            PG8_LDB(B0, 0, 0); PG8_LDB(B1, 0, 1); PG8_SCHED; PG8_LDA(At, 0, 0); PG8_STAGE(PG8_SA(1, 1), a1 + hstep, voffA);
            PG8_WAIT_V(8); PG8_WAIT_L(0); PG8_BAR; PG8_MMA(0, 0, At, B0); PG8_MMA(0, 1, At, B1); PG8_BAR; PG8_SCHED;
            PG8_LDA(At, 0, 1); PG8_STAGE(PG8_SB(0, 0), b2, voffB); PG8_STAGE(PG8_SB(0, 1), b2 + hstep, voffB); PG8_STAGE(PG8_SA(0, 0), a2, voffA);
            PG8_WAIT_V(8); PG8_WAIT_L(0); PG8_BAR; PG8_MMA(1, 0, At, B0); PG8_MMA(1, 1, At, B1); PG8_BAR; PG8_SCHED;
            PG8_LDB(B0, 1, 0); PG8_LDB(B1, 1, 1); PG8_SCHED; PG8_LDA(At, 1, 0); PG8_STAGE(PG8_SA(0, 1), a2 + hstep, voffA);
            PG8_WAIT_V(8); PG8_WAIT_L(0); PG8_BAR; PG8_MMA(0, 0, At, B0); PG8_MMA(0, 1, At, B1); PG8_BAR; PG8_SCHED;
            PG8_LDA(At, 1, 1); PG8_STAGE(PG8_SB(1, 0), b3, voffB); PG8_STAGE(PG8_SB(1, 1), b3 + hstep, voffB); PG8_STAGE(PG8_SA(1, 0), a3, voffA);
            PG8_WAIT_V(8); PG8_WAIT_L(0); PG8_BAR; PG8_MMA(1, 0, At, B0); PG8_MMA(1, 1, At, B1); PG8_BAR; PG8_SCHED;
            } else {
            PG8_LDB(B0, 0, 0); PG8_SCHED; PG8_LDA(At, 0, 0); PG8_STAGE(PG8_SA(1, 1), a1 + hstep, voffA);
            PG8_WAIT_L(8); PG8_BAR; PG8_WAIT_L(0); PG8_MMA(0, 0, At, B0); PG8_BAR; PG8_SCHED;
            PG8_LDB(B1, 0, 1); PG8_STAGE(PG8_SB(0, 0), b2, voffB);
            PG8_BAR; PG8_WAIT_L(0); PG8_MMA(0, 1, At, B1); PG8_BAR;
            PG8_LDA(At, 0, 1); PG8_STAGE(PG8_SA(0, 0), a2, voffA);
            PG8_BAR; PG8_WAIT_L(0); PG8_MMA(1, 0, At, B0); PG8_BAR; PG8_SCHED;
            PG8_STAGE(PG8_SB(0, 1), b2 + hstep, voffB);
            PG8_WAIT_V(6); PG8_BAR; PG8_MMA(1, 1, At, B1); PG8_BAR;
            PG8_LDB(B0, 1, 0); PG8_SCHED; PG8_LDA(At, 1, 0); PG8_STAGE(PG8_SA(0, 1), a2 + hstep, voffA);
            PG8_WAIT_L(8); PG8_BAR; PG8_WAIT_L(0); PG8_MMA(0, 0, At, B0); PG8_BAR; PG8_SCHED;
            PG8_LDB(B1, 1, 1); PG8_STAGE(PG8_SB(1, 0), b3, voffB);
            PG8_BAR; PG8_WAIT_L(0); PG8_MMA(0, 1, At, B1); PG8_BAR;
            PG8_LDA(At, 1, 1); PG8_STAGE(PG8_SA(1, 0), a3, voffA);
            PG8_BAR; PG8_WAIT_L(0); PG8_MMA(1, 0, At, B0); PG8_BAR; PG8_SCHED;
            PG8_STAGE(PG8_SB(1, 1), b3 + hstep, voffB);
            PG8_WAIT_V(6); PG8_BAR; PG8_MMA(1, 1, At, B1); PG8_BAR;
            }
        }
        if constexpr (ALIGN_EPI) { if (wr == 0) PG8_BAR; }
        if constexpr (!Epi::AFTER_DRAIN) { E(acc, cur, wr, wc, fr, fq); S.done(cur); }
        if (!has_next) break;
#pragma unroll
        for (int a = 0; a < 2; ++a)
#pragma unroll
            for (int b = 0; b < 2; ++b)
#pragma unroll
                for (int m = 0; m < 4; ++m)
#pragma unroll
                    for (int n = 0; n < 2; ++n) acc[a][b][m][n] = (f32x4){0.f, 0.f, 0.f, 0.f};
        cur = nxt; cA = nA; cB = nB; ++ui;
        if constexpr (ALIGN_EPI) { if (wr == 1) PG8_BAR; }
    }
    PG8_WAIT_V(0);
    if constexpr (!ALIGN_EPI) { if (wr == 0) PG8_BAR; }
    PG8_BAR;
    if constexpr (Epi::AFTER_DRAIN) { E.fused(acc, cur, wr, wc, fr, fq, lds, wid, lane); S.done(cur); }
#undef PG8_SA
#undef PG8_SB
#undef PG8_STAGE
#undef PG8_LDA
#undef PG8_LDB
#undef PG8_MMA
#undef PG8_WAIT_V
#undef PG8_WAIT_L
#undef PG8_BAR
#undef PG8_SCHED
}
}
#define GAS __attribute__((address_space(1)))
#define LAS __attribute__((address_space(3)))
typedef unsigned short bf16;
typedef unsigned v4u __attribute__((ext_vector_type(4)));
typedef float f32x4 __attribute__((ext_vector_type(4)));
typedef short bf16x8 __attribute__((ext_vector_type(8)));
typedef GAS unsigned gu32;
typedef GAS unsigned long long gu64;
#define RLX_AGENT __ATOMIC_RELAXED, __HIP_MEMORY_SCOPE_AGENT
#define LDS_WAIT() asm volatile("s_waitcnt lgkmcnt(0)" ::: "memory")
#define VM_WAIT() asm volatile("s_waitcnt vmcnt(0)" ::: "memory")
__device__ __forceinline__ unsigned long long rt() { return __builtin_amdgcn_s_memrealtime(); }
__device__ __forceinline__ unsigned f2bf(float f) { unsigned u = __builtin_bit_cast(unsigned, f); return (u + 0x7fffu + ((u >> 16) & 1u)) >> 16; }
__device__ __forceinline__ unsigned pk2(float lo, float hi) { return f2bf(lo) | (f2bf(hi) << 16); }

#define XB_TMO      128
#define XB_XCNT(j)  (256  + 64 * (j))
#define XB_XSUB(j)  (1280 + 64 * (j))
#define XB_XGEN(j)  (2304 + 64 * (j))
#define XB_TOP      3328
#define XB_TOPGEN   3392
#define XCD_BAR_WORDS 3456
#define XB_SPIN_CAP (1u << 18)

__device__ __forceinline__ unsigned xb_ld(unsigned* p)              { return __hip_atomic_load(p, __ATOMIC_RELAXED, __HIP_MEMORY_SCOPE_AGENT); }
__device__ __forceinline__ unsigned xb_add(unsigned* p, unsigned v) { return __hip_atomic_fetch_add(p, v, __ATOMIC_RELAXED, __HIP_MEMORY_SCOPE_AGENT); }
__device__ __forceinline__ unsigned xb_xcc_id() { return (unsigned)__builtin_amdgcn_s_getreg((3 << 11) | 20) & 0xFu; }
#define XB_SPIN(cond, bar) do { unsigned _sp = 0; while (cond) { __builtin_amdgcn_s_sleep(1); \
    if ((++_sp & 255u) == 0u) { if (xb_ld(&(bar)[XB_TMO])) break; if (_sp > XB_SPIN_CAP) { atomicAdd(&(bar)[XB_TMO], 1u); break; } } } } while (0)

struct XcdBarrier {
    unsigned* bar; unsigned x;
    volatile LAS unsigned* st;
};

__device__ __forceinline__ XcdBarrier xcd_barrier_post(unsigned* bar, volatile LAS unsigned* st, bool leader) {
    XcdBarrier b; b.bar = bar; b.x = xb_xcc_id(); b.st = st;
    if (leader) (void)xb_add(&bar[XB_XCNT(b.x)], 1u);
    return b;
}
__device__ __forceinline__ void xcd_barrier_complete(unsigned* bar, unsigned x, unsigned& nloc, unsigned& nx) {
    const unsigned G = gridDim.x * gridDim.y * gridDim.z;
    unsigned sum, cnt, mine, sp = 0u;
    for (;;) {
        sum = 0u; cnt = 0u; mine = 0u;
#pragma unroll
        for (unsigned j = 0; j < 16; ++j) { const unsigned c = xb_ld(&bar[XB_XCNT(j)]); sum += c; cnt += (c > 0u) ? 1u : 0u; mine = (j == x) ? c : mine; }
        if (sum == G) break;
        __builtin_amdgcn_s_sleep(1);
        if ((++sp & 255u) == 0u) { if (xb_ld(&bar[XB_TMO])) break; if (sp > XB_SPIN_CAP) { atomicAdd(&bar[XB_TMO], 1u); break; } }
    }
    nloc = mine > 0u ? mine : 1u; nx = cnt > 0u ? cnt : 1u;
}

__device__ __forceinline__ void xcd_barrier(const XcdBarrier& b, bool leader) {
    asm volatile("s_waitcnt vmcnt(0)" ::: "memory");
    __syncthreads();
    if (leader) {
        unsigned* bar = b.bar;
        __builtin_amdgcn_s_waitcnt(0);
        unsigned nloc = b.st[0], nx = b.st[1];
        if (nloc == 0u) { xcd_barrier_complete(bar, b.x, nloc, nx); b.st[0] = nloc; b.st[1] = nx; }
        const unsigned old = xb_add(&bar[XB_XSUB(b.x)], 1u);
        const unsigned gen = old / nloc;
        if (old + 1u == (gen + 1u) * nloc) {
            __builtin_amdgcn_fence(__ATOMIC_RELEASE, "agent");
            asm volatile("s_waitcnt vmcnt(0)" ::: "memory");
            const unsigned og = xb_add(&bar[XB_TOP], 1u);
            const unsigned tg = og / nx;
            if (og + 1u == (tg + 1u) * nx) xb_add(&bar[XB_TOPGEN], 1u);
            else XB_SPIN(xb_ld(&bar[XB_TOPGEN]) == tg, bar);
            __builtin_amdgcn_fence(__ATOMIC_ACQUIRE, "agent");
            xb_add(&bar[XB_XGEN(b.x)], 1u);
            asm volatile("s_waitcnt vmcnt(0)" ::: "memory");
        } else {
            XB_SPIN(xb_ld(&bar[XB_XGEN(b.x)]) == gen, bar);
            __builtin_amdgcn_fence(__ATOMIC_ACQUIRE, "agent");
            asm volatile("s_waitcnt vmcnt(0)" ::: "memory");
        }
    }
    __syncthreads();
}
constexpr int NWAVES = 8;
constexpr size_t MiB = 1u << 20;
constexpr size_t WS_CTL = 0, CTL_ZERO_BYTES = 1 * MiB;
constexpr size_t WS_TAB = 1 * MiB;
constexpr size_t WS_WIN = 4 * MiB, WS_WOUT = 10 * MiB, WS_WGATE = 12 * MiB, WS_WPROJ = 14 * MiB, WS_WUP = 16 * MiB, WS_WDOWN = 80 * MiB;
constexpr size_t WS_N1 = 112 * MiB;
constexpr size_t WS_QKVZ = 144 * MiB;
constexpr size_t WS_U = 208 * MiB;
constexpr size_t WS_AB = 224 * MiB;
constexpr size_t WS_PBF = 226 * MiB;
constexpr int NIN_T = 3072;
constexpr int CW_TMO = 0, CW_CODE = 1, CW_BAR = 4096;
constexpr int RING_OFF = 0, RING_BYTES = 131072, LDSCTL_OFF = RING_BYTES, MISC_OFF = LDSCTL_OFF + 320, LDS_BYTES = 163840;

struct Frame {
    LAS unsigned char* lds; volatile LAS unsigned* MISC; gu32* ctl;
    int wave, vcu, G;
};
__device__ __forceinline__ int lane_now() { int l; asm volatile("v_mbcnt_lo_u32_b32 %0, -1, 0\n\tv_mbcnt_hi_u32_b32 %0, -1, %0" : "=v"(l)); return l; }
__device__ __forceinline__ float wave_sum_f(float v) {
#pragma unroll
    for (int o = 1; o < 64; o <<= 1) v += __shfl_xor(v, o);
    return v;
}
__device__ __forceinline__ float fsigmoid(float x) { return __builtin_amdgcn_rcpf(1.f + __expf(-x)); }
__device__ __forceinline__ float fsilu(float x) { return x * __builtin_amdgcn_rcpf(1.f + __expf(-x)); }

struct MapId  { __device__ __forceinline__ int operator()(int n) const { return n; } };
struct MapWin { __device__ __forceinline__ int operator()(int n) const { if (n < 2048) return n; const int j = n - 2048; return O4 + (j >> 3) * 4 + (j & 3) + ((j >> 2) & 1) * CCH; } };
struct MapWup { __device__ __forceinline__ int operator()(int n) const { return (n >> 3) * 4 + (n & 3) + ((n >> 2) & 1) * DEXP; } };

template <class Map>
__device__ __forceinline__ void p0_transpose_item(const float* W, int K, int Nsrc, int Ndst, bf16* WT, LAS float* scr, int item, int lane, Map map) {
    const int nblk = Ndst / 32, kb = item / nblk, nb = item % nblk, k0 = 64 * kb, n0 = 32 * nb;
    const int sc = map(n0 + (lane & 31));
#pragma unroll 8
    for (int i = 0; i < 32; ++i) { const int kk = 2 * i + (lane >> 5); scr[kk * 33 + (lane & 31)] = W[(size_t)(k0 + kk) * Nsrc + sc]; }
    LDS_WAIT(); asm volatile("" ::: "memory");
    const int c = lane & 7;
#pragma unroll
    for (int j = 0; j < 4; ++j) { const int n = (lane >> 3) + 8 * j; const LAS float* s = scr + (8 * c) * 33 + n;
        v4u o; o.x = pk2(s[0 * 33], s[1 * 33]); o.y = pk2(s[2 * 33], s[3 * 33]); o.z = pk2(s[4 * 33], s[5 * 33]); o.w = pk2(s[6 * 33], s[7 * 33]);
        *(GAS v4u*)(WT + (size_t)(n0 + n) * K + k0 + 8 * c) = o; }
    LDS_WAIT(); asm volatile("" ::: "memory");
}

struct Ptrs {
    const float *x, *p, *g_mix, *w_in, *w_conv_qkv, *a_log, *dt_bias, *g_gdn_out, *b_glu, *w_conv_dw, *b_conv_dw, *ln_g, *ln_b, *w_out, *g_moe, *w_gr, *w_er, *w_up, *w_down, *g_ple, *w_pg, *w_pp, *g_final;
    float* out; unsigned char* ws;
};

__device__ __forceinline__ void p0_prologue(Frame& F, const Ptrs& P) {
    const int lane = lane_now(), tid = F.wave * 64 + lane;
    LAS float* scr = (LAS float*)(F.lds + RING_OFF + F.wave * 16384);
    const int gw = F.vcu * NWAVES + F.wave, NGW = F.G * NWAVES;
    bf16* Win_t = (bf16*)(P.ws + WS_WIN); bf16* Wout_t = (bf16*)(P.ws + WS_WOUT); bf16* Wgate_t = (bf16*)(P.ws + WS_WGATE); bf16* Wproj_t = (bf16*)(P.ws + WS_WPROJ);
    bf16* Wup_t = (bf16*)(P.ws + WS_WUP); bf16* Wdown_t = (bf16*)(P.ws + WS_WDOWN);
    constexpr int I_IN = 16 * (NIN_T / 32), I_SQ = 16 * 32, I_PR = 4 * 32, I_UP1 = 16 * 16, I_UP = NEXP * I_UP1, I_DN1 = 4 * 32, I_DN = NEXP * I_DN1;
    constexpr int NITEMS = I_IN + 2 * I_SQ + I_PR + I_UP + I_DN;
    for (int it = gw; it < NITEMS; it += NGW) {
        int r = it;
        if (r < I_IN) { p0_transpose_item(P.w_in, DM, INC, NIN_T, Win_t, scr, r, lane, MapWin()); continue; } r -= I_IN;
        if (r < I_SQ) { p0_transpose_item(P.w_out, DM, DM, DM, Wout_t, scr, r, lane, MapId()); continue; } r -= I_SQ;
        if (r < I_SQ) { p0_transpose_item(P.w_pg, DM, DM, DM, Wgate_t, scr, r, lane, MapId()); continue; } r -= I_SQ;
        if (r < I_PR) { p0_transpose_item(P.w_pp, PLE, DM, DM, Wproj_t, scr, r, lane, MapId()); continue; } r -= I_PR;
        if (r < I_UP) { const int e = r / I_UP1; p0_transpose_item(P.w_up + (size_t)e * DM * 512, DM, 512, 512, Wup_t + (size_t)e * 512 * DM, scr, r % I_UP1, lane, MapWup()); continue; } r -= I_UP;
        { const int e = r / I_DN1; p0_transpose_item(P.w_down + (size_t)e * DEXP * DM, DEXP, DM, DM, Wdown_t + (size_t)e * DM * DEXP, scr, r % I_DN1, lane, MapId()); }
    }
    __syncthreads();
    LAS float* wabT = (LAS float*)(F.lds + RING_OFF);
    for (int idx = tid; idx < 8 * DM; idx += NWAVES * 64) { const int k = idx >> 3, c = idx & 7; wabT[c * DM + k] = P.w_in[(size_t)k * INC + O2 + c]; }
    __syncthreads();
    bf16* N1 = (bf16*)(P.ws + WS_N1); float* AB = (float*)(P.ws + WS_AB);
    for (int m = gw; m < M; m += NGW) {
        const GAS f32x4* xr = (const GAS f32x4*)(P.x + (size_t)m * DM) + lane;
        f32x4 v[4]; float s = 0.f;
#pragma unroll
        for (int j = 0; j < 4; ++j) { v[j] = xr[64 * j]; s += (v[j].x * v[j].x + v[j].y * v[j].y) + (v[j].z * v[j].z + v[j].w * v[j].w); }
        const float r = rsqrtf(wave_sum_f(s) * (1.f / DM) + EPS);
        float ab[8];
#pragma unroll
        for (int c = 0; c < 8; ++c) ab[c] = 0.f;
#pragma unroll
        for (int j = 0; j < 4; ++j) { const f32x4 g = ((const GAS f32x4*)P.g_mix)[64 * j + lane]; v[j] = v[j] * r * g;
#pragma unroll
            for (int c = 0; c < 8; ++c) { const f32x4 w = *(const LAS f32x4*)(wabT + c * DM + 256 * j + 4 * lane); ab[c] += (v[j].x * w.x + v[j].y * w.y) + (v[j].z * w.z + v[j].w * w.w); } }
        GAS unsigned long long* o8 = (GAS unsigned long long*)(N1 + (size_t)m * DM) + lane;
#pragma unroll
        for (int j = 0; j < 4; ++j) o8[64 * j] = (unsigned long long)pk2(v[j].x, v[j].y) | ((unsigned long long)pk2(v[j].z, v[j].w) << 32);
#pragma unroll
        for (int c = 0; c < 8; ++c) ab[c] = wave_sum_f(ab[c]);
        if (lane == 0) { *(GAS f32x4*)(AB + (size_t)m * 8) = (f32x4){ab[0], ab[1], ab[2], ab[3]}; *(GAS f32x4*)(AB + (size_t)m * 8 + 4) = (f32x4){ab[4], ab[5], ab[6], ab[7]}; }
    }
    { bf16* Wr = (bf16*)(P.ws + 15 * MiB);
      for (int i = F.vcu * (NWAVES * 64) + tid; i < 80 * DM; i += F.G * NWAVES * 64) { const int n = i >> 10, k = i & 1023;
          const float v = n < NGRP ? P.w_gr[k * NGRP + n] : (n < NGRP + NEXP ? P.w_er[k * NEXP + n - NGRP] : 0.f); Wr[i] = (bf16)f2bf(v); } }
    bf16* PB = (bf16*)(P.ws + WS_PBF);
    for (size_t i = (size_t)F.vcu * (NWAVES * 64) + tid; i < (size_t)M * PLE / 8; i += (size_t)F.G * NWAVES * 64) {
        const f32x4 a = ((const GAS f32x4*)P.p)[2 * i], b = ((const GAS f32x4*)P.p)[2 * i + 1];
        v4u o; o.x = pk2(a.x, a.y); o.y = pk2(a.z, a.w); o.z = pk2(b.x, b.y); o.w = pk2(b.z, b.w);
        ((GAS v4u*)PB)[i] = o;
    }
}

struct EpiIn {
    static constexpr bool PERM = true, AFTER_DRAIN = false;
    pg8::bf16_t* QKVZ; pg8::bf16_t* U; const float* b_glu;
    __device__ __forceinline__ void operator()(const pg8::f32x4 (&acc)[2][2][4][2], const pg8::Unit& u, int wr, int wc, int fr, int fq) const {
        using namespace pg8;
        const int row0 = u.pm * BM + wr * 64 + fr;
        if (u.pn < 8) {
            const int col0 = u.pn * BM + wc * 32 + 8 * fq;
#pragma unroll
            for (int ai = 0; ai < 2; ++ai)
#pragma unroll
                for (int m = 0; m < 4; ++m) { bf16_t* rowp = QKVZ + (size_t)(row0 + ai * HALF + m * 16) * 2048 + col0;
#pragma unroll
                    for (int bj = 0; bj < 2; ++bj) { const f32x4 v0 = acc[ai][bj][m][0], v1 = acc[ai][bj][m][1];
                        u32x4 w; w.x = cvt_pk_bf16(v0[0], v0[1]); w.y = cvt_pk_bf16(v0[2], v0[3]); w.z = cvt_pk_bf16(v1[0], v1[1]); w.w = cvt_pk_bf16(v1[2], v1[3]);
                        *(u32x4*)(rowp + bj * HALF) = w; } }
        } else {
            const int hid0 = (u.pn - 8) * 128 + wc * 16 + 4 * fq;
            f32x4 ba[2], bg[2];
#pragma unroll
            for (int bj = 0; bj < 2; ++bj) { ba[bj] = *(const f32x4*)(b_glu + hid0 + bj * 64); bg[bj] = *(const f32x4*)(b_glu + CCH + hid0 + bj * 64); }
#pragma unroll
            for (int ai = 0; ai < 2; ++ai)
#pragma unroll
                for (int m = 0; m < 4; ++m) { bf16_t* rowp = U + (size_t)(row0 + ai * HALF + m * 16) * CCH + hid0;
#pragma unroll
                    for (int bj = 0; bj < 2; ++bj) { const f32x4 a = acc[ai][bj][m][0] + ba[bj], g = acc[ai][bj][m][1] + bg[bj];
                        typedef unsigned u32x2v __attribute__((ext_vector_type(2)));
                        u32x2v w; w.x = cvt_pk_bf16(a[0] * fsigmoid(g[0]), a[1] * fsigmoid(g[1])); w.y = cvt_pk_bf16(a[2] * fsigmoid(g[2]), a[3] * fsigmoid(g[3]));
                        *(u32x2v*)(rowp + bj * 64) = w; } }
        }
    }
};

constexpr size_t WS_GT = 225 * MiB;
constexpr size_t WS_GDN = 234 * MiB, GDN_ITEM = 73728;
constexpr size_t GI_WNEG = 0, GI_KDT = 16384, GI_UFR = 32768, GI_QD = 49152, GI_QK = 65536;
constexpr size_t WS_SN = 306 * MiB;
constexpr size_t WS_VN = 338 * MiB;
constexpr size_t WS_MIX = 354 * MiB;
constexpr size_t WS_H1 = 386 * MiB;
constexpr size_t WS_PROJ = 450 * MiB;
constexpr int NSCAN = 32;
typedef float f32x16 __attribute__((ext_vector_type(16)));
typedef unsigned u32x2 __attribute__((ext_vector_type(2)));
#define LBAR() do { asm volatile("s_waitcnt lgkmcnt(0)" ::: "memory"); __builtin_amdgcn_s_barrier(); asm volatile("" ::: "memory"); } while (0)
__device__ __forceinline__ float bf2f(unsigned short b) { return __uint_as_float((unsigned)b << 16); }
__device__ __forceinline__ __amdgpu_buffer_rsrc_t mk_rsrc(const void* p, unsigned bytes) { return __builtin_amdgcn_make_buffer_rsrc((void*)p, (short)0, (int)bytes, 0x00020000); }
__device__ __forceinline__ float buf_ld_bf16(__amdgpu_buffer_rsrc_t r, unsigned voff, unsigned soff) { return bf2f((unsigned short)__builtin_amdgcn_raw_buffer_load_b16(r, (int)voff, (int)soff, 0)); }
__device__ __forceinline__ void buf_st_b64(__amdgpu_buffer_rsrc_t r, unsigned voff, unsigned soff, u32x2 v) { __builtin_amdgcn_raw_buffer_store_b64(v, r, (int)voff, (int)soff, 0); }
__device__ __forceinline__ void buf_st_b128(__amdgpu_buffer_rsrc_t r, unsigned voff, unsigned soff, v4u v) { __builtin_amdgcn_raw_buffer_store_b128(v, r, (int)voff, (int)soff, 0); }
__device__ __forceinline__ void buf_st_bf16(__amdgpu_buffer_rsrc_t r, unsigned voff, unsigned soff, float v) { __builtin_amdgcn_raw_buffer_store_b16((short)f2bf(v), r, (int)voff, (int)soff, 0); }

template <int I>
struct SolveRow {
    static __device__ __forceinline__ void run(float (&X)[64], const LAS float* LS, const LAS float* SC) {
        int one; asm volatile("s_mov_b32 %0, 1" : "=s"(one));
        if (one) {
            float x0 = X[I] * SC[I], x1 = 0.f, x2 = 0.f, x3 = 0.f;
            constexpr int NQ = (I + 3) / 4;
#pragma unroll
            for (int q = 0; q < NQ; ++q) {
                const f32x4 l = *(const LAS f32x4*)(LS + I * 64 + 4 * q);
                if (4 * q + 0 < I) x0 = fmaf(-l.x, X[4 * q + 0], x0);
                if (4 * q + 1 < I) x1 = fmaf(-l.y, X[4 * q + 1], x1);
                if (4 * q + 2 < I) x2 = fmaf(-l.z, X[4 * q + 2], x2);
                if (4 * q + 3 < I) x3 = fmaf(-l.w, X[4 * q + 3], x3);
            }
            X[I] = (x0 + x1) + (x2 + x3);
        }
        if constexpr (I < 63) SolveRow<I + 1>::run(X, LS, SC);
    }
};

__device__ __forceinline__ void p2_gdn_prep(Frame& F, const Ptrs& P) {
    LAS unsigned char* QT = F.lds; LAS unsigned char* KT = F.lds + 17408; LAS float* LS = (LAS float*)(F.lds + 34816);
    LAS float* gcs = (LAS float*)(F.lds + 51200); LAS float* betas = gcs + 64; LAS float* nk2 = gcs + 128; LAS float* nq2 = gcs + 192; LAS float* sc_w = gcs + 256; LAS float* sc_kd = gcs + 320; LAS float* sc_qd = gcs + 384;
    const bf16* QKVZ = (const bf16*)(P.ws + WS_QKVZ); const float* AB = (const float*)(P.ws + WS_AB);
    const int wave = F.wave;
    const int grp = wave >> 1;
    for (int it = F.vcu; it < 1024; it += F.G) {
        const int lane = lane_now();
        const int c = ((wave & 1) << 6) | lane, tid = wave * 64 + lane;
        const int bh = it >> 7, n = it & 127, b = bh >> 2, h = bh & 3;
        const size_t m0 = (size_t)b * SEQ + (size_t)n * 64;
        unsigned char* item = P.ws + WS_GDN + (size_t)it * GDN_ITEM;
        float y[64];
        if (grp < 3) {
            const int col = grp * 512 + h * 128 + c;
            const float w0 = P.w_conv_qkv[0 * 1536 + col], w1 = P.w_conv_qkv[1 * 1536 + col], w2 = P.w_conv_qkv[2 * 1536 + col], w3 = P.w_conv_qkv[3 * 1536 + col];
            float xr[67];
            const __amdgpu_buffer_rsrc_t rs = mk_rsrc(QKVZ + (size_t)b * SEQ * 2048, (unsigned)SEQ * 2048u * 2u);
#pragma unroll
            for (int j = 0; j < 67; ++j) { const int t = n * 64 + j - 3; xr[j] = (j >= 3 || t >= 0) ? buf_ld_bf16(rs, (unsigned)col * 2u, (unsigned)t * 4096u) : 0.f; }
#pragma unroll
            for (int i = 0; i < 64; ++i) { const float s = fmaf(w3, xr[i + 3], fmaf(w2, xr[i + 2], fmaf(w1, xr[i + 1], w0 * xr[i]))); y[i] = fsilu(s); }
            if (grp < 2) { LAS unsigned char* tile = grp == 0 ? QT : KT;
#pragma unroll
                for (int i = 0; i < 64; ++i) *(LAS unsigned short*)(tile + i * 272 + c * 2) = (unsigned short)f2bf(y[i]); }
        }
        if (wave == 7) {
            const float araw = AB[(m0 + lane) * 8 + 4 + h], braw = AB[(m0 + lane) * 8 + h];
            const float xx = araw + P.dt_bias[h];
            const float sp = (xx > 20.f) ? xx : log1pf(expf(xx));
            float g = -expf(P.a_log[h]) * sp;
#pragma unroll
            for (int off = 1; off < 64; off <<= 1) { const float t = __shfl_up(g, off); if (lane >= off) g += t; }
            gcs[lane] = g; betas[lane] = 1.f / (1.f + expf(-braw));
        }
        LBAR();
        const int kind = wave < 3 ? 0 : (wave < 6 ? 1 : 2);
        const int tsel = wave < 6 ? wave % 3 : (wave - 6) * 2;
        const int ib = tsel >= 1 ? 1 : 0, jb = tsel == 2 ? 1 : 0;
        const int r32 = lane & 31, hh = lane >> 5;
        f32x16 acc;
#pragma unroll
        for (int i = 0; i < 16; ++i) acc[i] = 0.f;
        {
            const LAS unsigned char* At = (kind == 0 ? KT : QT) + (32 * ib + r32) * 272 + hh * 16;
            const LAS unsigned char* Bt = (kind == 2 ? QT : KT) + (32 * jb + r32) * 272 + hh * 16;
#pragma unroll
            for (int s = 0; s < 8; ++s) { const bf16x8 a = *(const LAS bf16x8*)(At + s * 32), bb = *(const LAS bf16x8*)(Bt + s * 32); acc = __builtin_amdgcn_mfma_f32_32x32x16_bf16(a, bb, acc, 0, 0, 0); }
        }
        if ((kind == 0 || kind == 2) && ib == jb) {
            if (((r32 >> 2) & 1) == hh) {
                const int rsel = (r32 & 3) + 4 * (r32 >> 3); float v = 0.f;
#pragma unroll
                for (int i = 0; i < 16; ++i) v = (i == rsel) ? acc[i] : v;
                (kind == 0 ? nk2 : nq2)[32 * ib + r32] = v;
            }
        }
        LBAR();
        {
            const int j = 32 * jb + r32; const float gj = gcs[j], rkj = rsqrtf(nk2[j] + EPS);
            const __amdgpu_buffer_rsrc_t rqk = mk_rsrc(item + GI_QK, 8192u);
            const unsigned vqk = (unsigned)(4 * hh * 64 + j) * 2u;
#pragma unroll
            for (int reg = 0; reg < 16; ++reg) {
                const int iu = 32 * ib + (reg & 3) + 8 * (reg >> 2), i = iu + 4 * hh;
                const float dec = __expf(fminf(gcs[i] - gj, 0.f));
                if (kind == 0) { const float v = (j < i) ? acc[reg] * betas[i] * rsqrtf(nk2[i] + EPS) * rkj * dec : 0.f; LS[i * 64 + j] = v; }
                else if (kind == 1) { const float v = (j <= i) ? acc[reg] * rsqrtf(nq2[i] + EPS) * 0.08838834764831845f * rkj * dec : 0.f; buf_st_bf16(rqk, vqk, (unsigned)iu * 128u, v); }
            }
            if (wave == 7) {
                const float rk = rsqrtf(nk2[lane] + EPS), rq = rsqrtf(nq2[lane] + EPS), gi = gcs[lane], eg = __expf(gi);
                sc_w[lane] = betas[lane] * rk * eg; sc_kd[lane] = rk * __expf(gcs[63] - gi); sc_qd[lane] = rq * 0.08838834764831845f * eg;
            }
            if (kind == 2 && tsel == 0) {
#pragma unroll
                for (int reg = 0; reg < 16; ++reg) { const int iu = (reg & 3) + 8 * (reg >> 2); buf_st_bf16(rqk, (unsigned)(4 * hh * 64 + 32 + r32) * 2u, (unsigned)iu * 128u, 0.f); }
            }
        }
        LBAR();
        const float gl = gcs[63];
        if (grp == 1) {
            const __amdgpu_buffer_rsrc_t rit = mk_rsrc(item, (unsigned)GDN_ITEM);
            SolveRow<0>::run(y, LS, sc_w);
#pragma unroll
            for (int i = 0; i < 64; ++i) buf_st_bf16(rit, (unsigned)c * 2u, (unsigned)(GI_WNEG + i * 256), -y[i]);
        } else if (grp == 2) {
            SolveRow<0>::run(y, LS, betas);
            const __amdgpu_buffer_rsrc_t rit = mk_rsrc(item, (unsigned)GDN_ITEM);
            const int et = c >> 4, r = c & 15;
#pragma unroll
            for (int i4 = 0; i4 < 16; ++i4) { const int ct = i4 >> 2, q = i4 & 3;
                u32x2 o; o.x = pk2(y[4 * i4 + 0], y[4 * i4 + 1]); o.y = pk2(y[4 * i4 + 2], y[4 * i4 + 3]);
                buf_st_b64(rit, (unsigned)(et * 64 + r) * 8u, (unsigned)(GI_UFR + (ct * 8 * 64 + q * 16) * 8), o); }
        } else if (grp == 0) {
            const __amdgpu_buffer_rsrc_t rit = mk_rsrc(item, (unsigned)GDN_ITEM);
#pragma unroll
            for (int i = 0; i < 64; ++i) buf_st_bf16(rit, (unsigned)c * 2u, (unsigned)(GI_QD + i * 256), y[i] * sc_qd[i]);
        } else {
            const __amdgpu_buffer_rsrc_t rit = mk_rsrc(item, (unsigned)GDN_ITEM);
#pragma unroll
            for (int i8 = 0; i8 < 8; ++i8) { float kd[8];
#pragma unroll
                for (int q = 0; q < 8; ++q) { const int i = i8 * 8 + q; kd[q] = bf2f(*(const LAS unsigned short*)(KT + i * 272 + c * 2)) * sc_kd[i]; }
                v4u o; o.x = pk2(kd[0], kd[1]); o.y = pk2(kd[2], kd[3]); o.z = pk2(kd[4], kd[5]); o.w = pk2(kd[6], kd[7]);
                buf_st_b128(rit, (unsigned)c * 128u, (unsigned)(GI_KDT + i8 * 16), o); }
        }
        if (tid == 0) ((float*)(P.ws + WS_GT))[it] = __expf(gl);
        LBAR();
    }
}

__device__ __forceinline__ void p3_scan(Frame& F, const Ptrs& P, int blk) {
    LAS unsigned char* ST = F.lds; LAS unsigned char* VT = F.lds + 8704;
    const int bh = blk >> 2, es = blk & 3;
    const int lane = lane_now(), wave = F.wave, r = lane & 15, q = lane >> 4, tid = wave * 64 + lane;
    const int ct = wave >> 1, et = wave & 1;
    const int dt = wave;
    for (int i = tid; i < 8704 / 4; i += NWAVES * 64) ((LAS unsigned*)ST)[i] = 0u;
    f32x4 sacc[2] = {(f32x4){0.f, 0.f, 0.f, 0.f}, (f32x4){0.f, 0.f, 0.f, 0.f}};
    const float* GT = (const float*)(P.ws + WS_GT);
    const unsigned char* item0 = P.ws + WS_GDN + (size_t)(bh * 128) * GDN_ITEM;
    bf16x8 wA[4], kA[2]; u32x2 uC; float gt;
    bf16x8 nwA[4], nkA[2]; u32x2 nuC; float ngt;
#define SCAN_LOAD(n_, wA_, kA_, uC_, gt_) do { const unsigned char* itp = item0 + (size_t)(n_) * GDN_ITEM; \
        _Pragma("unroll") for (int s = 0; s < 4; ++s) wA_[s] = *(const GAS bf16x8*)(itp + GI_WNEG + ((16 * ct + r) * 128 + 32 * s + 8 * q) * 2); \
        _Pragma("unroll") for (int s = 0; s < 2; ++s) kA_[s] = *(const GAS bf16x8*)(itp + GI_KDT + ((16 * dt + r) * 64 + 32 * s + 8 * q) * 2); \
        uC_ = *(const GAS u32x2*)(itp + GI_UFR + ((size_t)((ct * 8 + 2 * es + et) * 64 + lane)) * 8); gt_ = GT[bh * 128 + (n_)]; } while (0)
    SCAN_LOAD(0, wA, kA, uC, gt);
    LBAR();
    for (int n = 0; n < 128; ++n) {
        if (n + 1 < 128) SCAN_LOAD(n + 1, nwA, nkA, nuC, ngt);
        f32x4 acc; acc.x = __uint_as_float(uC.x << 16); acc.y = __uint_as_float(uC.x & 0xffff0000u); acc.z = __uint_as_float(uC.y << 16); acc.w = __uint_as_float(uC.y & 0xffff0000u);
#pragma unroll
        for (int s = 0; s < 4; ++s) { const bf16x8 sf = *(const LAS bf16x8*)(ST + (16 * et + r) * 272 + (32 * s + 8 * q) * 2); acc = __builtin_amdgcn_mfma_f32_16x16x32_bf16(wA[s], sf, acc, 0, 0, 0); }
        { u32x2 o; o.x = pk2(acc.x, acc.y); o.y = pk2(acc.z, acc.w);
          *(LAS u32x2*)(VT + (16 * et + r) * 144 + (16 * ct + 4 * q) * 2) = o;
          *(GAS u32x2*)(P.ws + WS_VN + ((size_t)(bh * 128 + n) * 128 + 32 * es + 16 * et + r) * 128 + (16 * ct + 4 * q) * 2) = o; }
        LBAR();
#pragma unroll
        for (int t = 0; t < 2; ++t) {
            sacc[t] = sacc[t] * gt;
#pragma unroll
            for (int s = 0; s < 2; ++s) { const bf16x8 vf = *(const LAS bf16x8*)(VT + (16 * t + r) * 144 + (32 * s + 8 * q) * 2); sacc[t] = __builtin_amdgcn_mfma_f32_16x16x32_bf16(kA[s], vf, sacc[t], 0, 0, 0); }
        }
#pragma unroll
        for (int t = 0; t < 2; ++t) { u32x2 o; o.x = pk2(sacc[t].x, sacc[t].y); o.y = pk2(sacc[t].z, sacc[t].w);
            *(LAS u32x2*)(ST + (16 * t + r) * 272 + (16 * dt + 4 * q) * 2) = o;
            if (n + 1 < 128) *(GAS u32x2*)(P.ws + WS_SN + ((size_t)(bh * 128 + n + 1) * 128 + 32 * es + 16 * t + r) * 256 + (16 * dt + 4 * q) * 2) = o; }
        LBAR();
#pragma unroll
        for (int s = 0; s < 4; ++s) wA[s] = nwA[s];
        kA[0] = nkA[0]; kA[1] = nkA[1]; uC = nuC; gt = ngt;
    }
#undef SCAN_LOAD
}

__device__ __forceinline__ void p3_conf_tile(Frame& F, const Ptrs& P, int tile) {
    LAS float* part = (LAS float*)F.lds; LAS float* stat = (LAS float*)(F.lds + 2048);
    const bf16* U = (const bf16*)(P.ws + WS_U); bf16* MIX = (bf16*)(P.ws + WS_MIX);
    const int lane = lane_now(), ch = F.wave * 64 + lane; const size_t m0 = (size_t)tile * 32; const int t0 = (int)(m0 % SEQ);
    float uu[62];
    const __amdgpu_buffer_rsrc_t rs = mk_rsrc(U + (m0 - t0) * CCH, (unsigned)SEQ * CCH * 2u);
#pragma unroll
    for (int j = 0; j < 62; ++j) { const int t = t0 - 30 + j; uu[j] = (j >= 30 || t >= 0) ? buf_ld_bf16(rs, (unsigned)ch * 2u, (unsigned)t * (CCH * 2u)) : 0.f; }
    float cv[32];
    const float bias = P.b_conv_dw[ch];
#pragma unroll
    for (int i = 0; i < 32; ++i) cv[i] = bias;
#pragma unroll
    for (int k = 0; k < CWID; ++k) { const float w = P.w_conv_dw[k * CCH + ch];
#pragma unroll
        for (int i = 0; i < 32; ++i) cv[i] = fmaf(w, uu[i + k], cv[i]); }
#pragma unroll
    for (int i = 0; i < 32; ++i) { const float s1 = wave_sum_f(cv[i]), s2 = wave_sum_f(cv[i] * cv[i]); if (lane == 0) { part[(F.wave * 32 + i) * 2] = s1; part[(F.wave * 32 + i) * 2 + 1] = s2; } }
    LBAR();
    if (ch < 32) { float s1 = 0.f, s2 = 0.f;
#pragma unroll
        for (int w = 0; w < 8; ++w) { s1 += part[(w * 32 + ch) * 2]; s2 += part[(w * 32 + ch) * 2 + 1]; }
        const float mu = s1 * (1.f / CCH); const float var = fmaxf(s2 * (1.f / CCH) - mu * mu, 0.f);
        stat[ch * 2] = mu; stat[ch * 2 + 1] = rsqrtf(var + EPS); }
    LBAR();
    const float lg = P.ln_g[ch], lb = P.ln_b[ch];
    const __amdgpu_buffer_rsrc_t ro = mk_rsrc(MIX + m0 * DM, 32u * DM * 2u);
#pragma unroll
    for (int i = 0; i < 32; ++i) { const float yv = (cv[i] - stat[i * 2]) * stat[i * 2 + 1] * lg + lb; buf_st_bf16(ro, (unsigned)(512 + ch) * 2u, (unsigned)i * (DM * 2u), fsilu(yv)); }
    LBAR();
}

__device__ __forceinline__ void p4_gdn_out(Frame& F, const Ptrs& P) {
    LAS float* ssq = (LAS float*)F.lds;
    const bf16* QKVZ = (const bf16*)(P.ws + WS_QKVZ); bf16* MIX = (bf16*)(P.ws + WS_MIX);
    const int wave = F.wave;
    const int ct2 = wave >> 2, et4 = wave & 3;
    for (int it = F.vcu; it < 1024; it += F.G) {
        const int lane = lane_now();
        const int r32 = lane & 31, hh = lane >> 5;
        const int bh = it >> 7, n = it & 127, b = bh >> 2, h = bh & 3;
        const size_t m0 = (size_t)b * SEQ + (size_t)n * 64;
        const unsigned char* item = P.ws + WS_GDN + (size_t)it * GDN_ITEM;
        f32x16 acc;
#pragma unroll
        for (int i = 0; i < 16; ++i) acc[i] = 0.f;
        if (n > 0) {
            const unsigned char* Ap = item + GI_QD + ((32 * ct2 + r32) * 128 + 8 * hh) * 2;
            const unsigned char* Bp = P.ws + WS_SN + ((size_t)it * 128 + 32 * et4 + r32) * 256 + 8 * hh * 2;
#pragma unroll
            for (int s = 0; s < 8; ++s) { const bf16x8 a = *(const GAS bf16x8*)(Ap + s * 32), bb = *(const GAS bf16x8*)(Bp + s * 32); acc = __builtin_amdgcn_mfma_f32_32x32x16_bf16(a, bb, acc, 0, 0, 0); }
        }
        {
            const unsigned char* Ap = item + GI_QK + ((32 * ct2 + r32) * 64 + 8 * hh) * 2;
            const unsigned char* Bp = P.ws + WS_VN + ((size_t)it * 128 + 32 * et4 + r32) * 128 + 8 * hh * 2;
#pragma unroll
            for (int s = 0; s < 4; ++s) { const bf16x8 a = *(const GAS bf16x8*)(Ap + s * 32), bb = *(const GAS bf16x8*)(Bp + s * 32); acc = __builtin_amdgcn_mfma_f32_32x32x16_bf16(a, bb, acc, 0, 0, 0); }
        }
#pragma unroll
        for (int reg = 0; reg < 16; ++reg) { float s = acc[reg] * acc[reg];
            s += __shfl_xor(s, 1); s += __shfl_xor(s, 2); s += __shfl_xor(s, 4); s += __shfl_xor(s, 8); s += __shfl_xor(s, 16);
            if (r32 == 0) ssq[(32 * ct2 + (reg & 3) + 8 * (reg >> 2) + 4 * hh) * 4 + et4] = s; }
        LBAR();
        const int e = 32 * et4 + r32; const float gg = P.g_gdn_out[e];
        const __amdgpu_buffer_rsrc_t rz = mk_rsrc(QKVZ + m0 * 2048, 64u * 2048u * 2u), ro = mk_rsrc(MIX + m0 * DM, 64u * DM * 2u);
        const unsigned vz = (unsigned)(1536 + h * 128 + e) * 2u + (unsigned)(4 * hh) * 4096u, vo = (unsigned)(h * 128 + e) * 2u + (unsigned)(4 * hh) * 2048u;
#pragma unroll
        for (int reg = 0; reg < 16; ++reg) { const int rowu = 32 * ct2 + (reg & 3) + 8 * (reg >> 2);
            const f32x4 sq = *(const LAS f32x4*)(ssq + (rowu + 4 * hh) * 4);
            const float rs = rsqrtf(((sq.x + sq.y) + (sq.z + sq.w)) * (1.f / DV) + EPS);
            const float z = buf_ld_bf16(rz, vz, (unsigned)rowu * 4096u);
            buf_st_bf16(ro, vo, (unsigned)rowu * 2048u, acc[reg] * rs * gg * fsilu(z)); }
        LBAR();
    }
}

constexpr size_t WS_WR = 15 * MiB;
constexpr size_t WS_CNT = 1 * MiB;
constexpr size_t WS_TPOS = 1 * MiB + 256 * 1024;
constexpr size_t WS_GATEW = 1 * MiB + 512 * 1024;
constexpr size_t WS_TEX = 2 * MiB;
constexpr size_t WS_XG = 144 * MiB;
constexpr size_t WS_Y = 240 * MiB;
constexpr size_t WS_ACT = 336 * MiB;
constexpr int PSLOTS = 49152;
constexpr size_t WS_XN3 = WS_N1;
constexpr int LDS_LG = 131584, LDS_TE = LDS_LG + 64 * 80 * 4, LDS_TW = LDS_TE + 512, LDS_CNT = LDS_TW + 512, LDS_POS = LDS_CNT + 256, LDS_BASE = LDS_POS + 512, LDS_PART = LDS_BASE + 256;

struct EpiRes {
    static constexpr bool PERM = false, AFTER_DRAIN = false;
    const float* base; float* out;
    __device__ __forceinline__ void operator()(const pg8::f32x4 (&acc)[2][2][4][2], const pg8::Unit& u, int wr, int wc, int fr, int fq) const {
        using namespace pg8;
        const int row0 = u.pm * BM + wr * 64 + fr, col0 = u.pn * BM + wc * 32 + 4 * fq;
#pragma unroll
        for (int ai = 0; ai < 2; ++ai)
#pragma unroll
            for (int m = 0; m < 4; ++m) { const size_t off = (size_t)(row0 + ai * HALF + m * 16) * DM + col0;
#pragma unroll
                for (int bj = 0; bj < 2; ++bj)
#pragma unroll
                    for (int n = 0; n < 2; ++n) *(f32x4*)(out + off + bj * HALF + n * 16) = *(const f32x4*)(base + off + bj * HALF + n * 16) + acc[ai][bj][m][n]; }
    }
};
struct EpiSwiGLU {
    static constexpr bool PERM = true, AFTER_DRAIN = false;
    pg8::bf16_t* ACT;
    __device__ __forceinline__ void operator()(const pg8::f32x4 (&acc)[2][2][4][2], const pg8::Unit& u, int wr, int wc, int fr, int fq) const {
        using namespace pg8;
        const int row0 = u.pm * BM + wr * 64 + fr, hid0 = u.pn * 128 + wc * 16 + 4 * fq;
#pragma unroll
        for (int ai = 0; ai < 2; ++ai)
#pragma unroll
            for (int m = 0; m < 4; ++m) { bf16_t* rowp = ACT + (size_t)(row0 + ai * HALF + m * 16) * DEXP + hid0;
#pragma unroll
                for (int bj = 0; bj < 2; ++bj) { const f32x4 a = acc[ai][bj][m][0], g = acc[ai][bj][m][1];
                    u32x2 w; w.x = cvt_pk_bf16(fsilu(a[0]) * g[0], fsilu(a[1]) * g[1]); w.y = cvt_pk_bf16(fsilu(a[2]) * g[2], fsilu(a[3]) * g[3]);
                    *(u32x2*)(rowp + bj * 64) = w; } }
    }
};
struct EpiGate {
    static constexpr bool PERM = true, AFTER_DRAIN = false;
    pg8::bf16_t* Y; const float* gatew;
    __device__ __forceinline__ void operator()(const pg8::f32x4 (&acc)[2][2][4][2], const pg8::Unit& u, int wr, int wc, int fr, int fq) const {
        using namespace pg8;
        const int row0 = u.pm * BM + wr * 64 + fr, col0 = u.pn * BM + wc * 32 + 8 * fq;
#pragma unroll
        for (int ai = 0; ai < 2; ++ai)
#pragma unroll
            for (int m = 0; m < 4; ++m) { const int row = row0 + ai * HALF + m * 16; const float gw = gatew[row]; bf16_t* rowp = Y + (size_t)row * DM + col0;
#pragma unroll
                for (int bj = 0; bj < 2; ++bj) { const f32x4 v0 = acc[ai][bj][m][0] * gw, v1 = acc[ai][bj][m][1] * gw;
                    u32x4 w; w.x = cvt_pk_bf16(v0[0], v0[1]); w.y = cvt_pk_bf16(v0[2], v0[3]); w.z = cvt_pk_bf16(v1[0], v1[1]); w.w = cvt_pk_bf16(v1[2], v1[3]);
                    *(u32x4*)(rowp + bj * HALF) = w; } }
    }
};
struct EpiPle {
    static constexpr bool PERM = false, AFTER_DRAIN = false;
    const float* h2; const pg8::bf16_t* proj; float* out;
    __device__ __forceinline__ void operator()(const pg8::f32x4 (&acc)[2][2][4][2], const pg8::Unit& u, int wr, int wc, int fr, int fq) const {
        using namespace pg8;
        const int row0 = u.pm * BM + wr * 64 + fr, col0 = u.pn * BM + wc * 32 + 4 * fq;
#pragma unroll
        for (int ai = 0; ai < 2; ++ai)
#pragma unroll
            for (int m = 0; m < 4; ++m) { const size_t off = (size_t)(row0 + ai * HALF + m * 16) * DM + col0;
#pragma unroll
                for (int bj = 0; bj < 2; ++bj)
#pragma unroll
                    for (int n = 0; n < 2; ++n) { const size_t o = off + bj * HALF + n * 16; const f32x4 a = acc[ai][bj][m][n]; const u32x2 pp = *(const u32x2*)(proj + o);
                        f32x4 r = *(const f32x4*)(h2 + o);
                        r.x += fsigmoid(a.x) * __uint_as_float(pp.x << 16); r.y += fsigmoid(a.y) * __uint_as_float(pp.x & 0xffff0000u);
                        r.z += fsigmoid(a.z) * __uint_as_float(pp.y << 16); r.w += fsigmoid(a.w) * __uint_as_float(pp.y & 0xffff0000u);
                        *(f32x4*)(out + o) = r; } }
    }
};
struct MoeOrder {
    const int* tex; int nN, G, c;
    __device__ __forceinline__ bool next(int i, pg8::Unit& u) const {
        const int nt = __builtin_amdgcn_readfirstlane(__hip_atomic_load(tex, __ATOMIC_RELAXED, __HIP_MEMORY_SCOPE_AGENT)); const long L = (long)i * G + c; if (L >= (long)nt * nN) return false;
        const int rt = (int)(L / nN); u.pm = rt; u.pn = (int)(L % nN); u.be = __builtin_amdgcn_readfirstlane(__hip_atomic_load(tex + 64 + rt, __ATOMIC_RELAXED, __HIP_MEMORY_SCOPE_AGENT)); return true;
    }
    __device__ __forceinline__ void a_ready(const pg8::Unit&) const {}
    __device__ __forceinline__ void done(const pg8::Unit&) const {}
};

__device__ __forceinline__ void p6_router(Frame& F, const Ptrs& P) {
    const int lane = lane_now(), wave = F.wave, tid = wave * 64 + lane;
    const int tile = F.vcu; const size_t m0 = (size_t)tile * 64;
    const float* H1 = (const float*)(P.ws + WS_H1);
    LAS unsigned char* XT = F.lds;
    LAS float* LG = (LAS float*)(F.lds + LDS_LG); LAS int* te_l = (LAS int*)(F.lds + LDS_TE); LAS float* tw_l = (LAS float*)(F.lds + LDS_TW); LAS int* cnt_l = (LAS int*)(F.lds + LDS_CNT);
    if (tid < 64) cnt_l[tid] = 0;
    for (int rr = 0; rr < 8; ++rr) { const int row = wave * 8 + rr;
        const GAS f32x4* xr = (const GAS f32x4*)(H1 + (m0 + row) * DM) + lane;
        f32x4 v[4]; float s = 0.f;
#pragma unroll
        for (int j = 0; j < 4; ++j) { v[j] = xr[64 * j]; s += (v[j].x * v[j].x + v[j].y * v[j].y) + (v[j].z * v[j].z + v[j].w * v[j].w); }
        const float r = rsqrtf(wave_sum_f(s) * (1.f / DM) + EPS);
#pragma unroll
        for (int j = 0; j < 4; ++j) { const f32x4 g = ((const GAS f32x4*)P.g_moe)[64 * j + lane]; v[j] = v[j] * r * g;
            u32x2 o; o.x = pk2(v[j].x, v[j].y); o.y = pk2(v[j].z, v[j].w); *(LAS u32x2*)(XT + row * 2048 + (256 * j + 4 * lane) * 2) = o; } }
    LBAR();
    {
        const int r = lane & 15, q = lane >> 4, mt = wave & 3, nt0 = wave < 4 ? 0 : 3, nnt = wave < 4 ? 3 : 2;
        f32x4 acc[3];
#pragma unroll
        for (int t = 0; t < 3; ++t) acc[t] = (f32x4){0.f, 0.f, 0.f, 0.f};
        const unsigned char* Wr = P.ws + WS_WR;
        for (int s = 0; s < 32; ++s) { const bf16x8 a = *(const LAS bf16x8*)(XT + (16 * mt + r) * 2048 + (32 * s + 8 * q) * 2);
#pragma unroll
            for (int t = 0; t < 3; ++t) if (t < nnt) { const bf16x8 b = *(const GAS bf16x8*)(Wr + ((size_t)(16 * (nt0 + t) + r) * DM + 32 * s + 8 * q) * 2); acc[t] = __builtin_amdgcn_mfma_f32_16x16x32_bf16(a, b, acc[t], 0, 0, 0); } }
#pragma unroll
        for (int t = 0; t < 3; ++t) if (t < nnt) {
#pragma unroll
            for (int reg = 0; reg < 4; ++reg) LG[(16 * mt + 4 * q + reg) * 80 + 16 * (nt0 + t) + r] = acc[t][reg]; }
    }
    LBAR();
    if (tid < 64) {
        const LAS float* lg = LG + tid * 80;
        float mx = lg[0]; int gi = 0;
#pragma unroll
        for (int j = 1; j < NGRP; ++j) { const float v = lg[j]; if (v > mx) { mx = v; gi = j; } }
        float den = 0.f;
#pragma unroll
        for (int j = 0; j < NGRP; ++j) den += __expf(lg[j] - mx);
        const float gw = 1.f / den;
        float m1 = -INFINITY, m2 = -INFINITY; int i1 = 0, i2 = 0;
#pragma unroll
        for (int j = 0; j < EPG; ++j) { const float v = lg[8 + gi * EPG + j]; if (v > m1) { m2 = m1; i2 = i1; m1 = v; i1 = j; } else if (v > m2) { m2 = v; i2 = j; } }
        const float p2 = __expf(m2 - m1);
        const int e1 = gi * EPG + i1, e2 = gi * EPG + i2;
        te_l[tid * 2] = e1; te_l[tid * 2 + 1] = e2; tw_l[tid * 2] = gw / (1.f + p2); tw_l[tid * 2 + 1] = gw * p2 / (1.f + p2);
        __hip_atomic_fetch_add(cnt_l + e1, 1, __ATOMIC_RELAXED, __HIP_MEMORY_SCOPE_WORKGROUP); __hip_atomic_fetch_add(cnt_l + e2, 1, __ATOMIC_RELAXED, __HIP_MEMORY_SCOPE_WORKGROUP);
    }
    LBAR();
    if (tid < 64) ((int*)(P.ws + WS_CNT))[tile * 64 + tid] = cnt_l[tid];
}
__device__ __forceinline__ void p7_dispatch(Frame& F, const Ptrs& P) {
    const int lane = lane_now(), wave = F.wave, tid = wave * 64 + lane;
    const int tile = F.vcu; const size_t m0 = (size_t)tile * 64;
    LAS unsigned char* XT = F.lds;
    LAS int* te_l = (LAS int*)(F.lds + LDS_TE); LAS float* tw_l = (LAS float*)(F.lds + LDS_TW); LAS int* pos_l = (LAS int*)(F.lds + LDS_POS); LAS int* base_l = (LAS int*)(F.lds + LDS_BASE);
    LAS int* part = (LAS int*)(F.lds + LDS_PART);
    const int* CNT = (const int*)(P.ws + WS_CNT);
    { const int e = lane, pt = wave; int tot = 0, bef = 0;
      for (int t = 32 * pt; t < 32 * pt + 32; ++t) { const int v = CNT[t * 64 + e]; tot += v; bef += (t < tile) ? v : 0; }
      part[(pt * 64 + e) * 2] = tot; part[(pt * 64 + e) * 2 + 1] = bef; }
    LBAR();
    if (wave == 0) { int tot = 0, bef = 0;
#pragma unroll
        for (int pt = 0; pt < 8; ++pt) { tot += part[(pt * 64 + lane) * 2]; bef += part[(pt * 64 + lane) * 2 + 1]; }
        const int pc = (tot + 255) & ~255; int incl = pc;
#pragma unroll
        for (int off = 1; off < 64; off <<= 1) { const int t = __shfl_up(incl, off); if (lane >= off) incl += t; }
        const int pstart = incl - pc;
        base_l[lane] = pstart + bef;
        if (tile == 0) { int* TEX = (int*)(P.ws + WS_TEX); for (int r = pstart >> 8; r < (pstart + pc) >> 8; ++r) TEX[64 + r] = lane; if (lane == 63) TEX[0] = (pstart + pc) >> 8; }
    }
    LBAR();
    if (tid < 128) { const int e = te_l[tid]; int rank = 0; for (int j = 0; j < tid; ++j) rank += (te_l[j] == e) ? 1 : 0;
        const int pos = base_l[e] + rank; pos_l[tid] = pos;
        ((int*)(P.ws + WS_TPOS))[m0 * 2 + tid] = pos; ((float*)(P.ws + WS_GATEW))[pos] = tw_l[tid]; }
    LBAR();
    for (int rr = 0; rr < 8; ++rr) { const int row = wave * 8 + rr; const int p0 = pos_l[row * 2], p1 = pos_l[row * 2 + 1];
#pragma unroll
        for (int c = 0; c < 2; ++c) { const v4u v = *(const LAS v4u*)(XT + row * 2048 + (lane + 64 * c) * 16);
            *(GAS v4u*)(P.ws + WS_XG + (size_t)p0 * 2048 + (lane + 64 * c) * 16) = v; *(GAS v4u*)(P.ws + WS_XG + (size_t)p1 * 2048 + (lane + 64 * c) * 16) = v; } }
}
__device__ __forceinline__ void p10_combine(Frame& F, const Ptrs& P) {
    const int lane = lane_now(); const int gw = F.vcu * NWAVES + F.wave, NGW = F.G * NWAVES;
    float* H = (float*)(P.ws + WS_H1); const int* TPOS = (const int*)(P.ws + WS_TPOS); bf16* XN3 = (bf16*)(P.ws + WS_XN3);
    for (int m = gw; m < M; m += NGW) {
        const int p0 = TPOS[m * 2], p1 = TPOS[m * 2 + 1];
        GAS f32x4* hr = (GAS f32x4*)(H + (size_t)m * DM) + lane;
        const GAS u32x2* y0 = (const GAS u32x2*)(P.ws + WS_Y + (size_t)p0 * 2048) + lane; const GAS u32x2* y1 = (const GAS u32x2*)(P.ws + WS_Y + (size_t)p1 * 2048) + lane;
        f32x4 v[4]; float s = 0.f;
#pragma unroll
        for (int j = 0; j < 4; ++j) { v[j] = hr[64 * j]; const u32x2 a = y0[64 * j], b = y1[64 * j];
            v[j].x += __uint_as_float(a.x << 16) + __uint_as_float(b.x << 16); v[j].y += __uint_as_float(a.x & 0xffff0000u) + __uint_as_float(b.x & 0xffff0000u);
            v[j].z += __uint_as_float(a.y << 16) + __uint_as_float(b.y << 16); v[j].w += __uint_as_float(a.y & 0xffff0000u) + __uint_as_float(b.y & 0xffff0000u);
            hr[64 * j] = v[j]; s += (v[j].x * v[j].x + v[j].y * v[j].y) + (v[j].z * v[j].z + v[j].w * v[j].w); }
        const float r = rsqrtf(wave_sum_f(s) * (1.f / DM) + EPS);
        GAS unsigned long long* o8 = (GAS unsigned long long*)(XN3 + (size_t)m * DM) + lane;
#pragma unroll
        for (int j = 0; j < 4; ++j) { const f32x4 g = ((const GAS f32x4*)P.g_ple)[64 * j + lane]; const f32x4 w = v[j] * r * g;
            o8[64 * j] = (unsigned long long)pk2(w.x, w.y) | ((unsigned long long)pk2(w.z, w.w) << 32); }
    }
}
__device__ __forceinline__ void p12_final(Frame& F, const Ptrs& P) {
    const int lane = lane_now(); const int gw = F.vcu * NWAVES + F.wave, NGW = F.G * NWAVES;
    for (int m = gw; m < M; m += NGW) {
        GAS f32x4* hr = (GAS f32x4*)(P.out + (size_t)m * DM) + lane;
        f32x4 v[4]; float s = 0.f;
#pragma unroll
        for (int j = 0; j < 4; ++j) { v[j] = hr[64 * j]; s += (v[j].x * v[j].x + v[j].y * v[j].y) + (v[j].z * v[j].z + v[j].w * v[j].w); }
        const float r = rsqrtf(wave_sum_f(s) * (1.f / DM) + EPS);
#pragma unroll
        for (int j = 0; j < 4; ++j) { const f32x4 g = ((const GAS f32x4*)P.g_final)[64 * j + lane]; hr[64 * j] = v[j] * r * g; }
    }
}
struct Args { const float* in[23]; float* out; unsigned char* ws; int ph_lo, ph_hi, use_bar, bar_region; };
constexpr int N_PHASES = 13;
__global__ void __launch_bounds__(NWAVES * 64, 2) mk_fwd(Args args) {
    extern __shared__ __attribute__((aligned(16))) unsigned char lds[];
    Frame F;
    F.lds = (LAS unsigned char*)lds; F.MISC = (volatile LAS unsigned*)(F.lds + MISC_OFF);
    F.wave = __builtin_amdgcn_readfirstlane((int)threadIdx.x >> 6);
    F.G = gridDim.x; { const int bx = blockIdx.x; F.vcu = (F.G % 8 == 0) ? (bx % 8) * (F.G / 8) + bx / 8 : bx; }
    Ptrs P;
    P.x = args.in[0]; P.p = args.in[1]; P.g_mix = args.in[2]; P.w_in = args.in[3]; P.w_conv_qkv = args.in[4]; P.a_log = args.in[5]; P.dt_bias = args.in[6]; P.g_gdn_out = args.in[7];
    P.b_glu = args.in[8]; P.w_conv_dw = args.in[9]; P.b_conv_dw = args.in[10]; P.ln_g = args.in[11]; P.ln_b = args.in[12]; P.w_out = args.in[13]; P.g_moe = args.in[14]; P.w_gr = args.in[15];
    P.w_er = args.in[16]; P.w_up = args.in[17]; P.w_down = args.in[18]; P.g_ple = args.in[19]; P.w_pg = args.in[20]; P.w_pp = args.in[21]; P.g_final = args.in[22];
    P.out = args.out; P.ws = args.ws;
    F.ctl = (gu32*)(P.ws + WS_CTL);
    for (int u = (int)threadIdx.x; u < (LDS_BYTES - LDSCTL_OFF) / 4; u += NWAVES * 64) ((LAS unsigned*)(F.lds + LDSCTL_OFF))[u] = 0u;
    __syncthreads();
    XcdBarrier bar; bar.bar = (unsigned*)(F.ctl + CW_BAR) + args.bar_region * XCD_BAR_WORDS; bar.x = 0; bar.st = nullptr;
    if (args.use_bar) bar = xcd_barrier_post((unsigned*)(F.ctl + CW_BAR) + args.bar_region * XCD_BAR_WORDS, F.MISC + 8, threadIdx.x == 0);
    const int lo = args.ph_lo, hi = args.ph_hi;
#define IN(k) (lo <= (k) && (k) < hi)
#define SEAM(k) do { if (IN(k) && IN((k) + 1)) xcd_barrier(bar, F.wave == 0 && lane_now() == 0); } while (0)

    if (IN(0)) { p0_prologue(F, P); SEAM(0); }
    if (IN(1)) {
        pg8::Gemm g{(const pg8::bf16_t*)(P.ws + WS_N1), (const pg8::bf16_t*)(P.ws + WS_WIN), M, NIN_T, DM, 0};
        pg8::StaticOrder S; S.init(M, NIN_T, F.G, (int)blockIdx.x);
        EpiIn E{(pg8::bf16_t*)(P.ws + WS_QKVZ), (pg8::bf16_t*)(P.ws + WS_U), P.b_glu};
        pg8::gemm_phase<EpiIn, pg8::StaticOrder, true, true>(F.lds + RING_OFF, g, S, E, F.wave);
        SEAM(1);
    }
#ifndef SKIP_P2
    if (IN(2)) { p2_gdn_prep(F, P); SEAM(2); }
#endif
    if (IN(3)) {
#ifndef SKIP_SCAN
        if ((int)blockIdx.x < NSCAN) p3_scan(F, P, (int)blockIdx.x);
        else
#endif
        {
            const int idx = (int)blockIdx.x - NSCAN, cnt = F.G - NSCAN;
#ifndef SKIP_CONF
            for (int t = idx; t < M / 32; t += cnt) p3_conf_tile(F, P, t);
#endif
            pg8::Gemm g{(const pg8::bf16_t*)(P.ws + WS_PBF), (const pg8::bf16_t*)(P.ws + WS_WPROJ), M, DM, PLE, 0};
            pg8::StaticOrder S; S.init(M, DM, cnt, idx);
            pg8::EpiBf16<0> E{(pg8::bf16_t*)(P.ws + WS_PROJ), DM, nullptr, 0, 0, 1.f};
            pg8::gemm_phase<pg8::EpiBf16<0>, pg8::StaticOrder, true, true>(F.lds + RING_OFF, g, S, E, F.wave);
        }
        SEAM(3);
    }
#ifndef SKIP_P4
    if (IN(4)) { p4_gdn_out(F, P); SEAM(4); }
#endif
    if (IN(5)) {
        pg8::Gemm g{(const pg8::bf16_t*)(P.ws + WS_MIX), (const pg8::bf16_t*)(P.ws + WS_WOUT), M, DM, DM, 0};
        pg8::StaticOrder S; S.init(M, DM, F.G, (int)blockIdx.x);
        EpiRes E{P.x, (float*)(P.ws + WS_H1)};
        pg8::gemm_phase<EpiRes, pg8::StaticOrder, true, true>(F.lds + RING_OFF, g, S, E, F.wave);
        SEAM(5);
    }
    if (IN(6)) { p6_router(F, P); SEAM(6); }
    if (IN(7)) { p7_dispatch(F, P); SEAM(7); }
    if (IN(8)) {
        pg8::Gemm g{(const pg8::bf16_t*)(P.ws + WS_XG), (const pg8::bf16_t*)(P.ws + WS_WUP), PSLOTS, 512, DM, (size_t)512 * DM * 2};
        MoeOrder S{(const int*)(P.ws + WS_TEX), 2, F.G, F.vcu};
        EpiSwiGLU E{(pg8::bf16_t*)(P.ws + WS_ACT)};
        pg8::gemm_phase<EpiSwiGLU, MoeOrder, true, true>(F.lds + RING_OFF, g, S, E, F.wave);
        SEAM(8);
    }
    if (IN(9)) {
        pg8::Gemm g{(const pg8::bf16_t*)(P.ws + WS_ACT), (const pg8::bf16_t*)(P.ws + WS_WDOWN), PSLOTS, DM, DEXP, (size_t)DM * DEXP * 2};
        MoeOrder S{(const int*)(P.ws + WS_TEX), 4, F.G, F.vcu};
        EpiGate E{(pg8::bf16_t*)(P.ws + WS_Y), (const float*)(P.ws + WS_GATEW)};
        pg8::gemm_phase<EpiGate, MoeOrder, true, true>(F.lds + RING_OFF, g, S, E, F.wave);
        SEAM(9);
    }
    if (IN(10)) { p10_combine(F, P); SEAM(10); }
    if (IN(11)) {
        pg8::Gemm g{(const pg8::bf16_t*)(P.ws + WS_XN3), (const pg8::bf16_t*)(P.ws + WS_WGATE), M, DM, DM, 0};
        pg8::StaticOrder S; S.init(M, DM, F.G, (int)blockIdx.x);
        EpiPle E{(const float*)(P.ws + WS_H1), (const pg8::bf16_t*)(P.ws + WS_PROJ), P.out};
        pg8::gemm_phase<EpiPle, pg8::StaticOrder, true, true>(F.lds + RING_OFF, g, S, E, F.wave);
        SEAM(11);
    }
    if (IN(12)) { p12_final(F, P); }
#undef IN
#undef SEAM
}

__global__ void __launch_bounds__(256) k_shimA(const unsigned short* __restrict__ QKVZ, const float* __restrict__ AB, const unsigned short* __restrict__ U, float* __restrict__ proj, int ldp, float* __restrict__ u) {
    const size_t i = (size_t)blockIdx.x * 256 + threadIdx.x;
    if (i < (size_t)M * 2048) { const size_t m = i / 2048; const int c = (int)(i % 2048); proj[m * ldp + c] = __uint_as_float((unsigned)QKVZ[i] << 16); }
    if (i < (size_t)M * 8) { const size_t m = i / 8; const int c = (int)(i % 8); proj[m * ldp + 2048 + c] = AB[i]; }
    if (i < (size_t)M * CCH) u[i] = __uint_as_float((unsigned)U[i] << 16);
}
__global__ void __launch_bounds__(256) k_shimB(const unsigned short* __restrict__ MIX, float* __restrict__ mix) {
    const size_t i = (size_t)blockIdx.x * 256 + threadIdx.x;
    if (i < (size_t)M * DM) mix[i] = __uint_as_float((unsigned)MIX[i] << 16);
}
struct NvMap { int *counts, *pstart, *cursor, *tile_e, *te, *tpos, *rowidx; float *tw, *gb; float *n1, *proj, *qkv, *o, *u, *mix, *h, *xn, *logits, *UP, *ACT, *Y, *G, *PP; int ldp; };
static inline dim3 g2(int Mr, int N) { return dim3((N + 63) / 64, (Mr + 63) / 64); }
constexpr int NTILE_MAX = 640, PMAX = NTILE_MAX * 64;

static NvMap nv_default_map(char* ws) {
    NvMap m;
    m.counts = (int*)(ws + 0); m.pstart = (int*)(ws + 1024); m.cursor = (int*)(ws + 2048); m.tile_e = (int*)(ws + 4096);
    m.te = (int*)(ws + 64 * 1024); m.tw = (float*)(ws + 256 * 1024); m.tpos = (int*)(ws + 512 * 1024); m.rowidx = (int*)(ws + 1 * MiB); m.gb = (float*)(ws + 2 * MiB);
    float* A0 = (float*)(ws + 4 * MiB); float* A1 = (float*)(ws + 68 * MiB); float* A2 = (float*)(ws + 264 * MiB); float* A3 = (float*)(ws + 360 * MiB);
    float* A5 = (float*)(ws + 392 * MiB); float* A4 = (float*)(ws + 424 * MiB);
    m.n1 = A0; m.proj = A1; m.qkv = A2; m.o = A3; m.u = A5; m.mix = A0; m.h = A4; m.xn = A0; m.logits = A3; m.UP = A2; m.ACT = A3; m.Y = A1; m.G = A2; m.PP = A1; m.ldp = INC;
    return m;
}
static void run_naive(void* const* d_in, float* out, const NvMap& m, int start, hipStream_t stream) {
    const float* x = (const float*)d_in[0]; const float* p = (const float*)d_in[1]; const float* g_mix = (const float*)d_in[2]; const float* w_in = (const float*)d_in[3];
    const float* w_conv_qkv = (const float*)d_in[4]; const float* a_log = (const float*)d_in[5]; const float* dt_bias = (const float*)d_in[6]; const float* g_gdn_out = (const float*)d_in[7];
    const float* b_glu = (const float*)d_in[8]; const float* w_conv_dw = (const float*)d_in[9]; const float* b_conv_dw = (const float*)d_in[10]; const float* ln_g = (const float*)d_in[11];
    const float* ln_b = (const float*)d_in[12]; const float* w_out = (const float*)d_in[13]; const float* g_moe = (const float*)d_in[14]; const float* w_gr = (const float*)d_in[15];
    const float* w_er = (const float*)d_in[16]; const float* w_up = (const float*)d_in[17]; const float* w_down = (const float*)d_in[18]; const float* g_ple = (const float*)d_in[19];
    const float* w_pg = (const float*)d_in[20]; const float* w_pp = (const float*)d_in[21]; const float* g_final = (const float*)d_in[22];
    if (start <= 0) {
        nv::k_rmsnorm<<<M, 256, 0, stream>>>(x, g_mix, m.n1);
        nv::k_gemm<<<g2(M, INC), 256, 0, stream>>>(m.n1, DM, w_in, INC, m.proj, INC, M, INC, DM, nullptr, nullptr, 0);
        nv::k_glu<<<(int)(((size_t)M * CCH + 255) / 256), 256, 0, stream>>>(m.proj, b_glu, m.u);
    }
    if (start <= 1) {
        nv::k_conv4<<<(int)(((size_t)M * O1 + 255) / 256), 256, 0, stream>>>(m.proj, m.ldp, w_conv_qkv, m.qkv);
        nv::k_l2norm<<<M * 8 / 4, 256, 0, stream>>>(m.qkv);
        nv::k_gbeta<<<M * NH / 256, 256, 0, stream>>>(m.proj, m.ldp, a_log, dt_bias, m.gb);
        nv::k_scan<<<NB * NH, 128, 0, stream>>>(m.qkv, m.gb, m.o);
        nv::k_gatednorm<<<M * NH / 4, 256, 0, stream>>>(m.o, m.proj, m.ldp, g_gdn_out, m.mix);
        nv::k_conf<<<M, 256, 0, stream>>>(m.u, w_conv_dw, b_conv_dw, ln_g, ln_b, m.mix);
    }
    if (start <= 2) {
        nv::k_gemm<<<g2(M, DM), 256, 0, stream>>>(m.mix, DM, w_out, DM, m.h, DM, M, DM, DM, nullptr, nullptr, 0);
        nv::k_addx<<<M * DM / 4 / 256, 256, 0, stream>>>(m.h, x);
    }
    if (start <= 3) {
        nv::k_rmsnorm<<<M, 256, 0, stream>>>(m.h, g_moe, m.xn);
        nv::k_gemm<<<g2(M, NGRP), 256, 0, stream>>>(m.xn, DM, w_gr, NGRP, m.logits, 72, M, NGRP, DM, nullptr, nullptr, 0);
        nv::k_gemm<<<g2(M, NEXP), 256, 0, stream>>>(m.xn, DM, w_er, NEXP, m.logits + 8, 72, M, NEXP, DM, nullptr, nullptr, 0);
        (void)hipMemsetAsync(m.counts, 0, 1024, stream);
        (void)hipMemsetAsync(m.rowidx, 0xFF, PMAX * 4, stream);
        nv::k_route<<<M / 256, 256, 0, stream>>>(m.logits, m.te, m.tw, m.counts);
        nv::k_offsets<<<1, 64, 0, stream>>>(m.counts, m.pstart, m.cursor, m.tile_e, NTILE_MAX);
        nv::k_scatter<<<M * 2 / 256, 256, 0, stream>>>(m.te, m.pstart, m.cursor, m.rowidx, m.tpos);
        nv::k_gemm<<<g2(PMAX, 512), 256, 0, stream>>>(m.xn, DM, w_up, 512, m.UP, 512, PMAX, 512, DM, m.rowidx, m.tile_e, (size_t)DM * 512);
        nv::k_act<<<(int)(((size_t)PMAX * DEXP + 255) / 256), 256, 0, stream>>>(m.UP, m.ACT, PMAX);
        nv::k_gemm<<<g2(PMAX, DM), 256, 0, stream>>>(m.ACT, DEXP, w_down, DM, m.Y, DM, PMAX, DM, DEXP, nullptr, m.tile_e, (size_t)DEXP * DM);
        nv::k_combine<<<M, 256, 0, stream>>>(m.h, m.Y, m.tpos, m.tw);
    }
    nv::k_rmsnorm<<<M, 256, 0, stream>>>(m.h, g_ple, m.xn);
    nv::k_gemm<<<g2(M, DM), 256, 0, stream>>>(m.xn, DM, w_pg, DM, m.G, DM, M, DM, DM, nullptr, nullptr, 0);
    nv::k_gemm<<<g2(M, DM), 256, 0, stream>>>(p, PLE, w_pp, DM, m.PP, DM, M, DM, PLE, nullptr, nullptr, 0);
    nv::k_final<<<M, 256, 0, stream>>>(m.h, m.G, m.PP, g_final, out);
}

#ifndef HYB
#define HYB 1
#endif
static int launch_fast(void* const* d_in, float* out, void* d_ws, const int* seg, int nseg, hipStream_t stream) {
    static int grid = 0;
    if (grid == 0) {
        int dev = 0, cus = 0;
        if (hipGetDevice(&dev) != hipSuccess || hipDeviceGetAttribute(&cus, hipDeviceAttributeMultiprocessorCount, dev) != hipSuccess) { fprintf(stderr, "device query failed\n"); grid = -1; return -1; }
        if (hipFuncSetAttribute((const void*)mk_fwd, hipFuncAttributeMaxDynamicSharedMemorySize, LDS_BYTES) != hipSuccess) { fprintf(stderr, "hipFuncSetAttribute failed\n"); grid = -1; return -1; }
        int per_cu = 0;
        if (hipOccupancyMaxActiveBlocksPerMultiprocessor(&per_cu, (const void*)mk_fwd, NWAVES * 64, LDS_BYTES) != hipSuccess || per_cu < 1) fprintf(stderr, "note: occupancy query says %d\n", per_cu);
        (void)hipGetLastError();
        grid = cus;
        if (grid != 256) { fprintf(stderr, "kernel_launch: built for a 256-CU device (router tiles = workgroups); got %d\n", cus); grid = -1; return -1; }
    }
    if (grid < 0) return -1;
    Args a{};
    for (int i = 0; i < 23; ++i) a.in[i] = (const float*)d_in[i];
    a.out = out; a.ws = (unsigned char*)d_ws;
    for (int i = 0; i < nseg; ++i) { a.ph_lo = seg[2 * i]; a.ph_hi = seg[2 * i + 1]; a.use_bar = (a.ph_hi - a.ph_lo > 1) ? 1 : 0; a.bar_region = i;
        hipLaunchKernelGGL(mk_fwd, dim3(grid), dim3(NWAVES * 64), LDS_BYTES, stream, a); }
    return 0;
}

extern "C" void kernel_launch(void* const* d_in, const int* in_sizes, int n_in, void* d_out, int out_size, void* d_ws, size_t ws_size, hipStream_t stream) {
    char* ws = (char*)d_ws; float* out = (float*)d_out;
#if HYB == 0
    run_naive(d_in, out, nv_default_map(ws), 0, stream);
#elif HYB == 1
    (void)hipMemsetAsync(ws + WS_CTL, 0, CTL_ZERO_BYTES, stream);
    { const int seg[] = {0, 1, 1, 2}; if (launch_fast(d_in, out, d_ws, seg, 2, stream) != 0) return; }
    NvMap m = nv_default_map(ws);
    m.proj = (float*)(ws + 226 * MiB); m.ldp = 2056; m.qkv = (float*)(ws + 4 * MiB); m.o = (float*)(ws + 100 * MiB); m.mix = (float*)(ws + 132 * MiB); m.u = (float*)(ws + 392 * MiB); m.h = (float*)(ws + 424 * MiB);
    m.xn = m.mix; m.logits = m.o; m.UP = (float*)(ws + 4 * MiB); m.ACT = (float*)(ws + 356 * MiB); m.Y = (float*)(ws + 196 * MiB); m.G = (float*)(ws + 4 * MiB); m.PP = (float*)(ws + 196 * MiB);
    k_shimA<<<(int)(((size_t)M * 2048 + 255) / 256), 256, 0, stream>>>((const unsigned short*)(ws + WS_QKVZ), (const float*)(ws + WS_AB), (const unsigned short*)(ws + WS_U), m.proj, m.ldp, m.u);
    run_naive(d_in, out, m, 1, stream);
#elif HYB == 2
    (void)hipMemsetAsync(ws + WS_CTL, 0, CTL_ZERO_BYTES, stream);
    { const int seg[] = {0, 1, 1, 2, 2, 3, 3, 4, 4, 5}; if (launch_fast(d_in, out, d_ws, seg, 5, stream) != 0) return; }
    NvMap m = nv_default_map(ws);
    k_shimB<<<(int)(((size_t)M * DM + 255) / 256), 256, 0, stream>>>((const unsigned short*)(ws + WS_MIX), m.mix);
    run_naive(d_in, out, m, 2, stream);
#elif HYB == 3
    (void)hipMemsetAsync(ws + WS_CTL, 0, CTL_ZERO_BYTES, stream);
    { const int seg[] = {0, 1, 1, 2, 2, 3, 3, 4, 4, 5, 5, 6}; if (launch_fast(d_in, out, d_ws, seg, 6, stream) != 0) return; }
    NvMap m = nv_default_map(ws); m.h = (float*)(ws + WS_H1);
    run_naive(d_in, out, m, 3, stream);
#elif HYB == 4
    (void)hipMemsetAsync(ws + WS_CTL, 0, CTL_ZERO_BYTES, stream);
    { const int seg[] = {0, 1, 1, 2, 2, 3, 3, 4, 4, 5, 5, 6, 6, 8, 8, 9, 9, 10, 10, 11}; if (launch_fast(d_in, out, d_ws, seg, 10, stream) != 0) return; }
    NvMap m = nv_default_map(ws); m.h = (float*)(ws + WS_H1);
    run_naive(d_in, out, m, 4, stream);
#elif HYB == 5
    (void)hipMemsetAsync(ws + WS_CTL, 0, CTL_ZERO_BYTES, stream);
    { const int seg[] = {0, 1, 1, 2, 2, 3, 3, 4, 4, 5, 5, 6, 6, 8, 8, 9, 9, 10, 10, 11, 11, 12, 12, 13}; if (launch_fast(d_in, out, d_ws, seg, 12, stream) != 0) return; }
#elif HYB == 6
    (void)hipMemsetAsync(ws + WS_CTL, 0, CTL_ZERO_BYTES, stream);
    { const int seg[] = {0, 13}; if (launch_fast(d_in, out, d_ws, seg, 1, stream) != 0) return; }
#endif
}
```

```cpp
#include <hip/hip_runtime.h>
#include <cstdio>
#include <cstdint>

constexpr int DM = 1024, NB = 2, SEQ = 8192, M = NB * SEQ, PLE = 256;
constexpr int NH = 4, DK = 128, DV = 128, QKW = 512, VW = 512, CCH = 512, CWID = 31;
constexpr int NGRP = 8, EPG = 8, NEXP = 64, DEXP = 256, INC = 3080;
constexpr int O1 = 1536, O2 = 2048, O3 = 2052, O4 = 2056;
constexpr float EPS = 1e-6f;

#define HYB 6
namespace pg8 {
#define PG8_LAS __attribute__((address_space(3)))
typedef unsigned short bf16_t;
typedef short bf16x8 __attribute__((ext_vector_type(8)));
typedef float f32x4 __attribute__((ext_vector_type(4)));
typedef unsigned u32x4 __attribute__((ext_vector_type(4)));
constexpr int BM = 256, BK = 64, HALF = 128, HTB = HALF * BK * 2  , STAGE_BYTES = 8 * HTB, NXCD = 8, WGM = 8;

__host__ __device__ __forceinline__ int lds_byte(int r, int c) { const int st = (r >> 4) * 2 + (c >> 5), rr = r & 15, cc = c & 31, ob = rr * 64 + cc * 2; return st * 1024 + (ob ^ (((ob >> 9) & 1) << 5)); }
__host__ __device__ __forceinline__ void stage_rc(int b, int& R, int& C) { const int st = b / 1024, sb = b % 1024, swz = sb ^ (((sb >> 9) & 1) << 5); R = (st >> 1) * 16 + swz / 64; C = (st & 1) * 32 + (swz % 64) / 2; }
__host__ __device__ __forceinline__ int perm32(int rho) { const int n = rho >> 4, i = rho & 15; return 8 * (i >> 2) + 4 * n + (i & 3); }

struct Unit { int pm, pn, be; };
struct Gemm { const bf16_t* A; const bf16_t* Bt; int M, N, K; size_t bstride; };

struct StaticOrder {
    int nM, nN, nwg, G, c;
    __host__ __device__ void init(int M, int N, int G_, int c_) { nM = M / BM; nN = N / BM; nwg = nM * nN; G = G_; c = c_; }
    __host__ __device__ bool next(int i, Unit& u) const {
        const long L = (long)i * G + c; if (L >= nwg) return false;
        int wgid = (int)L; { const int q = nwg / NXCD, r = nwg % NXCD, xcd = wgid % NXCD, off = wgid / NXCD; wgid = (xcd < r ? xcd * (q + 1) : r * (q + 1) + (xcd - r) * q) + off; }
        const int nig = WGM * nN, gid = wgid / nig, fm = gid * WGM, gsz = (nM - fm) < WGM ? (nM - fm) : WGM;
        u.pm = fm + ((wgid % nig) % gsz); u.pn = (wgid % nig) / gsz; u.be = 0; return true;
    }
    __device__ __forceinline__ void a_ready(const Unit&) const {}
    __device__ __forceinline__ void done(const Unit&) const {}
};

__device__ __forceinline__ unsigned cvt_pk_bf16(float lo, float hi) { unsigned r; asm volatile("v_cvt_pk_bf16_f32 %0, %1, %2" : "=v"(r) : "v"(lo), "v"(hi)); return r; }
typedef float f32x2 __attribute__((ext_vector_type(2)));
__device__ __forceinline__ f32x2 gelu_pk(f32x2 v) {
    const f32x2 av = __builtin_elementwise_abs(v), d = av * 0.2316418882f + 1.0f;
    f32x2 t; t.x = __builtin_amdgcn_rcpf(d.x); t.y = __builtin_amdgcn_rcpf(d.y);
    f32x2 q = t * 0.5307027145f + (-0.7265760135f); q = q * t + 0.7107068705f; q = q * t + (-0.142248368f); q = q * t + 0.127414796f; q = q * t;
    const f32x2 s = (v * v) * (-0.72134752044f);
    f32x2 e; e.x = __builtin_amdgcn_exp2f(s.x); e.y = __builtin_amdgcn_exp2f(s.y);
    const f32x2 m = v * (q * e), r = v - m;
    f32x2 o; o.x = v.x < 0.f ? m.x : r.x; o.y = v.y < 0.f ? m.y : r.y; return o;
}

template <int ACT  > struct EpiBf16 {
    static constexpr bool PERM = true, AFTER_DRAIN = false; static_assert(ACT == 0 || ACT == 1, "EpiBf16: ACT is 0 (none) or 1 (gelu_pk)");
    bf16_t* O; int ldc; const float* bias; int split_cols; size_t split_stride; float scale0;
    __device__ __forceinline__ void operator()(const f32x4 (&acc)[2][2][4][2], const Unit& u, int wr, int wc, int fr, int fq) const {
        const int row0 = u.pm * BM + wr * 64 + fr; int colt = u.pn * BM; bf16_t* base = O;
        float sc = 1.f; if (split_cols) { const int t = colt / split_cols; base += (size_t)t * split_stride; colt -= t * split_cols; if (t == 0) sc = scale0; }
        const int col0 = colt + wc * 32 + 8 * fq, bcol0 = u.pn * BM + wc * 32 + 8 * fq;
        f32x4 bv[2][2];
#pragma unroll
        for (int bj = 0; bj < 2; ++bj)
#pragma unroll
            for (int n = 0; n < 2; ++n) bv[bj][n] = bias ? *(const f32x4*)(bias + bcol0 + bj * HALF + 4 * n) : (f32x4){0.f, 0.f, 0.f, 0.f};
#pragma unroll
        for (int ai = 0; ai < 2; ++ai)
#pragma unroll
            for (int m = 0; m < 4; ++m) { bf16_t* rowp = base + (size_t)(row0 + ai * HALF + m * 16) * ldc + col0;
#pragma unroll
                for (int bj = 0; bj < 2; ++bj) { f32x4 v0 = acc[ai][bj][m][0] + bv[bj][0], v1 = acc[ai][bj][m][1] + bv[bj][1];
                    if (ACT == 1) { f32x2 a = gelu_pk((f32x2){v0[0], v0[1]}), b = gelu_pk((f32x2){v0[2], v0[3]}), c = gelu_pk((f32x2){v1[0], v1[1]}), d = gelu_pk((f32x2){v1[2], v1[3]});
                        v0 = (f32x4){a.x, a.y, b.x, b.y}; v1 = (f32x4){c.x, c.y, d.x, d.y}; }
                    v0 = v0 * sc; v1 = v1 * sc; u32x4 w; w.x = cvt_pk_bf16(v0[0], v0[1]); w.y = cvt_pk_bf16(v0[2], v0[3]); w.z = cvt_pk_bf16(v1[0], v1[1]); w.w = cvt_pk_bf16(v1[2], v1[3]);
                    *(u32x4*)(rowp + bj * HALF) = w; } }
    }
};

struct PanelStats {
    unsigned* xbuf;
    unsigned* cnt;
    unsigned* tmo;
    int ntn; float eps;
    unsigned code;
    __device__ __forceinline__ bool run(const f32x4 (&v)[2][2][4][2], const Unit& u, int wr, int wc, int fr, int fq, PG8_LAS unsigned char* lds, int wid, int lane) const {
        typedef float f32x2v __attribute__((ext_vector_type(2)));
        PG8_LAS f32x2v* P = (PG8_LAS f32x2v*)lds;
        PG8_LAS f32x2v* S = (PG8_LAS f32x2v*)(lds + 8192);
        PG8_LAS unsigned* flag = (PG8_LAS unsigned*)(lds + 8192 + 2048);
#pragma unroll
        for (int ai = 0; ai < 2; ++ai)
#pragma unroll
            for (int m = 0; m < 4; ++m) {
                float s = 0.f;
#pragma unroll
                for (int bj = 0; bj < 2; ++bj)
#pragma unroll
                    for (int n = 0; n < 2; ++n) { const f32x4 x = v[ai][bj][m][n]; s += (x[0] + x[1]) + (x[2] + x[3]); }
                s += __shfl_xor(s, 16); s += __shfl_xor(s, 32);
                const float mw = s * (1.0f / 64.0f); float q = 0.f;
#pragma unroll
                for (int bj = 0; bj < 2; ++bj)
#pragma unroll
                    for (int n = 0; n < 2; ++n) { const f32x4 d = v[ai][bj][m][n] - mw; q += (d[0] * d[0] + d[1] * d[1]) + (d[2] * d[2] + d[3] * d[3]); }
                q += __shfl_xor(q, 16); q += __shfl_xor(q, 32);
                if (fq == 0) P[(ai * HALF + wr * 64 + m * 16 + fr) * 4 + wc] = (f32x2v){mw, q};
            }
        asm volatile("s_waitcnt lgkmcnt(0)" ::: "memory"); __builtin_amdgcn_s_barrier(); asm volatile("" ::: "memory");
#if defined(BROKEN_EXCHANGE_NO_WAIT)
#warning BROKEN CONTROL BUILD: the row-statistics exchange does not wait; results are wrong by design
        if (blockIdx.x >= 64) { const long long t0_ = clock64(); while (clock64() - t0_ < 60000) __builtin_amdgcn_s_sleep(8); }
#endif
        const int row = wid * 32 + (lane & 31);
        if (lane < 32) {
            const f32x2v a = P[row * 4 + 0], b = P[row * 4 + 1], c = P[row * 4 + 2], d = P[row * 4 + 3];
            const float mt = (a.x + b.x + c.x + d.x) * 0.25f;
            const float da = a.x - mt, db = b.x - mt, dc = c.x - mt, dd = d.x - mt;
            const float m2 = (a.y + b.y) + (c.y + d.y) + 64.0f * ((da * da + db * db) + (dc * dc + dd * dd));
            unsigned long long* slot = (unsigned long long*)xbuf + ((size_t)(u.pm * BM + row) * 4 + u.pn);
            __hip_atomic_store(slot, ((unsigned long long)__float_as_uint(m2) << 32) | __float_as_uint(mt), __ATOMIC_RELAXED, __HIP_MEMORY_SCOPE_AGENT);
        }
        asm volatile("s_waitcnt vmcnt(0)" ::: "memory");
        if (lane == 0) __hip_atomic_fetch_add(cnt + 64 * u.pm, 1u, __ATOMIC_RELAXED, __HIP_MEMORY_SCOPE_AGENT);
        if (wid == 0) {
            bool dead = false; const unsigned long long t0 = __builtin_amdgcn_s_memrealtime(); const unsigned want = 8u * (unsigned)ntn;
            for (;;) {
#if defined(BROKEN_EXCHANGE_NO_WAIT)
                break;
#endif
                if ((unsigned)__builtin_amdgcn_readfirstlane(__hip_atomic_load(cnt + 64 * u.pm, __ATOMIC_RELAXED, __HIP_MEMORY_SCOPE_AGENT)) >= want) break;
                if (__builtin_amdgcn_s_memrealtime() - t0 > 2000000ull) {
                    if (lane == 0) { unsigned expect = 0u; __hip_atomic_compare_exchange_strong(tmo + 1, &expect, code | (unsigned)(u.pm & 0xff), __ATOMIC_RELAXED, __ATOMIC_RELAXED, __HIP_MEMORY_SCOPE_AGENT);
                                     __hip_atomic_store(tmo, 1u, __ATOMIC_RELAXED, __HIP_MEMORY_SCOPE_AGENT); }
                    dead = true; break; }
                __builtin_amdgcn_s_sleep(2);
            }
            __builtin_amdgcn_fence(__ATOMIC_ACQUIRE, "agent");
            if (lane == 0) flag[0] = dead ? 1u : 0u;
        }
        asm volatile("s_waitcnt vmcnt(0) lgkmcnt(0)" ::: "memory"); __builtin_amdgcn_s_barrier(); asm volatile("" ::: "memory");
        const bool bad = flag[0] != 0u;
        if (lane < 32) {
            const unsigned long long* slot = (const unsigned long long*)xbuf + (size_t)(u.pm * BM + row) * 4; float mt[4], m2[4]; float ms = 0.f;
#pragma unroll
            for (int t = 0; t < 4; ++t) { if (t < ntn) { const unsigned long long w = __hip_atomic_load(slot + t, __ATOMIC_RELAXED, __HIP_MEMORY_SCOPE_AGENT); mt[t] = __uint_as_float((unsigned)w); m2[t] = __uint_as_float((unsigned)(w >> 32)); } else { mt[t] = 0.f; m2[t] = 0.f; } ms += mt[t]; }
            const float mean = ms / (float)ntn; float q = 0.f;
#pragma unroll
            for (int t = 0; t < 4; ++t) if (t < ntn) { const float dm = mt[t] - mean; q += m2[t] + 256.0f * dm * dm; }
            S[row] = (f32x2v){mean, 1.0f / sqrtf(q / (256.0f * (float)ntn) + eps)};
        }
        asm volatile("s_waitcnt lgkmcnt(0)" ::: "memory"); __builtin_amdgcn_s_barrier(); asm volatile("" ::: "memory");
        return bad;
    }
};
struct EpiLnRes {
    static constexpr bool PERM = false, AFTER_DRAIN = true;
    const float* base; float* out; int ldc; const float* bias; PanelStats st; unsigned poison;
    __device__ __forceinline__ void fused(f32x4 (&acc)[2][2][4][2], const Unit& u, int wr, int wc, int fr, int fq, PG8_LAS unsigned char* lds, int wid, int lane) const {
        typedef float f32x2v __attribute__((ext_vector_type(2)));
        const PG8_LAS f32x2v* S = (const PG8_LAS f32x2v*)(lds + 8192);
        const int col0 = u.pn * BM + wc * 32 + 4 * fq;
#pragma unroll
        for (int bj = 0; bj < 2; ++bj)
#pragma unroll
            for (int n = 0; n < 2; ++n) { const f32x4 bv = bias ? *(const f32x4*)(bias + col0 + bj * HALF + n * 16) : (f32x4){0.f, 0.f, 0.f, 0.f};
#pragma unroll
                for (int ai = 0; ai < 2; ++ai)
#pragma unroll
                    for (int m = 0; m < 4; ++m) acc[ai][bj][m][n] += bv; }
        f32x4 pre[4][2][2];
#pragma unroll
        for (int m = 0; m < 4; ++m) { const size_t off = (size_t)(u.pm * BM + wr * 64 + m * 16 + fr) * ldc + col0;
#pragma unroll
            for (int bj = 0; bj < 2; ++bj)
#pragma unroll
                for (int n = 0; n < 2; ++n) pre[m][bj][n] = *(const f32x4*)(base + off + bj * HALF + n * 16); }
        const bool bad = st.run(acc, u, wr, wc, fr, fq, lds, wid, lane) || poison != 0u;
        const float qnan = __builtin_nanf("");
#pragma unroll
        for (int ai = 0; ai < 2; ++ai)
#pragma unroll
            for (int m = 0; m < 4; ++m) { const int r = ai * HALF + wr * 64 + m * 16 + fr; const f32x2v sr = S[r]; const size_t off = (size_t)(u.pm * BM + r) * ldc + col0;
#pragma unroll
                for (int bj = 0; bj < 2; ++bj)
#pragma unroll
                    for (int n = 0; n < 2; ++n) { const f32x4 bs = ai == 0 ? pre[m][bj][n] : *(const f32x4*)(base + off + bj * HALF + n * 16); f32x4 o = bs + (acc[ai][bj][m][n] - sr.x) * sr.y;
                        if (bad) o = (f32x4){qnan, qnan, qnan, qnan}; *(f32x4*)(out + off + bj * HALF + n * 16) = o; }
                if (m & 1) asm volatile("" ::: "memory"); }
    }
};
struct EpiLnResLn {
    static constexpr bool PERM = false, AFTER_DRAIN = true;
    const float* base; float* out; bf16_t* xn; int ldc; const float* bias; PanelStats st1, st2; unsigned poison;
    __device__ __forceinline__ void fused(f32x4 (&acc)[2][2][4][2], const Unit& u, int wr, int wc, int fr, int fq, PG8_LAS unsigned char* lds, int wid, int lane) const {
        typedef float f32x2v __attribute__((ext_vector_type(2))); typedef unsigned u32x2v __attribute__((ext_vector_type(2)));
        const PG8_LAS f32x2v* S = (const PG8_LAS f32x2v*)(lds + 8192);
        const int col0 = u.pn * BM + wc * 32 + 4 * fq;
#pragma unroll
        for (int bj = 0; bj < 2; ++bj)
#pragma unroll
            for (int n = 0; n < 2; ++n) { const f32x4 bv = bias ? *(const f32x4*)(bias + col0 + bj * HALF + n * 16) : (f32x4){0.f, 0.f, 0.f, 0.f};
#pragma unroll
                for (int ai = 0; ai < 2; ++ai)
#pragma unroll
                    for (int m = 0; m < 4; ++m) acc[ai][bj][m][n] += bv; }
        bool bad = st1.run(acc, u, wr, wc, fr, fq, lds, wid, lane) || poison != 0u;
        const float qnan = __builtin_nanf("");
#pragma unroll
        for (int ai = 0; ai < 2; ++ai)
#pragma unroll
            for (int m = 0; m < 4; ++m) { const int r = ai * HALF + wr * 64 + m * 16 + fr; const f32x2v sr = S[r]; const size_t off = (size_t)(u.pm * BM + r) * ldc + col0;
#pragma unroll
                for (int bj = 0; bj < 2; ++bj)
#pragma unroll
                    for (int n = 0; n < 2; ++n) { const f32x4 bs = *(const f32x4*)(base + off + bj * HALF + n * 16); acc[ai][bj][m][n] = bs + (acc[ai][bj][m][n] - sr.x) * sr.y; }
                asm volatile("" : "+v"(acc[ai][0][m][0]), "+v"(acc[ai][0][m][1]), "+v"(acc[ai][1][m][0]), "+v"(acc[ai][1][m][1]));
                if (m & 1) asm volatile("" ::: "memory"); }
        const bool bad1 = bad;
        bad = st2.run(acc, u, wr, wc, fr, fq, lds, wid, lane) || bad;
#pragma unroll
        for (int ai = 0; ai < 2; ++ai)
#pragma unroll
            for (int m = 0; m < 4; ++m) { const int r = ai * HALF + wr * 64 + m * 16 + fr; const f32x2v sr = S[r]; const size_t off = (size_t)(u.pm * BM + r) * ldc + col0;
#pragma unroll
                for (int bj = 0; bj < 2; ++bj)
#pragma unroll
                    for (int n = 0; n < 2; ++n) { const f32x4 x1 = acc[ai][bj][m][n]; *(f32x4*)(out + off + bj * HALF + n * 16) = bad1 ? (f32x4){qnan, qnan, qnan, qnan} : x1;
                        const f32x4 o = (x1 - sr.x) * sr.y; u32x2v w; w.x = cvt_pk_bf16(o[0], o[1]); w.y = cvt_pk_bf16(o[2], o[3]);
                        if (bad) { w.x = 0x7fc07fc0u; w.y = 0x7fc07fc0u; } *(u32x2v*)(xn + off + bj * HALF + n * 16) = w; }
                asm volatile("" ::: "memory"); }
    }
};

template <class Epi, class Sched, bool ALIGN_EPI = false, bool SP2 = false>
__device__ __forceinline__ void gemm_phase(PG8_LAS unsigned char* lds, const Gemm g, const Sched& S, const Epi& E, const int wid  ) {
    int lane; asm volatile("v_mbcnt_lo_u32_b32 %0, -1, 0\n\tv_mbcnt_hi_u32_b32 %0, -1, %0" : "=v"(lane));
    const int tid = wid * 64 + lane, wr = wid >> 2, wc = wid & 3, fr = lane & 15, fq = lane >> 4;
    const int K = g.K, nt = K / BK;
    unsigned voffA[2], voffB[2];
#pragma unroll
    for (int i = 0; i < 2; ++i) { int R, C; stage_rc(tid * 16 + i * 8192, R, C); const int Rb = Epi::PERM ? ((R & ~31) + perm32(R & 31)) : R;
        voffA[i] = (unsigned)(R * K + C) * 2u; voffB[i] = (unsigned)(Rb * K + C) * 2u; }
    const size_t kstep = (size_t)(BK * 2);
    const size_t hstep = (size_t)HALF * K * 2;
    const size_t tstep = 2 * hstep;
    const unsigned ldsw = (unsigned)wid * 1024u;
    const int aoff = lds_byte(wr * 64 + fr, fq * 8), boff = lds_byte(wc * 32 + fr, fq * 8);
#define PG8_SA(b, h) (((b) * 2 + (h)) * HTB)
#define PG8_SB(b, h) ((4 + (b) * 2 + (h)) * HTB)
#define PG8_STAGE(bufoff, gbase, voff) do { _Pragma("unroll") for (int _i = 0; _i < 2; ++_i) \
        __builtin_amdgcn_global_load_lds((const unsigned*)((const char*)(gbase) + (voff)[_i]), (PG8_LAS unsigned*)(lds + (bufoff) + ldsw + _i * 8192), 16, 0, 0); } while (0)
#define PG8_LDA(dst, b, h) do { _Pragma("unroll") for (int m = 0; m < 4; ++m) _Pragma("unroll") for (int k = 0; k < 2; ++k) dst[m][k] = *(const PG8_LAS bf16x8*)(lds + PG8_SA(b, h) + aoff + m * 2048 + k * 1024); } while (0)
#define PG8_LDB(dst, b, h) do { _Pragma("unroll") for (int n = 0; n < 2; ++n) _Pragma("unroll") for (int k = 0; k < 2; ++k) dst[n][k] = *(const PG8_LAS bf16x8*)(lds + PG8_SB(b, h) + boff + n * 2048 + k * 1024); } while (0)
#define PG8_MMA(ai, bj, At, Bt) do { __builtin_amdgcn_s_setprio(1); _Pragma("unroll") for (int m = 0; m < 4; ++m) _Pragma("unroll") for (int n = 0; n < 2; ++n) _Pragma("unroll") for (int k = 0; k < 2; ++k) \
        acc[ai][bj][m][n] = __builtin_amdgcn_mfma_f32_16x16x32_bf16(Bt[n][k], At[m][k], acc[ai][bj][m][n], 0, 0, 0); __builtin_amdgcn_s_setprio(0); } while (0)
#define PG8_WAIT_V(n) asm volatile("s_waitcnt vmcnt(" #n ")" ::: "memory")
#define PG8_WAIT_L(n) asm volatile("s_waitcnt lgkmcnt(" #n ")" ::: "memory")
#define PG8_BAR __builtin_amdgcn_s_barrier()
#define PG8_SCHED __builtin_amdgcn_sched_barrier(0)
    Unit cur, nxt; int ui = 0;
    if (!S.next(0, cur)) return;
    f32x4 acc[2][2][4][2];
#pragma unroll
    for (int a = 0; a < 2; ++a)
#pragma unroll
        for (int b = 0; b < 2; ++b)
#pragma unroll
            for (int m = 0; m < 4; ++m)
#pragma unroll
                for (int n = 0; n < 2; ++n) acc[a][b][m][n] = (f32x4){0.f, 0.f, 0.f, 0.f};
    bf16x8 At[4][2], B0[2][2], B1[2][2];
    const char* cA = (const char*)g.A + (size_t)cur.pm * tstep; const char* cB = (const char*)g.Bt + (size_t)cur.pn * tstep + (size_t)cur.be * g.bstride;
    S.a_ready(cur);
    if constexpr (SP2) {
        PG8_STAGE(PG8_SB(0, 0), cB, voffB); PG8_STAGE(PG8_SB(0, 1), cB + hstep, voffB); PG8_STAGE(PG8_SA(0, 0), cA, voffA); PG8_STAGE(PG8_SA(0, 1), cA + hstep, voffA);
        if (wr == 1) PG8_BAR;
        PG8_WAIT_V(2); PG8_BAR;
        PG8_STAGE(PG8_SB(1, 0), cB + kstep, voffB); PG8_STAGE(PG8_SA(1, 0), cA + kstep, voffA); PG8_STAGE(PG8_SB(1, 1), cB + hstep + kstep, voffB);
        PG8_WAIT_V(6); PG8_BAR;
    } else {
        PG8_STAGE(PG8_SB(0, 0), cB, voffB); PG8_STAGE(PG8_SA(0, 0), cA, voffA); PG8_STAGE(PG8_SB(0, 1), cB + hstep, voffB); PG8_STAGE(PG8_SA(0, 1), cA + hstep, voffA);
        if (wr == 1) PG8_BAR;
        PG8_WAIT_V(4); PG8_BAR;
        PG8_STAGE(PG8_SB(1, 0), cB + kstep, voffB); PG8_STAGE(PG8_SA(1, 0), cA + kstep, voffA); PG8_STAGE(PG8_SB(1, 1), cB + hstep + kstep, voffB);
        PG8_WAIT_V(6); PG8_BAR;
    }
    for (;;) {
        const bool has_next = S.next(ui + 1, nxt);
        const char* nA = has_next ? (const char*)g.A + (size_t)nxt.pm * tstep : cA; const char* nB = has_next ? (const char*)g.Bt + (size_t)nxt.pn * tstep + (size_t)nxt.be * g.bstride : cB;
        for (int t = 0; t < nt; t += 2) {
            const bool last = (t == nt - 2);
            const char* a1 = cA + (size_t)(t + 1) * kstep;
            const char* a2 = last ? nA : cA + (size_t)(t + 2) * kstep; const char* b2 = last ? nB : cB + (size_t)(t + 2) * kstep;
            const char* a3 = a2 + kstep; const char* b3 = b2 + kstep;
            if (last && has_next) S.a_ready(nxt);
            if constexpr (SP2) {
            PG8_LDB(B0, 0, 0); PG8_LDB(B1, 0, 1); PG8_SCHED; PG8_LDA(At, 0, 0); PG8_STAGE(PG8_SA(1, 1), a1 + hstep, voffA);
            PG8_WAIT_V(8); PG8_WAIT_L(0); PG8_BAR; PG8_MMA(0, 0, At, B0); PG8_MMA(0, 1, At, B1); PG8_BAR; PG8_SCHED;
            PG8_LDA(At, 0, 1); PG8_STAGE(PG8_SB(0, 0), b2, voffB); PG8_STAGE(PG8_SB(0, 1), b2 + hstep, voffB); PG8_STAGE(PG8_SA(0, 0), a2, voffA);
            PG8_WAIT_V(8); PG8_WAIT_L(0); PG8_BAR; PG8_MMA(1, 0, At, B0); PG8_MMA(1, 1, At, B1); PG8_BAR; PG8_SCHED;
            PG8_LDB(B0, 1, 0); PG8_LDB(B1, 1, 1); PG8_SCHED; PG8_LDA(At, 1, 0); PG8_STAGE(PG8_SA(0, 1), a2 + hstep, voffA);
            PG8_WAIT_V(8); PG8_WAIT_L(0); PG8_BAR; PG8_MMA(0, 0, At, B0); PG8_MMA(0, 1, At, B1); PG8_BAR; PG8_SCHED;
            PG8_LDA(At, 1, 1); PG8_STAGE(PG8_SB(1, 0), b3, voffB); PG8_STAGE(PG8_SB(1, 1), b3 + hstep, voffB); PG8_STAGE(PG8_SA(1, 0), a3, voffA);
            PG8_WAIT_V(8); PG8_WAIT_L(0); PG8_BAR; PG8_MMA(1, 0, At, B0); PG8_MMA(1, 1, At, B1); PG8_BAR; PG8_SCHED;
            } else {
            PG8_LDB(B0, 0, 0); PG8_SCHED; PG8_LDA(At, 0, 0); PG8_STAGE(PG8_SA(1, 1), a1 + hstep, voffA);
            PG8_WAIT_L(8); PG8_BAR; PG8_WAIT_L(0); PG8_MMA(0, 0, At, B0); PG8_BAR; PG8_SCHED;
            PG8_LDB(B1, 0, 1); PG8_STAGE(PG8_SB(0, 0), b2, voffB);
            PG8_BAR; PG8_WAIT_L(0); PG8_MMA(0, 1, At, B1); PG8_BAR;
            PG8_LDA(At, 0, 1); PG8_STAGE(PG8_SA(0, 0), a2, voffA);
            PG8_BAR; PG8_WAIT_L(0); PG8_MMA(1, 0, At, B0); PG8_BAR; PG8_SCHED;
            PG8_STAGE(PG8_SB(0, 1), b2 + hstep, voffB);
            PG8_WAIT_V(6); PG8_BAR; PG8_MMA(1, 1, At, B1); PG8_BAR;
            PG8_LDB(B0, 1, 0); PG8_SCHED; PG8_LDA(At, 1, 0); PG8_STAGE(PG8_SA(0, 1), a2 + hstep, voffA);
            PG8_WAIT_L(8); PG8_BAR; PG8_WAIT_L(0); PG8_MMA(0, 0, At, B0); PG8_BAR; PG8_SCHED;
            PG8_LDB(B1, 1, 1); PG8_STAGE(PG8_SB(1, 0), b3, voffB);
            PG8_BAR; PG8_WAIT_L(0); PG8_MMA(0, 1, At, B1); PG8_BAR;
            PG8_LDA(At, 1, 1); PG8_STAGE(PG8_SA(1, 0), a3, voffA);
            PG8_BAR; PG8_WAIT_L(0); PG8_MMA(1, 0, At, B0); PG8_BAR; PG8_SCHED;
            PG8_STAGE(PG8_SB(1, 1), b3 + hstep, voffB);
            PG8_WAIT_V(6); PG8_BAR; PG8_MMA(1, 1, At, B1); PG8_BAR;
            }
        }
        if constexpr (ALIGN_EPI) { if (wr == 0) PG8_BAR; }
        if constexpr (!Epi::AFTER_DRAIN) { E(acc, cur, wr, wc, fr, fq); S.done(cur); }
        if (!has_next) break;
#pragma unroll
        for (int a = 0; a < 2; ++a)
#pragma unroll
            for (int b = 0; b < 2; ++b)
#pragma unroll
                for (int m = 0; m < 4; ++m)
#pragma unroll
                    for (int n = 0; n < 2; ++n) acc[a][b][m][n] = (f32x4){0.f, 0.f, 0.f, 0.f};
        cur = nxt; cA = nA; cB = nB; ++ui;
        if constexpr (ALIGN_EPI) { if (wr == 1) PG8_BAR; }
    }
    PG8_WAIT_V(0);
    if constexpr (!ALIGN_EPI) { if (wr == 0) PG8_BAR; }
    PG8_BAR;
    if constexpr (Epi::AFTER_DRAIN) { E.fused(acc, cur, wr, wc, fr, fq, lds, wid, lane); S.done(cur); }
#undef PG8_SA
#undef PG8_SB
#undef PG8_STAGE
#undef PG8_LDA
#undef PG8_LDB
#undef PG8_MMA
#undef PG8_WAIT_V
#undef PG8_WAIT_L
#undef PG8_BAR
#undef PG8_SCHED
}
}
#define GAS __attribute__((address_space(1)))
#define LAS __attribute__((address_space(3)))
typedef unsigned short bf16;
typedef unsigned v4u __attribute__((ext_vector_type(4)));
typedef float f32x4 __attribute__((ext_vector_type(4)));
typedef short bf16x8 __attribute__((ext_vector_type(8)));
typedef GAS unsigned gu32;
typedef GAS unsigned long long gu64;
#define RLX_AGENT __ATOMIC_RELAXED, __HIP_MEMORY_SCOPE_AGENT
#define LDS_WAIT() asm volatile("s_waitcnt lgkmcnt(0)" ::: "memory")
#define VM_WAIT() asm volatile("s_waitcnt vmcnt(0)" ::: "memory")
__device__ __forceinline__ unsigned long long rt() { return __builtin_amdgcn_s_memrealtime(); }
__device__ __forceinline__ unsigned f2bf(float f) { unsigned u = __builtin_bit_cast(unsigned, f); return (u + 0x7fffu + ((u >> 16) & 1u)) >> 16; }
__device__ __forceinline__ unsigned pk2(float lo, float hi) { return f2bf(lo) | (f2bf(hi) << 16); }

#define XB_TMO      128
#define XB_XCNT(j)  (256  + 64 * (j))
#define XB_XSUB(j)  (1280 + 64 * (j))
#define XB_XGEN(j)  (2304 + 64 * (j))
#define XB_TOP      3328
#define XB_TOPGEN   3392
#define XCD_BAR_WORDS 3456
#define XB_SPIN_CAP (1u << 18)

__device__ __forceinline__ unsigned xb_ld(unsigned* p)              { return __hip_atomic_load(p, __ATOMIC_RELAXED, __HIP_MEMORY_SCOPE_AGENT); }
__device__ __forceinline__ unsigned xb_add(unsigned* p, unsigned v) { return __hip_atomic_fetch_add(p, v, __ATOMIC_RELAXED, __HIP_MEMORY_SCOPE_AGENT); }
__device__ __forceinline__ unsigned xb_xcc_id() { return (unsigned)__builtin_amdgcn_s_getreg((3 << 11) | 20) & 0xFu; }
#define XB_SPIN(cond, bar) do { unsigned _sp = 0; while (cond) { __builtin_amdgcn_s_sleep(1); \
    if ((++_sp & 255u) == 0u) { if (xb_ld(&(bar)[XB_TMO])) break; if (_sp > XB_SPIN_CAP) { atomicAdd(&(bar)[XB_TMO], 1u); break; } } } } while (0)

struct XcdBarrier {
    unsigned* bar; unsigned x;
    volatile LAS unsigned* st;
};

__device__ __forceinline__ XcdBarrier xcd_barrier_post(unsigned* bar, volatile LAS unsigned* st, bool leader) {
    XcdBarrier b; b.bar = bar; b.x = xb_xcc_id(); b.st = st;
    if (leader) (void)xb_add(&bar[XB_XCNT(b.x)], 1u);
    return b;
}
__device__ __forceinline__ void xcd_barrier_complete(unsigned* bar, unsigned x, unsigned& nloc, unsigned& nx) {
    const unsigned G = gridDim.x * gridDim.y * gridDim.z;
    unsigned sum, cnt, mine, sp = 0u;
    for (;;) {
        sum = 0u; cnt = 0u; mine = 0u;
#pragma unroll
        for (unsigned j = 0; j < 16; ++j) { const unsigned c = xb_ld(&bar[XB_XCNT(j)]); sum += c; cnt += (c > 0u) ? 1u : 0u; mine = (j == x) ? c : mine; }
        if (sum == G) break;
        __builtin_amdgcn_s_sleep(1);
        if ((++sp & 255u) == 0u) { if (xb_ld(&bar[XB_TMO])) break; if (sp > XB_SPIN_CAP) { atomicAdd(&bar[XB_TMO], 1u); break; } }
    }
    nloc = mine > 0u ? mine : 1u; nx = cnt > 0u ? cnt : 1u;
}

__device__ __forceinline__ void xcd_barrier(const XcdBarrier& b, bool leader) {
    asm volatile("s_waitcnt vmcnt(0)" ::: "memory");
    __syncthreads();
    if (leader) {
        unsigned* bar = b.bar;
        __builtin_amdgcn_s_waitcnt(0);
        unsigned nloc = b.st[0], nx = b.st[1];
        if (nloc == 0u) { xcd_barrier_complete(bar, b.x, nloc, nx); b.st[0] = nloc; b.st[1] = nx; }
        const unsigned old = xb_add(&bar[XB_XSUB(b.x)], 1u);
        const unsigned gen = old / nloc;
        if (old + 1u == (gen + 1u) * nloc) {
            __builtin_amdgcn_fence(__ATOMIC_RELEASE, "agent");
            asm volatile("s_waitcnt vmcnt(0)" ::: "memory");
            const unsigned og = xb_add(&bar[XB_TOP], 1u);
            const unsigned tg = og / nx;
            if (og + 1u == (tg + 1u) * nx) xb_add(&bar[XB_TOPGEN], 1u);
            else XB_SPIN(xb_ld(&bar[XB_TOPGEN]) == tg, bar);
            __builtin_amdgcn_fence(__ATOMIC_ACQUIRE, "agent");
            xb_add(&bar[XB_XGEN(b.x)], 1u);
            asm volatile("s_waitcnt vmcnt(0)" ::: "memory");
        } else {
            XB_SPIN(xb_ld(&bar[XB_XGEN(b.x)]) == gen, bar);
            __builtin_amdgcn_fence(__ATOMIC_ACQUIRE, "agent");
            asm volatile("s_waitcnt vmcnt(0)" ::: "memory");
        }
    }
    __syncthreads();
}
constexpr int NWAVES = 8;
constexpr size_t MiB = 1u << 20;
constexpr size_t WS_CTL = 0, CTL_ZERO_BYTES = 1 * MiB;
constexpr size_t WS_TAB = 1 * MiB;
constexpr size_t WS_WIN = 4 * MiB, WS_WOUT = 10 * MiB, WS_WGATE = 12 * MiB, WS_WPROJ = 14 * MiB, WS_WUP = 16 * MiB, WS_WDOWN = 80 * MiB;
constexpr size_t WS_N1 = 112 * MiB;
constexpr size_t WS_QKVZ = 144 * MiB;
constexpr size_t WS_U = 208 * MiB;
constexpr size_t WS_AB = 224 * MiB;
constexpr size_t WS_PBF = 226 * MiB;
constexpr int NIN_T = 3072;
constexpr int CW_TMO = 0, CW_CODE = 1, CW_BAR = 4096, CW_READY = 65536, CW_PROG = 131072;
constexpr int RING_OFF = 0, RING_BYTES = 131072, LDSCTL_OFF = RING_BYTES, MISC_OFF = LDSCTL_OFF + 320, LDS_BYTES = 163840;

struct Frame {
    LAS unsigned char* lds; volatile LAS unsigned* MISC; gu32* ctl;
    int wave, vcu, G;
};
__device__ __forceinline__ int lane_now() { int l; asm volatile("v_mbcnt_lo_u32_b32 %0, -1, 0\n\tv_mbcnt_hi_u32_b32 %0, -1, %0" : "=v"(l)); return l; }
template <int CTRL, int ROW_MASK> __device__ __forceinline__ float dpp_add(float v) {
    return v + __builtin_bit_cast(float, __builtin_amdgcn_update_dpp(0, __builtin_bit_cast(int, v), CTRL, ROW_MASK, 0xF, true));
}
__device__ __forceinline__ float wave_sum_f(float v) {
    v = dpp_add<0xB1, 0xF>(v);
    v = dpp_add<0x4E, 0xF>(v);
    v = dpp_add<0x141, 0xF>(v);
    v = dpp_add<0x140, 0xF>(v);
    v = dpp_add<0x142, 0xA>(v);
    v = dpp_add<0x143, 0xC>(v);
    return __builtin_bit_cast(float, __builtin_amdgcn_readlane(__builtin_bit_cast(int, v), 63));
}
__device__ __forceinline__ float fsigmoid(float x) { return __builtin_amdgcn_rcpf(1.f + __expf(-x)); }
__device__ __forceinline__ float fsilu(float x) { return x * __builtin_amdgcn_rcpf(1.f + __expf(-x)); }

struct MapId  { __device__ __forceinline__ int operator()(int n) const { return n; } };
struct MapWin { __device__ __forceinline__ int operator()(int n) const { if (n < 2048) return n; const int j = n - 2048; return O4 + (j >> 3) * 4 + (j & 3) + ((j >> 2) & 1) * CCH; } };
struct MapWup { __device__ __forceinline__ int operator()(int n) const { return (n >> 3) * 4 + (n & 3) + ((n >> 2) & 1) * DEXP; } };

template <class Map>
__device__ __forceinline__ void p0_transpose_item(const float* W, int K, int Nsrc, int Ndst, bf16* WT, LAS float* scr, int item, int lane, Map map) {
    const int nblk = Ndst / 32, kb = item / nblk, nb = item % nblk, k0 = 64 * kb, n0 = 32 * nb;
    const int sc = map(n0 + (lane & 31));
#pragma unroll 8
    for (int i = 0; i < 32; ++i) { const int kk = 2 * i + (lane >> 5); scr[kk * 33 + (lane & 31)] = W[(size_t)(k0 + kk) * Nsrc + sc]; }
    LDS_WAIT(); asm volatile("" ::: "memory");
    const int c = lane & 7;
#pragma unroll
    for (int j = 0; j < 4; ++j) { const int n = (lane >> 3) + 8 * j; const LAS float* s = scr + (8 * c) * 33 + n;
        v4u o; o.x = pk2(s[0 * 33], s[1 * 33]); o.y = pk2(s[2 * 33], s[3 * 33]); o.z = pk2(s[4 * 33], s[5 * 33]); o.w = pk2(s[6 * 33], s[7 * 33]);
        *(GAS v4u*)(WT + (size_t)(n0 + n) * K + k0 + 8 * c) = o; }
    LDS_WAIT(); asm volatile("" ::: "memory");
}

struct Ptrs {
    const float *x, *p, *g_mix, *w_in, *w_conv_qkv, *a_log, *dt_bias, *g_gdn_out, *b_glu, *w_conv_dw, *b_conv_dw, *ln_g, *ln_b, *w_out, *g_moe, *w_gr, *w_er, *w_up, *w_down, *g_ple, *w_pg, *w_pp, *g_final;
    float* out; unsigned char* ws;
};

__device__ __forceinline__ void p0_prologue(Frame& F, const Ptrs& P) {
    const int lane = lane_now(), tid = F.wave * 64 + lane;
    LAS float* scr = (LAS float*)(F.lds + RING_OFF + F.wave * 16384);
    const int gw = F.vcu * NWAVES + F.wave, NGW = F.G * NWAVES;
    bf16* Win_t = (bf16*)(P.ws + WS_WIN); bf16* Wout_t = (bf16*)(P.ws + WS_WOUT); bf16* Wgate_t = (bf16*)(P.ws + WS_WGATE); bf16* Wproj_t = (bf16*)(P.ws + WS_WPROJ);
    bf16* Wup_t = (bf16*)(P.ws + WS_WUP); bf16* Wdown_t = (bf16*)(P.ws + WS_WDOWN);
    constexpr int I_IN = 16 * (NIN_T / 32), I_SQ = 16 * 32, I_PR = 4 * 32, I_UP1 = 16 * 16, I_UP = NEXP * I_UP1, I_DN1 = 4 * 32, I_DN = NEXP * I_DN1;
    constexpr int NITEMS = I_IN + I_SQ + I_PR;
    (void)Wgate_t; (void)Wup_t; (void)Wdown_t; (void)I_UP; (void)I_DN;
    for (int it = gw; it < NITEMS; it += NGW) {
        int r = it;
        if (r < I_IN) { p0_transpose_item(P.w_in, DM, INC, NIN_T, Win_t, scr, r, lane, MapWin()); continue; } r -= I_IN;
        if (r < I_SQ) { p0_transpose_item(P.w_out, DM, DM, DM, Wout_t, scr, r, lane, MapId()); continue; } r -= I_SQ;
        p0_transpose_item(P.w_pp, PLE, DM, DM, Wproj_t, scr, r, lane, MapId());
    }
    __syncthreads();
    LAS float* wabT = (LAS float*)(F.lds + RING_OFF);
    for (int idx = tid; idx < 8 * DM; idx += NWAVES * 64) { const int k = idx >> 3, c = idx & 7; wabT[c * DM + k] = P.w_in[(size_t)k * INC + O2 + c]; }
    __syncthreads();
    bf16* N1 = (bf16*)(P.ws + WS_N1); float* AB = (float*)(P.ws + WS_AB);
    for (int m = gw; m < M; m += NGW) {
        const GAS f32x4* xr = (const GAS f32x4*)(P.x + (size_t)m * DM) + lane;
        f32x4 v[4]; float s = 0.f;
#pragma unroll
        for (int j = 0; j < 4; ++j) { v[j] = xr[64 * j]; s += (v[j].x * v[j].x + v[j].y * v[j].y) + (v[j].z * v[j].z + v[j].w * v[j].w); }
        const float r = rsqrtf(wave_sum_f(s) * (1.f / DM) + EPS);
        float ab[8];
#pragma unroll
        for (int c = 0; c < 8; ++c) ab[c] = 0.f;
#pragma unroll
        for (int j = 0; j < 4; ++j) { const f32x4 g = ((const GAS f32x4*)P.g_mix)[64 * j + lane]; v[j] = v[j] * r * g;
#pragma unroll
            for (int c = 0; c < 8; ++c) { const f32x4 w = *(const LAS f32x4*)(wabT + c * DM + 256 * j + 4 * lane); ab[c] += (v[j].x * w.x + v[j].y * w.y) + (v[j].z * w.z + v[j].w * w.w); } }
        GAS unsigned long long* o8 = (GAS unsigned long long*)(N1 + (size_t)m * DM) + lane;
#pragma unroll
        for (int j = 0; j < 4; ++j) o8[64 * j] = (unsigned long long)pk2(v[j].x, v[j].y) | ((unsigned long long)pk2(v[j].z, v[j].w) << 32);
#pragma unroll
        for (int c = 0; c < 8; ++c) ab[c] = wave_sum_f(ab[c]);
        if (lane == 0) { *(GAS f32x4*)(AB + (size_t)m * 8) = (f32x4){ab[0], ab[1], ab[2], ab[3]}; *(GAS f32x4*)(AB + (size_t)m * 8 + 4) = (f32x4){ab[4], ab[5], ab[6], ab[7]}; }
    }
    { bf16* Wr = (bf16*)(P.ws + 15 * MiB);
      for (int i = F.vcu * (NWAVES * 64) + tid; i < 80 * DM; i += F.G * NWAVES * 64) { const int n = i >> 10, k = i & 1023;
          const float v = n < NGRP ? P.w_gr[k * NGRP + n] : (n < NGRP + NEXP ? P.w_er[k * NEXP + n - NGRP] : 0.f); Wr[i] = (bf16)f2bf(v); } }
    bf16* PB = (bf16*)(P.ws + WS_PBF);
    for (size_t i = (size_t)F.vcu * (NWAVES * 64) + tid; i < (size_t)M * PLE / 8; i += (size_t)F.G * NWAVES * 64) {
        const f32x4 a = ((const GAS f32x4*)P.p)[2 * i], b = ((const GAS f32x4*)P.p)[2 * i + 1];
        v4u o; o.x = pk2(a.x, a.y); o.y = pk2(a.z, a.w); o.z = pk2(b.x, b.y); o.w = pk2(b.z, b.w);
        ((GAS v4u*)PB)[i] = o;
    }
}

__device__ __forceinline__ void p3_convert_late(Frame& F, const Ptrs& P, int idx, int cnt) {
    const int lane = lane_now();
    LAS float* scr = (LAS float*)(F.lds + RING_OFF + F.wave * 16384);
    const int gw = idx * NWAVES + F.wave, NGW = cnt * NWAVES;
    bf16* Wgate_t = (bf16*)(P.ws + WS_WGATE); bf16* Wup_t = (bf16*)(P.ws + WS_WUP); bf16* Wdown_t = (bf16*)(P.ws + WS_WDOWN);
    constexpr int I_SQ = 16 * 32, I_UP1 = 16 * 16, I_UP = NEXP * I_UP1, I_DN1 = 4 * 32, I_DN = NEXP * I_DN1;
    constexpr int NITEMS = I_SQ + I_UP + I_DN;
    for (int it = gw; it < NITEMS; it += NGW) {
        int r = it;
        if (r < I_SQ) { p0_transpose_item(P.w_pg, DM, DM, DM, Wgate_t, scr, r, lane, MapId()); continue; } r -= I_SQ;
        if (r < I_UP) { const int e = r / I_UP1; p0_transpose_item(P.w_up + (size_t)e * DM * 512, DM, 512, 512, Wup_t + (size_t)e * 512 * DM, scr, r % I_UP1, lane, MapWup()); continue; } r -= I_UP;
        { const int e = r / I_DN1; p0_transpose_item(P.w_down + (size_t)e * DEXP * DM, DEXP, DM, DM, Wdown_t + (size_t)e * DM * DEXP, scr, r % I_DN1, lane, MapId()); }
    }
    asm volatile("s_waitcnt lgkmcnt(0)" ::: "memory"); __builtin_amdgcn_s_barrier(); asm volatile("" ::: "memory");
}

struct EpiIn {
    static constexpr bool PERM = true, AFTER_DRAIN = false;
    pg8::bf16_t* QKVZ; pg8::bf16_t* U; const float* b_glu;
    __device__ __forceinline__ void operator()(const pg8::f32x4 (&acc)[2][2][4][2], const pg8::Unit& u, int wr, int wc, int fr, int fq) const {
        using namespace pg8;
        const int row0 = u.pm * BM + wr * 64 + fr;
        if (u.pn < 8) {
            const int col0 = u.pn * BM + wc * 32 + 8 * fq;
#pragma unroll
            for (int ai = 0; ai < 2; ++ai)
#pragma unroll
                for (int m = 0; m < 4; ++m) { bf16_t* rowp = QKVZ + (size_t)(row0 + ai * HALF + m * 16) * 2048 + col0;
#pragma unroll
                    for (int bj = 0; bj < 2; ++bj) { const f32x4 v0 = acc[ai][bj][m][0], v1 = acc[ai][bj][m][1];
                        u32x4 w; w.x = cvt_pk_bf16(v0[0], v0[1]); w.y = cvt_pk_bf16(v0[2], v0[3]); w.z = cvt_pk_bf16(v1[0], v1[1]); w.w = cvt_pk_bf16(v1[2], v1[3]);
                        *(u32x4*)(rowp + bj * HALF) = w; } }
        } else {
            const int hid0 = (u.pn - 8) * 128 + wc * 16 + 4 * fq;
            f32x4 ba[2], bg[2];
#pragma unroll
            for (int bj = 0; bj < 2; ++bj) { ba[bj] = *(const f32x4*)(b_glu + hid0 + bj * 64); bg[bj] = *(const f32x4*)(b_glu + CCH + hid0 + bj * 64); }
#pragma unroll
            for (int ai = 0; ai < 2; ++ai)
#pragma unroll
                for (int m = 0; m < 4; ++m) { bf16_t* rowp = U + (size_t)(row0 + ai * HALF + m * 16) * CCH + hid0;
#pragma unroll
                    for (int bj = 0; bj < 2; ++bj) { const f32x4 a = acc[ai][bj][m][0] + ba[bj], g = acc[ai][bj][m][1] + bg[bj];
                        typedef unsigned u32x2v __attribute__((ext_vector_type(2)));
                        u32x2v w; w.x = cvt_pk_bf16(a[0] * fsigmoid(g[0]), a[1] * fsigmoid(g[1])); w.y = cvt_pk_bf16(a[2] * fsigmoid(g[2]), a[3] * fsigmoid(g[3]));
                        *(u32x2v*)(rowp + bj * 64) = w; } }
        }
    }
};

constexpr size_t WS_GT = 225 * MiB;
constexpr size_t WS_GDN = 234 * MiB, GDN_ITEM = 73728;
constexpr size_t GI_WNEG = 0, GI_KDT = 16384, GI_UFR = 32768, GI_QD = 49152, GI_QK = 65536;
constexpr size_t WS_SN = 306 * MiB;
constexpr size_t WS_VN = 338 * MiB;
constexpr size_t WS_MIX = 354 * MiB;
constexpr size_t WS_H1 = 386 * MiB;
constexpr size_t WS_PROJ = 450 * MiB;
constexpr int NSCAN = 32;
typedef float f32x16 __attribute__((ext_vector_type(16)));
typedef unsigned u32x2 __attribute__((ext_vector_type(2)));
#define LBAR() do { asm volatile("s_waitcnt lgkmcnt(0)" ::: "memory"); __builtin_amdgcn_s_barrier(); asm volatile("" ::: "memory"); } while (0)
__device__ __forceinline__ float bf2f(unsigned short b) { return __uint_as_float((unsigned)b << 16); }
__device__ __forceinline__ __amdgpu_buffer_rsrc_t mk_rsrc(const void* p, unsigned bytes) { return __builtin_amdgcn_make_buffer_rsrc((void*)p, (short)0, (int)bytes, 0x00020000); }
__device__ __forceinline__ float buf_ld_bf16(__amdgpu_buffer_rsrc_t r, unsigned voff, unsigned soff) { return bf2f((unsigned short)__builtin_amdgcn_raw_buffer_load_b16(r, (int)voff, (int)soff, 0)); }
__device__ __forceinline__ void buf_st_b64(__amdgpu_buffer_rsrc_t r, unsigned voff, unsigned soff, u32x2 v) { __builtin_amdgcn_raw_buffer_store_b64(v, r, (int)voff, (int)soff, 0); }
__device__ __forceinline__ void buf_st_b128(__amdgpu_buffer_rsrc_t r, unsigned voff, unsigned soff, v4u v) { __builtin_amdgcn_raw_buffer_store_b128(v, r, (int)(voff + soff), 0, 0); }
__device__ __forceinline__ void buf_st_bf16(__amdgpu_buffer_rsrc_t r, unsigned voff, unsigned soff, float v) { __builtin_amdgcn_raw_buffer_store_b16((short)f2bf(v), r, (int)voff, (int)soff, 0); }

#ifndef XCHK
#define XCHK 0
#endif
#ifndef S5BAR
#define S5BAR 0
#endif
constexpr int CK_P1 = 2112, CK_P2 = 2176;
#define FMAC1(acc, a, b) asm("v_fmac_f32 %0, %1, %2" : "+v"(acc) : "v"(a), "v"(b))
template <int I>
struct SolveRow {
    static __device__ __forceinline__ void run(float (&X)[64], const LAS float* LS, const LAS float* SC) {
        int one; asm volatile("s_mov_b32 %0, 1" : "=s"(one));
        if (one) {
            constexpr int NQ = (I + 3) / 4;
            f32x4 lc[NQ > 0 ? NQ : 1];
#pragma unroll
            for (int q = 0; q < NQ; ++q) lc[q] = *(const volatile LAS f32x4*)(LS + I * 64 + 4 * q);
            float x0 = X[I] * SC[I], x1 = 0.f, x2 = 0.f, x3 = 0.f;
#pragma unroll
            for (int q = 0; q < NQ; ++q) {
                const f32x4 l = lc[q];
                if (4 * q + 0 < I) FMAC1(x0, l.x, X[4 * q + 0]);
                if (4 * q + 1 < I) FMAC1(x1, l.y, X[4 * q + 1]);
                if (4 * q + 2 < I) FMAC1(x2, l.z, X[4 * q + 2]);
                if (4 * q + 3 < I) FMAC1(x3, l.w, X[4 * q + 3]);
            }
            X[I] = (x0 + x1) + (x2 + x3);
        }
        if constexpr (I < 63) SolveRow<I + 1>::run(X, LS, SC);
    }
};

#ifndef SOLVE_PF
#define SOLVE_PF 0
#endif
#ifndef SOLVE2
#define SOLVE2 0
#endif
typedef float f32x2 __attribute__((ext_vector_type(2)));
#define PKFMA_LO(acc, l2, x) asm("v_pk_fma_f32 %0, %1, %2, %0 op_sel_hi:[0,1,1]" : "+v"(acc) : "v"(l2), "v"(x))
#define PKFMA_HI(acc, l2, x) asm("v_pk_fma_f32 %0, %1, %2, %0 op_sel:[1,0,0] op_sel_hi:[1,1,1]" : "+v"(acc) : "v"(l2), "v"(x))
template <int I>
struct SolveRow2 {
    static __device__ __forceinline__ void run(f32x2 (&X)[64], const LAS float* LS, const LAS float* SCW, const LAS float* BET) {
        int one; asm volatile("s_mov_b32 %0, 1" : "=s"(one));
        if (one) {
            constexpr int NQ = (I + 3) / 4, NG = (NQ + 3) / 4;
            f32x4 buf[2][4];
#pragma unroll
            for (int g = 0; g < 2; ++g)
#pragma unroll
                for (int u = 0; u < 4; ++u) if (g < NG && 4 * g + u < NQ) buf[g][u] = *(const volatile LAS f32x4*)(LS + I * 64 + 4 * (4 * g + u));
            const f32x2 sc = {SCW[I], BET[I]};
            f32x2 x0 = X[I] * sc, x1 = {0.f, 0.f}, x2 = {0.f, 0.f}, x3 = {0.f, 0.f};
#pragma unroll
            for (int g = 0; g < NG; ++g) {
#pragma unroll
                for (int u = 0; u < 4; ++u) { const int q = 4 * g + u; if (q < NQ) { const f32x4 l = buf[g & 1][u]; const f32x2 lxy = {l.x, l.y}, lzw = {l.z, l.w};
                    if (4 * q + 0 < I) PKFMA_LO(x0, lxy, X[4 * q + 0]);
                    if (4 * q + 1 < I) PKFMA_HI(x1, lxy, X[4 * q + 1]);
                    if (4 * q + 2 < I) PKFMA_LO(x2, lzw, X[4 * q + 2]);
                    if (4 * q + 3 < I) PKFMA_HI(x3, lzw, X[4 * q + 3]); } }
                if (g + 2 < NG) {
#pragma unroll
                    for (int u = 0; u < 4; ++u) if (4 * (g + 2) + u < NQ) buf[g & 1][u] = *(const volatile LAS f32x4*)(LS + I * 64 + 4 * (4 * (g + 2) + u)); }
            }
            X[I] = (x0 + x1) + (x2 + x3);
        }
        if constexpr (I < 63) SolveRow2<I + 1>::run(X, LS, SCW, BET);
    }
};
#if SOLVE_PF
template <int I>
struct SolveRowPF {
    static constexpr int NQ = (I + 3) / 4, NP = NQ < 8 ? NQ : 8;
    static __device__ __forceinline__ void run(float (&X)[64], const LAS float* LS, const LAS float* SC, const f32x4 (&pre)[8]) {
        int one; asm volatile("s_mov_b32 %0, 1" : "=s"(one));
        f32x4 nxt[8];
        if (one) {
            constexpr int NQ1 = (I + 4) / 4, NP1 = NQ1 < 8 ? NQ1 : 8, NR = NQ > 8 ? NQ - 8 : 0;
            f32x4 rest[NR > 0 ? NR : 1];
#pragma unroll
            for (int q = 0; q < NR; ++q) rest[q] = *(const volatile LAS f32x4*)(LS + I * 64 + 4 * (8 + q));
            if constexpr (I < 63) {
#pragma unroll
                for (int q = 0; q < NP1; ++q) nxt[q] = *(const volatile LAS f32x4*)(LS + (I + 1) * 64 + 4 * q);
            }
            float x0 = X[I] * SC[I], x1 = 0.f, x2 = 0.f, x3 = 0.f;
#pragma unroll
            for (int q = 0; q < NQ; ++q) {
                const f32x4 l = q < NP ? pre[q] : rest[q < 8 ? 0 : q - 8];
                if (4 * q + 0 < I) FMAC1(x0, l.x, X[4 * q + 0]);
                if (4 * q + 1 < I) FMAC1(x1, l.y, X[4 * q + 1]);
                if (4 * q + 2 < I) FMAC1(x2, l.z, X[4 * q + 2]);
                if (4 * q + 3 < I) FMAC1(x3, l.w, X[4 * q + 3]);
            }
            X[I] = (x0 + x1) + (x2 + x3);
        }
        if constexpr (I < 63) SolveRowPF<I + 1>::run(X, LS, SC, nxt);
    }
};
#endif
__device__ __forceinline__ void solve64(float (&X)[64], const LAS float* LS, const LAS float* SC) {
#if SOLVE_PF
    f32x4 pre[8]; SolveRowPF<0>::run(X, LS, SC, pre);
#else
    SolveRow<0>::run(X, LS, SC);
#endif
}

__device__ __forceinline__ void p2_gdn_prep(Frame& F, const Ptrs& P, const size_t gdn_off = WS_GDN, const size_t gt_off = WS_GT) {
    LAS unsigned char* QT = F.lds; LAS unsigned char* KT = F.lds + 17408; LAS float* LS = (LAS float*)(F.lds + 34816);
    LAS unsigned char* XS = F.lds + 53248;
    LAS unsigned char* QDT = F.lds + 53248;
    LAS unsigned char* QKT = F.lds + 53248 + 17408;
    LAS float* gcs = (LAS float*)(F.lds + 51200); LAS float* betas = gcs + 64; LAS float* nk2 = gcs + 128; LAS float* nq2 = gcs + 192; LAS float* sc_w = gcs + 256; LAS float* sc_kd = gcs + 320; LAS float* sc_qd = gcs + 384;
    const bf16* QKVZ = (const bf16*)(P.ws + WS_QKVZ); const float* AB = (const float*)(P.ws + WS_AB);
    const int wave = F.wave;
    const int grp = wave >> 1;
    v4u pre[7];
#define P2_PREFETCH(it_) do { const int lane_ = lane_now(), tid_ = wave * 64 + lane_; const int bh_ = (it_) >> 7, n_ = (it_) & 127; \
        const unsigned char* src_ = (const unsigned char*)(QKVZ + ((size_t)(bh_ >> 2) * SEQ + (size_t)n_ * 64 - 3) * 2048 + (bh_ & 3) * 128); \
        _Pragma("unroll") for (int u = 0; u < 7; ++u) { const int cid = tid_ + 512 * u; pre[u] = (v4u){0u, 0u, 0u, 0u}; if (cid < 67 * 48) { const int row = cid / 48, cc = cid - row * 48, seg3 = cc >> 4; \
            if (n_ * 64 + row - 3 >= 0) pre[u] = *(const GAS v4u*)(src_ + (size_t)row * 4096 + seg3 * 1024 + (cc & 15) * 16); } } } while (0)
    if (F.vcu < 1024) P2_PREFETCH(F.vcu);
    for (int it = F.vcu; it < 1024; it += F.G) {
        const int lane = lane_now();
        const int c = ((wave & 1) << 6) | lane, tid = wave * 64 + lane;
        const int bh = it >> 7, n = it & 127, b = bh >> 2, h = bh & 3;
        const size_t m0 = (size_t)b * SEQ + (size_t)n * 64;
        unsigned char* item = P.ws + gdn_off + (size_t)it * GDN_ITEM;
        float y[64];
#pragma unroll
        for (int u = 0; u < 7; ++u) { const int cid = tid + 512 * u; if (cid < 67 * 48) *(LAS v4u*)(XS + cid * 16) = pre[u]; }
        LBAR();
        if (grp < 3) {
            const int col = grp * 512 + h * 128 + c;
            const float w0 = P.w_conv_qkv[0 * 1536 + col], w1 = P.w_conv_qkv[1 * 1536 + col], w2 = P.w_conv_qkv[2 * 1536 + col], w3 = P.w_conv_qkv[3 * 1536 + col];
            float xr[67];
#pragma unroll
            for (int j = 0; j < 67; ++j) xr[j] = bf2f(*(const LAS unsigned short*)(XS + j * 768 + grp * 256 + c * 2));
#pragma unroll
            for (int i = 0; i < 64; ++i) { const float s = fmaf(w3, xr[i + 3], fmaf(w2, xr[i + 2], fmaf(w1, xr[i + 1], w0 * xr[i]))); y[i] = fsilu(s); }
            if (grp < 2) { LAS unsigned char* tile = grp == 0 ? QT : KT;
#pragma unroll
                for (int i = 0; i < 64; ++i) *(LAS unsigned short*)(tile + i * 272 + c * 2) = (unsigned short)f2bf(y[i]); }
        }
        if (wave == 7) {
            const float araw = AB[(m0 + lane) * 8 + 4 + h], braw = AB[(m0 + lane) * 8 + h];
            const float xx = araw + P.dt_bias[h];
            const float sp = (xx > 20.f) ? xx : log1pf(expf(xx));
            float g = -expf(P.a_log[h]) * sp;
#pragma unroll
            for (int off = 1; off < 64; off <<= 1) { const float t = __shfl_up(g, off); if (lane >= off) g += t; }
            gcs[lane] = g; betas[lane] = 1.f / (1.f + expf(-braw));
        }
        LBAR();
        const int kind = wave < 3 ? 0 : (wave < 6 ? 1 : 2);
        const int tsel = wave < 6 ? wave % 3 : (wave - 6) * 2;
        const int ib = tsel >= 1 ? 1 : 0, jb = tsel == 2 ? 1 : 0;
        const int r32 = lane & 31, hh = lane >> 5;
        f32x16 acc;
#pragma unroll
        for (int i = 0; i < 16; ++i) acc[i] = 0.f;
        {
            const LAS unsigned char* At = (kind == 0 ? KT : QT) + (32 * ib + r32) * 272 + hh * 16;
            const LAS unsigned char* Bt = (kind == 2 ? QT : KT) + (32 * jb + r32) * 272 + hh * 16;
#pragma unroll
            for (int s = 0; s < 8; ++s) { const bf16x8 a = *(const LAS bf16x8*)(At + s * 32), bb = *(const LAS bf16x8*)(Bt + s * 32); acc = __builtin_amdgcn_mfma_f32_32x32x16_bf16(a, bb, acc, 0, 0, 0); }
        }
        if ((kind == 0 || kind == 2) && ib == jb) {
            if (((r32 >> 2) & 1) == hh) {
                const int rsel = (r32 & 3) + 4 * (r32 >> 3); float v = 0.f;
#pragma unroll
                for (int i = 0; i < 16; ++i) v = (i == rsel) ? acc[i] : v;
                (kind == 0 ? nk2 : nq2)[32 * ib + r32] = v;
            }
        }
        LBAR();
        {
            const int j = 32 * jb + r32; const float gj = gcs[j], rkj = rsqrtf(nk2[j] + EPS);
#pragma unroll
            for (int reg = 0; reg < 16; ++reg) {
                const int iu = 32 * ib + (reg & 3) + 8 * (reg >> 2), i = iu + 4 * hh;
                const float dec = __expf(fminf(gcs[i] - gj, 0.f));
                if (kind == 0) { const float v = (j < i) ? acc[reg] * betas[i] * rsqrtf(nk2[i] + EPS) * rkj * dec : 0.f; LS[i * 64 + j] = -v; }
                else if (kind == 1) { const float v = (j <= i) ? acc[reg] * rsqrtf(nq2[i] + EPS) * 0.08838834764831845f * rkj * dec : 0.f; *(LAS unsigned short*)(QKT + i * 144 + j * 2) = (unsigned short)f2bf(v); }
            }
            if (wave == 7) {
                const float rk = rsqrtf(nk2[lane] + EPS), rq = rsqrtf(nq2[lane] + EPS), gi = gcs[lane], eg = __expf(gi);
                sc_w[lane] = betas[lane] * rk * eg; sc_kd[lane] = rk * __expf(gcs[63] - gi); sc_qd[lane] = rq * 0.08838834764831845f * eg;
            }
            if (kind == 2 && tsel == 0) {
#pragma unroll
                for (int reg = 0; reg < 16; ++reg) { const int i = (reg & 3) + 8 * (reg >> 2) + 4 * hh; *(LAS unsigned short*)(QKT + i * 144 + (32 + r32) * 2) = 0; }
            }
        }
        LBAR();
        const float gl = gcs[63];
#if SOLVE2
        if (grp == 2) {
            f32x2 X[64];
#pragma unroll
            for (int i = 0; i < 64; ++i) { X[i].x = bf2f(*(const LAS unsigned short*)(KT + i * 272 + c * 2)); X[i].y = y[i]; }
            SolveRow2<0>::run(X, LS, sc_w, betas);
#pragma unroll
            for (int i = 0; i < 64; ++i) *(LAS unsigned short*)(QT + i * 272 + c * 2) = (unsigned short)f2bf(-X[i].x);
            const __amdgpu_buffer_rsrc_t rit = mk_rsrc(item, (unsigned)GDN_ITEM);
            const int et = c >> 4, r = c & 15;
#pragma unroll
            for (int i4 = 0; i4 < 16; ++i4) { const int ct = i4 >> 2, q = i4 & 3;
                u32x2 o; o.x = pk2(X[4 * i4 + 0].y, X[4 * i4 + 1].y); o.y = pk2(X[4 * i4 + 2].y, X[4 * i4 + 3].y);
                buf_st_b64(rit, (unsigned)((((et >> 1) * 64 + r) * 2 + (et & 1)) * 8), (unsigned)(GI_UFR + (ct * 4 * 64 + q * 16) * 16), o); }
#else
        if (grp == 1 || grp == 2) solve64(y, LS, grp == 1 ? sc_w : betas);
        if (grp == 1) {
#pragma unroll
            for (int i = 0; i < 64; ++i) *(LAS unsigned short*)(QT + i * 272 + c * 2) = (unsigned short)f2bf(-y[i]);
        } else if (grp == 2) {
            const __amdgpu_buffer_rsrc_t rit = mk_rsrc(item, (unsigned)GDN_ITEM);
            const int et = c >> 4, r = c & 15;
#pragma unroll
            for (int i4 = 0; i4 < 16; ++i4) { const int ct = i4 >> 2, q = i4 & 3;
                u32x2 o; o.x = pk2(y[4 * i4 + 0], y[4 * i4 + 1]); o.y = pk2(y[4 * i4 + 2], y[4 * i4 + 3]);
                buf_st_b64(rit, (unsigned)((((et >> 1) * 64 + r) * 2 + (et & 1)) * 8), (unsigned)(GI_UFR + (ct * 4 * 64 + q * 16) * 16), o); }
#endif
        } else if (grp == 0) {
#pragma unroll
            for (int i = 0; i < 64; ++i) *(LAS unsigned short*)(QDT + i * 272 + c * 2) = (unsigned short)f2bf(y[i] * sc_qd[i]);
        }
        LBAR();
        if (it + F.G < 1024) P2_PREFETCH(it + F.G);
        {
            const __amdgpu_buffer_rsrc_t rit = mk_rsrc(item, (unsigned)GDN_ITEM);
#pragma unroll
            for (int u = 0; u < 2; ++u) { const int cid = tid + 512 * u, ln = cid & 63, r = ln & 15, q = ln >> 4;
                { const int ct = cid >> 8, sx = (cid >> 6) & 3;
                  const v4u v = *(const LAS v4u*)(QT + (16 * ct + r) * 272 + (32 * sx + 8 * q) * 2);
                  buf_st_b128(rit, (unsigned)cid * 16u, (unsigned)GI_WNEG, v); }
                { const int dt = cid >> 7, sx = (cid >> 6) & 1; float kd[8];
#pragma unroll
                  for (int j = 0; j < 8; ++j) { const int cc = 32 * sx + 8 * q + j; kd[j] = bf2f(*(const LAS unsigned short*)(KT + cc * 272 + (16 * dt + r) * 2)) * sc_kd[cc]; }
                  v4u o; o.x = pk2(kd[0], kd[1]); o.y = pk2(kd[2], kd[3]); o.z = pk2(kd[4], kd[5]); o.w = pk2(kd[6], kd[7]);
                  buf_st_b128(rit, (unsigned)cid * 16u, (unsigned)GI_KDT, o); }
                { const int r32c = ln & 31, hhc = ln >> 5, ct2 = cid >> 9, sx = (cid >> 6) & 7;
                  const v4u v = *(const LAS v4u*)(QDT + (32 * ct2 + r32c) * 272 + (16 * sx + 8 * hhc) * 2);
                  buf_st_b128(rit, (unsigned)cid * 16u, (unsigned)GI_QD, v); }
                if (u == 0) { const int r32c = ln & 31, hhc = ln >> 5, ct2 = cid >> 8, sx = (cid >> 6) & 3;
                  const v4u v = *(const LAS v4u*)(QKT + (32 * ct2 + r32c) * 144 + (16 * sx + 8 * hhc) * 2);
                  buf_st_b128(rit, (unsigned)cid * 16u, (unsigned)GI_QK, v); }
            }
        }
        if (tid == 0) ((float*)(P.ws + gt_off))[it] = __expf(gl);
        LBAR();
    }
}
#undef P2_PREFETCH

template <int ROT, int LS_OFF, int AR_OFF, int QT_OFF, int KT_OFF> struct P2S {
    static __device__ __forceinline__ int wv(const Frame& F) { return (F.wave + ROT) & 7; }
    static __device__ __forceinline__ LAS unsigned char* QT(const Frame& F) { unsigned o = QT_OFF; asm volatile("" : "+v"(o)); return F.lds + o; }
    static __device__ __forceinline__ LAS unsigned char* KT(const Frame& F) { unsigned o = KT_OFF; asm volatile("" : "+v"(o)); return F.lds + o; }
    static __device__ __forceinline__ LAS float* LS(const Frame& F) { return (LAS float*)(F.lds + LS_OFF); }
    static __device__ __forceinline__ LAS float* AR(const Frame& F) { return (LAS float*)(F.lds + AR_OFF); }

    static __device__ __forceinline__ void s1(Frame& F, const Ptrs& P, int it, float (&ys)[64]) {
        const int w = wv(F), grp = w >> 1, lane = lane_now(), c = ((w & 1) << 6) | lane;
        const int bh = it >> 7, n = it & 127, b = bh >> 2, h = bh & 3; const size_t m0 = (size_t)b * SEQ + (size_t)n * 64;
        const bf16* QKVZ = (const bf16*)(P.ws + WS_QKVZ); const float* AB = (const float*)(P.ws + WS_AB);
        if (grp < 3) {
            const int col = grp * 512 + h * 128 + c;
            const float w0 = P.w_conv_qkv[0 * 1536 + col], w1 = P.w_conv_qkv[1 * 1536 + col], w2 = P.w_conv_qkv[2 * 1536 + col], w3 = P.w_conv_qkv[3 * 1536 + col];
            const __amdgpu_buffer_rsrc_t rs = mk_rsrc(QKVZ + (size_t)b * SEQ * 2048, (unsigned)SEQ * 2048u * 2u);
            LAS unsigned char* tile = grp == 0 ? QT(F) : KT(F);
#pragma unroll
            for (int hf = 0; hf < 2; ++hf) {
                float xr[35];
#pragma unroll
                for (int j = 0; j < 35; ++j) { const int t = n * 64 + 32 * hf + j - 3; xr[j] = (hf > 0 || j >= 3 || t >= 0) ? buf_ld_bf16(rs, (unsigned)col * 2u, (unsigned)t * 4096u) : 0.f; }
#pragma unroll
                for (int i = 0; i < 32; ++i) { const float sv = fsilu(fmaf(w3, xr[i + 3], fmaf(w2, xr[i + 2], fmaf(w1, xr[i + 1], w0 * xr[i]))));
                    if (grp < 2) *(LAS unsigned short*)(tile + (32 * hf + i) * 272 + c * 2) = (unsigned short)f2bf(sv); else ys[32 * hf + i] = sv; }
            }
        }
        if (w == 7) {
            LAS float* gcs = AR(F); LAS float* betas = gcs + 64;
            const float araw = AB[(m0 + lane) * 8 + 4 + h], braw = AB[(m0 + lane) * 8 + h];
            const float xx = araw + P.dt_bias[h];
            const float sp = (xx > 20.f) ? xx : log1pf(expf(xx));
            float g = -expf(P.a_log[h]) * sp;
#pragma unroll
            for (int off = 1; off < 64; off <<= 1) { const float t = __shfl_up(g, off); if (lane >= off) g += t; }
            gcs[lane] = g; betas[lane] = 1.f / (1.f + expf(-braw));
        }
    }
    static __device__ __forceinline__ void s2(Frame& F, f32x16& acc) {
        const int w = wv(F), lane = lane_now(), r32 = lane & 31, hh = lane >> 5;
        const int kind = w < 3 ? 0 : (w < 6 ? 1 : 2), tsel = w < 6 ? w % 3 : (w - 6) * 2, ib = tsel >= 1 ? 1 : 0, jb = tsel == 2 ? 1 : 0;
        LAS float* nk2 = AR(F) + 128; LAS float* nq2 = AR(F) + 192;
#pragma unroll
        for (int i = 0; i < 16; ++i) acc[i] = 0.f;
        const LAS unsigned char* At = (kind == 0 ? KT(F) : QT(F)) + (32 * ib + r32) * 272 + hh * 16;
        const LAS unsigned char* Bt = (kind == 2 ? QT(F) : KT(F)) + (32 * jb + r32) * 272 + hh * 16;
#pragma unroll
        for (int s = 0; s < 8; ++s) { const bf16x8 a = *(const LAS bf16x8*)(At + s * 32), bb = *(const LAS bf16x8*)(Bt + s * 32); acc = __builtin_amdgcn_mfma_f32_32x32x16_bf16(a, bb, acc, 0, 0, 0); }
        if ((kind == 0 || kind == 2) && ib == jb) {
            if (((r32 >> 2) & 1) == hh) {
                const int rsel = (r32 & 3) + 4 * (r32 >> 3); float v = 0.f;
#pragma unroll
                for (int i = 0; i < 16; ++i) v = (i == rsel) ? acc[i] : v;
                (kind == 0 ? nk2 : nq2)[32 * ib + r32] = v;
            }
        }
    }
    static __device__ __forceinline__ void s3(Frame& F, const Ptrs& P, int it, const f32x16& acc, const size_t gdn_off) {
        const int w = wv(F), lane = lane_now(), r32 = lane & 31, hh = lane >> 5;
        const int kind = w < 3 ? 0 : (w < 6 ? 1 : 2), tsel = w < 6 ? w % 3 : (w - 6) * 2, ib = tsel >= 1 ? 1 : 0, jb = tsel == 2 ? 1 : 0;
        LAS float* gcs = AR(F); LAS float* betas = gcs + 64; LAS float* nk2 = gcs + 128; LAS float* nq2 = gcs + 192; LAS float* sc_w = gcs + 256; LAS float* sc_kd = gcs + 320; LAS float* sc_qd = gcs + 384;
        LAS float* Ls = LS(F);
        unsigned char* item = P.ws + gdn_off + (size_t)it * GDN_ITEM;
        const int j = 32 * jb + r32; const float gj = gcs[j], rkj = rsqrtf(nk2[j] + EPS);
        const __amdgpu_buffer_rsrc_t rqk = mk_rsrc(item + GI_QK, 8192u);
        const unsigned vqk = (unsigned)(((j >> 4) * 64 + 32 * ((j >> 3) & 1)) * 16 + (j & 7) * 2 + 64 * hh);
#pragma unroll
        for (int reg = 0; reg < 16; ++reg) {
            const int iu = 32 * ib + (reg & 3) + 8 * (reg >> 2), i = iu + 4 * hh;
            const float dec = __expf(fminf(gcs[i] - gj, 0.f));
            if (kind == 0) { const float v = (j < i) ? acc[reg] * betas[i] * rsqrtf(nk2[i] + EPS) * rkj * dec : 0.f; Ls[i * 64 + j] = -v; }
            else if (kind == 1) { const float v = (j <= i) ? acc[reg] * rsqrtf(nq2[i] + EPS) * 0.08838834764831845f * rkj * dec : 0.f; buf_st_bf16(rqk, vqk, (unsigned)((iu >> 5) * 4096 + (iu & 31) * 16), v); }
        }
        if (w == 7) {
            const float rk = rsqrtf(nk2[lane] + EPS), rq = rsqrtf(nq2[lane] + EPS), gi = gcs[lane], eg = __expf(gi);
            sc_w[lane] = betas[lane] * rk * eg; sc_kd[lane] = rk * __expf(gcs[63] - gi); sc_qd[lane] = rq * 0.08838834764831845f * eg;
        }
        if (kind == 2 && tsel == 0) {
#pragma unroll
            for (int reg = 0; reg < 16; ++reg) { const int iu = (reg & 3) + 8 * (reg >> 2); const int jz = 32 + r32;
                buf_st_bf16(rqk, (unsigned)(((jz >> 4) * 64 + 32 * ((jz >> 3) & 1)) * 16 + (jz & 7) * 2 + 64 * hh), (unsigned)(iu * 16), 0.f); }
        }
        if ((w >> 1) == 0) {
            const int c = ((w & 1) << 6) | lane;
            const __amdgpu_buffer_rsrc_t rit = mk_rsrc(item, (unsigned)GDN_ITEM);
            const unsigned vqd = (unsigned)(((c >> 4) * 64 + 32 * ((c >> 3) & 1)) * 16 + (c & 7) * 2);
#pragma unroll
            for (int i = 0; i < 64; ++i) { const float q = bf2f(*(const LAS unsigned short*)(QT(F) + i * 272 + c * 2));
                buf_st_bf16(rit, vqd, (unsigned)(GI_QD + (i >> 5) * 8192 + (i & 31) * 16), q * rsqrtf(nq2[i] + EPS) * 0.08838834764831845f * __expf(gcs[i])); }
        }
    }
    static __device__ __forceinline__ void s4v(Frame& F, const Ptrs& P, int it, float (&ys)[64], const size_t gdn_off) {
        const int w = wv(F), grp = w >> 1, lane = lane_now(), c = ((w & 1) << 6) | lane;
        if (grp == 2) {
            LAS float* betas = AR(F) + 64;
            unsigned char* item = P.ws + gdn_off + (size_t)it * GDN_ITEM;
            SolveRow<0>::run(ys, LS(F), betas);
            const __amdgpu_buffer_rsrc_t rit = mk_rsrc(item, (unsigned)GDN_ITEM);
            const int et = c >> 4, r = c & 15;
#pragma unroll
            for (int i4 = 0; i4 < 16; ++i4) { const int ct = i4 >> 2, q = i4 & 3;
                u32x2 o; o.x = pk2(ys[4 * i4 + 0], ys[4 * i4 + 1]); o.y = pk2(ys[4 * i4 + 2], ys[4 * i4 + 3]);
                buf_st_b64(rit, (unsigned)((((et >> 1) * 64 + r) * 2 + (et & 1)) * 8), (unsigned)(GI_UFR + (ct * 4 * 64 + q * 16) * 16), o); }
        }
    }
    static __device__ __forceinline__ void s4k(Frame& F) {
        const int w = wv(F), grp = w >> 1, lane = lane_now(), c = ((w & 1) << 6) | lane;
        if (grp == 1) {
            LAS float* sc_w = AR(F) + 256;
            float yk[64];
#pragma unroll
            for (int i = 0; i < 64; ++i) yk[i] = bf2f(*(const LAS unsigned short*)(KT(F) + i * 272 + c * 2));
            SolveRow<0>::run(yk, LS(F), sc_w);
#pragma unroll
            for (int i = 0; i < 64; ++i) *(LAS unsigned short*)(QT(F) + i * 272 + c * 2) = (unsigned short)f2bf(-yk[i]);
        }
    }
    static __device__ __forceinline__ void s5(Frame& F, const Ptrs& P, int it, const size_t gdn_off, const size_t gt_off) {
        const int lane = lane_now(), tid = F.wave * 64 + lane;
        LAS float* gcs = AR(F); LAS float* sc_kd = gcs + 320;
        unsigned char* item = P.ws + gdn_off + (size_t)it * GDN_ITEM;
        const __amdgpu_buffer_rsrc_t rit = mk_rsrc(item, (unsigned)GDN_ITEM);
#if XCHK
        v4u okeep[2];
#endif
#pragma unroll
        for (int u = 0; u < 2; ++u) { const int cid = tid + 512 * u, ln = cid & 63, r = ln & 15, q = ln >> 4;
            { const int ct = cid >> 8, sx = (cid >> 6) & 3;
              const v4u v = *(const LAS v4u*)(QT(F) + (16 * ct + r) * 272 + (32 * sx + 8 * q) * 2);
              buf_st_b128(rit, (unsigned)cid * 16u, (unsigned)GI_WNEG, v); }
            { const int dt = cid >> 7, sx = (cid >> 6) & 1; float kd[8];
#pragma unroll
              for (int j = 0; j < 8; ++j) { const int cc = 32 * sx + 8 * q + j; kd[j] = bf2f(*(const LAS unsigned short*)(KT(F) + cc * 272 + (16 * dt + r) * 2)) * sc_kd[cc]; }
              v4u o; o.x = pk2(kd[0], kd[1]); o.y = pk2(kd[2], kd[3]); o.z = pk2(kd[4], kd[5]); o.w = pk2(kd[6], kd[7]);
              buf_st_b128(rit, (unsigned)cid * 16u, (unsigned)GI_KDT, o);
#if XCHK
              okeep[u] = o;
#endif
            }
        }
#if XCHK
        LBAR();
        {
            unsigned bad = 0;
#pragma unroll
            for (int u = 0; u < 2; ++u) { const int cid = tid + 512 * u, ln = cid & 63, r = ln & 15, q = ln >> 4; const int dt = cid >> 7, sx = (cid >> 6) & 1; float kd[8];
#pragma unroll
              for (int j = 0; j < 8; ++j) { const int cc = 32 * sx + 8 * q + j; kd[j] = bf2f(*(const LAS unsigned short*)(KT(F) + cc * 272 + (16 * dt + r) * 2)) * sc_kd[cc]; }
              v4u o; o.x = pk2(kd[0], kd[1]); o.y = pk2(kd[2], kd[3]); o.z = pk2(kd[4], kd[5]); o.w = pk2(kd[6], kd[7]);
              bad |= (o.x != okeep[u].x) | (o.y != okeep[u].y) | (o.z != okeep[u].z) | (o.w != okeep[u].w); }
            if (bad) __hip_atomic_fetch_add((unsigned*)(P.ws + WS_CTL) + CK_P2 + 8, 1u, __ATOMIC_RELAXED, __HIP_MEMORY_SCOPE_AGENT);
        }
#endif
        if (tid == 0) ((float*)(P.ws + gt_off))[it] = __expf(gcs[63]);
#if XCHK
        if (gt_off == WS_GT) {
            if (tid < 64) __hip_atomic_fetch_add((unsigned*)(P.ws + WS_CTL) + CK_P2 + 6, __float_as_uint(sc_kd[tid]) * 17u + (unsigned)(tid + it * 7), __ATOMIC_RELAXED, __HIP_MEMORY_SCOPE_AGENT);
            unsigned acc = 0; for (int i = tid; i < 64 * 64; i += 512) { const int rr = i >> 6, cw = i & 63; acc += *(const LAS unsigned*)(KT(F) + rr * 272 + cw * 4) * 19u + (unsigned)(i + it * 3); }
            __hip_atomic_fetch_add((unsigned*)(P.ws + WS_CTL) + CK_P2 + 7, acc, __ATOMIC_RELAXED, __HIP_MEMORY_SCOPE_AGENT);
        }
#endif
    }
};
__device__ __forceinline__ void p2_gdn_prep_dual(Frame& F, const Ptrs& P, const size_t gdn_off = WS_GDN, const size_t gt_off = WS_GT) {
    typedef P2S<0, 0, 32768, 36864, 54272> A; typedef P2S<4, 16384, 34816, 71680, 89088> B;
    for (int it = F.vcu; it < 1024; it += 2 * F.G) {
        const int itB = it + F.G;
        float ys[64]; f32x16 accA, accB;
        A::s1(F, P, it, ys); B::s1(F, P, itB, ys);
        LBAR();
        A::s2(F, accA); B::s2(F, accB);
        LBAR();
        A::s3(F, P, it, accA, gdn_off); B::s3(F, P, itB, accB, gdn_off);
        LBAR();
        A::s4v(F, P, it, ys, gdn_off); B::s4v(F, P, itB, ys, gdn_off);
        A::s4k(F); B::s4k(F);
        LBAR();
        A::s5(F, P, it, gdn_off, gt_off);
#if S5BAR
        LBAR();
#endif
        B::s5(F, P, itB, gdn_off, gt_off);
        LBAR();
    }
}

#ifndef P2_DUAL
#define P2_DUAL 0
#endif
#ifndef DTEST
#define DTEST 0
#endif
constexpr int CW_DT = 2048;
__device__ __forceinline__ void p2_dtest(Frame& F, const Ptrs& P) {
    const int lane = lane_now(), tid = F.wave * 64 + lane;
    for (int i = tid; i < 131072 / 4; i += NWAVES * 64) ((LAS unsigned*)F.lds)[i] = 0x7fc12345u ^ (unsigned)(i * 2654435761u);
    __syncthreads();
    const size_t off2 = 354 * MiB, gt2 = 434 * MiB;
#if P2_DUAL
    p2_gdn_prep_dual(F, P, off2, gt2);
#else
    p2_gdn_prep(F, P, off2, gt2);
#endif
    asm volatile("s_waitcnt vmcnt(0)" ::: "memory"); __syncthreads();
    unsigned bad = 0;
    for (int it = F.vcu; it < 1024; it += F.G) {
        const GAS v4u* a = (const GAS v4u*)(P.ws + WS_GDN + (size_t)it * GDN_ITEM); const GAS v4u* b = (const GAS v4u*)(P.ws + off2 + (size_t)it * GDN_ITEM);
        for (int c = tid; c < (int)(GDN_ITEM / 16); c += NWAVES * 64) { const v4u x = a[c], y = b[c]; const bool ne = (x.x != y.x) | (x.y != y.y) | (x.z != y.z) | (x.w != y.w);
            const int reg = c < 1024 ? 0 : (c < 2048 ? 1 : (c < 3072 ? 2 : (c < 4096 ? 3 : 4)));
            if (ne) bad |= 1u << reg; }
        if (tid == 0 && __float_as_uint(((const float*)(P.ws + WS_GT))[it]) != __float_as_uint(((const float*)(P.ws + gt2))[it])) bad |= 1u << 5;
    }
    if (bad) __hip_atomic_fetch_or((unsigned*)(P.ws + WS_CTL) + CW_DT, bad, __ATOMIC_RELAXED, __HIP_MEMORY_SCOPE_AGENT);
}

__device__ __forceinline__ void xchk_sum(Frame& F, const Ptrs& P, const unsigned char* base, size_t bytes, int ckword) {
    const int lane = lane_now(); const size_t nthr = (size_t)F.G * NWAVES * 64, t0 = (size_t)F.vcu * NWAVES * 64 + F.wave * 64 + lane;
    unsigned acc = 0; const GAS v4u* p4 = (const GAS v4u*)base;
    for (size_t i = t0; i < bytes / 16; i += nthr) { const v4u v = p4[i]; acc += v.x * 3u + v.y * 5u + v.z * 7u + v.w * 11u + (unsigned)i; }
    acc = (unsigned)wave_sum_f(0.f) + acc;
    __hip_atomic_fetch_add((unsigned*)(P.ws + WS_CTL) + ckword, acc, __ATOMIC_RELAXED, __HIP_MEMORY_SCOPE_AGENT);
}
constexpr int SCAN_DIST = 6;
#ifndef SCAN_WARM_AHEAD
#define SCAN_WARM_AHEAD 18
#endif
#ifndef SCAN_WARM
#define SCAN_WARM 0
#endif
constexpr int NWARM = SCAN_WARM ? 8 : 0;
template <int ROLE>
__device__ __forceinline__ void p3_scan_role(Frame& F, const Ptrs& P, int blk) {
    LAS unsigned char* ST = F.lds; LAS unsigned char* VT = F.lds + 8704;
    const int bh = blk & 7, es = blk >> 3;
    const int lane = lane_now(), wave = F.wave, r = lane & 15, q = lane >> 4, tid = wave * 64 + lane;
    const int dt = wave;
    for (int i = tid; i < 8704 / 4; i += NWAVES * 64) ((LAS unsigned*)ST)[i] = 0u;
    f32x4 sacc[2] = {(f32x4){0.f, 0.f, 0.f, 0.f}, (f32x4){0.f, 0.f, 0.f, 0.f}};
    const float* GT = (const float*)(P.ws + WS_GT);
    const unsigned char* item0 = P.ws + WS_GDN + (size_t)(bh * 128) * GDN_ITEM;
#define SCAN_LOAD(n_, wA_, kA_, uC_, gt_) do { const unsigned char* itp = item0 + (size_t)(n_) * GDN_ITEM; \
        if constexpr (ROLE < 2) { _Pragma("unroll") for (int s = 0; s < 4; ++s) wA_[s] = *(const GAS bf16x8*)(itp + GI_WNEG + ((wave * 4 + s) * 64 + lane) * 16); \
            uC_ = *(const GAS v4u*)(itp + GI_UFR + ((size_t)((wave * 4 + es) * 64 + lane)) * 16); } \
        _Pragma("unroll") for (int s = 0; s < 2; ++s) kA_[s] = *(const GAS bf16x8*)(itp + GI_KDT + ((dt * 2 + s) * 64 + lane) * 16); \
        } while (0)
#define SCAN_STEP(n_, wA_, kA_, uC_, unused_) do { __builtin_amdgcn_sched_barrier(0);   \
        if constexpr (ROLE < 2) { v4u o4; \
            _Pragma("unroll") for (int t = 0; t < 2; ++t) { const unsigned u0 = t ? uC_.z : uC_.x, u1 = t ? uC_.w : uC_.y; \
                f32x4 acc; acc.x = __uint_as_float(u0 << 16); acc.y = __uint_as_float(u0 & 0xffff0000u); acc.z = __uint_as_float(u1 << 16); acc.w = __uint_as_float(u1 & 0xffff0000u); \
                _Pragma("unroll") for (int s = 0; s < 4; ++s) { const bf16x8 sf = *(const LAS bf16x8*)(ST + (16 * t + r) * 272 + (32 * s + 8 * q) * 2); acc = __builtin_amdgcn_mfma_f32_16x16x32_bf16(wA_[s], sf, acc, 0, 0, 0); } \
                u32x2 o; o.x = pk2(acc.x, acc.y); o.y = pk2(acc.z, acc.w); \
                *(LAS u32x2*)(VT + (16 * t + r) * 144 + (16 * wave + 4 * q) * 2) = o; \
                if (t == 0) { o4.x = o.x; o4.y = o.y; } else { o4.z = o.x; o4.w = o.y; } } \
            __builtin_amdgcn_raw_buffer_store_b128(o4, rvn, (int)(((wave * 4 + es) * 64 + lane) * 16 + (bh * 128 + (n_)) * 16384), 0, 16  ); } \
        LBAR(); \
        const float gt_ = GTL[n_]; \
        _Pragma("unroll") for (int t = 0; t < 2; ++t) { sacc[t] = sacc[t] * gt_; \
            _Pragma("unroll") for (int s = 0; s < 2; ++s) { const bf16x8 vf = *(const LAS bf16x8*)(VT + (16 * t + r) * 144 + (32 * s + 8 * q) * 2); sacc[t] = __builtin_amdgcn_mfma_f32_16x16x32_bf16(kA_[s], vf, sacc[t], 0, 0, 0); } } \
        { v4u o4; \
        _Pragma("unroll") for (int t = 0; t < 2; ++t) { u32x2 o; o.x = pk2(sacc[t].x, sacc[t].y); o.y = pk2(sacc[t].z, sacc[t].w); \
            *(LAS u32x2*)(ST + (16 * t + r) * 272 + (16 * dt + 4 * q) * 2) = o; \
            if (t == 0) { o4.x = o.x; o4.y = o.y; } else { o4.z = o.x; o4.w = o.y; } } \
        __builtin_amdgcn_raw_buffer_store_b128(o4, rsn, (int)(((dt * 4 + es) * 64 + lane) * 16 + (bh * 128 + (((n_) + 1) & 127)) * 32768), 0, 16  ); }   \
        SCAN_LOAD(((n_) + SCAN_DIST) & 127, wA_, kA_, uC_, 0);   \
        LBAR(); \
          \
        if constexpr (ROLE == 0) __builtin_amdgcn_raw_buffer_store_b32((unsigned)((n_) - SCAN_DIST), rprog, (lane == 0 && (n_) >= SCAN_DIST + 1) ? 0 : 64, 0, 16  );   } while (0)
    const __amdgpu_buffer_rsrc_t rsn = mk_rsrc(P.ws + WS_SN, 32u * 1024u * 1024u), rvn = mk_rsrc(P.ws + WS_VN, 16u * 1024u * 1024u);
    unsigned* prog = (unsigned*)(P.ws + WS_CTL) + CW_PROG + bh * 64 + es;
    const __amdgpu_buffer_rsrc_t rprog = mk_rsrc(prog, 4u);
    LAS float* GTL = (LAS float*)(F.lds + 13312);
    if (tid < 128) GTL[tid] = GT[bh * 128 + tid];
    bf16x8 wA0[4], kA0[2]; v4u uC0;
    bf16x8 wA1[4], kA1[2]; v4u uC1;
    bf16x8 wA2[4], kA2[2]; v4u uC2;
    bf16x8 wA3[4], kA3[2]; v4u uC3;
    bf16x8 wA4[4], kA4[2]; v4u uC4;
    bf16x8 wA5[4], kA5[2]; v4u uC5;
    SCAN_LOAD(0, wA0, kA0, uC0, 0);
    SCAN_LOAD(1, wA1, kA1, uC1, 0);
    SCAN_LOAD(2, wA2, kA2, uC2, 0);
    SCAN_LOAD(3, wA3, kA3, uC3, 0);
    SCAN_LOAD(4, wA4, kA4, uC4, 0);
    SCAN_LOAD(5, wA5, kA5, uC5, 0);
    LBAR();
    SCAN_STEP(0, wA0, kA0, uC0, 0);
    SCAN_STEP(1, wA1, kA1, uC1, 0);
    SCAN_STEP(2, wA2, kA2, uC2, 0);
    SCAN_STEP(3, wA3, kA3, uC3, 0);
    SCAN_STEP(4, wA4, kA4, uC4, 0);
    SCAN_STEP(5, wA5, kA5, uC5, 0);
    for (int n = 6; n < 126; n += 6) {
#if defined(TPROBE_B) && TPROBE_B == 26
        if constexpr (ROLE == 0) { if (n == 60 && blockIdx.x == 0 && lane == 0) __hip_atomic_store((unsigned*)(P.ws + WS_CTL) + 2305, (unsigned)rt(), __ATOMIC_RELAXED, __HIP_MEMORY_SCOPE_AGENT); }
#endif
        SCAN_STEP(n, wA0, kA0, uC0, 0);
        SCAN_STEP(n + 1, wA1, kA1, uC1, 0);
        SCAN_STEP(n + 2, wA2, kA2, uC2, 0);
        SCAN_STEP(n + 3, wA3, kA3, uC3, 0);
        SCAN_STEP(n + 4, wA4, kA4, uC4, 0);
        SCAN_STEP(n + 5, wA5, kA5, uC5, 0);
    }
    SCAN_STEP(126, wA0, kA0, uC0, 0);
    SCAN_STEP(127, wA1, kA1, uC1, 0);
#undef SCAN_LOAD
#undef SCAN_STEP
    asm volatile("s_waitcnt vmcnt(0)" ::: "memory");
    LBAR();
    if (tid == 0) __hip_atomic_store(prog, 128u, __ATOMIC_RELAXED, __HIP_MEMORY_SCOPE_AGENT);
}
__device__ __forceinline__ void p3_scan(Frame& F, const Ptrs& P, int blk) {
    if (F.wave == 0) p3_scan_role<0>(F, P, blk); else if (F.wave < 4) p3_scan_role<1>(F, P, blk); else p3_scan_role<2>(F, P, blk);
}

#ifndef P4_POLL_SLEEP
#define P4_POLL_SLEEP 24
#endif
__device__ __forceinline__ unsigned scan_poll4(const unsigned* pg) {
    const v4u w = __builtin_amdgcn_raw_buffer_load_b128(mk_rsrc(pg, 16u), 0, 0, 16  );
    const unsigned a = w.x < w.y ? w.x : w.y, b = w.z < w.w ? w.z : w.w;
    return (unsigned)__builtin_amdgcn_readfirstlane(a < b ? a : b);
}
__device__ __forceinline__ void p3_scan_warm(Frame& F, const Ptrs& P, int bh) {
    const unsigned* pg = (const unsigned*)(P.ws + WS_CTL) + CW_PROG + bh * 64;
    const unsigned char* item0 = P.ws + WS_GDN + (size_t)(bh * 128) * GDN_ITEM;
    const int tid = F.wave * 64 + lane_now();
    int nx = 2 * SCAN_DIST;
    unsigned acc = 0, t0 = 0, t1 = 0, t2 = 0, t3 = 0;
    const bool act = tid < 384;
    for (unsigned spins = 0; nx < 128 && spins < (1u << 22); ++spins) {
        unsigned mn = scan_poll4(pg);
        acc += t0 + t1 + t2 + t3;
        int tgt = (int)mn + SCAN_WARM_AHEAD; tgt = tgt > 128 ? 128 : tgt;
        if (nx < (int)mn + 2 * SCAN_DIST) nx = (int)mn + 2 * SCAN_DIST;
        if (nx >= tgt) { __builtin_amdgcn_s_sleep(8); continue; }
        const unsigned char* ip = item0 + (size_t)nx * GDN_ITEM + tid * 128;
        const int k = tgt - nx;
        if (act) { t0 = *(const volatile unsigned*)ip;
            if (k > 1) t1 = *(const volatile unsigned*)(ip + GDN_ITEM);
            if (k > 2) t2 = *(const volatile unsigned*)(ip + 2 * GDN_ITEM);
            if (k > 3) t3 = *(const volatile unsigned*)(ip + 3 * GDN_ITEM); }
        nx += k > 4 ? 4 : k;
    }
    acc += t0 + t1 + t2 + t3;
    if (acc == 0x9E3779B9u) F.MISC[15] = acc;
}

struct ConfTaps { float w[CWID]; float bias, lg, lb; };
__device__ __forceinline__ void p3_conf_load_taps(const Ptrs& P, int ch, ConfTaps& T) {
#pragma unroll
    for (int k = 0; k < CWID; ++k) T.w[k] = P.w_conv_dw[k * CCH + ch];
    T.bias = P.b_conv_dw[ch]; T.lg = P.ln_g[ch]; T.lb = P.ln_b[ch];
}
__device__ __forceinline__ void p3_conf_tile(Frame& F, const Ptrs& P, int tile, const ConfTaps& T) {
    LAS float* part = (LAS float*)F.lds; LAS float* stat = (LAS float*)(F.lds + 2048);
    LAS unsigned char* UT = F.lds + 4096; LAS unsigned char* OT = F.lds + 67584;
    const unsigned char* U = P.ws + WS_U; unsigned char* MIX = P.ws + WS_MIX;
    const int lane = lane_now(), ch = F.wave * 64 + lane; const size_t m0 = (size_t)tile * 32; const int t0 = (int)(m0 % SEQ);
#pragma unroll
    for (int u = 0; u < 8; ++u) { const int cid = ch + 512 * u; if (cid < 62 * 64) { const int row = cid >> 6, t = t0 - 30 + row;
        v4u v = {0u, 0u, 0u, 0u}; if (t >= 0) v = *(const GAS v4u*)(U + ((m0 + row) - 30) * (CCH * 2) + (cid & 63) * 16);
        *(LAS v4u*)(UT + cid * 16) = v; } }
    LBAR();
    float cv[32];
#pragma unroll
    for (int i = 0; i < 32; ++i) cv[i] = T.bias;
    {
        float uu[62];
#pragma unroll
        for (int j = 0; j < 62; ++j) uu[j] = bf2f(*(const LAS unsigned short*)(UT + j * (CCH * 2) + ch * 2));
#pragma unroll
        for (int k = 0; k < CWID; ++k)
#pragma unroll
            for (int i = 0; i < 32; ++i) cv[i] = fmaf(T.w[k], uu[i + k], cv[i]);
    }
#pragma unroll
    for (int i = 0; i < 32; ++i) { const float s1 = wave_sum_f(cv[i]), s2 = wave_sum_f(cv[i] * cv[i]); if (lane == 0) { part[(F.wave * 32 + i) * 2] = s1; part[(F.wave * 32 + i) * 2 + 1] = s2; } }
    LBAR();
    if (ch < 32) { float s1 = 0.f, s2 = 0.f;
#pragma unroll
        for (int w = 0; w < 8; ++w) { s1 += part[(w * 32 + ch) * 2]; s2 += part[(w * 32 + ch) * 2 + 1]; }
        const float mu = s1 * (1.f / CCH); const float var = fmaxf(s2 * (1.f / CCH) - mu * mu, 0.f);
        stat[ch * 2] = mu; stat[ch * 2 + 1] = rsqrtf(var + EPS); }
    LBAR();
#pragma unroll
    for (int i = 0; i < 32; ++i) { const float yv = (cv[i] - stat[i * 2]) * stat[i * 2 + 1] * T.lg + T.lb; *(LAS unsigned short*)(OT + i * (CCH * 2) + ch * 2) = (unsigned short)f2bf(fsilu(yv)); }
    LBAR();
#pragma unroll
    for (int u = 0; u < 4; ++u) { const int cid = ch + 512 * u, row = cid >> 6;
        *(GAS v4u*)(MIX + (m0 + row) * (DM * 2) + 1024 + (cid & 63) * 16) = *(const LAS v4u*)(OT + cid * 16); }
    LBAR();
}

__device__ __forceinline__ void p4_gdn_out(Frame& F, const Ptrs& P, int idx, int cnt) {
    LAS float* ssq = (LAS float*)F.lds;
    const bf16* QKVZ = (const bf16*)(P.ws + WS_QKVZ); bf16* MIX = (bf16*)(P.ws + WS_MIX);
    const int wave = F.wave;
    const int ct2 = wave >> 2, et4 = wave & 3;
    for (int itc = idx; itc < 1024; itc += cnt) {
        const int lane = lane_now();
        const int r32 = lane & 31, hh = lane >> 5;
        const int bh = itc & 7, n = itc >> 3, b = bh >> 2, h = bh & 3, it = bh * 128 + n;
        const size_t m0 = (size_t)b * SEQ + (size_t)n * 64;
        const unsigned char* item = P.ws + WS_GDN + (size_t)it * GDN_ITEM;
        if (wave == 0) {
            const unsigned* pg = (const unsigned*)(P.ws + WS_CTL) + CW_PROG + bh * 64; unsigned spins = 0;
            for (;;) { const unsigned mn = scan_poll4(pg);
                if (mn >= (unsigned)(n + 1) || ++spins > (1u << 22)) break;
                __builtin_amdgcn_s_sleep(P4_POLL_SLEEP); }
            asm volatile("s_waitcnt vmcnt(0)" ::: "memory");
        }
        asm volatile("" ::: "memory"); __builtin_amdgcn_s_barrier(); asm volatile("" ::: "memory");
        f32x16 acc;
#pragma unroll
        for (int i = 0; i < 16; ++i) acc[i] = 0.f;
        const int e = 32 * et4 + r32;
        LAS unsigned char* ZT = F.lds + 4096; LAS unsigned char* OT = F.lds + 4096 + 16384;
        {
            bf16x8 a1[8], b1[8], a2[4], b2[4];
            v4u zc[2];
#pragma unroll
            for (int u = 0; u < 2; ++u) { const int cid = wave * 64 + lane + 512 * u; zc[u] = *(const GAS v4u*)((const unsigned char*)QKVZ + (m0 + (cid >> 4)) * 4096 + (1536 + h * 128) * 2 + (cid & 15) * 16); }
            const unsigned char* Ap = item + GI_QD + ((ct2 * 8) * 64 + lane) * 16;
            const __amdgpu_buffer_rsrc_t rsn4 = mk_rsrc(P.ws + WS_SN + (size_t)it * 32768, 32768u), rvn4 = mk_rsrc(P.ws + WS_VN + (size_t)it * 16384, 16384u);
            const int boff = (((et4 * 64) + (r32 & 15) + 32 * hh) * 2 + (r32 >> 4)) * 8;
            const unsigned char* Ap2 = item + GI_QK + ((ct2 * 4) * 64 + lane) * 16;
            constexpr int BSTEP = 4096, BHI = 256;
            if (n > 0) {
#pragma unroll
                for (int s = 0; s < 8; ++s) { a1[s] = *(const GAS bf16x8*)(Ap + s * 1024);
                    const u32x2 lo = __builtin_amdgcn_raw_buffer_load_b64(rsn4, boff + s * BSTEP, 0, 16  ), hi = __builtin_amdgcn_raw_buffer_load_b64(rsn4, boff + s * BSTEP + BHI, 0, 16); const v4u w = {lo.x, lo.y, hi.x, hi.y}; b1[s] = __builtin_bit_cast(bf16x8, w); }
            }
#pragma unroll
            for (int s = 0; s < 4; ++s) { a2[s] = *(const GAS bf16x8*)(Ap2 + s * 1024);
                const u32x2 lo = __builtin_amdgcn_raw_buffer_load_b64(rvn4, boff + s * BSTEP, 0, 16  ), hi = __builtin_amdgcn_raw_buffer_load_b64(rvn4, boff + s * BSTEP + BHI, 0, 16); const v4u w = {lo.x, lo.y, hi.x, hi.y}; b2[s] = __builtin_bit_cast(bf16x8, w); }
#pragma unroll
            for (int u = 0; u < 2; ++u) *(LAS v4u*)(ZT + (wave * 64 + lane + 512 * u) * 16) = zc[u];
            if (n > 0) {
#pragma unroll
                for (int s = 0; s < 8; ++s) acc = __builtin_amdgcn_mfma_f32_32x32x16_bf16(a1[s], b1[s], acc, 0, 0, 0);
            }
#pragma unroll
            for (int s = 0; s < 4; ++s) acc = __builtin_amdgcn_mfma_f32_32x32x16_bf16(a2[s], b2[s], acc, 0, 0, 0);
            float sq[16];
#pragma unroll
            for (int reg = 0; reg < 16; ++reg) sq[reg] = acc[reg] * acc[reg];
#pragma unroll
            for (int st = 1; st < 32; st <<= 1) { float t[16];
#pragma unroll
                for (int reg = 0; reg < 16; ++reg) t[reg] = __shfl_xor(sq[reg], st);
#pragma unroll
                for (int reg = 0; reg < 16; ++reg) sq[reg] += t[reg]; }
            if (r32 == 0) {
#pragma unroll
                for (int reg = 0; reg < 16; ++reg) ssq[(32 * ct2 + (reg & 3) + 8 * (reg >> 2) + 4 * hh) * 4 + et4] = sq[reg]; }
            LBAR();
            const float gg = P.g_gdn_out[e];
#pragma unroll
            for (int reg = 0; reg < 16; ++reg) { const int row = 32 * ct2 + (reg & 3) + 8 * (reg >> 2) + 4 * hh;
                const f32x4 sv = *(const LAS f32x4*)(ssq + row * 4);
                const float rs = rsqrtf(((sv.x + sv.y) + (sv.z + sv.w)) * (1.f / DV) + EPS);
                const float z = bf2f(*(const LAS unsigned short*)(ZT + row * 256 + e * 2));
                *(LAS unsigned short*)(OT + row * 256 + e * 2) = (unsigned short)f2bf(acc[reg] * rs * gg * fsilu(z)); }
            LBAR();
#pragma unroll
            for (int u = 0; u < 2; ++u) { const int cid = wave * 64 + lane + 512 * u;
                *(GAS v4u*)((unsigned char*)MIX + (m0 + (cid >> 4)) * 2048 + h * 256 + (cid & 15) * 16) = *(const LAS v4u*)(OT + cid * 16); }
        }
        LBAR();
    }
}

constexpr size_t WS_WR = 15 * MiB;
constexpr size_t WS_CNT = 1 * MiB;
constexpr size_t WS_TPOS = 1 * MiB + 256 * 1024;
constexpr size_t WS_GATEW = 1 * MiB + 512 * 1024;
constexpr size_t WS_TEX = 2 * MiB;
constexpr size_t WS_XG = 144 * MiB;
constexpr size_t WS_Y = 240 * MiB;
constexpr size_t WS_ACT = 336 * MiB;
constexpr int PSLOTS = 49152;
constexpr size_t WS_XN3 = WS_N1;
constexpr size_t WS_H2 = 144 * MiB;
constexpr size_t WS_H3 = 240 * MiB;
constexpr int LDS_LG = 131584, LDS_TE = LDS_LG + 64 * 80 * 4, LDS_TW = LDS_TE + 512, LDS_CNT = LDS_TW + 512, LDS_POS = LDS_CNT + 256, LDS_BASE = LDS_POS + 512, LDS_PART = LDS_BASE + 256;

__device__ __forceinline__ void unpack8(const v4u w, float (&f)[8]) {
    f[0] = __uint_as_float(w.x << 16); f[1] = __uint_as_float(w.x & 0xffff0000u); f[2] = __uint_as_float(w.y << 16); f[3] = __uint_as_float(w.y & 0xffff0000u);
    f[4] = __uint_as_float(w.z << 16); f[5] = __uint_as_float(w.z & 0xffff0000u); f[6] = __uint_as_float(w.w << 16); f[7] = __uint_as_float(w.w & 0xffff0000u);
}
__device__ __forceinline__ v4u pack8(const float (&f)[8]) { v4u w; w.x = pk2(f[0], f[1]); w.y = pk2(f[2], f[3]); w.z = pk2(f[4], f[5]); w.w = pk2(f[6], f[7]); return w; }
struct EpiRes {
    static constexpr bool PERM = true, AFTER_DRAIN = false;
    const float* base; pg8::bf16_t* out;
    __device__ __forceinline__ void operator()(const pg8::f32x4 (&acc)[2][2][4][2], const pg8::Unit& u, int wr, int wc, int fr, int fq) const {
        using namespace pg8;
        const int row0 = u.pm * BM + wr * 64 + fr, col0 = u.pn * BM + wc * 32 + 8 * fq;
#pragma unroll
        for (int ai = 0; ai < 2; ++ai)
#pragma unroll
            for (int m = 0; m < 4; ++m) { const size_t off = (size_t)(row0 + ai * HALF + m * 16) * DM + col0;
#pragma unroll
                for (int bj = 0; bj < 2; ++bj) { const size_t o = off + bj * HALF;
                    const f32x4 v0 = *(const f32x4*)(base + o) + acc[ai][bj][m][0], v1 = *(const f32x4*)(base + o + 4) + acc[ai][bj][m][1];
                    u32x4 w; w.x = cvt_pk_bf16(v0[0], v0[1]); w.y = cvt_pk_bf16(v0[2], v0[3]); w.z = cvt_pk_bf16(v1[0], v1[1]); w.w = cvt_pk_bf16(v1[2], v1[3]);
                    *(u32x4*)(out + o) = w; } }
    }
};
struct EpiSwiGLU {
    static constexpr bool PERM = true, AFTER_DRAIN = false;
    pg8::bf16_t* ACT;
    __device__ __forceinline__ void operator()(const pg8::f32x4 (&acc)[2][2][4][2], const pg8::Unit& u, int wr, int wc, int fr, int fq) const {
        using namespace pg8;
        const int row0 = u.pm * BM + wr * 64 + fr, hid0 = u.pn * 128 + wc * 16 + 4 * fq;
#pragma unroll
        for (int ai = 0; ai < 2; ++ai)
#pragma unroll
            for (int m = 0; m < 4; ++m) { bf16_t* rowp = ACT + (size_t)(row0 + ai * HALF + m * 16) * DEXP + hid0;
#pragma unroll
                for (int bj = 0; bj < 2; ++bj) { const f32x4 a = acc[ai][bj][m][0], g = acc[ai][bj][m][1];
                    const unsigned lo = cvt_pk_bf16(fsilu(a[0]) * g[0], fsilu(a[1]) * g[1]), hi = cvt_pk_bf16(fsilu(a[2]) * g[2], fsilu(a[3]) * g[3]);
                    __hip_atomic_store((unsigned long long*)(rowp + bj * 64), (unsigned long long)lo | ((unsigned long long)hi << 32), __ATOMIC_RELAXED, __HIP_MEMORY_SCOPE_AGENT); } }
    }
};
struct EpiGate {
    static constexpr bool PERM = true, AFTER_DRAIN = false;
    pg8::bf16_t* Y; const float* gatew;
    __device__ __forceinline__ void operator()(const pg8::f32x4 (&acc)[2][2][4][2], const pg8::Unit& u, int wr, int wc, int fr, int fq) const {
        using namespace pg8;
        const int row0 = u.pm * BM + wr * 64 + fr, col0 = u.pn * BM + wc * 32 + 8 * fq;
#pragma unroll
        for (int ai = 0; ai < 2; ++ai)
#pragma unroll
            for (int m = 0; m < 4; ++m) { const int row = row0 + ai * HALF + m * 16; const float gw = gatew[row]; bf16_t* rowp = Y + (size_t)row * DM + col0;
#pragma unroll
                for (int bj = 0; bj < 2; ++bj) { const f32x4 v0 = acc[ai][bj][m][0] * gw, v1 = acc[ai][bj][m][1] * gw;
                    u32x4 w; w.x = cvt_pk_bf16(v0[0], v0[1]); w.y = cvt_pk_bf16(v0[2], v0[3]); w.z = cvt_pk_bf16(v1[0], v1[1]); w.w = cvt_pk_bf16(v1[2], v1[3]);
                    *(u32x4*)(rowp + bj * HALF) = w; } }
    }
};
struct EpiPle {
    static constexpr bool PERM = true, AFTER_DRAIN = false;
    const pg8::bf16_t* h2; const pg8::bf16_t* proj; pg8::bf16_t* out;
    __device__ __forceinline__ void operator()(const pg8::f32x4 (&acc)[2][2][4][2], const pg8::Unit& u, int wr, int wc, int fr, int fq) const {
        using namespace pg8;
        const int row0 = u.pm * BM + wr * 64 + fr, col0 = u.pn * BM + wc * 32 + 8 * fq;
#pragma unroll
        for (int ai = 0; ai < 2; ++ai)
#pragma unroll
            for (int m = 0; m < 4; ++m) { const size_t off = (size_t)(row0 + ai * HALF + m * 16) * DM + col0;
#pragma unroll
                for (int bj = 0; bj < 2; ++bj) { const size_t o = off + bj * HALF; float hh_[8], pp_[8], r_[8];
                    unpack8(*(const v4u*)(h2 + o), hh_); unpack8(*(const v4u*)(proj + o), pp_);
#pragma unroll
                    for (int i = 0; i < 4; ++i) { r_[i] = hh_[i] + fsigmoid(acc[ai][bj][m][0][i]) * pp_[i]; r_[4 + i] = hh_[4 + i] + fsigmoid(acc[ai][bj][m][1][i]) * pp_[4 + i]; }
                    *(v4u*)(out + o) = pack8(r_); } }
    }
};
struct MoeOrder {
    const int* tex; int nN, G, c;
    __device__ __forceinline__ bool next(int i, pg8::Unit& u) const {
        const int nt = __builtin_amdgcn_readfirstlane(__hip_atomic_load(tex, __ATOMIC_RELAXED, __HIP_MEMORY_SCOPE_AGENT)); const long L = (long)i * G + c; if (L >= (long)nt * nN) return false;
        const int rt = (int)(L / nN); u.pm = rt; u.pn = (int)(L % nN); u.be = __builtin_amdgcn_readfirstlane(__hip_atomic_load(tex + 64 + rt, __ATOMIC_RELAXED, __HIP_MEMORY_SCOPE_AGENT)); return true;
    }
    __device__ __forceinline__ void a_ready(const pg8::Unit&) const {}
    __device__ __forceinline__ void done(const pg8::Unit&) const {}
};

struct MoeUpOrder {
    unsigned char* ws; int G, c;
    __device__ __forceinline__ bool next(int i, pg8::Unit& u) const {
        const int nt = __builtin_amdgcn_readfirstlane(__hip_atomic_load((const int*)(ws + WS_TEX), __ATOMIC_RELAXED, __HIP_MEMORY_SCOPE_AGENT)); const int L = i * G + c; if (L >= 2 * nt) return false;
        const int rt = L >> 1; u.pm = rt; u.pn = L & 1; u.be = __builtin_amdgcn_readfirstlane(__hip_atomic_load((const int*)(ws + WS_TEX) + 64 + rt, __ATOMIC_RELAXED, __HIP_MEMORY_SCOPE_AGENT)); return true;
    }
    __device__ __forceinline__ void a_ready(const pg8::Unit&) const {}
    __device__ __forceinline__ void done(const pg8::Unit& u) const {
        asm volatile("s_waitcnt vmcnt(0)" ::: "memory");
        if (lane_now() == 0) __hip_atomic_fetch_add((unsigned*)(ws + WS_CTL) + CW_READY + 64 * u.pm, 1u, __ATOMIC_RELAXED, __HIP_MEMORY_SCOPE_AGENT);
    }
};
struct MoeDownOrder {
    unsigned char* ws; int G, c, wave;
    __device__ __forceinline__ bool next(int i, pg8::Unit& u) const {
        const int nt = __builtin_amdgcn_readfirstlane(__hip_atomic_load((const int*)(ws + WS_TEX), __ATOMIC_RELAXED, __HIP_MEMORY_SCOPE_AGENT)); const int H = (2 * nt > G) ? 2 * nt - G : 0;
        int L;
        if (i == 0) L = c; else { if (c < H) return false; L = G + (i - 1) * (G - H) + (c - H); }
        if (L >= 4 * nt) return false;
        const int rt = L >> 2; u.pm = rt; u.pn = L & 3; u.be = __builtin_amdgcn_readfirstlane(__hip_atomic_load((const int*)(ws + WS_TEX) + 64 + rt, __ATOMIC_RELAXED, __HIP_MEMORY_SCOPE_AGENT)); return true;
    }
    __device__ __forceinline__ void wait_ready(const pg8::Unit& u) const {
        if (wave == 0) {
            unsigned spins = 0;
            while ((unsigned)__builtin_amdgcn_readfirstlane(__hip_atomic_load((unsigned*)(ws + WS_CTL) + CW_READY + 64 * u.pm, __ATOMIC_RELAXED, __HIP_MEMORY_SCOPE_AGENT)) < 16u && ++spins < (1u << 22)) __builtin_amdgcn_s_sleep(2);
            __builtin_amdgcn_fence(__ATOMIC_ACQUIRE, "agent");
            asm volatile("s_waitcnt vmcnt(0)" ::: "memory");
        }
        asm volatile("" ::: "memory"); __builtin_amdgcn_s_barrier(); asm volatile("" ::: "memory");
    }
};
struct OneUnit {
    pg8::Unit u0;
    __device__ __forceinline__ bool next(int i, pg8::Unit& u) const { if (i != 0) return false; u = u0; return true; }
    __device__ __forceinline__ void a_ready(const pg8::Unit&) const {}
    __device__ __forceinline__ void done(const pg8::Unit&) const {}
};

__device__ __forceinline__ void p6_router(Frame& F, const Ptrs& P) {
    const int lane = lane_now(), wave = F.wave, tid = wave * 64 + lane;
    const int tile = F.vcu; const size_t m0 = (size_t)tile * 64;
    const bf16* H1 = (const bf16*)(P.ws + WS_H1);
    LAS unsigned char* XT = F.lds;
    LAS float* LG = (LAS float*)(F.lds + LDS_LG); LAS int* te_l = (LAS int*)(F.lds + LDS_TE); LAS float* tw_l = (LAS float*)(F.lds + LDS_TW); LAS int* cnt_l = (LAS int*)(F.lds + LDS_CNT);
    if (tid < 64) cnt_l[tid] = 0;
    const int r = lane & 15, q = lane >> 4, mt = wave & 3, nt0 = wave < 4 ? 0 : 3, nnt = wave < 4 ? 3 : 2;
    const unsigned char* Wr = P.ws + WS_WR + ((size_t)(16 * nt0 + r) * DM + 8 * q) * 2;
    bf16x8 bA[8][3], bB[8][3];
#define P6_LOADB(dst, s8) _Pragma("unroll") for (int u = 0; u < 8; ++u) _Pragma("unroll") for (int t = 0; t < 3; ++t) if (t < nnt) dst[u][t] = *(const GAS bf16x8*)(Wr + (size_t)t * (16 * DM * 2) + 64 * ((s8) + u))
#define P6_MFMA(src, s8) _Pragma("unroll") for (int u = 0; u < 8; ++u) { const bf16x8 a = *(const LAS bf16x8*)(XT + (16 * mt + r) * 2048 + (32 * ((s8) + u) + 8 * q) * 2); \
        _Pragma("unroll") for (int t = 0; t < 3; ++t) if (t < nnt) acc[t] = __builtin_amdgcn_mfma_f32_16x16x32_bf16(a, src[u][t], acc[t], 0, 0, 0); }
    P6_LOADB(bA, 0);
    {
        v4u raw[8][2];
#pragma unroll
        for (int rr = 0; rr < 8; ++rr) { const GAS v4u* xr = (const GAS v4u*)(H1 + (m0 + wave * 8 + rr) * DM) + lane; raw[rr][0] = xr[0]; raw[rr][1] = xr[64]; }
        f32x4 gm[2][2];
#pragma unroll
        for (int j = 0; j < 2; ++j) { gm[j][0] = ((const GAS f32x4*)P.g_moe)[2 * (64 * j + lane)]; gm[j][1] = ((const GAS f32x4*)P.g_moe)[2 * (64 * j + lane) + 1]; }
#pragma unroll
        for (int rr = 0; rr < 8; ++rr) { const int row = wave * 8 + rr;
            float v[2][8]; float s = 0.f;
#pragma unroll
            for (int j = 0; j < 2; ++j) { unpack8(raw[rr][j], v[j]);
#pragma unroll
                for (int i = 0; i < 8; ++i) s += v[j][i] * v[j][i]; }
            const float rs = rsqrtf(wave_sum_f(s) * (1.f / DM) + EPS);
#pragma unroll
            for (int j = 0; j < 2; ++j) {
#pragma unroll
                for (int i = 0; i < 4; ++i) { v[j][i] *= rs * gm[j][0][i]; v[j][4 + i] *= rs * gm[j][1][i]; }
                *(LAS v4u*)(XT + row * 2048 + (64 * j + lane) * 16) = pack8(v[j]); } }
    }
    LBAR();
    {
        f32x4 acc[3];
#pragma unroll
        for (int t = 0; t < 3; ++t) acc[t] = (f32x4){0.f, 0.f, 0.f, 0.f};
        P6_LOADB(bB, 8);  P6_MFMA(bA, 0);
        P6_LOADB(bA, 16); P6_MFMA(bB, 8);
        P6_LOADB(bB, 24); P6_MFMA(bA, 16);
        P6_MFMA(bB, 24);
#pragma unroll
        for (int t = 0; t < 3; ++t) if (t < nnt) {
#pragma unroll
            for (int reg = 0; reg < 4; ++reg) LG[(16 * mt + 4 * q + reg) * 80 + 16 * (nt0 + t) + r] = acc[t][reg]; }
    }
#undef P6_LOADB
#undef P6_MFMA
    LBAR();
    if (tid < 64) {
        const LAS float* lg = LG + tid * 80;
        float mx = lg[0]; int gi = 0;
#pragma unroll
        for (int j = 1; j < NGRP; ++j) { const float v = lg[j]; if (v > mx) { mx = v; gi = j; } }
        float den = 0.f;
#pragma unroll
        for (int j = 0; j < NGRP; ++j) den += __expf(lg[j] - mx);
        const float gw = 1.f / den;
        float m1 = -INFINITY, m2 = -INFINITY; int i1 = 0, i2 = 0;
#pragma unroll
        for (int j = 0; j < EPG; ++j) { const float v = lg[8 + gi * EPG + j]; if (v > m1) { m2 = m1; i2 = i1; m1 = v; i1 = j; } else if (v > m2) { m2 = v; i2 = j; } }
        const float p2 = __expf(m2 - m1);
        const int e1 = gi * EPG + i1, e2 = gi * EPG + i2;
        te_l[tid * 2] = e1; te_l[tid * 2 + 1] = e2; tw_l[tid * 2] = gw / (1.f + p2); tw_l[tid * 2 + 1] = gw * p2 / (1.f + p2);
        __hip_atomic_fetch_add(cnt_l + e1, 1, __ATOMIC_RELAXED, __HIP_MEMORY_SCOPE_WORKGROUP); __hip_atomic_fetch_add(cnt_l + e2, 1, __ATOMIC_RELAXED, __HIP_MEMORY_SCOPE_WORKGROUP);
    }
    LBAR();
    if (tid < 64) ((int*)(P.ws + WS_CNT))[tile * 64 + tid] = cnt_l[tid];
}
__device__ __forceinline__ void p7_dispatch(Frame& F, const Ptrs& P) {
    const int lane = lane_now(), wave = F.wave, tid = wave * 64 + lane;
    const int tile = F.vcu; const size_t m0 = (size_t)tile * 64;
    LAS unsigned char* XT = F.lds;
    LAS int* te_l = (LAS int*)(F.lds + LDS_TE); LAS float* tw_l = (LAS float*)(F.lds + LDS_TW); LAS int* pos_l = (LAS int*)(F.lds + LDS_POS); LAS int* base_l = (LAS int*)(F.lds + LDS_BASE);
    LAS int* part = (LAS int*)(F.lds + LDS_PART);
    const int* CNT = (const int*)(P.ws + WS_CNT);
    { const int e = lane, pt = wave; int tot = 0, bef = 0;
      int cv[32];
#pragma unroll
      for (int t = 0; t < 32; ++t) cv[t] = CNT[(32 * pt + t) * 64 + e];
#pragma unroll
      for (int t = 0; t < 32; ++t) { tot += cv[t]; bef += (32 * pt + t < tile) ? cv[t] : 0; }
      part[(pt * 64 + e) * 2] = tot; part[(pt * 64 + e) * 2 + 1] = bef; }
    LBAR();
    if (wave == 0) { int tot = 0, bef = 0;
#pragma unroll
        for (int pt = 0; pt < 8; ++pt) { tot += part[(pt * 64 + lane) * 2]; bef += part[(pt * 64 + lane) * 2 + 1]; }
        const int pc = (tot + 255) & ~255; int incl = pc;
#pragma unroll
        for (int off = 1; off < 64; off <<= 1) { const int t = __shfl_up(incl, off); if (lane >= off) incl += t; }
        const int pstart = incl - pc;
        base_l[lane] = pstart + bef;
        if (tile == 0) { int* TEX = (int*)(P.ws + WS_TEX); for (int r = pstart >> 8; r < (pstart + pc) >> 8; ++r) TEX[64 + r] = lane; if (lane == 63) TEX[0] = (pstart + pc) >> 8; }
    }
    LBAR();
    if (wave < 2) { const int e = te_l[tid]; int rank = 0;
#pragma unroll
        for (int j4 = 0; j4 < 32; ++j4) { const v4u t4 = *(const LAS v4u*)(te_l + 4 * j4);
            rank += ((4 * j4 + 0 < tid && (int)t4.x == e) ? 1 : 0) + ((4 * j4 + 1 < tid && (int)t4.y == e) ? 1 : 0) + ((4 * j4 + 2 < tid && (int)t4.z == e) ? 1 : 0) + ((4 * j4 + 3 < tid && (int)t4.w == e) ? 1 : 0); }
        const int pos = base_l[e] + rank; pos_l[tid] = pos;
        ((int*)(P.ws + WS_TPOS))[m0 * 2 + tid] = pos; ((float*)(P.ws + WS_GATEW))[pos] = tw_l[tid]; }
    LBAR();
    for (int rr = 0; rr < 8; ++rr) { const int row = wave * 8 + rr; const int p0 = pos_l[row * 2], p1 = pos_l[row * 2 + 1];
#pragma unroll
        for (int c = 0; c < 2; ++c) { const v4u v = *(const LAS v4u*)(XT + row * 2048 + (lane + 64 * c) * 16);
            *(GAS v4u*)(P.ws + WS_XG + (size_t)p0 * 2048 + (lane + 64 * c) * 16) = v; *(GAS v4u*)(P.ws + WS_XG + (size_t)p1 * 2048 + (lane + 64 * c) * 16) = v; } }
}
__device__ __forceinline__ void p10_combine(Frame& F, const Ptrs& P) {
    const int lane = lane_now(); const int gw = F.vcu * NWAVES + F.wave, NGW = F.G * NWAVES;
    const bf16* H = (const bf16*)(P.ws + WS_H1); bf16* H2 = (bf16*)(P.ws + WS_H2); const int* TPOS = (const int*)(P.ws + WS_TPOS); bf16* XN3 = (bf16*)(P.ws + WS_XN3);
    for (int m = gw; m < M; m += NGW) {
        const int p0 = TPOS[m * 2], p1 = TPOS[m * 2 + 1];
        const GAS v4u* hr = (const GAS v4u*)(H + (size_t)m * DM) + lane; GAS v4u* ho = (GAS v4u*)(H2 + (size_t)m * DM) + lane;
        const GAS v4u* y0 = (const GAS v4u*)(P.ws + WS_Y + (size_t)p0 * 2048) + lane; const GAS v4u* y1 = (const GAS v4u*)(P.ws + WS_Y + (size_t)p1 * 2048) + lane;
        float v[2][8]; float s = 0.f;
#pragma unroll
        for (int j = 0; j < 2; ++j) { float a[8], b[8]; unpack8(hr[64 * j], v[j]); unpack8(y0[64 * j], a); unpack8(y1[64 * j], b);
#pragma unroll
            for (int i = 0; i < 8; ++i) { v[j][i] += a[i] + b[i]; s += v[j][i] * v[j][i]; }
            ho[64 * j] = pack8(v[j]); }
        const float r = rsqrtf(wave_sum_f(s) * (1.f / DM) + EPS);
        GAS v4u* o8 = (GAS v4u*)(XN3 + (size_t)m * DM) + lane;
#pragma unroll
        for (int j = 0; j < 2; ++j) { const f32x4 g0 = ((const GAS f32x4*)P.g_ple)[2 * (64 * j + lane)], g1 = ((const GAS f32x4*)P.g_ple)[2 * (64 * j + lane) + 1];
#pragma unroll
            for (int i = 0; i < 4; ++i) { v[j][i] *= r * g0[i]; v[j][4 + i] *= r * g1[i]; }
            o8[64 * j] = pack8(v[j]); }
    }
}
__device__ __forceinline__ void p12_final(Frame& F, const Ptrs& P) {
    const int lane = lane_now(); const int gw = F.vcu * NWAVES + F.wave, NGW = F.G * NWAVES;
    for (int m = gw; m < M; m += NGW) {
        const GAS v4u* hr = (const GAS v4u*)((const bf16*)(P.ws + WS_H3) + (size_t)m * DM) + lane; GAS f32x4* ho = (GAS f32x4*)(P.out + (size_t)m * DM);
        float v[2][8]; float s = 0.f;
#pragma unroll
        for (int j = 0; j < 2; ++j) { unpack8(hr[64 * j], v[j]);
#pragma unroll
            for (int i = 0; i < 8; ++i) s += v[j][i] * v[j][i]; }
        float r = rsqrtf(wave_sum_f(s) * (1.f / DM) + EPS);
#if XCHK
        { const unsigned c1 = __hip_atomic_load((const unsigned*)(P.ws + WS_CTL) + CK_P1, __ATOMIC_RELAXED, __HIP_MEMORY_SCOPE_AGENT), c2 = __hip_atomic_load((const unsigned*)(P.ws + WS_CTL) + CK_P2, __ATOMIC_RELAXED, __HIP_MEMORY_SCOPE_AGENT);
          const unsigned p1 = ((const unsigned*)(P.ws + 3 * MiB))[0]; (void)c2;
          if (__hip_atomic_load((const unsigned*)(P.ws + WS_CTL) + CK_P2 + 8, __ATOMIC_RELAXED, __HIP_MEMORY_SCOPE_AGENT) != 0u) r *= 3.0f;
          if (p1 != 0xAAAAAAAAu && p1 != c1) r *= 1.1f;
          else {
#pragma unroll
            for (int g = 7; g >= 0; --g) { const unsigned cg = __hip_atomic_load((const unsigned*)(P.ws + WS_CTL) + CK_P2 + g, __ATOMIC_RELAXED, __HIP_MEMORY_SCOPE_AGENT), pg = ((const unsigned*)(P.ws + 3 * MiB))[1 + g];
                if (pg != 0xAAAAAAAAu && pg != cg) r *= 1.2f + 0.1f * (float)g; } } }
#endif
#if DTEST
        { const unsigned dtm = __hip_atomic_load((const unsigned*)(P.ws + WS_CTL) + CW_DT, __ATOMIC_RELAXED, __HIP_MEMORY_SCOPE_AGENT);
          if (dtm != 0u) r *= 1.0f + 0.05f * (float)(__builtin_ctz(dtm) + 1) + 0.5f * (float)(__builtin_popcount(dtm) - 1); }
#endif
#pragma unroll
        for (int j = 0; j < 2; ++j) { const int c4 = 2 * (64 * j + lane); const f32x4 g0 = ((const GAS f32x4*)P.g_final)[c4], g1 = ((const GAS f32x4*)P.g_final)[c4 + 1];
            ho[c4] = (f32x4){v[j][0] * r * g0[0], v[j][1] * r * g0[1], v[j][2] * r * g0[2], v[j][3] * r * g0[3]};
            ho[c4 + 1] = (f32x4){v[j][4] * r * g1[0], v[j][5] * r * g1[1], v[j][6] * r * g1[2], v[j][7] * r * g1[3]}; }
    }
#if XCHK
    if (F.vcu == F.G - 1 && F.wave == 7 && lane == 0) { __builtin_amdgcn_s_sleep(127); __builtin_amdgcn_s_sleep(127); __builtin_amdgcn_s_sleep(127);
        ((unsigned*)(P.ws + 3 * MiB))[0] = __hip_atomic_load((const unsigned*)(P.ws + WS_CTL) + CK_P1, __ATOMIC_RELAXED, __HIP_MEMORY_SCOPE_AGENT);
        for (int g = 0; g < 8; ++g) ((unsigned*)(P.ws + 3 * MiB))[1 + g] = __hip_atomic_load((const unsigned*)(P.ws + WS_CTL) + CK_P2 + g, __ATOMIC_RELAXED, __HIP_MEMORY_SCOPE_AGENT); }
#endif
}
struct Args { const float* in[23]; float* out; unsigned char* ws; int ph_lo, ph_hi, use_bar, bar_region; };
constexpr int N_PHASES = 13;
__global__ void __launch_bounds__(NWAVES * 64, 2) mk_fwd(Args args) {
    extern __shared__ __attribute__((aligned(16))) unsigned char lds[];
#if defined(VINIT) && VINIT
    asm volatile("v_mov_b32 v8, 0\n\tv_mov_b32 v9, 0\n\tv_mov_b32 v10, 0\n\tv_mov_b32 v11, 0\n\tv_mov_b32 v12, 0\n\tv_mov_b32 v13, 0\n\tv_mov_b32 v14, 0\n\tv_mov_b32 v15, 0\n\tv_mov_b32 v16, 0\n\tv_mov_b32 v17, 0\n\tv_mov_b32 v18, 0\n\tv_mov_b32 v19, 0\n\tv_mov_b32 v20, 0\n\tv_mov_b32 v21, 0\n\tv_mov_b32 v22, 0\n\tv_mov_b32 v23, 0\n\tv_mov_b32 v24, 0\n\tv_mov_b32 v25, 0\n\tv_mov_b32 v26, 0\n\tv_mov_b32 v27, 0\n\tv_mov_b32 v28, 0\n\tv_mov_b32 v29, 0\n\tv_mov_b32 v30, 0\n\tv_mov_b32 v31, 0\n\tv_mov_b32 v32, 0\n\tv_mov_b32 v33, 0\n\tv_mov_b32 v34, 0\n\tv_mov_b32 v35, 0\n\tv_mov_b32 v36, 0\n\tv_mov_b32 v37, 0\n\tv_mov_b32 v38, 0\n\tv_mov_b32 v39, 0\n\tv_mov_b32 v40, 0\n\tv_mov_b32 v41, 0\n\tv_mov_b32 v42, 0\n\tv_mov_b32 v43, 0\n\tv_mov_b32 v44, 0\n\tv_mov_b32 v45, 0\n\tv_mov_b32 v46, 0\n\tv_mov_b32 v47, 0\n\tv_mov_b32 v48, 0\n\tv_mov_b32 v49, 0\n\tv_mov_b32 v50, 0\n\tv_mov_b32 v51, 0\n\tv_mov_b32 v52, 0\n\tv_mov_b32 v53, 0\n\tv_mov_b32 v54, 0\n\tv_mov_b32 v55, 0\n\tv_mov_b32 v56, 0\n\tv_mov_b32 v57, 0\n\tv_mov_b32 v58, 0\n\tv_mov_b32 v59, 0\n\tv_mov_b32 v60, 0\n\tv_mov_b32 v61, 0\n\tv_mov_b32 v62, 0\n\tv_mov_b32 v63, 0" ::: "v8", "v9", "v10", "v11", "v12", "v13", "v14", "v15", "v16", "v17", "v18", "v19", "v20", "v21", "v22", "v23", "v24", "v25", "v26", "v27", "v28", "v29", "v30", "v31", "v32", "v33", "v34", "v35", "v36", "v37", "v38", "v39", "v40", "v41", "v42", "v43", "v44", "v45", "v46", "v47", "v48", "v49", "v50", "v51", "v52", "v53", "v54", "v55", "v56", "v57", "v58", "v59", "v60", "v61", "v62", "v63");
    asm volatile("v_mov_b32 v64, 0\n\tv_mov_b32 v65, 0\n\tv_mov_b32 v66, 0\n\tv_mov_b32 v67, 0\n\tv_mov_b32 v68, 0\n\tv_mov_b32 v69, 0\n\tv_mov_b32 v70, 0\n\tv_mov_b32 v71, 0\n\tv_mov_b32 v72, 0\n\tv_mov_b32 v73, 0\n\tv_mov_b32 v74, 0\n\tv_mov_b32 v75, 0\n\tv_mov_b32 v76, 0\n\tv_mov_b32 v77, 0\n\tv_mov_b32 v78, 0\n\tv_mov_b32 v79, 0\n\tv_mov_b32 v80, 0\n\tv_mov_b32 v81, 0\n\tv_mov_b32 v82, 0\n\tv_mov_b32 v83, 0\n\tv_mov_b32 v84, 0\n\tv_mov_b32 v85, 0\n\tv_mov_b32 v86, 0\n\tv_mov_b32 v87, 0\n\tv_mov_b32 v88, 0\n\tv_mov_b32 v89, 0\n\tv_mov_b32 v90, 0\n\tv_mov_b32 v91, 0\n\tv_mov_b32 v92, 0\n\tv_mov_b32 v93, 0\n\tv_mov_b32 v94, 0\n\tv_mov_b32 v95, 0\n\tv_mov_b32 v96, 0\n\tv_mov_b32 v97, 0\n\tv_mov_b32 v98, 0\n\tv_mov_b32 v99, 0\n\tv_mov_b32 v100, 0\n\tv_mov_b32 v101, 0\n\tv_mov_b32 v102, 0\n\tv_mov_b32 v103, 0\n\tv_mov_b32 v104, 0\n\tv_mov_b32 v105, 0\n\tv_mov_b32 v106, 0\n\tv_mov_b32 v107, 0\n\tv_mov_b32 v108, 0\n\tv_mov_b32 v109, 0\n\tv_mov_b32 v110, 0\n\tv_mov_b32 v111, 0\n\tv_mov_b32 v112, 0\n\tv_mov_b32 v113, 0\n\tv_mov_b32 v114, 0\n\tv_mov_b32 v115, 0\n\tv_mov_b32 v116, 0\n\tv_mov_b32 v117, 0\n\tv_mov_b32 v118, 0\n\tv_mov_b32 v119, 0\n\tv_mov_b32 v120, 0\n\tv_mov_b32 v121, 0\n\tv_mov_b32 v122, 0\n\tv_mov_b32 v123, 0\n\tv_mov_b32 v124, 0\n\tv_mov_b32 v125, 0\n\tv_mov_b32 v126, 0\n\tv_mov_b32 v127, 0" ::: "v64", "v65", "v66", "v67", "v68", "v69", "v70", "v71", "v72", "v73", "v74", "v75", "v76", "v77", "v78", "v79", "v80", "v81", "v82", "v83", "v84", "v85", "v86", "v87", "v88", "v89", "v90", "v91", "v92", "v93", "v94", "v95", "v96", "v97", "v98", "v99", "v100", "v101", "v102", "v103", "v104", "v105", "v106", "v107", "v108", "v109", "v110", "v111", "v112", "v113", "v114", "v115", "v116", "v117", "v118", "v119", "v120", "v121", "v122", "v123", "v124", "v125", "v126", "v127");
    asm volatile("v_mov_b32 v128, 0\n\tv_mov_b32 v129, 0\n\tv_mov_b32 v130, 0\n\tv_mov_b32 v131, 0\n\tv_mov_b32 v132, 0\n\tv_mov_b32 v133, 0\n\tv_mov_b32 v134, 0\n\tv_mov_b32 v135, 0\n\tv_mov_b32 v136, 0\n\tv_mov_b32 v137, 0\n\tv_mov_b32 v138, 0\n\tv_mov_b32 v139, 0\n\tv_mov_b32 v140, 0\n\tv_mov_b32 v141, 0\n\tv_mov_b32 v142, 0\n\tv_mov_b32 v143, 0\n\tv_mov_b32 v144, 0\n\tv_mov_b32 v145, 0\n\tv_mov_b32 v146, 0\n\tv_mov_b32 v147, 0\n\tv_mov_b32 v148, 0\n\tv_mov_b32 v149, 0\n\tv_mov_b32 v150, 0\n\tv_mov_b32 v151, 0\n\tv_mov_b32 v152, 0\n\tv_mov_b32 v153, 0\n\tv_mov_b32 v154, 0\n\tv_mov_b32 v155, 0\n\tv_mov_b32 v156, 0\n\tv_mov_b32 v157, 0\n\tv_mov_b32 v158, 0\n\tv_mov_b32 v159, 0\n\tv_mov_b32 v160, 0\n\tv_mov_b32 v161, 0\n\tv_mov_b32 v162, 0\n\tv_mov_b32 v163, 0\n\tv_mov_b32 v164, 0\n\tv_mov_b32 v165, 0\n\tv_mov_b32 v166, 0\n\tv_mov_b32 v167, 0\n\tv_mov_b32 v168, 0\n\tv_mov_b32 v169, 0\n\tv_mov_b32 v170, 0\n\tv_mov_b32 v171, 0\n\tv_mov_b32 v172, 0\n\tv_mov_b32 v173, 0\n\tv_mov_b32 v174, 0\n\tv_mov_b32 v175, 0\n\tv_mov_b32 v176, 0\n\tv_mov_b32 v177, 0\n\tv_mov_b32 v178, 0\n\tv_mov_b32 v179, 0\n\tv_mov_b32 v180, 0\n\tv_mov_b32 v181, 0\n\tv_mov_b32 v182, 0\n\tv_mov_b32 v183, 0\n\tv_mov_b32 v184, 0\n\tv_mov_b32 v185, 0\n\tv_mov_b32 v186, 0\n\tv_mov_b32 v187, 0\n\tv_mov_b32 v188, 0\n\tv_mov_b32 v189, 0\n\tv_mov_b32 v190, 0\n\tv_mov_b32 v191, 0" ::: "v128", "v129", "v130", "v131", "v132", "v133", "v134", "v135", "v136", "v137", "v138", "v139", "v140", "v141", "v142", "v143", "v144", "v145", "v146", "v147", "v148", "v149", "v150", "v151", "v152", "v153", "v154", "v155", "v156", "v157", "v158", "v159", "v160", "v161", "v162", "v163", "v164", "v165", "v166", "v167", "v168", "v169", "v170", "v171", "v172", "v173", "v174", "v175", "v176", "v177", "v178", "v179", "v180", "v181", "v182", "v183", "v184", "v185", "v186", "v187", "v188", "v189", "v190", "v191");
    asm volatile("v_mov_b32 v192, 0\n\tv_mov_b32 v193, 0\n\tv_mov_b32 v194, 0\n\tv_mov_b32 v195, 0\n\tv_mov_b32 v196, 0\n\tv_mov_b32 v197, 0\n\tv_mov_b32 v198, 0\n\tv_mov_b32 v199, 0\n\tv_mov_b32 v200, 0\n\tv_mov_b32 v201, 0\n\tv_mov_b32 v202, 0\n\tv_mov_b32 v203, 0\n\tv_mov_b32 v204, 0\n\tv_mov_b32 v205, 0\n\tv_mov_b32 v206, 0\n\tv_mov_b32 v207, 0\n\tv_mov_b32 v208, 0\n\tv_mov_b32 v209, 0\n\tv_mov_b32 v210, 0\n\tv_mov_b32 v211, 0\n\tv_mov_b32 v212, 0\n\tv_mov_b32 v213, 0\n\tv_mov_b32 v214, 0\n\tv_mov_b32 v215, 0\n\tv_mov_b32 v216, 0\n\tv_mov_b32 v217, 0\n\tv_mov_b32 v218, 0\n\tv_mov_b32 v219, 0\n\tv_mov_b32 v220, 0\n\tv_mov_b32 v221, 0\n\tv_mov_b32 v222, 0\n\tv_mov_b32 v223, 0\n\tv_mov_b32 v224, 0\n\tv_mov_b32 v225, 0\n\tv_mov_b32 v226, 0\n\tv_mov_b32 v227, 0\n\tv_mov_b32 v228, 0\n\tv_mov_b32 v229, 0\n\tv_mov_b32 v230, 0\n\tv_mov_b32 v231, 0\n\tv_mov_b32 v232, 0\n\tv_mov_b32 v233, 0\n\tv_mov_b32 v234, 0\n\tv_mov_b32 v235, 0\n\tv_mov_b32 v236, 0\n\tv_mov_b32 v237, 0\n\tv_mov_b32 v238, 0\n\tv_mov_b32 v239, 0\n\tv_mov_b32 v240, 0\n\tv_mov_b32 v241, 0\n\tv_mov_b32 v242, 0\n\tv_mov_b32 v243, 0\n\tv_mov_b32 v244, 0\n\tv_mov_b32 v245, 0\n\tv_mov_b32 v246, 0\n\tv_mov_b32 v247, 0\n\tv_mov_b32 v248, 0\n\tv_mov_b32 v249, 0" ::: "v192", "v193", "v194", "v195", "v196", "v197", "v198", "v199", "v200", "v201", "v202", "v203", "v204", "v205", "v206", "v207", "v208", "v209", "v210", "v211", "v212", "v213", "v214", "v215", "v216", "v217", "v218", "v219", "v220", "v221", "v222", "v223", "v224", "v225", "v226", "v227", "v228", "v229", "v230", "v231", "v232", "v233", "v234", "v235", "v236", "v237", "v238", "v239", "v240", "v241", "v242", "v243", "v244", "v245", "v246", "v247", "v248", "v249");
#endif
    Frame F;
    F.lds = (LAS unsigned char*)lds; F.MISC = (volatile LAS unsigned*)(F.lds + MISC_OFF);
    F.wave = __builtin_amdgcn_readfirstlane((int)threadIdx.x >> 6);
    F.G = gridDim.x; { const int bx = blockIdx.x; F.vcu = (F.G % 8 == 0) ? (bx % 8) * (F.G / 8) + bx / 8 : bx; }
    Ptrs P;
    P.x = args.in[0]; P.p = args.in[1]; P.g_mix = args.in[2]; P.w_in = args.in[3]; P.w_conv_qkv = args.in[4]; P.a_log = args.in[5]; P.dt_bias = args.in[6]; P.g_gdn_out = args.in[7];
    P.b_glu = args.in[8]; P.w_conv_dw = args.in[9]; P.b_conv_dw = args.in[10]; P.ln_g = args.in[11]; P.ln_b = args.in[12]; P.w_out = args.in[13]; P.g_moe = args.in[14]; P.w_gr = args.in[15];
    P.w_er = args.in[16]; P.w_up = args.in[17]; P.w_down = args.in[18]; P.g_ple = args.in[19]; P.w_pg = args.in[20]; P.w_pp = args.in[21]; P.g_final = args.in[22];
    P.out = args.out; P.ws = args.ws;
    F.ctl = (gu32*)(P.ws + WS_CTL);
    for (int u = (int)threadIdx.x; u < (LDS_BYTES - LDSCTL_OFF) / 4; u += NWAVES * 64) ((LAS unsigned*)(F.lds + LDSCTL_OFF))[u] = 0u;
    __syncthreads();
    XcdBarrier bar; bar.bar = (unsigned*)(F.ctl + CW_BAR) + args.bar_region * XCD_BAR_WORDS; bar.x = 0; bar.st = nullptr;
    if (args.use_bar) bar = xcd_barrier_post((unsigned*)(F.ctl + CW_BAR) + args.bar_region * XCD_BAR_WORDS, F.MISC + 8, threadIdx.x == 0);
    const int lo = args.ph_lo, hi = args.ph_hi;
#ifndef VINIT
#define VINIT 0
#endif
#ifndef REP_PH
#define REP_PH -1
#define REP_N 1
#endif
#ifndef TPROBE_A
#define TPROBE_A -1
#define TPROBE_B -1
#endif
#ifndef TPROBE_MULT
#define TPROBE_MULT 8
#endif
#define TP(k) do { if (TPROBE_A == (k) || TPROBE_B == (k)) { if (blockIdx.x == 0 && F.wave == 0 && lane_now() == 0) __hip_atomic_store((unsigned*)(P.ws + WS_CTL) + 2304 + (TPROBE_B == (k) ? 1 : 0), (unsigned)rt(), __ATOMIC_RELAXED, __HIP_MEMORY_SCOPE_AGENT); } } while (0)
#define TPX(k) do { if (TPROBE_A == (k) || TPROBE_B == (k)) { if ((int)blockIdx.x == (int)gridDim.x - 1 && F.wave == 0 && lane_now() == 0) __hip_atomic_store((unsigned*)(P.ws + WS_CTL) + 2304 + (TPROBE_B == (k) ? 1 : 0), (unsigned)rt(), __ATOMIC_RELAXED, __HIP_MEMORY_SCOPE_AGENT); } } while (0)
#define IN(k) (lo <= (k) && (k) < hi)
#define REPS(k) for (int rep_ = 0; rep_ < ((k) == REP_PH ? REP_N : 1); ++rep_)
#define REPBAR() do { if (rep_) xcd_barrier(bar, F.wave == 0 && lane_now() == 0); } while (0)
#define SEAM(k) do { if (IN(k) && IN((k) + 1)) xcd_barrier(bar, F.wave == 0 && lane_now() == 0); } while (0)
    TP(0);

    if (IN(0)) { REPS(0) { REPBAR(); p0_prologue(F, P); } SEAM(0); TP(1); }
    if (IN(1)) { REPS(1) { REPBAR();
        pg8::Gemm g{(const pg8::bf16_t*)(P.ws + WS_N1), (const pg8::bf16_t*)(P.ws + WS_WIN), M, NIN_T, DM, 0};
        pg8::StaticOrder S; S.init(M, NIN_T, F.G, (int)blockIdx.x);
        EpiIn E{(pg8::bf16_t*)(P.ws + WS_QKVZ), (pg8::bf16_t*)(P.ws + WS_U), P.b_glu};
        pg8::gemm_phase<EpiIn, pg8::StaticOrder, true, true>(F.lds + RING_OFF, g, S, E, F.wave); }
        SEAM(1); TP(2);
    }
#ifndef SKIP_P2
    if (IN(2)) { REPS(2) { REPBAR();
#if P2_DUAL
        p2_gdn_prep_dual(F, P);
#else
        p2_gdn_prep(F, P);
#endif
#if CONV_IN_P2
        p3_convert_late(F, P, F.vcu, F.G);
#endif
#if DTEST
        p2_dtest(F, P);
#endif
#if XCHK
        xchk_sum(F, P, P.ws + WS_QKVZ, (size_t)64 * MiB + 16 * MiB, CK_P1);
        asm volatile("s_waitcnt vmcnt(0)" ::: "memory"); __syncthreads();
        for (int it = F.vcu; it < 1024; it += F.G) {
            const int lane = lane_now(); unsigned acc = 0; const GAS v4u* p4 = (const GAS v4u*)(P.ws + WS_GDN + (size_t)it * GDN_ITEM);
            for (int i = F.wave * 64 + lane; i < (int)(GDN_ITEM / 16); i += NWAVES * 64) { const v4u v = p4[i]; acc = v.x * 3u + v.y * 5u + v.z * 7u + v.w * 11u + (unsigned)(i + it * 131);
                const int reg = i < 1024 ? 0 : (i < 2048 ? 1 : (i < 3072 ? 2 : (i < 4096 ? 3 : 4)));
                __hip_atomic_fetch_add((unsigned*)(P.ws + WS_CTL) + CK_P2 + reg, acc, __ATOMIC_RELAXED, __HIP_MEMORY_SCOPE_AGENT); }
            if (F.wave == 0 && lane == 0) __hip_atomic_fetch_add((unsigned*)(P.ws + WS_CTL) + CK_P2 + 5, __float_as_uint(((const float*)(P.ws + WS_GT))[it]) * 13u + (unsigned)it, __ATOMIC_RELAXED, __HIP_MEMORY_SCOPE_AGENT); }
#endif
        } SEAM(2); TP(3); }
#endif
    if (IN(3)) { REPS(3) { REPBAR();
#ifndef SKIP_SCAN
        if ((int)blockIdx.x < NSCAN) { for (int r3 = 0; r3 < (REP_PH == 31 ? REP_N : 1); ++r3) p3_scan(F, P, (int)blockIdx.x); TP(25); }
        else
#endif
        if ((int)blockIdx.x < NSCAN + NWARM) p3_scan_warm(F, P, (int)blockIdx.x - NSCAN);
        else {
            const int idx = (int)blockIdx.x - NSCAN - NWARM, cnt = F.G - NSCAN - NWARM;
            TPX(20);
#if defined(SCAN_ALONE) && SCAN_ALONE
            { if (F.wave == 0) { for (int j = 0; j < 32; ++j) { while (__builtin_amdgcn_readfirstlane(__hip_atomic_load((unsigned*)(P.ws + WS_CTL) + CW_PROG + (j >> 2) * 64 + (j & 3), __ATOMIC_RELAXED, __HIP_MEMORY_SCOPE_AGENT)) < 128u) __builtin_amdgcn_s_sleep(32); } }
              __syncthreads(); }
#endif
#ifndef SKIP_CONF
            { ConfTaps T; p3_conf_load_taps(P, F.wave * 64 + lane_now(), T);
              for (int r3 = 0; r3 < (REP_PH == 32 ? REP_N : 1); ++r3) for (int t = idx; t < M / 32; t += cnt) p3_conf_tile(F, P, t, T); }
#endif
            TPX(21);
            pg8::Gemm g{(const pg8::bf16_t*)(P.ws + WS_PBF), (const pg8::bf16_t*)(P.ws + WS_WPROJ), M, DM, PLE, 0};
            pg8::StaticOrder S; S.init(M, DM, cnt, idx);
            pg8::EpiBf16<0> E{(pg8::bf16_t*)(P.ws + WS_PROJ), DM, nullptr, 0, 0, 1.f};
            for (int r3 = 0; r3 < (REP_PH == 33 ? REP_N : 1); ++r3) pg8::gemm_phase<pg8::EpiBf16<0>, pg8::StaticOrder, true, true>(F.lds + RING_OFF, g, S, E, F.wave);
            TPX(22);
#if !CONV_IN_P2
            for (int r3 = 0; r3 < (REP_PH == 34 ? REP_N : 1); ++r3) p3_convert_late(F, P, idx, cnt);
#endif
            TPX(23);
#ifndef SKIP_P4
            p4_gdn_out(F, P, idx, cnt);
#endif
            TPX(24);
        } }
        SEAM(3); TP(4);
    }
    if (IN(5)) { REPS(5) { REPBAR();
        pg8::Gemm g{(const pg8::bf16_t*)(P.ws + WS_MIX), (const pg8::bf16_t*)(P.ws + WS_WOUT), M, DM, DM, 0};
        pg8::StaticOrder S; S.init(M, DM, F.G, (int)blockIdx.x);
        EpiRes E{P.x, (pg8::bf16_t*)(P.ws + WS_H1)};
        pg8::gemm_phase<EpiRes, pg8::StaticOrder, true, true>(F.lds + RING_OFF, g, S, E, F.wave); }
        SEAM(5); TP(5);
    }
    if (IN(6)) { REPS(6) { REPBAR(); p6_router(F, P); } SEAM(6); TP(6); }
    if (IN(7)) { REPS(7) { REPBAR(); p7_dispatch(F, P); } SEAM(7); TP(7); }
    if (IN(8)) { REPS(8) { REPBAR();
        { pg8::Gemm g{(const pg8::bf16_t*)(P.ws + WS_XG), (const pg8::bf16_t*)(P.ws + WS_WUP), PSLOTS, 512, DM, (size_t)512 * DM * 2};
          MoeUpOrder S{P.ws, F.G, F.vcu};
          EpiSwiGLU E{(pg8::bf16_t*)(P.ws + WS_ACT)};
          pg8::gemm_phase<EpiSwiGLU, MoeUpOrder, true, true>(F.lds + RING_OFF, g, S, E, F.wave); }
        { pg8::Gemm g{(const pg8::bf16_t*)(P.ws + WS_ACT), (const pg8::bf16_t*)(P.ws + WS_WDOWN), PSLOTS, DM, DEXP, (size_t)DM * DEXP * 2};
          MoeDownOrder S{P.ws, F.G, F.vcu, F.wave};
          EpiGate E{(pg8::bf16_t*)(P.ws + WS_Y), (const float*)(P.ws + WS_GATEW)};
          for (int i = 0; ; ++i) { OneUnit S1; if (!S.next(i, S1.u0)) break; S.wait_ready(S1.u0);
              pg8::gemm_phase<EpiGate, OneUnit, true, true>(F.lds + RING_OFF, g, S1, E, F.wave); } } }
        SEAM(8); TP(8);
    }
    if (IN(10)) { REPS(10) { REPBAR(); p10_combine(F, P); } SEAM(10); TP(9); }
    if (IN(11)) { REPS(11) { REPBAR();
        pg8::Gemm g{(const pg8::bf16_t*)(P.ws + WS_XN3), (const pg8::bf16_t*)(P.ws + WS_WGATE), M, DM, DM, 0};
        pg8::StaticOrder S; S.init(M, DM, F.G, (int)blockIdx.x);
        EpiPle E{(const pg8::bf16_t*)(P.ws + WS_H2), (const pg8::bf16_t*)(P.ws + WS_PROJ), (pg8::bf16_t*)(P.ws + WS_H3)};
        pg8::gemm_phase<EpiPle, pg8::StaticOrder, true, true>(F.lds + RING_OFF, g, S, E, F.wave); }
        SEAM(11); TP(10);
    }
    if (IN(12)) { REPS(12) { REPBAR(); p12_final(F, P); } }
    TP(11);
#if TPROBE_A >= 0
    if (blockIdx.x == 0 && F.wave == 0 && lane_now() == 0) {
        const unsigned ta = __hip_atomic_load((unsigned*)(P.ws + WS_CTL) + 2304, __ATOMIC_RELAXED, __HIP_MEMORY_SCOPE_AGENT), tb = __hip_atomic_load((unsigned*)(P.ws + WS_CTL) + 2305, __ATOMIC_RELAXED, __HIP_MEMORY_SCOPE_AGENT);
        const unsigned want = (tb - ta) * (unsigned)TPROBE_MULT; const unsigned t0 = (unsigned)rt();
        while ((unsigned)rt() - t0 < want) __builtin_amdgcn_s_sleep(4);
    }
#endif
#undef IN
#undef SEAM
}

#ifndef HYB
#define HYB 1
#endif
static int launch_fast(void* const* d_in, float* out, void* d_ws, const int* seg, int nseg, hipStream_t stream) {
    static int grid = 0;
    if (grid == 0) {
        int dev = 0, cus = 0;
        if (hipGetDevice(&dev) != hipSuccess || hipDeviceGetAttribute(&cus, hipDeviceAttributeMultiprocessorCount, dev) != hipSuccess) { fprintf(stderr, "device query failed\n"); grid = -1; return -1; }
        if (hipFuncSetAttribute((const void*)mk_fwd, hipFuncAttributeMaxDynamicSharedMemorySize, LDS_BYTES) != hipSuccess) { fprintf(stderr, "hipFuncSetAttribute failed\n"); grid = -1; return -1; }
        int per_cu = 0;
        if (hipOccupancyMaxActiveBlocksPerMultiprocessor(&per_cu, (const void*)mk_fwd, NWAVES * 64, LDS_BYTES) != hipSuccess || per_cu < 1) fprintf(stderr, "note: occupancy query says %d\n", per_cu);
        (void)hipGetLastError();
        grid = cus;
        if (grid != 256) { fprintf(stderr, "kernel_launch: built for a 256-CU device (router tiles = workgroups); got %d\n", cus); grid = -1; return -1; }
    }
    if (grid < 0) return -1;
    Args a{};
    for (int i = 0; i < 23; ++i) a.in[i] = (const float*)d_in[i];
    a.out = out; a.ws = (unsigned char*)d_ws;
    for (int i = 0; i < nseg; ++i) { a.ph_lo = seg[2 * i]; a.ph_hi = seg[2 * i + 1]; a.use_bar = (a.ph_hi - a.ph_lo > 1) ? 1 : 0; a.bar_region = i;
        hipLaunchKernelGGL(mk_fwd, dim3(grid), dim3(NWAVES * 64), LDS_BYTES, stream, a); }
    return 0;
}

extern "C" void kernel_launch(void* const* d_in, const int* in_sizes, int n_in, void* d_out, int out_size, void* d_ws, size_t ws_size, hipStream_t stream) {
    char* ws = (char*)d_ws; float* out = (float*)d_out;
#if HYB == 0
    run_naive(d_in, out, nv_default_map(ws), 0, stream);
#elif HYB == 1
    (void)hipMemsetAsync(ws + WS_CTL, 0, CTL_ZERO_BYTES, stream);
    { const int seg[] = {0, 1, 1, 2}; if (launch_fast(d_in, out, d_ws, seg, 2, stream) != 0) return; }
    NvMap m = nv_default_map(ws);
    m.proj = (float*)(ws + 226 * MiB); m.ldp = 2056; m.qkv = (float*)(ws + 4 * MiB); m.o = (float*)(ws + 100 * MiB); m.mix = (float*)(ws + 132 * MiB); m.u = (float*)(ws + 392 * MiB); m.h = (float*)(ws + 424 * MiB);
    m.xn = m.mix; m.logits = m.o; m.UP = (float*)(ws + 4 * MiB); m.ACT = (float*)(ws + 356 * MiB); m.Y = (float*)(ws + 196 * MiB); m.G = (float*)(ws + 4 * MiB); m.PP = (float*)(ws + 196 * MiB);
    k_shimA<<<(int)(((size_t)M * 2048 + 255) / 256), 256, 0, stream>>>((const unsigned short*)(ws + WS_QKVZ), (const float*)(ws + WS_AB), (const unsigned short*)(ws + WS_U), m.proj, m.ldp, m.u);
    run_naive(d_in, out, m, 1, stream);
#elif HYB == 2
    (void)hipMemsetAsync(ws + WS_CTL, 0, CTL_ZERO_BYTES, stream);
    { const int seg[] = {0, 1, 1, 2, 2, 3, 3, 4, 4, 5}; if (launch_fast(d_in, out, d_ws, seg, 5, stream) != 0) return; }
    NvMap m = nv_default_map(ws);
    k_shimB<<<(int)(((size_t)M * DM + 255) / 256), 256, 0, stream>>>((const unsigned short*)(ws + WS_MIX), m.mix);
    run_naive(d_in, out, m, 2, stream);
#elif HYB == 3
    (void)hipMemsetAsync(ws + WS_CTL, 0, CTL_ZERO_BYTES, stream);
    { const int seg[] = {0, 1, 1, 2, 2, 3, 3, 4, 4, 5, 5, 6}; if (launch_fast(d_in, out, d_ws, seg, 6, stream) != 0) return; }
    NvMap m = nv_default_map(ws); m.h = (float*)(ws + WS_H1);
    run_naive(d_in, out, m, 3, stream);
#elif HYB == 4
    (void)hipMemsetAsync(ws + WS_CTL, 0, CTL_ZERO_BYTES, stream);
    { const int seg[] = {0, 1, 1, 2, 2, 3, 3, 4, 4, 5, 5, 6, 6, 8, 8, 9, 9, 10, 10, 11}; if (launch_fast(d_in, out, d_ws, seg, 10, stream) != 0) return; }
    NvMap m = nv_default_map(ws); m.h = (float*)(ws + WS_H1);
    run_naive(d_in, out, m, 4, stream);
#elif HYB == 5
    (void)hipMemsetAsync(ws + WS_CTL, 0, CTL_ZERO_BYTES, stream);
    { const int seg[] = {0, 1, 1, 2, 2, 3, 3, 4, 4, 5, 5, 6, 6, 8, 8, 9, 9, 10, 10, 11, 11, 12, 12, 13}; if (launch_fast(d_in, out, d_ws, seg, 12, stream) != 0) return; }
#elif HYB == 6
    (void)hipMemsetAsync(ws + WS_CTL, 0, CTL_ZERO_BYTES, stream);
    { const int seg[] = {0, 13}; if (launch_fast(d_in, out, d_ws, seg, 1, stream) != 0) return; }
#endif
}
```

```cpp
#include <hip/hip_runtime.h>
#include <cstdio>
#include <cstdint>

constexpr int DM = 1024, NB = 2, SEQ = 8192, M = NB * SEQ, PLE = 256;
constexpr int NH = 4, DK = 128, DV = 128, QKW = 512, VW = 512, CCH = 512, CWID = 31;
constexpr int NGRP = 8, EPG = 8, NEXP = 64, DEXP = 256, INC = 3080;
constexpr int O1 = 1536, O2 = 2048, O3 = 2052, O4 = 2056;
constexpr float EPS = 1e-6f;

#define HYB 6
namespace pg8 {
#define PG8_LAS __attribute__((address_space(3)))
typedef unsigned short bf16_t;
typedef short bf16x8 __attribute__((ext_vector_type(8)));
typedef float f32x4 __attribute__((ext_vector_type(4)));
typedef unsigned u32x4 __attribute__((ext_vector_type(4)));
constexpr int BM = 256, BK = 64, HALF = 128, HTB = HALF * BK * 2  , STAGE_BYTES = 8 * HTB, NXCD = 8, WGM = 8;

__host__ __device__ __forceinline__ int lds_byte(int r, int c) { const int st = (r >> 4) * 2 + (c >> 5), rr = r & 15, cc = c & 31, ob = rr * 64 + cc * 2; return st * 1024 + (ob ^ (((ob >> 9) & 1) << 5)); }
__host__ __device__ __forceinline__ void stage_rc(int b, int& R, int& C) { const int st = b / 1024, sb = b % 1024, swz = sb ^ (((sb >> 9) & 1) << 5); R = (st >> 1) * 16 + swz / 64; C = (st & 1) * 32 + (swz % 64) / 2; }
__host__ __device__ __forceinline__ int perm32(int rho) { const int n = rho >> 4, i = rho & 15; return 8 * (i >> 2) + 4 * n + (i & 3); }

struct Unit { int pm, pn, be; };
struct Gemm { const bf16_t* A; const bf16_t* Bt; int M, N, K; size_t bstride; };

struct StaticOrder {
    int nM, nN, nwg, G, c;
    __host__ __device__ void init(int M, int N, int G_, int c_) { nM = M / BM; nN = N / BM; nwg = nM * nN; G = G_; c = c_; }
    __host__ __device__ bool next(int i, Unit& u) const {
        const long L = (long)i * G + c; if (L >= nwg) return false;
        int wgid = (int)L; { const int q = nwg / NXCD, r = nwg % NXCD, xcd = wgid % NXCD, off = wgid / NXCD; wgid = (xcd < r ? xcd * (q + 1) : r * (q + 1) + (xcd - r) * q) + off; }
        const int nig = WGM * nN, gid = wgid / nig, fm = gid * WGM, gsz = (nM - fm) < WGM ? (nM - fm) : WGM;
        u.pm = fm + ((wgid % nig) % gsz); u.pn = (wgid % nig) / gsz; u.be = 0; return true;
    }
    __device__ __forceinline__ void a_ready(const Unit&) const {}
    __device__ __forceinline__ void done(const Unit&) const {}
};

__device__ __forceinline__ unsigned cvt_pk_bf16(float lo, float hi) { unsigned r; asm volatile("v_cvt_pk_bf16_f32 %0, %1, %2" : "=v"(r) : "v"(lo), "v"(hi)); return r; }
typedef float f32x2 __attribute__((ext_vector_type(2)));
__device__ __forceinline__ f32x2 gelu_pk(f32x2 v) {
    const f32x2 av = __builtin_elementwise_abs(v), d = av * 0.2316418882f + 1.0f;
    f32x2 t; t.x = __builtin_amdgcn_rcpf(d.x); t.y = __builtin_amdgcn_rcpf(d.y);
    f32x2 q = t * 0.5307027145f + (-0.7265760135f); q = q * t + 0.7107068705f; q = q * t + (-0.142248368f); q = q * t + 0.127414796f; q = q * t;
    const f32x2 s = (v * v) * (-0.72134752044f);
    f32x2 e; e.x = __builtin_amdgcn_exp2f(s.x); e.y = __builtin_amdgcn_exp2f(s.y);
    const f32x2 m = v * (q * e), r = v - m;
    f32x2 o; o.x = v.x < 0.f ? m.x : r.x; o.y = v.y < 0.f ? m.y : r.y; return o;
}

template <int ACT  > struct EpiBf16 {
    static constexpr bool PERM = true, AFTER_DRAIN = false; static_assert(ACT == 0 || ACT == 1, "EpiBf16: ACT is 0 (none) or 1 (gelu_pk)");
    bf16_t* O; int ldc; const float* bias; int split_cols; size_t split_stride; float scale0;
    __device__ __forceinline__ void operator()(const f32x4 (&acc)[2][2][4][2], const Unit& u, int wr, int wc, int fr, int fq) const {
        const int row0 = u.pm * BM + wr * 64 + fr; int colt = u.pn * BM; bf16_t* base = O;
        float sc = 1.f; if (split_cols) { const int t = colt / split_cols; base += (size_t)t * split_stride; colt -= t * split_cols; if (t == 0) sc = scale0; }
        const int col0 = colt + wc * 32 + 8 * fq, bcol0 = u.pn * BM + wc * 32 + 8 * fq;
        f32x4 bv[2][2];
#pragma unroll
        for (int bj = 0; bj < 2; ++bj)
#pragma unroll
            for (int n = 0; n < 2; ++n) bv[bj][n] = bias ? *(const f32x4*)(bias + bcol0 + bj * HALF + 4 * n) : (f32x4){0.f, 0.f, 0.f, 0.f};
#pragma unroll
        for (int ai = 0; ai < 2; ++ai)
#pragma unroll
            for (int m = 0; m < 4; ++m) { bf16_t* rowp = base + (size_t)(row0 + ai * HALF + m * 16) * ldc + col0;
#pragma unroll
                for (int bj = 0; bj < 2; ++bj) { f32x4 v0 = acc[ai][bj][m][0] + bv[bj][0], v1 = acc[ai][bj][m][1] + bv[bj][1];
                    if (ACT == 1) { f32x2 a = gelu_pk((f32x2){v0[0], v0[1]}), b = gelu_pk((f32x2){v0[2], v0[3]}), c = gelu_pk((f32x2){v1[0], v1[1]}), d = gelu_pk((f32x2){v1[2], v1[3]});
                        v0 = (f32x4){a.x, a.y, b.x, b.y}; v1 = (f32x4){c.x, c.y, d.x, d.y}; }
                    v0 = v0 * sc; v1 = v1 * sc; u32x4 w; w.x = cvt_pk_bf16(v0[0], v0[1]); w.y = cvt_pk_bf16(v0[2], v0[3]); w.z = cvt_pk_bf16(v1[0], v1[1]); w.w = cvt_pk_bf16(v1[2], v1[3]);
                    *(u32x4*)(rowp + bj * HALF) = w; } }
    }
};

struct PanelStats {
    unsigned* xbuf;
    unsigned* cnt;
    unsigned* tmo;
    int ntn; float eps;
    unsigned code;
    __device__ __forceinline__ bool run(const f32x4 (&v)[2][2][4][2], const Unit& u, int wr, int wc, int fr, int fq, PG8_LAS unsigned char* lds, int wid, int lane) const {
        typedef float f32x2v __attribute__((ext_vector_type(2)));
        PG8_LAS f32x2v* P = (PG8_LAS f32x2v*)lds;
        PG8_LAS f32x2v* S = (PG8_LAS f32x2v*)(lds + 8192);
        PG8_LAS unsigned* flag = (PG8_LAS unsigned*)(lds + 8192 + 2048);
#pragma unroll
        for (int ai = 0; ai < 2; ++ai)
#pragma unroll
            for (int m = 0; m < 4; ++m) {
                float s = 0.f;
#pragma unroll
                for (int bj = 0; bj < 2; ++bj)
#pragma unroll
                    for (int n = 0; n < 2; ++n) { const f32x4 x = v[ai][bj][m][n]; s += (x[0] + x[1]) + (x[2] + x[3]); }
                s += __shfl_xor(s, 16); s += __shfl_xor(s, 32);
                const float mw = s * (1.0f / 64.0f); float q = 0.f;
#pragma unroll
                for (int bj = 0; bj < 2; ++bj)
#pragma unroll
                    for (int n = 0; n < 2; ++n) { const f32x4 d = v[ai][bj][m][n] - mw; q += (d[0] * d[0] + d[1] * d[1]) + (d[2] * d[2] + d[3] * d[3]); }
                q += __shfl_xor(q, 16); q += __shfl_xor(q, 32);
                if (fq == 0) P[(ai * HALF + wr * 64 + m * 16 + fr) * 4 + wc] = (f32x2v){mw, q};
            }
        asm volatile("s_waitcnt lgkmcnt(0)" ::: "memory"); __builtin_amdgcn_s_barrier(); asm volatile("" ::: "memory");
#if defined(BROKEN_EXCHANGE_NO_WAIT)
#warning BROKEN CONTROL BUILD: the row-statistics exchange does not wait; results are wrong by design
        if (blockIdx.x >= 64) { const long long t0_ = clock64(); while (clock64() - t0_ < 60000) __builtin_amdgcn_s_sleep(8); }
#endif
        const int row = wid * 32 + (lane & 31);
        if (lane < 32) {
            const f32x2v a = P[row * 4 + 0], b = P[row * 4 + 1], c = P[row * 4 + 2], d = P[row * 4 + 3];
            const float mt = (a.x + b.x + c.x + d.x) * 0.25f;
            const float da = a.x - mt, db = b.x - mt, dc = c.x - mt, dd = d.x - mt;
            const float m2 = (a.y + b.y) + (c.y + d.y) + 64.0f * ((da * da + db * db) + (dc * dc + dd * dd));
            unsigned long long* slot = (unsigned long long*)xbuf + ((size_t)(u.pm * BM + row) * 4 + u.pn);
            __hip_atomic_store(slot, ((unsigned long long)__float_as_uint(m2) << 32) | __float_as_uint(mt), __ATOMIC_RELAXED, __HIP_MEMORY_SCOPE_AGENT);
        }
        asm volatile("s_waitcnt vmcnt(0)" ::: "memory");
        if (lane == 0) __hip_atomic_fetch_add(cnt + 64 * u.pm, 1u, __ATOMIC_RELAXED, __HIP_MEMORY_SCOPE_AGENT);
        if (wid == 0) {
            bool dead = false; const unsigned long long t0 = __builtin_amdgcn_s_memrealtime(); const unsigned want = 8u * (unsigned)ntn;
            for (;;) {
#if defined(BROKEN_EXCHANGE_NO_WAIT)
                break;
#endif
                if ((unsigned)__builtin_amdgcn_readfirstlane(__hip_atomic_load(cnt + 64 * u.pm, __ATOMIC_RELAXED, __HIP_MEMORY_SCOPE_AGENT)) >= want) break;
                if (__builtin_amdgcn_s_memrealtime() - t0 > 2000000ull) {
                    if (lane == 0) { unsigned expect = 0u; __hip_atomic_compare_exchange_strong(tmo + 1, &expect, code | (unsigned)(u.pm & 0xff), __ATOMIC_RELAXED, __ATOMIC_RELAXED, __HIP_MEMORY_SCOPE_AGENT);
                                     __hip_atomic_store(tmo, 1u, __ATOMIC_RELAXED, __HIP_MEMORY_SCOPE_AGENT); }
                    dead = true; break; }
                __builtin_amdgcn_s_sleep(2);
            }
            __builtin_amdgcn_fence(__ATOMIC_ACQUIRE, "agent");
            if (lane == 0) flag[0] = dead ? 1u : 0u;
        }
        asm volatile("s_waitcnt vmcnt(0) lgkmcnt(0)" ::: "memory"); __builtin_amdgcn_s_barrier(); asm volatile("" ::: "memory");
        const bool bad = flag[0] != 0u;
        if (lane < 32) {
            const unsigned long long* slot = (const unsigned long long*)xbuf + (size_t)(u.pm * BM + row) * 4; float mt[4], m2[4]; float ms = 0.f;
#pragma unroll
            for (int t = 0; t < 4; ++t) { if (t < ntn) { const unsigned long long w = __hip_atomic_load(slot + t, __ATOMIC_RELAXED, __HIP_MEMORY_SCOPE_AGENT); mt[t] = __uint_as_float((unsigned)w); m2[t] = __uint_as_float((unsigned)(w >> 32)); } else { mt[t] = 0.f; m2[t] = 0.f; } ms += mt[t]; }
            const float mean = ms / (float)ntn; float q = 0.f;
#pragma unroll
            for (int t = 0; t < 4; ++t) if (t < ntn) { const float dm = mt[t] - mean; q += m2[t] + 256.0f * dm * dm; }
            S[row] = (f32x2v){mean, 1.0f / sqrtf(q / (256.0f * (float)ntn) + eps)};
        }
        asm volatile("s_waitcnt lgkmcnt(0)" ::: "memory"); __builtin_amdgcn_s_barrier(); asm volatile("" ::: "memory");
        return bad;
    }
};
struct EpiLnRes {
    static constexpr bool PERM = false, AFTER_DRAIN = true;
    const float* base; float* out; int ldc; const float* bias; PanelStats st; unsigned poison;
    __device__ __forceinline__ void fused(f32x4 (&acc)[2][2][4][2], const Unit& u, int wr, int wc, int fr, int fq, PG8_LAS unsigned char* lds, int wid, int lane) const {
        typedef float f32x2v __attribute__((ext_vector_type(2)));
        const PG8_LAS f32x2v* S = (const PG8_LAS f32x2v*)(lds + 8192);
        const int col0 = u.pn * BM + wc * 32 + 4 * fq;
#pragma unroll
        for (int bj = 0; bj < 2; ++bj)
#pragma unroll
            for (int n = 0; n < 2; ++n) { const f32x4 bv = bias ? *(const f32x4*)(bias + col0 + bj * HALF + n * 16) : (f32x4){0.f, 0.f, 0.f, 0.f};
#pragma unroll
                for (int ai = 0; ai < 2; ++ai)
#pragma unroll
                    for (int m = 0; m < 4; ++m) acc[ai][bj][m][n] += bv; }
        f32x4 pre[4][2][2];
#pragma unroll
        for (int m = 0; m < 4; ++m) { const size_t off = (size_t)(u.pm * BM + wr * 64 + m * 16 + fr) * ldc + col0;
#pragma unroll
            for (int bj = 0; bj < 2; ++bj)
#pragma unroll
                for (int n = 0; n < 2; ++n) pre[m][bj][n] = *(const f32x4*)(base + off + bj * HALF + n * 16); }
        const bool bad = st.run(acc, u, wr, wc, fr, fq, lds, wid, lane) || poison != 0u;
        const float qnan = __builtin_nanf("");
#pragma unroll
        for (int ai = 0; ai < 2; ++ai)
#pragma unroll
            for (int m = 0; m < 4; ++m) { const int r = ai * HALF + wr * 64 + m * 16 + fr; const f32x2v sr = S[r]; const size_t off = (size_t)(u.pm * BM + r) * ldc + col0;
#pragma unroll
                for (int bj = 0; bj < 2; ++bj)
#pragma unroll
                    for (int n = 0; n < 2; ++n) { const f32x4 bs = ai == 0 ? pre[m][bj][n] : *(const f32x4*)(base + off + bj * HALF + n * 16); f32x4 o = bs + (acc[ai][bj][m][n] - sr.x) * sr.y;
                        if (bad) o = (f32x4){qnan, qnan, qnan, qnan}; *(f32x4*)(out + off + bj * HALF + n * 16) = o; }
                if (m & 1) asm volatile("" ::: "memory"); }
    }
};
struct EpiLnResLn {
    static constexpr bool PERM = false, AFTER_DRAIN = true;
    const float* base; float* out; bf16_t* xn; int ldc; const float* bias; PanelStats st1, st2; unsigned poison;
    __device__ __forceinline__ void fused(f32x4 (&acc)[2][2][4][2], const Unit& u, int wr, int wc, int fr, int fq, PG8_LAS unsigned char* lds, int wid, int lane) const {
        typedef float f32x2v __attribute__((ext_vector_type(2))); typedef unsigned u32x2v __attribute__((ext_vector_type(2)));
        const PG8_LAS f32x2v* S = (const PG8_LAS f32x2v*)(lds + 8192);
        const int col0 = u.pn * BM + wc * 32 + 4 * fq;
#pragma unroll
        for (int bj = 0; bj < 2; ++bj)
#pragma unroll
            for (int n = 0; n < 2; ++n) { const f32x4 bv = bias ? *(const f32x4*)(bias + col0 + bj * HALF + n * 16) : (f32x4){0.f, 0.f, 0.f, 0.f};
#pragma unroll
                for (int ai = 0; ai < 2; ++ai)
#pragma unroll
                    for (int m = 0; m < 4; ++m) acc[ai][bj][m][n] += bv; }
        bool bad = st1.run(acc, u, wr, wc, fr, fq, lds, wid, lane) || poison != 0u;
        const float qnan = __builtin_nanf("");
#pragma unroll
        for (int ai = 0; ai < 2; ++ai)
#pragma unroll
            for (int m = 0; m < 4; ++m) { const int r = ai * HALF + wr * 64 + m * 16 + fr; const f32x2v sr = S[r]; const size_t off = (size_t)(u.pm * BM + r) * ldc + col0;
#pragma unroll
                for (int bj = 0; bj < 2; ++bj)
#pragma unroll
                    for (int n = 0; n < 2; ++n) { const f32x4 bs = *(const f32x4*)(base + off + bj * HALF + n * 16); acc[ai][bj][m][n] = bs + (acc[ai][bj][m][n] - sr.x) * sr.y; }
                asm volatile("" : "+v"(acc[ai][0][m][0]), "+v"(acc[ai][0][m][1]), "+v"(acc[ai][1][m][0]), "+v"(acc[ai][1][m][1]));
                if (m & 1) asm volatile("" ::: "memory"); }
        const bool bad1 = bad;
        bad = st2.run(acc, u, wr, wc, fr, fq, lds, wid, lane) || bad;
#pragma unroll
        for (int ai = 0; ai < 2; ++ai)
#pragma unroll
            for (int m = 0; m < 4; ++m) { const int r = ai * HALF + wr * 64 + m * 16 + fr; const f32x2v sr = S[r]; const size_t off = (size_t)(u.pm * BM + r) * ldc + col0;
#pragma unroll
                for (int bj = 0; bj < 2; ++bj)
#pragma unroll
                    for (int n = 0; n < 2; ++n) { const f32x4 x1 = acc[ai][bj][m][n]; *(f32x4*)(out + off + bj * HALF + n * 16) = bad1 ? (f32x4){qnan, qnan, qnan, qnan} : x1;
                        const f32x4 o = (x1 - sr.x) * sr.y; u32x2v w; w.x = cvt_pk_bf16(o[0], o[1]); w.y = cvt_pk_bf16(o[2], o[3]);
                        if (bad) { w.x = 0x7fc07fc0u; w.y = 0x7fc07fc0u; } *(u32x2v*)(xn + off + bj * HALF + n * 16) = w; }
                asm volatile("" ::: "memory"); }
    }
};

template <class Epi, class Sched, bool ALIGN_EPI = false, bool SP2 = false>
__device__ __forceinline__ void gemm_phase(PG8_LAS unsigned char* lds, const Gemm g, const Sched& S, const Epi& E, const int wid  ) {
    int lane; asm volatile("v_mbcnt_lo_u32_b32 %0, -1, 0\n\tv_mbcnt_hi_u32_b32 %0, -1, %0" : "=v"(lane));
    const int tid = wid * 64 + lane, wr = wid >> 2, wc = wid & 3, fr = lane & 15, fq = lane >> 4;
    const int K = g.K, nt = K / BK;
    unsigned voffA[2], voffB[2];
#pragma unroll
    for (int i = 0; i < 2; ++i) { int R, C; stage_rc(tid * 16 + i * 8192, R, C); const int Rb = Epi::PERM ? ((R & ~31) + perm32(R & 31)) : R;
        voffA[i] = (unsigned)(R * K + C) * 2u; voffB[i] = (unsigned)(Rb * K + C) * 2u; }
    const size_t kstep = (size_t)(BK * 2);
    const size_t hstep = (size_t)HALF * K * 2;
    const size_t tstep = 2 * hstep;
    const unsigned ldsw = (unsigned)wid * 1024u;
    const int aoff = lds_byte(wr * 64 + fr, fq * 8), boff = lds_byte(wc * 32 + fr, fq * 8);
#define PG8_SA(b, h) (((b) * 2 + (h)) * HTB)
#define PG8_SB(b, h) ((4 + (b) * 2 + (h)) * HTB)
#define PG8_STAGE(bufoff, gbase, voff) do { _Pragma("unroll") for (int _i = 0; _i < 2; ++_i) \
        __builtin_amdgcn_global_load_lds((const unsigned*)((const char*)(gbase) + (voff)[_i]), (PG8_LAS unsigned*)(lds + (bufoff) + ldsw + _i * 8192), 16, 0, 0); } while (0)
#define PG8_LDA(dst, b, h) do { _Pragma("unroll") for (int m = 0; m < 4; ++m) _Pragma("unroll") for (int k = 0; k < 2; ++k) dst[m][k] = *(const PG8_LAS bf16x8*)(lds + PG8_SA(b, h) + aoff + m * 2048 + k * 1024); } while (0)
#define PG8_LDB(dst, b, h) do { _Pragma("unroll") for (int n = 0; n < 2; ++n) _Pragma("unroll") for (int k = 0; k < 2; ++k) dst[n][k] = *(const PG8_LAS bf16x8*)(lds + PG8_SB(b, h) + boff + n * 2048 + k * 1024); } while (0)
#define PG8_MMA(ai, bj, At, Bt) do { __builtin_amdgcn_s_setprio(1); _Pragma("unroll") for (int m = 0; m < 4; ++m) _Pragma("unroll") for (int n = 0; n < 2; ++n) _Pragma("unroll") for (int k = 0; k < 2; ++k) \
        acc[ai][bj][m][n] = __builtin_amdgcn_mfma_f32_16x16x32_bf16(Bt[n][k], At[m][k], acc[ai][bj][m][n], 0, 0, 0); __builtin_amdgcn_s_setprio(0); } while (0)
#define PG8_WAIT_V(n) asm volatile("s_waitcnt vmcnt(" #n ")" ::: "memory")
#define PG8_WAIT_L(n) asm volatile("s_waitcnt lgkmcnt(" #n ")" ::: "memory")
#define PG8_BAR __builtin_amdgcn_s_barrier()
#define PG8_SCHED __builtin_amdgcn_sched_barrier(0)
    Unit cur, nxt; int ui = 0;
    if (!S.next(0, cur)) return;
    f32x4 acc[2][2][4][2];
#pragma unroll
    for (int a = 0; a < 2; ++a)
#pragma unroll
        for (int b = 0; b < 2; ++b)
#pragma unroll
            for (int m = 0; m < 4; ++m)
#pragma unroll
                for (int n = 0; n < 2; ++n) acc[a][b][m][n] = (f32x4){0.f, 0.f, 0.f, 0.f};
    bf16x8 At[4][2], B0[2][2], B1[2][2];
    const char* cA = (const char*)g.A + (size_t)cur.pm * tstep; const char* cB = (const char*)g.Bt + (size_t)cur.pn * tstep + (size_t)cur.be * g.bstride;
    S.a_ready(cur);
    if constexpr (SP2) {
        PG8_STAGE(PG8_SB(0, 0), cB, voffB); PG8_STAGE(PG8_SB(0, 1), cB + hstep, voffB); PG8_STAGE(PG8_SA(0, 0), cA, voffA); PG8_STAGE(PG8_SA(0, 1), cA + hstep, voffA);
        if (wr == 1) PG8_BAR;
        PG8_WAIT_V(2); PG8_BAR;
        PG8_STAGE(PG8_SB(1, 0), cB + kstep, voffB); PG8_STAGE(PG8_SA(1, 0), cA + kstep, voffA); PG8_STAGE(PG8_SB(1, 1), cB + hstep + kstep, voffB);
        PG8_WAIT_V(6); PG8_BAR;
    } else {
        PG8_STAGE(PG8_SB(0, 0), cB, voffB); PG8_STAGE(PG8_SA(0, 0), cA, voffA); PG8_STAGE(PG8_SB(0, 1), cB + hstep, voffB); PG8_STAGE(PG8_SA(0, 1), cA + hstep, voffA);
        if (wr == 1) PG8_BAR;
        PG8_WAIT_V(4); PG8_BAR;
        PG8_STAGE(PG8_SB(1, 0), cB + kstep, voffB); PG8_STAGE(PG8_SA(1, 0), cA + kstep, voffA); PG8_STAGE(PG8_SB(1, 1), cB + hstep + kstep, voffB);
        PG8_WAIT_V(6); PG8_BAR;
    }
    for (;;) {
        const bool has_next = S.next(ui + 1, nxt);
        const char* nA = has_next ? (const char*)g.A + (size_t)nxt.pm * tstep : cA; const char* nB = has_next ? (const char*)g.Bt + (size_t)nxt.pn * tstep + (size_t)nxt.be * g.bstride : cB;
        for (int t = 0; t < nt; t += 2) {
            const bool last = (t == nt - 2);
            const char* a1 = cA + (size_t)(t + 1) * kstep;
            const char* a2 = last ? nA : cA + (size_t)(t + 2) * kstep; const char* b2 = last ? nB : cB + (size_t)(t + 2) * kstep;
            const char* a3 = a2 + kstep; const char* b3 = b2 + kstep;
            if (last && has_next) S.a_ready(nxt);
            if constexpr (SP2) {
            PG8_LDB(B0, 0, 0); PG8_LDB(B1, 0, 1); PG8_SCHED; PG8_LDA(At, 0, 0); PG8_STAGE(PG8_SA(1, 1), a1 + hstep, voffA);
            PG8_WAIT_V(8); PG8_WAIT_L(0); PG8_BAR; PG8_MMA(0, 0, At, B0); PG8_MMA(0, 1, At, B1); PG8_BAR; PG8_SCHED;
            PG8_LDA(At, 0, 1); PG8_STAGE(PG8_SB(0, 0), b2, voffB); PG8_STAGE(PG8_SB(0, 1), b2 + hstep, voffB); PG8_STAGE(PG8_SA(0, 0), a2, voffA);
            PG8_WAIT_V(8); PG8_WAIT_L(0); PG8_BAR; PG8_MMA(1, 0, At, B0); PG8_MMA(1, 1, At, B1); PG8_BAR; PG8_SCHED;
            PG8_LDB(B0, 1, 0); PG8_LDB(B1, 1, 1); PG8_SCHED; PG8_LDA(At, 1, 0); PG8_STAGE(PG8_SA(0, 1), a2 + hstep, voffA);
            PG8_WAIT_V(8); PG8_WAIT_L(0); PG8_BAR; PG8_MMA(0, 0, At, B0); PG8_MMA(0, 1, At, B1); PG8_BAR; PG8_SCHED;
            PG8_LDA(At, 1, 1); PG8_STAGE(PG8_SB(1, 0), b3, voffB); PG8_STAGE(PG8_SB(1, 1), b3 + hstep, voffB); PG8_STAGE(PG8_SA(1, 0), a3, voffA);
            PG8_WAIT_V(8); PG8_WAIT_L(0); PG8_BAR; PG8_MMA(1, 0, At, B0); PG8_MMA(1, 1, At, B1); PG8_BAR; PG8_SCHED;
            } else {
            PG8_LDB(B0, 0, 0); PG8_SCHED; PG8_LDA(At, 0, 0); PG8_STAGE(PG8_SA(1, 1), a1 + hstep, voffA);
            PG8_WAIT_L(8); PG8_BAR; PG8_WAIT_L(0); PG8_MMA(0, 0, At, B0); PG8_BAR; PG8_SCHED;
            PG8_LDB(B1, 0, 1); PG8_STAGE(PG8_SB(0, 0), b2, voffB);
            PG8_BAR; PG8_WAIT_L(0); PG8_MMA(0, 1, At, B1); PG8_BAR;
            PG8_LDA(At, 0, 1); PG8_STAGE(PG8_SA(0, 0), a2, voffA);
            PG8_BAR; PG8_WAIT_L(0); PG8_MMA(1, 0, At, B0); PG8_BAR; PG8_SCHED;
            PG8_STAGE(PG8_SB(0, 1), b2 + hstep, voffB);
            PG8_WAIT_V(6); PG8_BAR; PG8_MMA(1, 1, At, B1); PG8_BAR;
            PG8_LDB(B0, 1, 0); PG8_SCHED; PG8_LDA(At, 1, 0); PG8_STAGE(PG8_SA(0, 1), a2 + hstep, voffA);
            PG8_WAIT_L(8); PG8_BAR; PG8_WAIT_L(0); PG8_MMA(0, 0, At, B0); PG8_BAR; PG8_SCHED;
            PG8_LDB(B1, 1, 1); PG8_STAGE(PG8_SB(1, 0), b3, voffB);
            PG8_BAR; PG8_WAIT_L(0); PG8_MMA(0, 1, At, B1); PG8_BAR;
            PG8_LDA(At, 1, 1); PG8_STAGE(PG8_SA(1, 0), a3, voffA);
            PG8_BAR; PG8_WAIT_L(0); PG8_MMA(1, 0, At, B0); PG8_BAR; PG8_SCHED;
            PG8_STAGE(PG8_SB(1, 1), b3 + hstep, voffB);
            PG8_WAIT_V(6); PG8_BAR; PG8_MMA(1, 1, At, B1); PG8_BAR;
            }
        }
        if constexpr (ALIGN_EPI) { if (wr == 0) PG8_BAR; }
        if constexpr (!Epi::AFTER_DRAIN) { E(acc, cur, wr, wc, fr, fq); S.done(cur); }
        if (!has_next) break;
#pragma unroll
        for (int a = 0; a < 2; ++a)
#pragma unroll
            for (int b = 0; b < 2; ++b)
#pragma unroll
                for (int m = 0; m < 4; ++m)
#pragma unroll
                    for (int n = 0; n < 2; ++n) acc[a][b][m][n] = (f32x4){0.f, 0.f, 0.f, 0.f};
        cur = nxt; cA = nA; cB = nB; ++ui;
        if constexpr (ALIGN_EPI) { if (wr == 1) PG8_BAR; }
    }
    PG8_WAIT_V(0);
    if constexpr (!ALIGN_EPI) { if (wr == 0) PG8_BAR; }
    PG8_BAR;
    if constexpr (Epi::AFTER_DRAIN) { E.fused(acc, cur, wr, wc, fr, fq, lds, wid, lane); S.done(cur); }
#undef PG8_SA
#undef PG8_SB
#undef PG8_STAGE
#undef PG8_LDA
#undef PG8_LDB
#undef PG8_MMA
#undef PG8_WAIT_V
#undef PG8_WAIT_L
#undef PG8_BAR
#undef PG8_SCHED
}
}
#define GAS __attribute__((address_space(1)))
#define LAS __attribute__((address_space(3)))
typedef unsigned short bf16;
typedef unsigned v4u __attribute__((ext_vector_type(4)));
typedef float f32x4 __attribute__((ext_vector_type(4)));
typedef short bf16x8 __attribute__((ext_vector_type(8)));
typedef GAS unsigned gu32;
typedef GAS unsigned long long gu64;
#define RLX_AGENT __ATOMIC_RELAXED, __HIP_MEMORY_SCOPE_AGENT
#define LDS_WAIT() asm volatile("s_waitcnt lgkmcnt(0)" ::: "memory")
#define VM_WAIT() asm volatile("s_waitcnt vmcnt(0)" ::: "memory")
__device__ __forceinline__ unsigned long long rt() { return __builtin_amdgcn_s_memrealtime(); }
__device__ __forceinline__ unsigned f2bf(float f) { unsigned u = __builtin_bit_cast(unsigned, f); return (u + 0x7fffu + ((u >> 16) & 1u)) >> 16; }
__device__ __forceinline__ unsigned pk2(float lo, float hi) { return f2bf(lo) | (f2bf(hi) << 16); }

#define XB_TMO      128
#define XB_XCNT(j)  (256  + 64 * (j))
#define XB_XSUB(j)  (1280 + 64 * (j))
#define XB_XGEN(j)  (2304 + 64 * (j))
#define XB_TOP      3328
#define XB_TOPGEN   3392
#define XCD_BAR_WORDS 3456
#define XB_SPIN_CAP (1u << 18)

__device__ __forceinline__ unsigned xb_ld(unsigned* p)              { return __hip_atomic_load(p, __ATOMIC_RELAXED, __HIP_MEMORY_SCOPE_AGENT); }
__device__ __forceinline__ unsigned xb_add(unsigned* p, unsigned v) { return __hip_atomic_fetch_add(p, v, __ATOMIC_RELAXED, __HIP_MEMORY_SCOPE_AGENT); }
__device__ __forceinline__ unsigned xb_xcc_id() { return (unsigned)__builtin_amdgcn_s_getreg((3 << 11) | 20) & 0xFu; }
#define XB_SPIN(cond, bar) do { unsigned _sp = 0; while (cond) { __builtin_amdgcn_s_sleep(1); \
    if ((++_sp & 255u) == 0u) { if (xb_ld(&(bar)[XB_TMO])) break; if (_sp > XB_SPIN_CAP) { atomicAdd(&(bar)[XB_TMO], 1u); break; } } } } while (0)

struct XcdBarrier {
    unsigned* bar; unsigned x;
    volatile LAS unsigned* st;
};

__device__ __forceinline__ XcdBarrier xcd_barrier_post(unsigned* bar, volatile LAS unsigned* st, bool leader) {
    XcdBarrier b; b.bar = bar; b.x = xb_xcc_id(); b.st = st;
    if (leader) (void)xb_add(&bar[XB_XCNT(b.x)], 1u);
    return b;
}
__device__ __forceinline__ void xcd_barrier_complete(unsigned* bar, unsigned x, unsigned& nloc, unsigned& nx) {
    const unsigned G = gridDim.x * gridDim.y * gridDim.z;
    unsigned sum, cnt, mine, sp = 0u;
    for (;;) {
        sum = 0u; cnt = 0u; mine = 0u;
#pragma unroll
        for (unsigned j = 0; j < 16; ++j) { const unsigned c = xb_ld(&bar[XB_XCNT(j)]); sum += c; cnt += (c > 0u) ? 1u : 0u; mine = (j == x) ? c : mine; }
        if (sum == G) break;
        __builtin_amdgcn_s_sleep(1);
        if ((++sp & 255u) == 0u) { if (xb_ld(&bar[XB_TMO])) break; if (sp > XB_SPIN_CAP) { atomicAdd(&bar[XB_TMO], 1u); break; } }
    }
    nloc = mine > 0u ? mine : 1u; nx = cnt > 0u ? cnt : 1u;
}

__device__ __forceinline__ void xcd_barrier(const XcdBarrier& b, bool leader) {
    asm volatile("s_waitcnt vmcnt(0)" ::: "memory");
    __syncthreads();
    if (leader) {
        unsigned* bar = b.bar;
        __builtin_amdgcn_s_waitcnt(0);
        unsigned nloc = b.st[0], nx = b.st[1];
        if (nloc == 0u) { xcd_barrier_complete(bar, b.x, nloc, nx); b.st[0] = nloc; b.st[1] = nx; }
        const unsigned old = xb_add(&bar[XB_XSUB(b.x)], 1u);
        const unsigned gen = old / nloc;
        if (old + 1u == (gen + 1u) * nloc) {
            __builtin_amdgcn_fence(__ATOMIC_RELEASE, "agent");
            asm volatile("s_waitcnt vmcnt(0)" ::: "memory");
            const unsigned og = xb_add(&bar[XB_TOP], 1u);
            const unsigned tg = og / nx;
            if (og + 1u == (tg + 1u) * nx) xb_add(&bar[XB_TOPGEN], 1u);
            else XB_SPIN(xb_ld(&bar[XB_TOPGEN]) == tg, bar);
            __builtin_amdgcn_fence(__ATOMIC_ACQUIRE, "agent");
            xb_add(&bar[XB_XGEN(b.x)], 1u);
            asm volatile("s_waitcnt vmcnt(0)" ::: "memory");
        } else {
            XB_SPIN(xb_ld(&bar[XB_XGEN(b.x)]) == gen, bar);
            __builtin_amdgcn_fence(__ATOMIC_ACQUIRE, "agent");
            asm volatile("s_waitcnt vmcnt(0)" ::: "memory");
        }
    }
    __syncthreads();
}
constexpr int NWAVES = 8;
constexpr size_t MiB = 1u << 20;
constexpr size_t WS_CTL = 0, CTL_ZERO_BYTES = 1 * MiB;
constexpr size_t WS_TAB = 1 * MiB;
constexpr size_t WS_WIN = 4 * MiB, WS_WOUT = 10 * MiB, WS_WGATE = 12 * MiB, WS_WPROJ = 14 * MiB, WS_WUP = 16 * MiB, WS_WDOWN = 80 * MiB;
constexpr size_t WS_N1 = 112 * MiB;
constexpr size_t WS_QKVZ = 144 * MiB;
constexpr size_t WS_U = 208 * MiB;
constexpr size_t WS_AB = 224 * MiB;
constexpr size_t WS_PBF = 226 * MiB;
constexpr int NIN_T = 3072;
constexpr int CW_TMO = 0, CW_CODE = 1, CW_BAR = 4096, CW_READY = 65536, CW_PROG = 131072;
constexpr int RING_OFF = 0, RING_BYTES = 131072, LDSCTL_OFF = RING_BYTES, MISC_OFF = LDSCTL_OFF + 320, LDS_BYTES = 163840;

struct Frame {
    LAS unsigned char* lds; volatile LAS unsigned* MISC; gu32* ctl;
    int wave, vcu, G;
};
__device__ __forceinline__ int lane_now() { int l; asm volatile("v_mbcnt_lo_u32_b32 %0, -1, 0\n\tv_mbcnt_hi_u32_b32 %0, -1, %0" : "=v"(l)); return l; }
template <int CTRL, int ROW_MASK> __device__ __forceinline__ float dpp_add(float v) {
    return v + __builtin_bit_cast(float, __builtin_amdgcn_update_dpp(0, __builtin_bit_cast(int, v), CTRL, ROW_MASK, 0xF, true));
}
__device__ __forceinline__ float wave_sum_f(float v) {
    v = dpp_add<0xB1, 0xF>(v);
    v = dpp_add<0x4E, 0xF>(v);
    v = dpp_add<0x141, 0xF>(v);
    v = dpp_add<0x140, 0xF>(v);
    v = dpp_add<0x142, 0xA>(v);
    v = dpp_add<0x143, 0xC>(v);
    return __builtin_bit_cast(float, __builtin_amdgcn_readlane(__builtin_bit_cast(int, v), 63));
}
__device__ __forceinline__ float fsigmoid(float x) { return __builtin_amdgcn_rcpf(1.f + __expf(-x)); }
__device__ __forceinline__ float fsilu(float x) { return x * __builtin_amdgcn_rcpf(1.f + __expf(-x)); }

struct MapId  { __device__ __forceinline__ int operator()(int n) const { return n; } };
struct MapWin { __device__ __forceinline__ int operator()(int n) const { if (n < 2048) return n; const int j = n - 2048; return O4 + (j >> 3) * 4 + (j & 3) + ((j >> 2) & 1) * CCH; } };
struct MapWup { __device__ __forceinline__ int operator()(int n) const { return (n >> 3) * 4 + (n & 3) + ((n >> 2) & 1) * DEXP; } };

template <class Map>
__device__ __forceinline__ void p0_transpose_item(const float* W, int K, int Nsrc, int Ndst, bf16* WT, LAS float* scr, int item, int lane, Map map) {
    const int nblk = Ndst / 32, kb = item / nblk, nb = item % nblk, k0 = 64 * kb, n0 = 32 * nb;
    const int sc = map(n0 + (lane & 31));
#pragma unroll 8
    for (int i = 0; i < 32; ++i) { const int kk = 2 * i + (lane >> 5); scr[kk * 33 + (lane & 31)] = W[(size_t)(k0 + kk) * Nsrc + sc]; }
    LDS_WAIT(); asm volatile("" ::: "memory");
    const int c = lane & 7;
#pragma unroll
    for (int j = 0; j < 4; ++j) { const int n = (lane >> 3) + 8 * j; const LAS float* s = scr + (8 * c) * 33 + n;
        v4u o; o.x = pk2(s[0 * 33], s[1 * 33]); o.y = pk2(s[2 * 33], s[3 * 33]); o.z = pk2(s[4 * 33], s[5 * 33]); o.w = pk2(s[6 * 33], s[7 * 33]);
        *(GAS v4u*)(WT + (size_t)(n0 + n) * K + k0 + 8 * c) = o; }
    LDS_WAIT(); asm volatile("" ::: "memory");
}

struct Ptrs {
    const float *x, *p, *g_mix, *w_in, *w_conv_qkv, *a_log, *dt_bias, *g_gdn_out, *b_glu, *w_conv_dw, *b_conv_dw, *ln_g, *ln_b, *w_out, *g_moe, *w_gr, *w_er, *w_up, *w_down, *g_ple, *w_pg, *w_pp, *g_final;
    float* out; unsigned char* ws;
};

__device__ __forceinline__ void p0_prologue(Frame& F, const Ptrs& P) {
    const int lane = lane_now(), tid = F.wave * 64 + lane;
    LAS float* scr = (LAS float*)(F.lds + RING_OFF + F.wave * 16384);
    const int gw = F.vcu * NWAVES + F.wave, NGW = F.G * NWAVES;
    bf16* Win_t = (bf16*)(P.ws + WS_WIN); bf16* Wout_t = (bf16*)(P.ws + WS_WOUT); bf16* Wgate_t = (bf16*)(P.ws + WS_WGATE); bf16* Wproj_t = (bf16*)(P.ws + WS_WPROJ);
    bf16* Wup_t = (bf16*)(P.ws + WS_WUP); bf16* Wdown_t = (bf16*)(P.ws + WS_WDOWN);
    constexpr int I_IN = 16 * (NIN_T / 32), I_SQ = 16 * 32, I_PR = 4 * 32, I_UP1 = 16 * 16, I_UP = NEXP * I_UP1, I_DN1 = 4 * 32, I_DN = NEXP * I_DN1;
    constexpr int NITEMS = I_IN + I_SQ + I_PR;
    (void)Wgate_t; (void)Wup_t; (void)Wdown_t; (void)I_UP; (void)I_DN;
    for (int it = gw; it < NITEMS; it += NGW) {
        int r = it;
        if (r < I_IN) { p0_transpose_item(P.w_in, DM, INC, NIN_T, Win_t, scr, r, lane, MapWin()); continue; } r -= I_IN;
        if (r < I_SQ) { p0_transpose_item(P.w_out, DM, DM, DM, Wout_t, scr, r, lane, MapId()); continue; } r -= I_SQ;
        p0_transpose_item(P.w_pp, PLE, DM, DM, Wproj_t, scr, r, lane, MapId());
    }
    __syncthreads();
    LAS float* wabT = (LAS float*)(F.lds + RING_OFF);
    for (int idx = tid; idx < 8 * DM; idx += NWAVES * 64) { const int k = idx >> 3, c = idx & 7; wabT[c * DM + k] = P.w_in[(size_t)k * INC + O2 + c]; }
    __syncthreads();
    bf16* N1 = (bf16*)(P.ws + WS_N1); float* AB = (float*)(P.ws + WS_AB);
    for (int m = gw; m < M; m += NGW) {
        const GAS f32x4* xr = (const GAS f32x4*)(P.x + (size_t)m * DM) + lane;
        f32x4 v[4]; float s = 0.f;
#pragma unroll
        for (int j = 0; j < 4; ++j) { v[j] = xr[64 * j]; s += (v[j].x * v[j].x + v[j].y * v[j].y) + (v[j].z * v[j].z + v[j].w * v[j].w); }
        const float r = rsqrtf(wave_sum_f(s) * (1.f / DM) + EPS);
        float ab[8];
#pragma unroll
        for (int c = 0; c < 8; ++c) ab[c] = 0.f;
#pragma unroll
        for (int j = 0; j < 4; ++j) { const f32x4 g = ((const GAS f32x4*)P.g_mix)[64 * j + lane]; v[j] = v[j] * r * g;
#pragma unroll
            for (int c = 0; c < 8; ++c) { const f32x4 w = *(const LAS f32x4*)(wabT + c * DM + 256 * j + 4 * lane); ab[c] += (v[j].x * w.x + v[j].y * w.y) + (v[j].z * w.z + v[j].w * w.w); } }
        GAS unsigned long long* o8 = (GAS unsigned long long*)(N1 + (size_t)m * DM) + lane;
#pragma unroll
        for (int j = 0; j < 4; ++j) o8[64 * j] = (unsigned long long)pk2(v[j].x, v[j].y) | ((unsigned long long)pk2(v[j].z, v[j].w) << 32);
#pragma unroll
        for (int c = 0; c < 8; ++c) ab[c] = wave_sum_f(ab[c]);
        if (lane == 0) { *(GAS f32x4*)(AB + (size_t)m * 8) = (f32x4){ab[0], ab[1], ab[2], ab[3]}; *(GAS f32x4*)(AB + (size_t)m * 8 + 4) = (f32x4){ab[4], ab[5], ab[6], ab[7]}; }
    }
    { bf16* Wr = (bf16*)(P.ws + 15 * MiB);
      for (int i = F.vcu * (NWAVES * 64) + tid; i < 80 * DM; i += F.G * NWAVES * 64) { const int n = i >> 10, k = i & 1023;
          const float v = n < NGRP ? P.w_gr[k * NGRP + n] : (n < NGRP + NEXP ? P.w_er[k * NEXP + n - NGRP] : 0.f); Wr[i] = (bf16)f2bf(v); } }
    bf16* PB = (bf16*)(P.ws + WS_PBF);
    for (size_t i = (size_t)F.vcu * (NWAVES * 64) + tid; i < (size_t)M * PLE / 8; i += (size_t)F.G * NWAVES * 64) {
        const f32x4 a = ((const GAS f32x4*)P.p)[2 * i], b = ((const GAS f32x4*)P.p)[2 * i + 1];
        v4u o; o.x = pk2(a.x, a.y); o.y = pk2(a.z, a.w); o.z = pk2(b.x, b.y); o.w = pk2(b.z, b.w);
        ((GAS v4u*)PB)[i] = o;
    }
}

__device__ __forceinline__ void p3_convert_late(Frame& F, const Ptrs& P, int idx, int cnt) {
    const int lane = lane_now();
    LAS float* scr = (LAS float*)(F.lds + RING_OFF + F.wave * 16384);
    const int gw = idx * NWAVES + F.wave, NGW = cnt * NWAVES;
    bf16* Wgate_t = (bf16*)(P.ws + WS_WGATE); bf16* Wup_t = (bf16*)(P.ws + WS_WUP); bf16* Wdown_t = (bf16*)(P.ws + WS_WDOWN);
    constexpr int I_SQ = 16 * 32, I_UP1 = 16 * 16, I_UP = NEXP * I_UP1, I_DN1 = 4 * 32, I_DN = NEXP * I_DN1;
    constexpr int NITEMS = I_SQ + I_UP + I_DN;
    for (int it = gw; it < NITEMS; it += NGW) {
        int r = it;
        if (r < I_SQ) { p0_transpose_item(P.w_pg, DM, DM, DM, Wgate_t, scr, r, lane, MapId()); continue; } r -= I_SQ;
        if (r < I_UP) { const int e = r / I_UP1; p0_transpose_item(P.w_up + (size_t)e * DM * 512, DM, 512, 512, Wup_t + (size_t)e * 512 * DM, scr, r % I_UP1, lane, MapWup()); continue; } r -= I_UP;
        { const int e = r / I_DN1; p0_transpose_item(P.w_down + (size_t)e * DEXP * DM, DEXP, DM, DM, Wdown_t + (size_t)e * DM * DEXP, scr, r % I_DN1, lane, MapId()); }
    }
    asm volatile("s_waitcnt lgkmcnt(0)" ::: "memory"); __builtin_amdgcn_s_barrier(); asm volatile("" ::: "memory");
}

struct EpiIn {
    static constexpr bool PERM = true, AFTER_DRAIN = false;
    pg8::bf16_t* QKVZ; pg8::bf16_t* U; const float* b_glu;
    __device__ __forceinline__ void operator()(const pg8::f32x4 (&acc)[2][2][4][2], const pg8::Unit& u, int wr, int wc, int fr, int fq) const {
        using namespace pg8;
        const int row0 = u.pm * BM + wr * 64 + fr;
        if (u.pn < 8) {
            const int col0 = u.pn * BM + wc * 32 + 8 * fq;
#pragma unroll
            for (int ai = 0; ai < 2; ++ai)
#pragma unroll
                for (int m = 0; m < 4; ++m) { bf16_t* rowp = QKVZ + (size_t)(row0 + ai * HALF + m * 16) * 2048 + col0;
#pragma unroll
                    for (int bj = 0; bj < 2; ++bj) { const f32x4 v0 = acc[ai][bj][m][0], v1 = acc[ai][bj][m][1];
                        u32x4 w; w.x = cvt_pk_bf16(v0[0], v0[1]); w.y = cvt_pk_bf16(v0[2], v0[3]); w.z = cvt_pk_bf16(v1[0], v1[1]); w.w = cvt_pk_bf16(v1[2], v1[3]);
                        *(u32x4*)(rowp + bj * HALF) = w; } }
        } else {
            const int hid0 = (u.pn - 8) * 128 + wc * 16 + 4 * fq;
            f32x4 ba[2], bg[2];
#pragma unroll
            for (int bj = 0; bj < 2; ++bj) { ba[bj] = *(const f32x4*)(b_glu + hid0 + bj * 64); bg[bj] = *(const f32x4*)(b_glu + CCH + hid0 + bj * 64); }
#pragma unroll
            for (int ai = 0; ai < 2; ++ai)
#pragma unroll
                for (int m = 0; m < 4; ++m) { bf16_t* rowp = U + (size_t)(row0 + ai * HALF + m * 16) * CCH + hid0;
#pragma unroll
                    for (int bj = 0; bj < 2; ++bj) { const f32x4 a = acc[ai][bj][m][0] + ba[bj], g = acc[ai][bj][m][1] + bg[bj];
                        typedef unsigned u32x2v __attribute__((ext_vector_type(2)));
                        u32x2v w; w.x = cvt_pk_bf16(a[0] * fsigmoid(g[0]), a[1] * fsigmoid(g[1])); w.y = cvt_pk_bf16(a[2] * fsigmoid(g[2]), a[3] * fsigmoid(g[3]));
                        *(u32x2v*)(rowp + bj * 64) = w; } }
        }
    }
};

constexpr size_t WS_GT = 225 * MiB;
constexpr size_t WS_GDN = 234 * MiB, GDN_ITEM = 73728;
constexpr size_t GI_WNEG = 0, GI_KDT = 16384, GI_UFR = 32768, GI_QD = 49152, GI_QK = 65536;
constexpr size_t WS_SN = 306 * MiB;
constexpr size_t WS_VN = 338 * MiB;
constexpr size_t WS_MIX = 354 * MiB;
constexpr size_t WS_H1 = 386 * MiB;
constexpr size_t WS_PROJ = 450 * MiB;
constexpr int NSCAN = 32;
typedef float f32x16 __attribute__((ext_vector_type(16)));
typedef unsigned u32x2 __attribute__((ext_vector_type(2)));
#define LBAR() do { asm volatile("s_waitcnt lgkmcnt(0)" ::: "memory"); __builtin_amdgcn_s_barrier(); asm volatile("" ::: "memory"); } while (0)
__device__ __forceinline__ float bf2f(unsigned short b) { return __uint_as_float((unsigned)b << 16); }
__device__ __forceinline__ __amdgpu_buffer_rsrc_t mk_rsrc(const void* p, unsigned bytes) { return __builtin_amdgcn_make_buffer_rsrc((void*)p, (short)0, (int)bytes, 0x00020000); }
__device__ __forceinline__ float buf_ld_bf16(__amdgpu_buffer_rsrc_t r, unsigned voff, unsigned soff) { return bf2f((unsigned short)__builtin_amdgcn_raw_buffer_load_b16(r, (int)voff, (int)soff, 0)); }
__device__ __forceinline__ void buf_st_b64(__amdgpu_buffer_rsrc_t r, unsigned voff, unsigned soff, u32x2 v) { __builtin_amdgcn_raw_buffer_store_b64(v, r, (int)voff, (int)soff, 0); }
__device__ __forceinline__ void buf_st_b128(__amdgpu_buffer_rsrc_t r, unsigned voff, unsigned soff, v4u v) { __builtin_amdgcn_raw_buffer_store_b128(v, r, (int)(voff + soff), 0, 0); }
__device__ __forceinline__ void buf_st_bf16(__amdgpu_buffer_rsrc_t r, unsigned voff, unsigned soff, float v) { __builtin_amdgcn_raw_buffer_store_b16((short)f2bf(v), r, (int)voff, (int)soff, 0); }

#ifndef XCHK
#define XCHK 0
#endif
#ifndef S5BAR
#define S5BAR 0
#endif
constexpr int CK_P1 = 2112, CK_P2 = 2176;
#define FMAC1(acc, a, b) asm("v_fmac_f32 %0, %1, %2" : "+v"(acc) : "v"(a), "v"(b))
template <int I>
struct SolveRow {
    static __device__ __forceinline__ void run(float (&X)[64], const LAS float* LS, const LAS float* SC) {
        int one; asm volatile("s_mov_b32 %0, 1" : "=s"(one));
        if (one) {
            constexpr int NQ = (I + 3) / 4;
            f32x4 lc[NQ > 0 ? NQ : 1];
#pragma unroll
            for (int q = 0; q < NQ; ++q) lc[q] = *(const volatile LAS f32x4*)(LS + I * 64 + 4 * q);
            float x0 = X[I] * SC[I], x1 = 0.f, x2 = 0.f, x3 = 0.f;
#pragma unroll
            for (int q = 0; q < NQ; ++q) {
                const f32x4 l = lc[q];
                if (4 * q + 0 < I) FMAC1(x0, l.x, X[4 * q + 0]);
                if (4 * q + 1 < I) FMAC1(x1, l.y, X[4 * q + 1]);
                if (4 * q + 2 < I) FMAC1(x2, l.z, X[4 * q + 2]);
                if (4 * q + 3 < I) FMAC1(x3, l.w, X[4 * q + 3]);
            }
            X[I] = (x0 + x1) + (x2 + x3);
        }
        if constexpr (I < 63) SolveRow<I + 1>::run(X, LS, SC);
    }
};

#ifndef SOLVE_PF
#define SOLVE_PF 0
#endif
#ifndef SOLVE_D
#define SOLVE_D 1
#endif
#ifndef SOLVE2
#define SOLVE2 0
#endif
typedef float f32x2 __attribute__((ext_vector_type(2)));
#define PKFMA_LO(acc, l2, x) asm("v_pk_fma_f32 %0, %1, %2, %0 op_sel_hi:[0,1,1]" : "+v"(acc) : "v"(l2), "v"(x))
#define PKFMA_HI(acc, l2, x) asm("v_pk_fma_f32 %0, %1, %2, %0 op_sel:[1,0,0] op_sel_hi:[1,1,1]" : "+v"(acc) : "v"(l2), "v"(x))
template <int I>
struct SolveRow2 {
    static __device__ __forceinline__ void run(f32x2 (&X)[64], const LAS float* LS, const LAS float* SCW, const LAS float* BET) {
        int one; asm volatile("s_mov_b32 %0, 1" : "=s"(one));
        if (one) {
            constexpr int NQ = (I + 3) / 4, NG = (NQ + 3) / 4;
            f32x4 buf[2][4];
#pragma unroll
            for (int g = 0; g < 2; ++g)
#pragma unroll
                for (int u = 0; u < 4; ++u) if (g < NG && 4 * g + u < NQ) buf[g][u] = *(const volatile LAS f32x4*)(LS + I * 64 + 4 * (4 * g + u));
            const f32x2 sc = {SCW[I], BET[I]};
            f32x2 x0 = X[I] * sc, x1 = {0.f, 0.f}, x2 = {0.f, 0.f}, x3 = {0.f, 0.f};
#pragma unroll
            for (int g = 0; g < NG; ++g) {
#pragma unroll
                for (int u = 0; u < 4; ++u) { const int q = 4 * g + u; if (q < NQ) { const f32x4 l = buf[g & 1][u]; const f32x2 lxy = {l.x, l.y}, lzw = {l.z, l.w};
                    if (4 * q + 0 < I) PKFMA_LO(x0, lxy, X[4 * q + 0]);
                    if (4 * q + 1 < I) PKFMA_HI(x1, lxy, X[4 * q + 1]);
                    if (4 * q + 2 < I) PKFMA_LO(x2, lzw, X[4 * q + 2]);
                    if (4 * q + 3 < I) PKFMA_HI(x3, lzw, X[4 * q + 3]); } }
                if (g + 2 < NG) {
#pragma unroll
                    for (int u = 0; u < 4; ++u) if (4 * (g + 2) + u < NQ) buf[g & 1][u] = *(const volatile LAS f32x4*)(LS + I * 64 + 4 * (4 * (g + 2) + u)); }
            }
            X[I] = (x0 + x1) + (x2 + x3);
        }
        if constexpr (I < 63) SolveRow2<I + 1>::run(X, LS, SCW, BET);
    }
};
#if SOLVE_PF
template <int I>
struct SolveRowPF {
    static constexpr int NQ = (I + 3) / 4, NP = NQ < 8 ? NQ : 8;
    static __device__ __forceinline__ void run(float (&X)[64], const LAS float* LS, const LAS float* SC, const f32x4 (&pre)[8]) {
        int one; asm volatile("s_mov_b32 %0, 1" : "=s"(one));
        f32x4 nxt[8];
        if (one) {
            constexpr int NQ1 = (I + 4) / 4, NP1 = NQ1 < 8 ? NQ1 : 8, NR = NQ > 8 ? NQ - 8 : 0;
            f32x4 rest[NR > 0 ? NR : 1];
#pragma unroll
            for (int q = 0; q < NR; ++q) rest[q] = *(const volatile LAS f32x4*)(LS + I * 64 + 4 * (8 + q));
            if constexpr (I < 63) {
#pragma unroll
                for (int q = 0; q < NP1; ++q) nxt[q] = *(const volatile LAS f32x4*)(LS + (I + 1) * 64 + 4 * q);
            }
            float x0 = X[I] * SC[I], x1 = 0.f, x2 = 0.f, x3 = 0.f;
#pragma unroll
            for (int q = 0; q < NQ; ++q) {
                const f32x4 l = q < NP ? pre[q] : rest[q < 8 ? 0 : q - 8];
                if (4 * q + 0 < I) FMAC1(x0, l.x, X[4 * q + 0]);
                if (4 * q + 1 < I) FMAC1(x1, l.y, X[4 * q + 1]);
                if (4 * q + 2 < I) FMAC1(x2, l.z, X[4 * q + 2]);
                if (4 * q + 3 < I) FMAC1(x3, l.w, X[4 * q + 3]);
            }
            X[I] = (x0 + x1) + (x2 + x3);
        }
        if constexpr (I < 63) SolveRowPF<I + 1>::run(X, LS, SC, nxt);
    }
};
#endif
template <int B> __device__ __forceinline__ void fmac_bc(float& acc, float l, float x) { asm("v_fmac_f32_dpp %0, %1, %2 row_newbcast:%3 row_mask:0xf bank_mask:0xf" : "+v"(acc) : "v"(l), "v"(x), "n"(B)); }
template <int J, int I>
__device__ __forceinline__ void solve_terms(const float (&X)[64], const f32x4& l, float& x0, float& x1, float& x2, float& x3) {
    if constexpr (J < I) {
        constexpr int k = J >> 4, b = J & 15;
        const float lk = k == 0 ? l.x : (k == 1 ? l.y : (k == 2 ? l.z : l.w));
        if constexpr ((J & 3) == 0) fmac_bc<b>(x0, lk, X[J]); else if constexpr ((J & 3) == 1) fmac_bc<b>(x1, lk, X[J]); else if constexpr ((J & 3) == 2) fmac_bc<b>(x2, lk, X[J]); else fmac_bc<b>(x3, lk, X[J]);
        solve_terms<J + 1, I>(X, l, x0, x1, x2, x3);
    }
}
template <int I>
struct SolveRowD {
    static __device__ __forceinline__ void run(float (&X)[64], const LAS float* LSl  , const f32x4 l, const f32x4 l1  ) {
        int one; asm volatile("s_mov_b32 %0, 1" : "=s"(one));
        f32x4 l2 = l1;
        if (one) {
            if constexpr (I < 62) l2 = *(const volatile LAS f32x4*)(LSl + (I + 2) * 64);
            float x0 = X[I], x1 = 0.f, x2 = 0.f, x3 = 0.f;
            solve_terms<0, I>(X, l, x0, x1, x2, x3);
            X[I] = (x0 + x1) + (x2 + x3);
        }
        if constexpr (I < 63) SolveRowD<I + 1>::run(X, LSl, l1, l2);
    }
};
__device__ __forceinline__ void solve64(float (&X)[64], const LAS float* LS, const LAS float* SC) {
#if SOLVE_D
    const LAS float* LSl = LS + (lane_now() & 15) * 4;
    const f32x4 l0 = *(const volatile LAS f32x4*)LSl, l1 = *(const volatile LAS f32x4*)(LSl + 64);
#pragma unroll
    for (int q = 0; q < 16; ++q) { const f32x4 sc = *(const volatile LAS f32x4*)(SC + 4 * q); X[4 * q + 0] *= sc.x; X[4 * q + 1] *= sc.y; X[4 * q + 2] *= sc.z; X[4 * q + 3] *= sc.w; }
    SolveRowD<0>::run(X, LSl, l0, l1);
    return;
#endif
#if SOLVE_PF
    f32x4 pre[8]; SolveRowPF<0>::run(X, LS, SC, pre);
#else
    SolveRow<0>::run(X, LS, SC);
#endif
}

#if defined(P2_TSTAGE)
#define P2T(k) do { if (P2_TSTAGE == (k)) p2t_s = (unsigned)rt(); if (P2_TSTAGE + 1 == (k)) p2t_a += (unsigned)rt() - p2t_s; } while (0)
#else
#define P2T(k) do { } while (0)
#endif
__device__ __forceinline__ void p2_gdn_prep(Frame& F, const Ptrs& P, const size_t gdn_off = WS_GDN, const size_t gt_off = WS_GT) {
    LAS unsigned char* QT = F.lds; LAS unsigned char* KT = F.lds + 17408; LAS float* LS = (LAS float*)(F.lds + 34816);
    LAS unsigned char* XS = F.lds + 53248;
    LAS unsigned char* QDT = F.lds + 53248;
    LAS unsigned char* QKT = F.lds + 53248 + 17408;
    LAS float* gcs = (LAS float*)(F.lds + 51200); LAS float* betas = gcs + 64; LAS float* nk2 = gcs + 128; LAS float* nq2 = gcs + 192; LAS float* sc_w = gcs + 256; LAS float* sc_kd = gcs + 320; LAS float* sc_qd = gcs + 384;
    const bf16* QKVZ = (const bf16*)(P.ws + WS_QKVZ); const float* AB = (const float*)(P.ws + WS_AB);
    const int wave = F.wave;
    const int grp = wave >> 1;
    v4u pre[7];
#define P2_PREFETCH(it_) do { const int lane_ = lane_now(), tid_ = wave * 64 + lane_; const int bh_ = (it_) >> 7, n_ = (it_) & 127; \
        const unsigned char* src_ = (const unsigned char*)(QKVZ + ((size_t)(bh_ >> 2) * SEQ + (size_t)n_ * 64 - 3) * 2048 + (bh_ & 3) * 128); \
        _Pragma("unroll") for (int u = 0; u < 7; ++u) { const int cid = tid_ + 512 * u; pre[u] = (v4u){0u, 0u, 0u, 0u}; if (cid < 67 * 48) { const int row = cid / 48, cc = cid - row * 48, seg3 = cc >> 4; \
            if (n_ * 64 + row - 3 >= 0) pre[u] = *(const GAS v4u*)(src_ + (size_t)row * 4096 + seg3 * 1024 + (cc & 15) * 16); } } } while (0)
    if (F.vcu < 1024) P2_PREFETCH(F.vcu);
    unsigned p2t_s = 0, p2t_a = 0; (void)p2t_s; (void)p2t_a;
    for (int it = F.vcu; it < 1024; it += F.G) {
        P2T(0);
        const int lane = lane_now();
        const int c = ((wave & 1) << 6) | lane, tid = wave * 64 + lane;
        const int bh = it >> 7, n = it & 127, b = bh >> 2, h = bh & 3;
        const size_t m0 = (size_t)b * SEQ + (size_t)n * 64;
        unsigned char* item = P.ws + gdn_off + (size_t)it * GDN_ITEM;
        float y[64];
#pragma unroll
        for (int u = 0; u < 7; ++u) { const int cid = tid + 512 * u; if (cid < 67 * 48) *(LAS v4u*)(XS + cid * 16) = pre[u]; }
        LBAR();
        P2T(1);
        if (grp < 3) {
            const int col = grp * 512 + h * 128 + c;
            const float w0 = P.w_conv_qkv[0 * 1536 + col], w1 = P.w_conv_qkv[1 * 1536 + col], w2 = P.w_conv_qkv[2 * 1536 + col], w3 = P.w_conv_qkv[3 * 1536 + col];
            float xr[67];
#pragma unroll
            for (int j = 0; j < 67; ++j) xr[j] = bf2f(*(const LAS unsigned short*)(XS + j * 768 + grp * 256 + c * 2));
#pragma unroll
            for (int i = 0; i < 64; ++i) { const float s = fmaf(w3, xr[i + 3], fmaf(w2, xr[i + 2], fmaf(w1, xr[i + 1], w0 * xr[i]))); y[i] = fsilu(s); }
            if (grp < 2) { LAS unsigned char* tile = grp == 0 ? QT : KT;
#pragma unroll
                for (int i = 0; i < 64; ++i) *(LAS unsigned short*)(tile + i * 272 + c * 2) = (unsigned short)f2bf(y[i]); }
        }
        if (wave == 7) {
            const float araw = AB[(m0 + lane) * 8 + 4 + h], braw = AB[(m0 + lane) * 8 + h];
            const float xx = araw + P.dt_bias[h];
            const float sp = (xx > 20.f) ? xx : log1pf(expf(xx));
            float g = -expf(P.a_log[h]) * sp;
#pragma unroll
            for (int off = 1; off < 64; off <<= 1) { const float t = __shfl_up(g, off); if (lane >= off) g += t; }
            gcs[lane] = g; betas[lane] = 1.f / (1.f + expf(-braw));
        }
        LBAR();
        P2T(2);
        const int kind = wave < 3 ? 0 : (wave < 6 ? 1 : 2);
        const int tsel = wave < 6 ? wave % 3 : (wave - 6) * 2;
        const int ib = tsel >= 1 ? 1 : 0, jb = tsel == 2 ? 1 : 0;
        const int r32 = lane & 31, hh = lane >> 5;
        f32x16 acc;
#pragma unroll
        for (int i = 0; i < 16; ++i) acc[i] = 0.f;
        {
            const LAS unsigned char* At = (kind == 0 ? KT : QT) + (32 * ib + r32) * 272 + hh * 16;
            const LAS unsigned char* Bt = (kind == 2 ? QT : KT) + (32 * jb + r32) * 272 + hh * 16;
#pragma unroll
            for (int s = 0; s < 8; ++s) { const bf16x8 a = *(const LAS bf16x8*)(At + s * 32), bb = *(const LAS bf16x8*)(Bt + s * 32); acc = __builtin_amdgcn_mfma_f32_32x32x16_bf16(a, bb, acc, 0, 0, 0); }
        }
        if ((kind == 0 || kind == 2) && ib == jb) {
            if (((r32 >> 2) & 1) == hh) {
                const int rsel = (r32 & 3) + 4 * (r32 >> 3); float v = 0.f;
#pragma unroll
                for (int i = 0; i < 16; ++i) v = (i == rsel) ? acc[i] : v;
                (kind == 0 ? nk2 : nq2)[32 * ib + r32] = v;
            }
        }
        LBAR();
        P2T(3);
        {
            const int j = 32 * jb + r32; const float gj = gcs[j], rkj = rsqrtf(nk2[j] + EPS);
#pragma unroll
            for (int reg = 0; reg < 16; ++reg) {
                const int iu = 32 * ib + (reg & 3) + 8 * (reg >> 2), i = iu + 4 * hh;
                const float dec = __expf(fminf(gcs[i] - gj, 0.f));
                if (kind == 0) { const float v = (j < i) ? acc[reg] * betas[i] * rsqrtf(nk2[i] + EPS) * rkj * dec : 0.f; LS[i * 64 + (j & 15) * 4 + (j >> 4)] = -v; }
                else if (kind == 1) { const float v = (j <= i) ? acc[reg] * rsqrtf(nq2[i] + EPS) * 0.08838834764831845f * rkj * dec : 0.f; *(LAS unsigned short*)(QKT + i * 144 + j * 2) = (unsigned short)f2bf(v); }
            }
            if (wave == 7) {
                const float rk = rsqrtf(nk2[lane] + EPS), rq = rsqrtf(nq2[lane] + EPS), gi = gcs[lane], eg = __expf(gi);
                sc_w[lane] = betas[lane] * rk * eg; sc_kd[lane] = rk * __expf(gcs[63] - gi); sc_qd[lane] = rq * 0.08838834764831845f * eg;
            }
            if (kind == 2 && tsel == 0) {
#pragma unroll
                for (int reg = 0; reg < 16; ++reg) { const int i = (reg & 3) + 8 * (reg >> 2) + 4 * hh; *(LAS unsigned short*)(QKT + i * 144 + (32 + r32) * 2) = 0; }
            }
        }
        LBAR();
        P2T(4);
        const float gl = gcs[63];
#if SOLVE2
        if (grp == 2) {
            f32x2 X[64];
#pragma unroll
            for (int i = 0; i < 64; ++i) { X[i].x = bf2f(*(const LAS unsigned short*)(KT + i * 272 + c * 2)); X[i].y = y[i]; }
            SolveRow2<0>::run(X, LS, sc_w, betas);
#pragma unroll
            for (int i = 0; i < 64; ++i) *(LAS unsigned short*)(QT + i * 272 + c * 2) = (unsigned short)f2bf(-X[i].x);
            const __amdgpu_buffer_rsrc_t rit = mk_rsrc(item, (unsigned)GDN_ITEM);
            const int et = c >> 4, r = c & 15;
#pragma unroll
            for (int i4 = 0; i4 < 16; ++i4) { const int ct = i4 >> 2, q = i4 & 3;
                u32x2 o; o.x = pk2(X[4 * i4 + 0].y, X[4 * i4 + 1].y); o.y = pk2(X[4 * i4 + 2].y, X[4 * i4 + 3].y);
                buf_st_b64(rit, (unsigned)((((et >> 1) * 64 + r) * 2 + (et & 1)) * 8), (unsigned)(GI_UFR + (ct * 4 * 64 + q * 16) * 16), o); }
#else
        if (grp == 1 || grp == 2) solve64(y, LS, grp == 1 ? sc_w : betas);
        if (grp == 1) {
#pragma unroll
            for (int i = 0; i < 64; ++i) *(LAS unsigned short*)(QT + i * 272 + c * 2) = (unsigned short)f2bf(-y[i]);
        } else if (grp == 2) {
            const __amdgpu_buffer_rsrc_t rit = mk_rsrc(item, (unsigned)GDN_ITEM);
            const int et = c >> 4, r = c & 15;
#pragma unroll
            for (int i4 = 0; i4 < 16; ++i4) { const int ct = i4 >> 2, q = i4 & 3;
                u32x2 o; o.x = pk2(y[4 * i4 + 0], y[4 * i4 + 1]); o.y = pk2(y[4 * i4 + 2], y[4 * i4 + 3]);
                buf_st_b64(rit, (unsigned)((((et >> 1) * 64 + r) * 2 + (et & 1)) * 8), (unsigned)(GI_UFR + (ct * 4 * 64 + q * 16) * 16), o); }
#endif
        } else if (grp == 0) {
#pragma unroll
            for (int i = 0; i < 64; ++i) *(LAS unsigned short*)(QDT + i * 272 + c * 2) = (unsigned short)f2bf(y[i] * sc_qd[i]);
        }
        LBAR();
        P2T(5);
        if (it + F.G < 1024) P2_PREFETCH(it + F.G);
        {
            const __amdgpu_buffer_rsrc_t rit = mk_rsrc(item, (unsigned)GDN_ITEM);
#pragma unroll
            for (int u = 0; u < 2; ++u) { const int cid = tid + 512 * u, ln = cid & 63, r = ln & 15, q = ln >> 4;
                { const int ct = cid >> 8, sx = (cid >> 6) & 3;
                  const v4u v = *(const LAS v4u*)(QT + (16 * ct + r) * 272 + (32 * sx + 8 * q) * 2);
                  buf_st_b128(rit, (unsigned)cid * 16u, (unsigned)GI_WNEG, v); }
                { const int dt = cid >> 7, sx = (cid >> 6) & 1; float kd[8];
#pragma unroll
                  for (int j = 0; j < 8; ++j) { const int cc = 32 * sx + 8 * q + j; kd[j] = bf2f(*(const LAS unsigned short*)(KT + cc * 272 + (16 * dt + r) * 2)) * sc_kd[cc]; }
                  v4u o; o.x = pk2(kd[0], kd[1]); o.y = pk2(kd[2], kd[3]); o.z = pk2(kd[4], kd[5]); o.w = pk2(kd[6], kd[7]);
                  buf_st_b128(rit, (unsigned)cid * 16u, (unsigned)GI_KDT, o); }
                { const int r32c = ln & 31, hhc = ln >> 5, ct2 = cid >> 9, sx = (cid >> 6) & 7;
                  const v4u v = *(const LAS v4u*)(QDT + (32 * ct2 + r32c) * 272 + (16 * sx + 8 * hhc) * 2);
                  buf_st_b128(rit, (unsigned)cid * 16u, (unsigned)GI_QD, v); }
                if (u == 0) { const int r32c = ln & 31, hhc = ln >> 5, ct2 = cid >> 8, sx = (cid >> 6) & 3;
                  const v4u v = *(const LAS v4u*)(QKT + (32 * ct2 + r32c) * 144 + (16 * sx + 8 * hhc) * 2);
                  buf_st_b128(rit, (unsigned)cid * 16u, (unsigned)GI_QK, v); }
            }
        }
        if (tid == 0) ((float*)(P.ws + gt_off))[it] = __expf(gl);
        LBAR();
        P2T(6);
    }
#if defined(P2_TSTAGE)
    if (blockIdx.x == 0 && wave == 0 && lane_now() == 0) { __hip_atomic_store((unsigned*)(P.ws + WS_CTL) + 2304, 0u, __ATOMIC_RELAXED, __HIP_MEMORY_SCOPE_AGENT); __hip_atomic_store((unsigned*)(P.ws + WS_CTL) + 2305, p2t_a, __ATOMIC_RELAXED, __HIP_MEMORY_SCOPE_AGENT); }
#endif
}
#undef P2_PREFETCH

template <int ROT, int LS_OFF, int AR_OFF, int QT_OFF, int KT_OFF> struct P2S {
    static __device__ __forceinline__ int wv(const Frame& F) { return (F.wave + ROT) & 7; }
    static __device__ __forceinline__ LAS unsigned char* QT(const Frame& F) { unsigned o = QT_OFF; asm volatile("" : "+v"(o)); return F.lds + o; }
    static __device__ __forceinline__ LAS unsigned char* KT(const Frame& F) { unsigned o = KT_OFF; asm volatile("" : "+v"(o)); return F.lds + o; }
    static __device__ __forceinline__ LAS float* LS(const Frame& F) { return (LAS float*)(F.lds + LS_OFF); }
    static __device__ __forceinline__ LAS float* AR(const Frame& F) { return (LAS float*)(F.lds + AR_OFF); }

    static __device__ __forceinline__ void s1(Frame& F, const Ptrs& P, int it, float (&ys)[64]) {
        const int w = wv(F), grp = w >> 1, lane = lane_now(), c = ((w & 1) << 6) | lane;
        const int bh = it >> 7, n = it & 127, b = bh >> 2, h = bh & 3; const size_t m0 = (size_t)b * SEQ + (size_t)n * 64;
        const bf16* QKVZ = (const bf16*)(P.ws + WS_QKVZ); const float* AB = (const float*)(P.ws + WS_AB);
        if (grp < 3) {
            const int col = grp * 512 + h * 128 + c;
            const float w0 = P.w_conv_qkv[0 * 1536 + col], w1 = P.w_conv_qkv[1 * 1536 + col], w2 = P.w_conv_qkv[2 * 1536 + col], w3 = P.w_conv_qkv[3 * 1536 + col];
            const __amdgpu_buffer_rsrc_t rs = mk_rsrc(QKVZ + (size_t)b * SEQ * 2048, (unsigned)SEQ * 2048u * 2u);
            LAS unsigned char* tile = grp == 0 ? QT(F) : KT(F);
#pragma unroll
            for (int hf = 0; hf < 2; ++hf) {
                float xr[35];
#pragma unroll
                for (int j = 0; j < 35; ++j) { const int t = n * 64 + 32 * hf + j - 3; xr[j] = (hf > 0 || j >= 3 || t >= 0) ? buf_ld_bf16(rs, (unsigned)col * 2u, (unsigned)t * 4096u) : 0.f; }
#pragma unroll
                for (int i = 0; i < 32; ++i) { const float sv = fsilu(fmaf(w3, xr[i + 3], fmaf(w2, xr[i + 2], fmaf(w1, xr[i + 1], w0 * xr[i]))));
                    if (grp < 2) *(LAS unsigned short*)(tile + (32 * hf + i) * 272 + c * 2) = (unsigned short)f2bf(sv); else ys[32 * hf + i] = sv; }
            }
        }
        if (w == 7) {
            LAS float* gcs = AR(F); LAS float* betas = gcs + 64;
            const float araw = AB[(m0 + lane) * 8 + 4 + h], braw = AB[(m0 + lane) * 8 + h];
            const float xx = araw + P.dt_bias[h];
            const float sp = (xx > 20.f) ? xx : log1pf(expf(xx));
            float g = -expf(P.a_log[h]) * sp;
#pragma unroll
            for (int off = 1; off < 64; off <<= 1) { const float t = __shfl_up(g, off); if (lane >= off) g += t; }
            gcs[lane] = g; betas[lane] = 1.f / (1.f + expf(-braw));
        }
    }
    static __device__ __forceinline__ void s2(Frame& F, f32x16& acc) {
        const int w = wv(F), lane = lane_now(), r32 = lane & 31, hh = lane >> 5;
        const int kind = w < 3 ? 0 : (w < 6 ? 1 : 2), tsel = w < 6 ? w % 3 : (w - 6) * 2, ib = tsel >= 1 ? 1 : 0, jb = tsel == 2 ? 1 : 0;
        LAS float* nk2 = AR(F) + 128; LAS float* nq2 = AR(F) + 192;
#pragma unroll
        for (int i = 0; i < 16; ++i) acc[i] = 0.f;
        const LAS unsigned char* At = (kind == 0 ? KT(F) : QT(F)) + (32 * ib + r32) * 272 + hh * 16;
        const LAS unsigned char* Bt = (kind == 2 ? QT(F) : KT(F)) + (32 * jb + r32) * 272 + hh * 16;
#pragma unroll
        for (int s = 0; s < 8; ++s) { const bf16x8 a = *(const LAS bf16x8*)(At + s * 32), bb = *(const LAS bf16x8*)(Bt + s * 32); acc = __builtin_amdgcn_mfma_f32_32x32x16_bf16(a, bb, acc, 0, 0, 0); }
        if ((kind == 0 || kind == 2) && ib == jb) {
            if (((r32 >> 2) & 1) == hh) {
                const int rsel = (r32 & 3) + 4 * (r32 >> 3); float v = 0.f;
#pragma unroll
                for (int i = 0; i < 16; ++i) v = (i == rsel) ? acc[i] : v;
                (kind == 0 ? nk2 : nq2)[32 * ib + r32] = v;
            }
        }
    }
    static __device__ __forceinline__ void s3(Frame& F, const Ptrs& P, int it, const f32x16& acc, const size_t gdn_off) {
        const int w = wv(F), lane = lane_now(), r32 = lane & 31, hh = lane >> 5;
        const int kind = w < 3 ? 0 : (w < 6 ? 1 : 2), tsel = w < 6 ? w % 3 : (w - 6) * 2, ib = tsel >= 1 ? 1 : 0, jb = tsel == 2 ? 1 : 0;
        LAS float* gcs = AR(F); LAS float* betas = gcs + 64; LAS float* nk2 = gcs + 128; LAS float* nq2 = gcs + 192; LAS float* sc_w = gcs + 256; LAS float* sc_kd = gcs + 320; LAS float* sc_qd = gcs + 384;
        LAS float* Ls = LS(F);
        unsigned char* item = P.ws + gdn_off + (size_t)it * GDN_ITEM;
        const int j = 32 * jb + r32; const float gj = gcs[j], rkj = rsqrtf(nk2[j] + EPS);
        const __amdgpu_buffer_rsrc_t rqk = mk_rsrc(item + GI_QK, 8192u);
        const unsigned vqk = (unsigned)(((j >> 4) * 64 + 32 * ((j >> 3) & 1)) * 16 + (j & 7) * 2 + 64 * hh);
#pragma unroll
        for (int reg = 0; reg < 16; ++reg) {
            const int iu = 32 * ib + (reg & 3) + 8 * (reg >> 2), i = iu + 4 * hh;
            const float dec = __expf(fminf(gcs[i] - gj, 0.f));
            if (kind == 0) { const float v = (j < i) ? acc[reg] * betas[i] * rsqrtf(nk2[i] + EPS) * rkj * dec : 0.f; Ls[i * 64 + j] = -v; }
            else if (kind == 1) { const float v = (j <= i) ? acc[reg] * rsqrtf(nq2[i] + EPS) * 0.08838834764831845f * rkj * dec : 0.f; buf_st_bf16(rqk, vqk, (unsigned)((iu >> 5) * 4096 + (iu & 31) * 16), v); }
        }
        if (w == 7) {
            const float rk = rsqrtf(nk2[lane] + EPS), rq = rsqrtf(nq2[lane] + EPS), gi = gcs[lane], eg = __expf(gi);
            sc_w[lane] = betas[lane] * rk * eg; sc_kd[lane] = rk * __expf(gcs[63] - gi); sc_qd[lane] = rq * 0.08838834764831845f * eg;
        }
        if (kind == 2 && tsel == 0) {
#pragma unroll
            for (int reg = 0; reg < 16; ++reg) { const int iu = (reg & 3) + 8 * (reg >> 2); const int jz = 32 + r32;
                buf_st_bf16(rqk, (unsigned)(((jz >> 4) * 64 + 32 * ((jz >> 3) & 1)) * 16 + (jz & 7) * 2 + 64 * hh), (unsigned)(iu * 16), 0.f); }
        }
        if ((w >> 1) == 0) {
            const int c = ((w & 1) << 6) | lane;
            const __amdgpu_buffer_rsrc_t rit = mk_rsrc(item, (unsigned)GDN_ITEM);
            const unsigned vqd = (unsigned)(((c >> 4) * 64 + 32 * ((c >> 3) & 1)) * 16 + (c & 7) * 2);
#pragma unroll
            for (int i = 0; i < 64; ++i) { const float q = bf2f(*(const LAS unsigned short*)(QT(F) + i * 272 + c * 2));
                buf_st_bf16(rit, vqd, (unsigned)(GI_QD + (i >> 5) * 8192 + (i & 31) * 16), q * rsqrtf(nq2[i] + EPS) * 0.08838834764831845f * __expf(gcs[i])); }
        }
    }
    static __device__ __forceinline__ void s4v(Frame& F, const Ptrs& P, int it, float (&ys)[64], const size_t gdn_off) {
        const int w = wv(F), grp = w >> 1, lane = lane_now(), c = ((w & 1) << 6) | lane;
        if (grp == 2) {
            LAS float* betas = AR(F) + 64;
            unsigned char* item = P.ws + gdn_off + (size_t)it * GDN_ITEM;
            SolveRow<0>::run(ys, LS(F), betas);
            const __amdgpu_buffer_rsrc_t rit = mk_rsrc(item, (unsigned)GDN_ITEM);
            const int et = c >> 4, r = c & 15;
#pragma unroll
            for (int i4 = 0; i4 < 16; ++i4) { const int ct = i4 >> 2, q = i4 & 3;
                u32x2 o; o.x = pk2(ys[4 * i4 + 0], ys[4 * i4 + 1]); o.y = pk2(ys[4 * i4 + 2], ys[4 * i4 + 3]);
                buf_st_b64(rit, (unsigned)((((et >> 1) * 64 + r) * 2 + (et & 1)) * 8), (unsigned)(GI_UFR + (ct * 4 * 64 + q * 16) * 16), o); }
        }
    }
    static __device__ __forceinline__ void s4k(Frame& F) {
        const int w = wv(F), grp = w >> 1, lane = lane_now(), c = ((w & 1) << 6) | lane;
        if (grp == 1) {
            LAS float* sc_w = AR(F) + 256;
            float yk[64];
#pragma unroll
            for (int i = 0; i < 64; ++i) yk[i] = bf2f(*(const LAS unsigned short*)(KT(F) + i * 272 + c * 2));
            SolveRow<0>::run(yk, LS(F), sc_w);
#pragma unroll
            for (int i = 0; i < 64; ++i) *(LAS unsigned short*)(QT(F) + i * 272 + c * 2) = (unsigned short)f2bf(-yk[i]);
        }
    }
    static __device__ __forceinline__ void s5(Frame& F, const Ptrs& P, int it, const size_t gdn_off, const size_t gt_off) {
        const int lane = lane_now(), tid = F.wave * 64 + lane;
        LAS float* gcs = AR(F); LAS float* sc_kd = gcs + 320;
        unsigned char* item = P.ws + gdn_off + (size_t)it * GDN_ITEM;
        const __amdgpu_buffer_rsrc_t rit = mk_rsrc(item, (unsigned)GDN_ITEM);
#if XCHK
        v4u okeep[2];
#endif
#pragma unroll
        for (int u = 0; u < 2; ++u) { const int cid = tid + 512 * u, ln = cid & 63, r = ln & 15, q = ln >> 4;
            { const int ct = cid >> 8, sx = (cid >> 6) & 3;
              const v4u v = *(const LAS v4u*)(QT(F) + (16 * ct + r) * 272 + (32 * sx + 8 * q) * 2);
              buf_st_b128(rit, (unsigned)cid * 16u, (unsigned)GI_WNEG, v); }
            { const int dt = cid >> 7, sx = (cid >> 6) & 1; float kd[8];
#pragma unroll
              for (int j = 0; j < 8; ++j) { const int cc = 32 * sx + 8 * q + j; kd[j] = bf2f(*(const LAS unsigned short*)(KT(F) + cc * 272 + (16 * dt + r) * 2)) * sc_kd[cc]; }
              v4u o; o.x = pk2(kd[0], kd[1]); o.y = pk2(kd[2], kd[3]); o.z = pk2(kd[4], kd[5]); o.w = pk2(kd[6], kd[7]);
              buf_st_b128(rit, (unsigned)cid * 16u, (unsigned)GI_KDT, o);
#if XCHK
              okeep[u] = o;
#endif
            }
        }
#if XCHK
        LBAR();
        {
            unsigned bad = 0;
#pragma unroll
            for (int u = 0; u < 2; ++u) { const int cid = tid + 512 * u, ln = cid & 63, r = ln & 15, q = ln >> 4; const int dt = cid >> 7, sx = (cid >> 6) & 1; float kd[8];
#pragma unroll
              for (int j = 0; j < 8; ++j) { const int cc = 32 * sx + 8 * q + j; kd[j] = bf2f(*(const LAS unsigned short*)(KT(F) + cc * 272 + (16 * dt + r) * 2)) * sc_kd[cc]; }
              v4u o; o.x = pk2(kd[0], kd[1]); o.y = pk2(kd[2], kd[3]); o.z = pk2(kd[4], kd[5]); o.w = pk2(kd[6], kd[7]);
              bad |= (o.x != okeep[u].x) | (o.y != okeep[u].y) | (o.z != okeep[u].z) | (o.w != okeep[u].w); }
            if (bad) __hip_atomic_fetch_add((unsigned*)(P.ws + WS_CTL) + CK_P2 + 8, 1u, __ATOMIC_RELAXED, __HIP_MEMORY_SCOPE_AGENT);
        }
#endif
        if (tid == 0) ((float*)(P.ws + gt_off))[it] = __expf(gcs[63]);
#if XCHK
        if (gt_off == WS_GT) {
            if (tid < 64) __hip_atomic_fetch_add((unsigned*)(P.ws + WS_CTL) + CK_P2 + 6, __float_as_uint(sc_kd[tid]) * 17u + (unsigned)(tid + it * 7), __ATOMIC_RELAXED, __HIP_MEMORY_SCOPE_AGENT);
            unsigned acc = 0; for (int i = tid; i < 64 * 64; i += 512) { const int rr = i >> 6, cw = i & 63; acc += *(const LAS unsigned*)(KT(F) + rr * 272 + cw * 4) * 19u + (unsigned)(i + it * 3); }
            __hip_atomic_fetch_add((unsigned*)(P.ws + WS_CTL) + CK_P2 + 7, acc, __ATOMIC_RELAXED, __HIP_MEMORY_SCOPE_AGENT);
        }
#endif
    }
};
__device__ __forceinline__ void p2_gdn_prep_dual(Frame& F, const Ptrs& P, const size_t gdn_off = WS_GDN, const size_t gt_off = WS_GT) {
    typedef P2S<0, 0, 32768, 36864, 54272> A; typedef P2S<4, 16384, 34816, 71680, 89088> B;
    for (int it = F.vcu; it < 1024; it += 2 * F.G) {
        const int itB = it + F.G;
        float ys[64]; f32x16 accA, accB;
        A::s1(F, P, it, ys); B::s1(F, P, itB, ys);
        LBAR();
        A::s2(F, accA); B::s2(F, accB);
        LBAR();
        A::s3(F, P, it, accA, gdn_off); B::s3(F, P, itB, accB, gdn_off);
        LBAR();
        A::s4v(F, P, it, ys, gdn_off); B::s4v(F, P, itB, ys, gdn_off);
        A::s4k(F); B::s4k(F);
        LBAR();
        A::s5(F, P, it, gdn_off, gt_off);
#if S5BAR
        LBAR();
#endif
        B::s5(F, P, itB, gdn_off, gt_off);
        LBAR();
    }
}

#ifndef P2_DUAL
#define P2_DUAL 0
#endif
#ifndef DTEST
#define DTEST 0
#endif
constexpr int CW_DT = 2048;
__device__ __forceinline__ void p2_dtest(Frame& F, const Ptrs& P) {
    const int lane = lane_now(), tid = F.wave * 64 + lane;
    for (int i = tid; i < 131072 / 4; i += NWAVES * 64) ((LAS unsigned*)F.lds)[i] = 0x7fc12345u ^ (unsigned)(i * 2654435761u);
    __syncthreads();
    const size_t off2 = 354 * MiB, gt2 = 434 * MiB;
#if P2_DUAL
    p2_gdn_prep_dual(F, P, off2, gt2);
#else
    p2_gdn_prep(F, P, off2, gt2);
#endif
    asm volatile("s_waitcnt vmcnt(0)" ::: "memory"); __syncthreads();
    unsigned bad = 0;
    for (int it = F.vcu; it < 1024; it += F.G) {
        const GAS v4u* a = (const GAS v4u*)(P.ws + WS_GDN + (size_t)it * GDN_ITEM); const GAS v4u* b = (const GAS v4u*)(P.ws + off2 + (size_t)it * GDN_ITEM);
        for (int c = tid; c < (int)(GDN_ITEM / 16); c += NWAVES * 64) { const v4u x = a[c], y = b[c]; const bool ne = (x.x != y.x) | (x.y != y.y) | (x.z != y.z) | (x.w != y.w);
            const int reg = c < 1024 ? 0 : (c < 2048 ? 1 : (c < 3072 ? 2 : (c < 4096 ? 3 : 4)));
            if (ne) bad |= 1u << reg; }
        if (tid == 0 && __float_as_uint(((const float*)(P.ws + WS_GT))[it]) != __float_as_uint(((const float*)(P.ws + gt2))[it])) bad |= 1u << 5;
    }
    if (bad) __hip_atomic_fetch_or((unsigned*)(P.ws + WS_CTL) + CW_DT, bad, __ATOMIC_RELAXED, __HIP_MEMORY_SCOPE_AGENT);
}

__device__ __forceinline__ void xchk_sum(Frame& F, const Ptrs& P, const unsigned char* base, size_t bytes, int ckword) {
    const int lane = lane_now(); const size_t nthr = (size_t)F.G * NWAVES * 64, t0 = (size_t)F.vcu * NWAVES * 64 + F.wave * 64 + lane;
    unsigned acc = 0; const GAS v4u* p4 = (const GAS v4u*)base;
    for (size_t i = t0; i < bytes / 16; i += nthr) { const v4u v = p4[i]; acc += v.x * 3u + v.y * 5u + v.z * 7u + v.w * 11u + (unsigned)i; }
    acc = (unsigned)wave_sum_f(0.f) + acc;
    __hip_atomic_fetch_add((unsigned*)(P.ws + WS_CTL) + ckword, acc, __ATOMIC_RELAXED, __HIP_MEMORY_SCOPE_AGENT);
}
constexpr int SCAN_DIST = 6;
#ifndef SCAN_WARM_AHEAD
#define SCAN_WARM_AHEAD 18
#endif
#ifndef SCAN_WARM
#define SCAN_WARM 0
#endif
constexpr int NWARM = SCAN_WARM ? 8 : 0;
template <int ROLE>
__device__ __forceinline__ void p3_scan_role(Frame& F, const Ptrs& P, int blk) {
    LAS unsigned char* ST = F.lds; LAS unsigned char* VT = F.lds + 8704;
    const int bh = blk & 7, es = blk >> 3;
    const int lane = lane_now(), wave = F.wave, r = lane & 15, q = lane >> 4, tid = wave * 64 + lane;
    const int dt = wave;
    for (int i = tid; i < 8704 / 4; i += NWAVES * 64) ((LAS unsigned*)ST)[i] = 0u;
    f32x4 sacc[2] = {(f32x4){0.f, 0.f, 0.f, 0.f}, (f32x4){0.f, 0.f, 0.f, 0.f}};
    const float* GT = (const float*)(P.ws + WS_GT);
    const unsigned char* item0 = P.ws + WS_GDN + (size_t)(bh * 128) * GDN_ITEM;
#define SCAN_LOAD(n_, wA_, kA_, uC_, gt_) do { const unsigned char* itp = item0 + (size_t)(n_) * GDN_ITEM; \
        if constexpr (ROLE < 2) { _Pragma("unroll") for (int s = 0; s < 4; ++s) wA_[s] = *(const GAS bf16x8*)(itp + GI_WNEG + ((wave * 4 + s) * 64 + lane) * 16); \
            uC_ = *(const GAS v4u*)(itp + GI_UFR + ((size_t)((wave * 4 + es) * 64 + lane)) * 16); } \
        _Pragma("unroll") for (int s = 0; s < 2; ++s) kA_[s] = *(const GAS bf16x8*)(itp + GI_KDT + ((dt * 2 + s) * 64 + lane) * 16); \
        } while (0)
#define SCAN_STEP(n_, wA_, kA_, uC_, unused_) do { __builtin_amdgcn_sched_barrier(0);   \
        if constexpr (ROLE < 2) { v4u o4; \
            _Pragma("unroll") for (int t = 0; t < 2; ++t) { const unsigned u0 = t ? uC_.z : uC_.x, u1 = t ? uC_.w : uC_.y; \
                f32x4 acc; acc.x = __uint_as_float(u0 << 16); acc.y = __uint_as_float(u0 & 0xffff0000u); acc.z = __uint_as_float(u1 << 16); acc.w = __uint_as_float(u1 & 0xffff0000u); \
                _Pragma("unroll") for (int s = 0; s < 4; ++s) { const bf16x8 sf = *(const LAS bf16x8*)(ST + (16 * t + r) * 272 + (32 * s + 8 * q) * 2); acc = __builtin_amdgcn_mfma_f32_16x16x32_bf16(wA_[s], sf, acc, 0, 0, 0); } \
                u32x2 o; o.x = pk2(acc.x, acc.y); o.y = pk2(acc.z, acc.w); \
                *(LAS u32x2*)(VT + (16 * t + r) * 144 + (16 * wave + 4 * q) * 2) = o; \
                if (t == 0) { o4.x = o.x; o4.y = o.y; } else { o4.z = o.x; o4.w = o.y; } } \
            __builtin_amdgcn_raw_buffer_store_b128(o4, rvn, (int)(((wave * 4 + es) * 64 + lane) * 16 + (bh * 128 + (n_)) * 16384), 0, 16  ); } \
        LBAR(); \
        const float gt_ = GTL[n_]; \
        _Pragma("unroll") for (int t = 0; t < 2; ++t) { sacc[t] = sacc[t] * gt_; \
            _Pragma("unroll") for (int s = 0; s < 2; ++s) { const bf16x8 vf = *(const LAS bf16x8*)(VT + (16 * t + r) * 144 + (32 * s + 8 * q) * 2); sacc[t] = __builtin_amdgcn_mfma_f32_16x16x32_bf16(kA_[s], vf, sacc[t], 0, 0, 0); } } \
        { v4u o4; \
        _Pragma("unroll") for (int t = 0; t < 2; ++t) { u32x2 o; o.x = pk2(sacc[t].x, sacc[t].y); o.y = pk2(sacc[t].z, sacc[t].w); \
            *(LAS u32x2*)(ST + (16 * t + r) * 272 + (16 * dt + 4 * q) * 2) = o; \
            if (t == 0) { o4.x = o.x; o4.y = o.y; } else { o4.z = o.x; o4.w = o.y; } } \
        __builtin_amdgcn_raw_buffer_store_b128(o4, rsn, (int)(((dt * 4 + es) * 64 + lane) * 16 + (bh * 128 + (((n_) + 1) & 127)) * 32768), 0, 16  ); }   \
        SCAN_LOAD(((n_) + SCAN_DIST) & 127, wA_, kA_, uC_, 0);   \
        LBAR(); \
          \
        if constexpr (ROLE == 0) __builtin_amdgcn_raw_buffer_store_b32((unsigned)((n_) - SCAN_DIST), rprog, (lane == 0 && (n_) >= SCAN_DIST + 1) ? 0 : 64, 0, 16  );   } while (0)
    const __amdgpu_buffer_rsrc_t rsn = mk_rsrc(P.ws + WS_SN, 32u * 1024u * 1024u), rvn = mk_rsrc(P.ws + WS_VN, 16u * 1024u * 1024u);
    unsigned* prog = (unsigned*)(P.ws + WS_CTL) + CW_PROG + bh * 64 + es;
    const __amdgpu_buffer_rsrc_t rprog = mk_rsrc(prog, 4u);
    LAS float* GTL = (LAS float*)(F.lds + 13312);
    if (tid < 128) GTL[tid] = GT[bh * 128 + tid];
    bf16x8 wA0[4], kA0[2]; v4u uC0;
    bf16x8 wA1[4], kA1[2]; v4u uC1;
    bf16x8 wA2[4], kA2[2]; v4u uC2;
    bf16x8 wA3[4], kA3[2]; v4u uC3;
    bf16x8 wA4[4], kA4[2]; v4u uC4;
    bf16x8 wA5[4], kA5[2]; v4u uC5;
    SCAN_LOAD(0, wA0, kA0, uC0, 0);
    SCAN_LOAD(1, wA1, kA1, uC1, 0);
    SCAN_LOAD(2, wA2, kA2, uC2, 0);
    SCAN_LOAD(3, wA3, kA3, uC3, 0);
    SCAN_LOAD(4, wA4, kA4, uC4, 0);
    SCAN_LOAD(5, wA5, kA5, uC5, 0);
    LBAR();
    SCAN_STEP(0, wA0, kA0, uC0, 0);
    SCAN_STEP(1, wA1, kA1, uC1, 0);
    SCAN_STEP(2, wA2, kA2, uC2, 0);
    SCAN_STEP(3, wA3, kA3, uC3, 0);
    SCAN_STEP(4, wA4, kA4, uC4, 0);
    SCAN_STEP(5, wA5, kA5, uC5, 0);
    for (int n = 6; n < 126; n += 6) {
#if defined(TPROBE_B) && TPROBE_B == 26
        if constexpr (ROLE == 0) { if (n == 60 && blockIdx.x == 0 && lane == 0) __hip_atomic_store((unsigned*)(P.ws + WS_CTL) + 2305, (unsigned)rt(), __ATOMIC_RELAXED, __HIP_MEMORY_SCOPE_AGENT); }
#endif
        SCAN_STEP(n, wA0, kA0, uC0, 0);
        SCAN_STEP(n + 1, wA1, kA1, uC1, 0);
        SCAN_STEP(n + 2, wA2, kA2, uC2, 0);
        SCAN_STEP(n + 3, wA3, kA3, uC3, 0);
        SCAN_STEP(n + 4, wA4, kA4, uC4, 0);
        SCAN_STEP(n + 5, wA5, kA5, uC5, 0);
    }
    SCAN_STEP(126, wA0, kA0, uC0, 0);
    SCAN_STEP(127, wA1, kA1, uC1, 0);
#undef SCAN_LOAD
#undef SCAN_STEP
    asm volatile("s_waitcnt vmcnt(0)" ::: "memory");
    LBAR();
    if (tid == 0) __hip_atomic_store(prog, 128u, __ATOMIC_RELAXED, __HIP_MEMORY_SCOPE_AGENT);
}
__device__ __forceinline__ void p3_scan(Frame& F, const Ptrs& P, int blk) {
    if (F.wave == 0) p3_scan_role<0>(F, P, blk); else if (F.wave < 4) p3_scan_role<1>(F, P, blk); else p3_scan_role<2>(F, P, blk);
}

#ifndef P4_POLL_SLEEP
#define P4_POLL_SLEEP 24
#endif
__device__ __forceinline__ unsigned scan_poll4(const unsigned* pg) {
    const v4u w = __builtin_amdgcn_raw_buffer_load_b128(mk_rsrc(pg, 16u), 0, 0, 16  );
    const unsigned a = w.x < w.y ? w.x : w.y, b = w.z < w.w ? w.z : w.w;
    return (unsigned)__builtin_amdgcn_readfirstlane(a < b ? a : b);
}
__device__ __forceinline__ void p3_scan_warm(Frame& F, const Ptrs& P, int bh) {
    const unsigned* pg = (const unsigned*)(P.ws + WS_CTL) + CW_PROG + bh * 64;
    const unsigned char* item0 = P.ws + WS_GDN + (size_t)(bh * 128) * GDN_ITEM;
    const int tid = F.wave * 64 + lane_now();
    int nx = 2 * SCAN_DIST;
    unsigned acc = 0, t0 = 0, t1 = 0, t2 = 0, t3 = 0;
    const bool act = tid < 384;
    for (unsigned spins = 0; nx < 128 && spins < (1u << 22); ++spins) {
        unsigned mn = scan_poll4(pg);
        acc += t0 + t1 + t2 + t3;
        int tgt = (int)mn + SCAN_WARM_AHEAD; tgt = tgt > 128 ? 128 : tgt;
        if (nx < (int)mn + 2 * SCAN_DIST) nx = (int)mn + 2 * SCAN_DIST;
        if (nx >= tgt) { __builtin_amdgcn_s_sleep(8); continue; }
        const unsigned char* ip = item0 + (size_t)nx * GDN_ITEM + tid * 128;
        const int k = tgt - nx;
        if (act) { t0 = *(const volatile unsigned*)ip;
            if (k > 1) t1 = *(const volatile unsigned*)(ip + GDN_ITEM);
            if (k > 2) t2 = *(const volatile unsigned*)(ip + 2 * GDN_ITEM);
            if (k > 3) t3 = *(const volatile unsigned*)(ip + 3 * GDN_ITEM); }
        nx += k > 4 ? 4 : k;
    }
    acc += t0 + t1 + t2 + t3;
    if (acc == 0x9E3779B9u) F.MISC[15] = acc;
}

struct ConfTaps { float w[CWID]; float bias, lg, lb; };
__device__ __forceinline__ void p3_conf_load_taps(const Ptrs& P, int ch, ConfTaps& T) {
#pragma unroll
    for (int k = 0; k < CWID; ++k) T.w[k] = P.w_conv_dw[k * CCH + ch];
    T.bias = P.b_conv_dw[ch]; T.lg = P.ln_g[ch]; T.lb = P.ln_b[ch];
}
__device__ __forceinline__ void p3_conf_tile(Frame& F, const Ptrs& P, int tile, const ConfTaps& T) {
    LAS float* part = (LAS float*)F.lds; LAS float* stat = (LAS float*)(F.lds + 2048);
    LAS unsigned char* UT = F.lds + 4096; LAS unsigned char* OT = F.lds + 67584;
    const unsigned char* U = P.ws + WS_U; unsigned char* MIX = P.ws + WS_MIX;
    const int lane = lane_now(), ch = F.wave * 64 + lane; const size_t m0 = (size_t)tile * 32; const int t0 = (int)(m0 % SEQ);
#pragma unroll
    for (int u = 0; u < 8; ++u) { const int cid = ch + 512 * u; if (cid < 62 * 64) { const int row = cid >> 6, t = t0 - 30 + row;
        v4u v = {0u, 0u, 0u, 0u}; if (t >= 0) v = *(const GAS v4u*)(U + ((m0 + row) - 30) * (CCH * 2) + (cid & 63) * 16);
        *(LAS v4u*)(UT + cid * 16) = v; } }
    LBAR();
    float cv[32];
#pragma unroll
    for (int i = 0; i < 32; ++i) cv[i] = T.bias;
    {
        float uu[62];
#pragma unroll
        for (int j = 0; j < 62; ++j) uu[j] = bf2f(*(const LAS unsigned short*)(UT + j * (CCH * 2) + ch * 2));
#pragma unroll
        for (int k = 0; k < CWID; ++k)
#pragma unroll
            for (int i = 0; i < 32; ++i) cv[i] = fmaf(T.w[k], uu[i + k], cv[i]);
    }
#pragma unroll
    for (int i = 0; i < 32; ++i) { const float s1 = wave_sum_f(cv[i]), s2 = wave_sum_f(cv[i] * cv[i]); if (lane == 0) { part[(F.wave * 32 + i) * 2] = s1; part[(F.wave * 32 + i) * 2 + 1] = s2; } }
    LBAR();
    if (ch < 32) { float s1 = 0.f, s2 = 0.f;
#pragma unroll
        for (int w = 0; w < 8; ++w) { s1 += part[(w * 32 + ch) * 2]; s2 += part[(w * 32 + ch) * 2 + 1]; }
        const float mu = s1 * (1.f / CCH); const float var = fmaxf(s2 * (1.f / CCH) - mu * mu, 0.f);
        stat[ch * 2] = mu; stat[ch * 2 + 1] = rsqrtf(var + EPS); }
    LBAR();
#pragma unroll
    for (int i = 0; i < 32; ++i) { const float yv = (cv[i] - stat[i * 2]) * stat[i * 2 + 1] * T.lg + T.lb; *(LAS unsigned short*)(OT + i * (CCH * 2) + ch * 2) = (unsigned short)f2bf(fsilu(yv)); }
    LBAR();
#pragma unroll
    for (int u = 0; u < 4; ++u) { const int cid = ch + 512 * u, row = cid >> 6;
        *(GAS v4u*)(MIX + (m0 + row) * (DM * 2) + 1024 + (cid & 63) * 16) = *(const LAS v4u*)(OT + cid * 16); }
    LBAR();
}

__device__ __forceinline__ void p4_gdn_out(Frame& F, const Ptrs& P, int idx, int cnt) {
    LAS float* ssq = (LAS float*)F.lds;
    const bf16* QKVZ = (const bf16*)(P.ws + WS_QKVZ); bf16* MIX = (bf16*)(P.ws + WS_MIX);
    const int wave = F.wave;
    const int ct2 = wave >> 2, et4 = wave & 3;
    for (int itc = idx; itc < 1024; itc += cnt) {
        const int lane = lane_now();
        const int r32 = lane & 31, hh = lane >> 5;
        const int bh = itc & 7, n = itc >> 3, b = bh >> 2, h = bh & 3, it = bh * 128 + n;
        const size_t m0 = (size_t)b * SEQ + (size_t)n * 64;
        const unsigned char* item = P.ws + WS_GDN + (size_t)it * GDN_ITEM;
        if (wave == 0) {
            const unsigned* pg = (const unsigned*)(P.ws + WS_CTL) + CW_PROG + bh * 64; unsigned spins = 0;
            for (;;) { const unsigned mn = scan_poll4(pg);
                if (mn >= (unsigned)(n + 1) || ++spins > (1u << 22)) break;
                __builtin_amdgcn_s_sleep(P4_POLL_SLEEP); }
            asm volatile("s_waitcnt vmcnt(0)" ::: "memory");
        }
        asm volatile("" ::: "memory"); __builtin_amdgcn_s_barrier(); asm volatile("" ::: "memory");
        f32x16 acc;
#pragma unroll
        for (int i = 0; i < 16; ++i) acc[i] = 0.f;
        const int e = 32 * et4 + r32;
        LAS unsigned char* ZT = F.lds + 4096; LAS unsigned char* OT = F.lds + 4096 + 16384;
        {
            bf16x8 a1[8], b1[8], a2[4], b2[4];
            v4u zc[2];
#pragma unroll
            for (int u = 0; u < 2; ++u) { const int cid = wave * 64 + lane + 512 * u; zc[u] = *(const GAS v4u*)((const unsigned char*)QKVZ + (m0 + (cid >> 4)) * 4096 + (1536 + h * 128) * 2 + (cid & 15) * 16); }
            const unsigned char* Ap = item + GI_QD + ((ct2 * 8) * 64 + lane) * 16;
            const __amdgpu_buffer_rsrc_t rsn4 = mk_rsrc(P.ws + WS_SN + (size_t)it * 32768, 32768u), rvn4 = mk_rsrc(P.ws + WS_VN + (size_t)it * 16384, 16384u);
            const int boff = (((et4 * 64) + (r32 & 15) + 32 * hh) * 2 + (r32 >> 4)) * 8;
            const unsigned char* Ap2 = item + GI_QK + ((ct2 * 4) * 64 + lane) * 16;
            constexpr int BSTEP = 4096, BHI = 256;
            if (n > 0) {
#pragma unroll
                for (int s = 0; s < 8; ++s) { a1[s] = *(const GAS bf16x8*)(Ap + s * 1024);
                    const u32x2 lo = __builtin_amdgcn_raw_buffer_load_b64(rsn4, boff + s * BSTEP, 0, 16  ), hi = __builtin_amdgcn_raw_buffer_load_b64(rsn4, boff + s * BSTEP + BHI, 0, 16); const v4u w = {lo.x, lo.y, hi.x, hi.y}; b1[s] = __builtin_bit_cast(bf16x8, w); }
            }
#pragma unroll
            for (int s = 0; s < 4; ++s) { a2[s] = *(const GAS bf16x8*)(Ap2 + s * 1024);
                const u32x2 lo = __builtin_amdgcn_raw_buffer_load_b64(rvn4, boff + s * BSTEP, 0, 16  ), hi = __builtin_amdgcn_raw_buffer_load_b64(rvn4, boff + s * BSTEP + BHI, 0, 16); const v4u w = {lo.x, lo.y, hi.x, hi.y}; b2[s] = __builtin_bit_cast(bf16x8, w); }
#pragma unroll
            for (int u = 0; u < 2; ++u) *(LAS v4u*)(ZT + (wave * 64 + lane + 512 * u) * 16) = zc[u];
            if (n > 0) {
#pragma unroll
                for (int s = 0; s < 8; ++s) acc = __builtin_amdgcn_mfma_f32_32x32x16_bf16(a1[s], b1[s], acc, 0, 0, 0);
            }
#pragma unroll
            for (int s = 0; s < 4; ++s) acc = __builtin_amdgcn_mfma_f32_32x32x16_bf16(a2[s], b2[s], acc, 0, 0, 0);
            float sq[16];
#pragma unroll
            for (int reg = 0; reg < 16; ++reg) sq[reg] = acc[reg] * acc[reg];
#pragma unroll
            for (int st = 1; st < 32; st <<= 1) { float t[16];
#pragma unroll
                for (int reg = 0; reg < 16; ++reg) t[reg] = __shfl_xor(sq[reg], st);
#pragma unroll
                for (int reg = 0; reg < 16; ++reg) sq[reg] += t[reg]; }
            if (r32 == 0) {
#pragma unroll
                for (int reg = 0; reg < 16; ++reg) ssq[(32 * ct2 + (reg & 3) + 8 * (reg >> 2) + 4 * hh) * 4 + et4] = sq[reg]; }
            LBAR();
            const float gg = P.g_gdn_out[e];
#pragma unroll
            for (int reg = 0; reg < 16; ++reg) { const int row = 32 * ct2 + (reg & 3) + 8 * (reg >> 2) + 4 * hh;
                const f32x4 sv = *(const LAS f32x4*)(ssq + row * 4);
                const float rs = rsqrtf(((sv.x + sv.y) + (sv.z + sv.w)) * (1.f / DV) + EPS);
                const float z = bf2f(*(const LAS unsigned short*)(ZT + row * 256 + e * 2));
                *(LAS unsigned short*)(OT + row * 256 + e * 2) = (unsigned short)f2bf(acc[reg] * rs * gg * fsilu(z)); }
            LBAR();
#pragma unroll
            for (int u = 0; u < 2; ++u) { const int cid = wave * 64 + lane + 512 * u;
                *(GAS v4u*)((unsigned char*)MIX + (m0 + (cid >> 4)) * 2048 + h * 256 + (cid & 15) * 16) = *(const LAS v4u*)(OT + cid * 16); }
        }
        LBAR();
    }
}

constexpr size_t WS_WR = 15 * MiB;
constexpr size_t WS_CNT = 1 * MiB;
constexpr size_t WS_TPOS = 1 * MiB + 256 * 1024;
constexpr size_t WS_GATEW = 1 * MiB + 512 * 1024;
constexpr size_t WS_TEX = 2 * MiB;
constexpr size_t WS_XG = 144 * MiB;
constexpr size_t WS_Y = 240 * MiB;
constexpr size_t WS_ACT = 336 * MiB;
constexpr int PSLOTS = 49152;
constexpr size_t WS_XN3 = WS_N1;
constexpr size_t WS_H2 = 144 * MiB;
constexpr size_t WS_H3 = 240 * MiB;
constexpr int LDS_LG = 131584, LDS_TE = LDS_LG + 64 * 80 * 4, LDS_TW = LDS_TE + 512, LDS_CNT = LDS_TW + 512, LDS_POS = LDS_CNT + 256, LDS_BASE = LDS_POS + 512, LDS_PART = LDS_BASE + 256;

__device__ __forceinline__ void unpack8(const v4u w, float (&f)[8]) {
    f[0] = __uint_as_float(w.x << 16); f[1] = __uint_as_float(w.x & 0xffff0000u); f[2] = __uint_as_float(w.y << 16); f[3] = __uint_as_float(w.y & 0xffff0000u);
    f[4] = __uint_as_float(w.z << 16); f[5] = __uint_as_float(w.z & 0xffff0000u); f[6] = __uint_as_float(w.w << 16); f[7] = __uint_as_float(w.w & 0xffff0000u);
}
__device__ __forceinline__ v4u pack8(const float (&f)[8]) { v4u w; w.x = pk2(f[0], f[1]); w.y = pk2(f[2], f[3]); w.z = pk2(f[4], f[5]); w.w = pk2(f[6], f[7]); return w; }
struct EpiRes {
    static constexpr bool PERM = true, AFTER_DRAIN = false;
    const float* base; pg8::bf16_t* out;
    __device__ __forceinline__ void operator()(const pg8::f32x4 (&acc)[2][2][4][2], const pg8::Unit& u, int wr, int wc, int fr, int fq) const {
        using namespace pg8;
        const int row0 = u.pm * BM + wr * 64 + fr, col0 = u.pn * BM + wc * 32 + 8 * fq;
#pragma unroll
        for (int ai = 0; ai < 2; ++ai)
#pragma unroll
            for (int m = 0; m < 4; ++m) { const size_t off = (size_t)(row0 + ai * HALF + m * 16) * DM + col0;
#pragma unroll
                for (int bj = 0; bj < 2; ++bj) { const size_t o = off + bj * HALF;
                    const f32x4 v0 = *(const f32x4*)(base + o) + acc[ai][bj][m][0], v1 = *(const f32x4*)(base + o + 4) + acc[ai][bj][m][1];
                    u32x4 w; w.x = cvt_pk_bf16(v0[0], v0[1]); w.y = cvt_pk_bf16(v0[2], v0[3]); w.z = cvt_pk_bf16(v1[0], v1[1]); w.w = cvt_pk_bf16(v1[2], v1[3]);
                    *(u32x4*)(out + o) = w; } }
    }
};
struct EpiSwiGLU {
    static constexpr bool PERM = true, AFTER_DRAIN = false;
    pg8::bf16_t* ACT;
    __device__ __forceinline__ void operator()(const pg8::f32x4 (&acc)[2][2][4][2], const pg8::Unit& u, int wr, int wc, int fr, int fq) const {
        using namespace pg8;
        const int row0 = u.pm * BM + wr * 64 + fr, hid0 = u.pn * 128 + wc * 16 + 4 * fq;
#pragma unroll
        for (int ai = 0; ai < 2; ++ai)
#pragma unroll
            for (int m = 0; m < 4; ++m) { bf16_t* rowp = ACT + (size_t)(row0 + ai * HALF + m * 16) * DEXP + hid0;
#pragma unroll
                for (int bj = 0; bj < 2; ++bj) { const f32x4 a = acc[ai][bj][m][0], g = acc[ai][bj][m][1];
                    const unsigned lo = cvt_pk_bf16(fsilu(a[0]) * g[0], fsilu(a[1]) * g[1]), hi = cvt_pk_bf16(fsilu(a[2]) * g[2], fsilu(a[3]) * g[3]);
                    __hip_atomic_store((unsigned long long*)(rowp + bj * 64), (unsigned long long)lo | ((unsigned long long)hi << 32), __ATOMIC_RELAXED, __HIP_MEMORY_SCOPE_AGENT); } }
    }
};
struct EpiGate {
    static constexpr bool PERM = true, AFTER_DRAIN = false;
    pg8::bf16_t* Y; const float* gatew;
    __device__ __forceinline__ void operator()(const pg8::f32x4 (&acc)[2][2][4][2], const pg8::Unit& u, int wr, int wc, int fr, int fq) const {
        using namespace pg8;
        const int row0 = u.pm * BM + wr * 64 + fr, col0 = u.pn * BM + wc * 32 + 8 * fq;
#pragma unroll
        for (int ai = 0; ai < 2; ++ai)
#pragma unroll
            for (int m = 0; m < 4; ++m) { const int row = row0 + ai * HALF + m * 16; const float gw = gatew[row]; bf16_t* rowp = Y + (size_t)row * DM + col0;
#pragma unroll
                for (int bj = 0; bj < 2; ++bj) { const f32x4 v0 = acc[ai][bj][m][0] * gw, v1 = acc[ai][bj][m][1] * gw;
                    u32x4 w; w.x = cvt_pk_bf16(v0[0], v0[1]); w.y = cvt_pk_bf16(v0[2], v0[3]); w.z = cvt_pk_bf16(v1[0], v1[1]); w.w = cvt_pk_bf16(v1[2], v1[3]);
                    *(u32x4*)(rowp + bj * HALF) = w; } }
    }
};
struct EpiPle {
    static constexpr bool PERM = true, AFTER_DRAIN = false;
    const pg8::bf16_t* h2; const pg8::bf16_t* proj; pg8::bf16_t* out;
    __device__ __forceinline__ void operator()(const pg8::f32x4 (&acc)[2][2][4][2], const pg8::Unit& u, int wr, int wc, int fr, int fq) const {
        using namespace pg8;
        const int row0 = u.pm * BM + wr * 64 + fr, col0 = u.pn * BM + wc * 32 + 8 * fq;
#pragma unroll
        for (int ai = 0; ai < 2; ++ai)
#pragma unroll
            for (int m = 0; m < 4; ++m) { const size_t off = (size_t)(row0 + ai * HALF + m * 16) * DM + col0;
#pragma unroll
                for (int bj = 0; bj < 2; ++bj) { const size_t o = off + bj * HALF; float hh_[8], pp_[8], r_[8];
                    unpack8(*(const v4u*)(h2 + o), hh_); unpack8(*(const v4u*)(proj + o), pp_);
#pragma unroll
                    for (int i = 0; i < 4; ++i) { r_[i] = hh_[i] + fsigmoid(acc[ai][bj][m][0][i]) * pp_[i]; r_[4 + i] = hh_[4 + i] + fsigmoid(acc[ai][bj][m][1][i]) * pp_[4 + i]; }
                    *(v4u*)(out + o) = pack8(r_); } }
    }
};
struct MoeOrder {
    const int* tex; int nN, G, c;
    __device__ __forceinline__ bool next(int i, pg8::Unit& u) const {
        const int nt = __builtin_amdgcn_readfirstlane(__hip_atomic_load(tex, __ATOMIC_RELAXED, __HIP_MEMORY_SCOPE_AGENT)); const long L = (long)i * G + c; if (L >= (long)nt * nN) return false;
        const int rt = (int)(L / nN); u.pm = rt; u.pn = (int)(L % nN); u.be = __builtin_amdgcn_readfirstlane(__hip_atomic_load(tex + 64 + rt, __ATOMIC_RELAXED, __HIP_MEMORY_SCOPE_AGENT)); return true;
    }
    __device__ __forceinline__ void a_ready(const pg8::Unit&) const {}
    __device__ __forceinline__ void done(const pg8::Unit&) const {}
};

struct MoeUpOrder {
    unsigned char* ws; int G, c;
    __device__ __forceinline__ bool next(int i, pg8::Unit& u) const {
        const int nt = __builtin_amdgcn_readfirstlane(__hip_atomic_load((const int*)(ws + WS_TEX), __ATOMIC_RELAXED, __HIP_MEMORY_SCOPE_AGENT)); const int L = i * G + c; if (L >= 2 * nt) return false;
        const int rt = L >> 1; u.pm = rt; u.pn = L & 1; u.be = __builtin_amdgcn_readfirstlane(__hip_atomic_load((const int*)(ws + WS_TEX) + 64 + rt, __ATOMIC_RELAXED, __HIP_MEMORY_SCOPE_AGENT)); return true;
    }
    __device__ __forceinline__ void a_ready(const pg8::Unit&) const {}
    __device__ __forceinline__ void done(const pg8::Unit& u) const {
        asm volatile("s_waitcnt vmcnt(0)" ::: "memory");
        if (lane_now() == 0) __hip_atomic_fetch_add((unsigned*)(ws + WS_CTL) + CW_READY + 64 * u.pm, 1u, __ATOMIC_RELAXED, __HIP_MEMORY_SCOPE_AGENT);
    }
};
struct MoeDownOrder {
    unsigned char* ws; int G, c, wave;
    __device__ __forceinline__ bool next(int i, pg8::Unit& u) const {
        const int nt = __builtin_amdgcn_readfirstlane(__hip_atomic_load((const int*)(ws + WS_TEX), __ATOMIC_RELAXED, __HIP_MEMORY_SCOPE_AGENT)); const int H = (2 * nt > G) ? 2 * nt - G : 0;
        int L;
        if (i == 0) L = c; else { if (c < H) return false; L = G + (i - 1) * (G - H) + (c - H); }
        if (L >= 4 * nt) return false;
        const int rt = L >> 2; u.pm = rt; u.pn = L & 3; u.be = __builtin_amdgcn_readfirstlane(__hip_atomic_load((const int*)(ws + WS_TEX) + 64 + rt, __ATOMIC_RELAXED, __HIP_MEMORY_SCOPE_AGENT)); return true;
    }
    __device__ __forceinline__ void wait_ready(const pg8::Unit& u) const {
        if (wave == 0) {
            unsigned spins = 0;
            while ((unsigned)__builtin_amdgcn_readfirstlane(__hip_atomic_load((unsigned*)(ws + WS_CTL) + CW_READY + 64 * u.pm, __ATOMIC_RELAXED, __HIP_MEMORY_SCOPE_AGENT)) < 16u && ++spins < (1u << 22)) __builtin_amdgcn_s_sleep(2);
            __builtin_amdgcn_fence(__ATOMIC_ACQUIRE, "agent");
            asm volatile("s_waitcnt vmcnt(0)" ::: "memory");
        }
        asm volatile("" ::: "memory"); __builtin_amdgcn_s_barrier(); asm volatile("" ::: "memory");
    }
};
struct OneUnit {
    pg8::Unit u0;
    __device__ __forceinline__ bool next(int i, pg8::Unit& u) const { if (i != 0) return false; u = u0; return true; }
    __device__ __forceinline__ void a_ready(const pg8::Unit&) const {}
    __device__ __forceinline__ void done(const pg8::Unit&) const {}
};

__device__ __forceinline__ void p6_router(Frame& F, const Ptrs& P) {
    const int lane = lane_now(), wave = F.wave, tid = wave * 64 + lane;
    const int tile = F.vcu; const size_t m0 = (size_t)tile * 64;
    const bf16* H1 = (const bf16*)(P.ws + WS_H1);
    LAS unsigned char* XT = F.lds;
    LAS float* LG = (LAS float*)(F.lds + LDS_LG); LAS int* te_l = (LAS int*)(F.lds + LDS_TE); LAS float* tw_l = (LAS float*)(F.lds + LDS_TW); LAS int* cnt_l = (LAS int*)(F.lds + LDS_CNT);
    if (tid < 64) cnt_l[tid] = 0;
    const int r = lane & 15, q = lane >> 4, mt = wave & 3, nt0 = wave < 4 ? 0 : 3, nnt = wave < 4 ? 3 : 2;
    const unsigned char* Wr = P.ws + WS_WR + ((size_t)(16 * nt0 + r) * DM + 8 * q) * 2;
    bf16x8 bA[8][3], bB[8][3];
#define P6_LOADB(dst, s8) _Pragma("unroll") for (int u = 0; u < 8; ++u) _Pragma("unroll") for (int t = 0; t < 3; ++t) if (t < nnt) dst[u][t] = *(const GAS bf16x8*)(Wr + (size_t)t * (16 * DM * 2) + 64 * ((s8) + u))
#define P6_MFMA(src, s8) _Pragma("unroll") for (int u = 0; u < 8; ++u) { const bf16x8 a = *(const LAS bf16x8*)(XT + (16 * mt + r) * 2048 + (32 * ((s8) + u) + 8 * q) * 2); \
        _Pragma("unroll") for (int t = 0; t < 3; ++t) if (t < nnt) acc[t] = __builtin_amdgcn_mfma_f32_16x16x32_bf16(a, src[u][t], acc[t], 0, 0, 0); }
    P6_LOADB(bA, 0);
    {
        v4u raw[8][2];
#pragma unroll
        for (int rr = 0; rr < 8; ++rr) { const GAS v4u* xr = (const GAS v4u*)(H1 + (m0 + wave * 8 + rr) * DM) + lane; raw[rr][0] = xr[0]; raw[rr][1] = xr[64]; }
        f32x4 gm[2][2];
#pragma unroll
        for (int j = 0; j < 2; ++j) { gm[j][0] = ((const GAS f32x4*)P.g_moe)[2 * (64 * j + lane)]; gm[j][1] = ((const GAS f32x4*)P.g_moe)[2 * (64 * j + lane) + 1]; }
#pragma unroll
        for (int rr = 0; rr < 8; ++rr) { const int row = wave * 8 + rr;
            float v[2][8]; float s = 0.f;
#pragma unroll
            for (int j = 0; j < 2; ++j) { unpack8(raw[rr][j], v[j]);
#pragma unroll
                for (int i = 0; i < 8; ++i) s += v[j][i] * v[j][i]; }
            const float rs = rsqrtf(wave_sum_f(s) * (1.f / DM) + EPS);
#pragma unroll
            for (int j = 0; j < 2; ++j) {
#pragma unroll
                for (int i = 0; i < 4; ++i) { v[j][i] *= rs * gm[j][0][i]; v[j][4 + i] *= rs * gm[j][1][i]; }
                *(LAS v4u*)(XT + row * 2048 + (64 * j + lane) * 16) = pack8(v[j]); } }
    }
    LBAR();
    {
        f32x4 acc[3];
#pragma unroll
        for (int t = 0; t < 3; ++t) acc[t] = (f32x4){0.f, 0.f, 0.f, 0.f};
        P6_LOADB(bB, 8);  P6_MFMA(bA, 0);
        P6_LOADB(bA, 16); P6_MFMA(bB, 8);
        P6_LOADB(bB, 24); P6_MFMA(bA, 16);
        P6_MFMA(bB, 24);
#pragma unroll
        for (int t = 0; t < 3; ++t) if (t < nnt) {
#pragma unroll
            for (int reg = 0; reg < 4; ++reg) LG[(16 * mt + 4 * q + reg) * 80 + 16 * (nt0 + t) + r] = acc[t][reg]; }
    }
#undef P6_LOADB
#undef P6_MFMA
    LBAR();
    if (tid < 64) {
        const LAS float* lg = LG + tid * 80;
        float mx = lg[0]; int gi = 0;
#pragma unroll
        for (int j = 1; j < NGRP; ++j) { const float v = lg[j]; if (v > mx) { mx = v; gi = j; } }
        float den = 0.f;
#pragma unroll
        for (int j = 0; j < NGRP; ++j) den += __expf(lg[j] - mx);
        const float gw = 1.f / den;
        float m1 = -INFINITY, m2 = -INFINITY; int i1 = 0, i2 = 0;
#pragma unroll
        for (int j = 0; j < EPG; ++j) { const float v = lg[8 + gi * EPG + j]; if (v > m1) { m2 = m1; i2 = i1; m1 = v; i1 = j; } else if (v > m2) { m2 = v; i2 = j; } }
        const float p2 = __expf(m2 - m1);
        const int e1 = gi * EPG + i1, e2 = gi * EPG + i2;
        te_l[tid * 2] = e1; te_l[tid * 2 + 1] = e2; tw_l[tid * 2] = gw / (1.f + p2); tw_l[tid * 2 + 1] = gw * p2 / (1.f + p2);
        __hip_atomic_fetch_add(cnt_l + e1, 1, __ATOMIC_RELAXED, __HIP_MEMORY_SCOPE_WORKGROUP); __hip_atomic_fetch_add(cnt_l + e2, 1, __ATOMIC_RELAXED, __HIP_MEMORY_SCOPE_WORKGROUP);
    }
    LBAR();
    if (tid < 64) ((int*)(P.ws + WS_CNT))[tile * 64 + tid] = cnt_l[tid];
}
__device__ __forceinline__ void p7_dispatch(Frame& F, const Ptrs& P) {
    const int lane = lane_now(), wave = F.wave, tid = wave * 64 + lane;
    const int tile = F.vcu; const size_t m0 = (size_t)tile * 64;
    LAS unsigned char* XT = F.lds;
    LAS int* te_l = (LAS int*)(F.lds + LDS_TE); LAS float* tw_l = (LAS float*)(F.lds + LDS_TW); LAS int* pos_l = (LAS int*)(F.lds + LDS_POS); LAS int* base_l = (LAS int*)(F.lds + LDS_BASE);
    LAS int* part = (LAS int*)(F.lds + LDS_PART);
    const int* CNT = (const int*)(P.ws + WS_CNT);
    { const int e = lane, pt = wave; int tot = 0, bef = 0;
      int cv[32];
#pragma unroll
      for (int t = 0; t < 32; ++t) cv[t] = CNT[(32 * pt + t) * 64 + e];
#pragma unroll
      for (int t = 0; t < 32; ++t) { tot += cv[t]; bef += (32 * pt + t < tile) ? cv[t] : 0; }
      part[(pt * 64 + e) * 2] = tot; part[(pt * 64 + e) * 2 + 1] = bef; }
    LBAR();
    if (wave == 0) { int tot = 0, bef = 0;
#pragma unroll
        for (int pt = 0; pt < 8; ++pt) { tot += part[(pt * 64 + lane) * 2]; bef += part[(pt * 64 + lane) * 2 + 1]; }
        const int pc = (tot + 255) & ~255; int incl = pc;
#pragma unroll
        for (int off = 1; off < 64; off <<= 1) { const int t = __shfl_up(incl, off); if (lane >= off) incl += t; }
        const int pstart = incl - pc;
        base_l[lane] = pstart + bef;
        if (tile == 0) { int* TEX = (int*)(P.ws + WS_TEX); for (int r = pstart >> 8; r < (pstart + pc) >> 8; ++r) TEX[64 + r] = lane; if (lane == 63) TEX[0] = (pstart + pc) >> 8; }
    }
    LBAR();
    if (wave < 2) { const int e = te_l[tid]; int rank = 0;
#pragma unroll
        for (int j4 = 0; j4 < 32; ++j4) { const v4u t4 = *(const LAS v4u*)(te_l + 4 * j4);
            rank += ((4 * j4 + 0 < tid && (int)t4.x == e) ? 1 : 0) + ((4 * j4 + 1 < tid && (int)t4.y == e) ? 1 : 0) + ((4 * j4 + 2 < tid && (int)t4.z == e) ? 1 : 0) + ((4 * j4 + 3 < tid && (int)t4.w == e) ? 1 : 0); }
        const int pos = base_l[e] + rank; pos_l[tid] = pos;
        ((int*)(P.ws + WS_TPOS))[m0 * 2 + tid] = pos; ((float*)(P.ws + WS_GATEW))[pos] = tw_l[tid]; }
    LBAR();
    for (int rr = 0; rr < 8; ++rr) { const int row = wave * 8 + rr; const int p0 = pos_l[row * 2], p1 = pos_l[row * 2 + 1];
#pragma unroll
        for (int c = 0; c < 2; ++c) { const v4u v = *(const LAS v4u*)(XT + row * 2048 + (lane + 64 * c) * 16);
            *(GAS v4u*)(P.ws + WS_XG + (size_t)p0 * 2048 + (lane + 64 * c) * 16) = v; *(GAS v4u*)(P.ws + WS_XG + (size_t)p1 * 2048 + (lane + 64 * c) * 16) = v; } }
}
__device__ __forceinline__ void p10_combine(Frame& F, const Ptrs& P) {
    const int lane = lane_now(); const int gw = F.vcu * NWAVES + F.wave, NGW = F.G * NWAVES;
    const bf16* H = (const bf16*)(P.ws + WS_H1); bf16* H2 = (bf16*)(P.ws + WS_H2); const int* TPOS = (const int*)(P.ws + WS_TPOS); bf16* XN3 = (bf16*)(P.ws + WS_XN3);
    for (int m = gw; m < M; m += NGW) {
        const int p0 = TPOS[m * 2], p1 = TPOS[m * 2 + 1];
        const GAS v4u* hr = (const GAS v4u*)(H + (size_t)m * DM) + lane; GAS v4u* ho = (GAS v4u*)(H2 + (size_t)m * DM) + lane;
        const GAS v4u* y0 = (const GAS v4u*)(P.ws + WS_Y + (size_t)p0 * 2048) + lane; const GAS v4u* y1 = (const GAS v4u*)(P.ws + WS_Y + (size_t)p1 * 2048) + lane;
        float v[2][8]; float s = 0.f;
#pragma unroll
        for (int j = 0; j < 2; ++j) { float a[8], b[8]; unpack8(hr[64 * j], v[j]); unpack8(y0[64 * j], a); unpack8(y1[64 * j], b);
#pragma unroll
            for (int i = 0; i < 8; ++i) { v[j][i] += a[i] + b[i]; s += v[j][i] * v[j][i]; }
            ho[64 * j] = pack8(v[j]); }
        const float r = rsqrtf(wave_sum_f(s) * (1.f / DM) + EPS);
        GAS v4u* o8 = (GAS v4u*)(XN3 + (size_t)m * DM) + lane;
#pragma unroll
        for (int j = 0; j < 2; ++j) { const f32x4 g0 = ((const GAS f32x4*)P.g_ple)[2 * (64 * j + lane)], g1 = ((const GAS f32x4*)P.g_ple)[2 * (64 * j + lane) + 1];
#pragma unroll
            for (int i = 0; i < 4; ++i) { v[j][i] *= r * g0[i]; v[j][4 + i] *= r * g1[i]; }
            o8[64 * j] = pack8(v[j]); }
    }
}
__device__ __forceinline__ void p12_final(Frame& F, const Ptrs& P) {
    const int lane = lane_now(); const int gw = F.vcu * NWAVES + F.wave, NGW = F.G * NWAVES;
    for (int m = gw; m < M; m += NGW) {
        const GAS v4u* hr = (const GAS v4u*)((const bf16*)(P.ws + WS_H3) + (size_t)m * DM) + lane; GAS f32x4* ho = (GAS f32x4*)(P.out + (size_t)m * DM);
        float v[2][8]; float s = 0.f;
#pragma unroll
        for (int j = 0; j < 2; ++j) { unpack8(hr[64 * j], v[j]);
#pragma unroll
            for (int i = 0; i < 8; ++i) s += v[j][i] * v[j][i]; }
        float r = rsqrtf(wave_sum_f(s) * (1.f / DM) + EPS);
#if XCHK
        { const unsigned c1 = __hip_atomic_load((const unsigned*)(P.ws + WS_CTL) + CK_P1, __ATOMIC_RELAXED, __HIP_MEMORY_SCOPE_AGENT), c2 = __hip_atomic_load((const unsigned*)(P.ws + WS_CTL) + CK_P2, __ATOMIC_RELAXED, __HIP_MEMORY_SCOPE_AGENT);
          const unsigned p1 = ((const unsigned*)(P.ws + 3 * MiB))[0]; (void)c2;
          if (__hip_atomic_load((const unsigned*)(P.ws + WS_CTL) + CK_P2 + 8, __ATOMIC_RELAXED, __HIP_MEMORY_SCOPE_AGENT) != 0u) r *= 3.0f;
          if (p1 != 0xAAAAAAAAu && p1 != c1) r *= 1.1f;
          else {
#pragma unroll
            for (int g = 7; g >= 0; --g) { const unsigned cg = __hip_atomic_load((const unsigned*)(P.ws + WS_CTL) + CK_P2 + g, __ATOMIC_RELAXED, __HIP_MEMORY_SCOPE_AGENT), pg = ((const unsigned*)(P.ws + 3 * MiB))[1 + g];
                if (pg != 0xAAAAAAAAu && pg != cg) r *= 1.2f + 0.1f * (float)g; } } }
#endif
#if DTEST
        { const unsigned dtm = __hip_atomic_load((const unsigned*)(P.ws + WS_CTL) + CW_DT, __ATOMIC_RELAXED, __HIP_MEMORY_SCOPE_AGENT);
          if (dtm != 0u) r *= 1.0f + 0.05f * (float)(__builtin_ctz(dtm) + 1) + 0.5f * (float)(__builtin_popcount(dtm) - 1); }
#endif
#pragma unroll
        for (int j = 0; j < 2; ++j) { const int c4 = 2 * (64 * j + lane); const f32x4 g0 = ((const GAS f32x4*)P.g_final)[c4], g1 = ((const GAS f32x4*)P.g_final)[c4 + 1];
            ho[c4] = (f32x4){v[j][0] * r * g0[0], v[j][1] * r * g0[1], v[j][2] * r * g0[2], v[j][3] * r * g0[3]};
            ho[c4 + 1] = (f32x4){v[j][4] * r * g1[0], v[j][5] * r * g1[1], v[j][6] * r * g1[2], v[j][7] * r * g1[3]}; }
    }
#if XCHK
    if (F.vcu == F.G - 1 && F.wave == 7 && lane == 0) { __builtin_amdgcn_s_sleep(127); __builtin_amdgcn_s_sleep(127); __builtin_amdgcn_s_sleep(127);
        ((unsigned*)(P.ws + 3 * MiB))[0] = __hip_atomic_load((const unsigned*)(P.ws + WS_CTL) + CK_P1, __ATOMIC_RELAXED, __HIP_MEMORY_SCOPE_AGENT);
        for (int g = 0; g < 8; ++g) ((unsigned*)(P.ws + 3 * MiB))[1 + g] = __hip_atomic_load((const unsigned*)(P.ws + WS_CTL) + CK_P2 + g, __ATOMIC_RELAXED, __HIP_MEMORY_SCOPE_AGENT); }
#endif
}
struct Args { const float* in[23]; float* out; unsigned char* ws; int ph_lo, ph_hi, use_bar, bar_region; };
constexpr int N_PHASES = 13;
__global__ void __launch_bounds__(NWAVES * 64, 2) mk_fwd(Args args) {
    extern __shared__ __attribute__((aligned(16))) unsigned char lds[];
#if defined(VINIT) && VINIT
    asm volatile("v_mov_b32 v8, 0\n\tv_mov_b32 v9, 0\n\tv_mov_b32 v10, 0\n\tv_mov_b32 v11, 0\n\tv_mov_b32 v12, 0\n\tv_mov_b32 v13, 0\n\tv_mov_b32 v14, 0\n\tv_mov_b32 v15, 0\n\tv_mov_b32 v16, 0\n\tv_mov_b32 v17, 0\n\tv_mov_b32 v18, 0\n\tv_mov_b32 v19, 0\n\tv_mov_b32 v20, 0\n\tv_mov_b32 v21, 0\n\tv_mov_b32 v22, 0\n\tv_mov_b32 v23, 0\n\tv_mov_b32 v24, 0\n\tv_mov_b32 v25, 0\n\tv_mov_b32 v26, 0\n\tv_mov_b32 v27, 0\n\tv_mov_b32 v28, 0\n\tv_mov_b32 v29, 0\n\tv_mov_b32 v30, 0\n\tv_mov_b32 v31, 0\n\tv_mov_b32 v32, 0\n\tv_mov_b32 v33, 0\n\tv_mov_b32 v34, 0\n\tv_mov_b32 v35, 0\n\tv_mov_b32 v36, 0\n\tv_mov_b32 v37, 0\n\tv_mov_b32 v38, 0\n\tv_mov_b32 v39, 0\n\tv_mov_b32 v40, 0\n\tv_mov_b32 v41, 0\n\tv_mov_b32 v42, 0\n\tv_mov_b32 v43, 0\n\tv_mov_b32 v44, 0\n\tv_mov_b32 v45, 0\n\tv_mov_b32 v46, 0\n\tv_mov_b32 v47, 0\n\tv_mov_b32 v48, 0\n\tv_mov_b32 v49, 0\n\tv_mov_b32 v50, 0\n\tv_mov_b32 v51, 0\n\tv_mov_b32 v52, 0\n\tv_mov_b32 v53, 0\n\tv_mov_b32 v54, 0\n\tv_mov_b32 v55, 0\n\tv_mov_b32 v56, 0\n\tv_mov_b32 v57, 0\n\tv_mov_b32 v58, 0\n\tv_mov_b32 v59, 0\n\tv_mov_b32 v60, 0\n\tv_mov_b32 v61, 0\n\tv_mov_b32 v62, 0\n\tv_mov_b32 v63, 0" ::: "v8", "v9", "v10", "v11", "v12", "v13", "v14", "v15", "v16", "v17", "v18", "v19", "v20", "v21", "v22", "v23", "v24", "v25", "v26", "v27", "v28", "v29", "v30", "v31", "v32", "v33", "v34", "v35", "v36", "v37", "v38", "v39", "v40", "v41", "v42", "v43", "v44", "v45", "v46", "v47", "v48", "v49", "v50", "v51", "v52", "v53", "v54", "v55", "v56", "v57", "v58", "v59", "v60", "v61", "v62", "v63");
    asm volatile("v_mov_b32 v64, 0\n\tv_mov_b32 v65, 0\n\tv_mov_b32 v66, 0\n\tv_mov_b32 v67, 0\n\tv_mov_b32 v68, 0\n\tv_mov_b32 v69, 0\n\tv_mov_b32 v70, 0\n\tv_mov_b32 v71, 0\n\tv_mov_b32 v72, 0\n\tv_mov_b32 v73, 0\n\tv_mov_b32 v74, 0\n\tv_mov_b32 v75, 0\n\tv_mov_b32 v76, 0\n\tv_mov_b32 v77, 0\n\tv_mov_b32 v78, 0\n\tv_mov_b32 v79, 0\n\tv_mov_b32 v80, 0\n\tv_mov_b32 v81, 0\n\tv_mov_b32 v82, 0\n\tv_mov_b32 v83, 0\n\tv_mov_b32 v84, 0\n\tv_mov_b32 v85, 0\n\tv_mov_b32 v86, 0\n\tv_mov_b32 v87, 0\n\tv_mov_b32 v88, 0\n\tv_mov_b32 v89, 0\n\tv_mov_b32 v90, 0\n\tv_mov_b32 v91, 0\n\tv_mov_b32 v92, 0\n\tv_mov_b32 v93, 0\n\tv_mov_b32 v94, 0\n\tv_mov_b32 v95, 0\n\tv_mov_b32 v96, 0\n\tv_mov_b32 v97, 0\n\tv_mov_b32 v98, 0\n\tv_mov_b32 v99, 0\n\tv_mov_b32 v100, 0\n\tv_mov_b32 v101, 0\n\tv_mov_b32 v102, 0\n\tv_mov_b32 v103, 0\n\tv_mov_b32 v104, 0\n\tv_mov_b32 v105, 0\n\tv_mov_b32 v106, 0\n\tv_mov_b32 v107, 0\n\tv_mov_b32 v108, 0\n\tv_mov_b32 v109, 0\n\tv_mov_b32 v110, 0\n\tv_mov_b32 v111, 0\n\tv_mov_b32 v112, 0\n\tv_mov_b32 v113, 0\n\tv_mov_b32 v114, 0\n\tv_mov_b32 v115, 0\n\tv_mov_b32 v116, 0\n\tv_mov_b32 v117, 0\n\tv_mov_b32 v118, 0\n\tv_mov_b32 v119, 0\n\tv_mov_b32 v120, 0\n\tv_mov_b32 v121, 0\n\tv_mov_b32 v122, 0\n\tv_mov_b32 v123, 0\n\tv_mov_b32 v124, 0\n\tv_mov_b32 v125, 0\n\tv_mov_b32 v126, 0\n\tv_mov_b32 v127, 0" ::: "v64", "v65", "v66", "v67", "v68", "v69", "v70", "v71", "v72", "v73", "v74", "v75", "v76", "v77", "v78", "v79", "v80", "v81", "v82", "v83", "v84", "v85", "v86", "v87", "v88", "v89", "v90", "v91", "v92", "v93", "v94", "v95", "v96", "v97", "v98", "v99", "v100", "v101", "v102", "v103", "v104", "v105", "v106", "v107", "v108", "v109", "v110", "v111", "v112", "v113", "v114", "v115", "v116", "v117", "v118", "v119", "v120", "v121", "v122", "v123", "v124", "v125", "v126", "v127");
    asm volatile("v_mov_b32 v128, 0\n\tv_mov_b32 v129, 0\n\tv_mov_b32 v130, 0\n\tv_mov_b32 v131, 0\n\tv_mov_b32 v132, 0\n\tv_mov_b32 v133, 0\n\tv_mov_b32 v134, 0\n\tv_mov_b32 v135, 0\n\tv_mov_b32 v136, 0\n\tv_mov_b32 v137, 0\n\tv_mov_b32 v138, 0\n\tv_mov_b32 v139, 0\n\tv_mov_b32 v140, 0\n\tv_mov_b32 v141, 0\n\tv_mov_b32 v142, 0\n\tv_mov_b32 v143, 0\n\tv_mov_b32 v144, 0\n\tv_mov_b32 v145, 0\n\tv_mov_b32 v146, 0\n\tv_mov_b32 v147, 0\n\tv_mov_b32 v148, 0\n\tv_mov_b32 v149, 0\n\tv_mov_b32 v150, 0\n\tv_mov_b32 v151, 0\n\tv_mov_b32 v152, 0\n\tv_mov_b32 v153, 0\n\tv_mov_b32 v154, 0\n\tv_mov_b32 v155, 0\n\tv_mov_b32 v156, 0\n\tv_mov_b32 v157, 0\n\tv_mov_b32 v158, 0\n\tv_mov_b32 v159, 0\n\tv_mov_b32 v160, 0\n\tv_mov_b32 v161, 0\n\tv_mov_b32 v162, 0\n\tv_mov_b32 v163, 0\n\tv_mov_b32 v164, 0\n\tv_mov_b32 v165, 0\n\tv_mov_b32 v166, 0\n\tv_mov_b32 v167, 0\n\tv_mov_b32 v168, 0\n\tv_mov_b32 v169, 0\n\tv_mov_b32 v170, 0\n\tv_mov_b32 v171, 0\n\tv_mov_b32 v172, 0\n\tv_mov_b32 v173, 0\n\tv_mov_b32 v174, 0\n\tv_mov_b32 v175, 0\n\tv_mov_b32 v176, 0\n\tv_mov_b32 v177, 0\n\tv_mov_b32 v178, 0\n\tv_mov_b32 v179, 0\n\tv_mov_b32 v180, 0\n\tv_mov_b32 v181, 0\n\tv_mov_b32 v182, 0\n\tv_mov_b32 v183, 0\n\tv_mov_b32 v184, 0\n\tv_mov_b32 v185, 0\n\tv_mov_b32 v186, 0\n\tv_mov_b32 v187, 0\n\tv_mov_b32 v188, 0\n\tv_mov_b32 v189, 0\n\tv_mov_b32 v190, 0\n\tv_mov_b32 v191, 0" ::: "v128", "v129", "v130", "v131", "v132", "v133", "v134", "v135", "v136", "v137", "v138", "v139", "v140", "v141", "v142", "v143", "v144", "v145", "v146", "v147", "v148", "v149", "v150", "v151", "v152", "v153", "v154", "v155", "v156", "v157", "v158", "v159", "v160", "v161", "v162", "v163", "v164", "v165", "v166", "v167", "v168", "v169", "v170", "v171", "v172", "v173", "v174", "v175", "v176", "v177", "v178", "v179", "v180", "v181", "v182", "v183", "v184", "v185", "v186", "v187", "v188", "v189", "v190", "v191");
    asm volatile("v_mov_b32 v192, 0\n\tv_mov_b32 v193, 0\n\tv_mov_b32 v194, 0\n\tv_mov_b32 v195, 0\n\tv_mov_b32 v196, 0\n\tv_mov_b32 v197, 0\n\tv_mov_b32 v198, 0\n\tv_mov_b32 v199, 0\n\tv_mov_b32 v200, 0\n\tv_mov_b32 v201, 0\n\tv_mov_b32 v202, 0\n\tv_mov_b32 v203, 0\n\tv_mov_b32 v204, 0\n\tv_mov_b32 v205, 0\n\tv_mov_b32 v206, 0\n\tv_mov_b32 v207, 0\n\tv_mov_b32 v208, 0\n\tv_mov_b32 v209, 0\n\tv_mov_b32 v210, 0\n\tv_mov_b32 v211, 0\n\tv_mov_b32 v212, 0\n\tv_mov_b32 v213, 0\n\tv_mov_b32 v214, 0\n\tv_mov_b32 v215, 0\n\tv_mov_b32 v216, 0\n\tv_mov_b32 v217, 0\n\tv_mov_b32 v218, 0\n\tv_mov_b32 v219, 0\n\tv_mov_b32 v220, 0\n\tv_mov_b32 v221, 0\n\tv_mov_b32 v222, 0\n\tv_mov_b32 v223, 0\n\tv_mov_b32 v224, 0\n\tv_mov_b32 v225, 0\n\tv_mov_b32 v226, 0\n\tv_mov_b32 v227, 0\n\tv_mov_b32 v228, 0\n\tv_mov_b32 v229, 0\n\tv_mov_b32 v230, 0\n\tv_mov_b32 v231, 0\n\tv_mov_b32 v232, 0\n\tv_mov_b32 v233, 0\n\tv_mov_b32 v234, 0\n\tv_mov_b32 v235, 0\n\tv_mov_b32 v236, 0\n\tv_mov_b32 v237, 0\n\tv_mov_b32 v238, 0\n\tv_mov_b32 v239, 0\n\tv_mov_b32 v240, 0\n\tv_mov_b32 v241, 0\n\tv_mov_b32 v242, 0\n\tv_mov_b32 v243, 0\n\tv_mov_b32 v244, 0\n\tv_mov_b32 v245, 0\n\tv_mov_b32 v246, 0\n\tv_mov_b32 v247, 0\n\tv_mov_b32 v248, 0\n\tv_mov_b32 v249, 0" ::: "v192", "v193", "v194", "v195", "v196", "v197", "v198", "v199", "v200", "v201", "v202", "v203", "v204", "v205", "v206", "v207", "v208", "v209", "v210", "v211", "v212", "v213", "v214", "v215", "v216", "v217", "v218", "v219", "v220", "v221", "v222", "v223", "v224", "v225", "v226", "v227", "v228", "v229", "v230", "v231", "v232", "v233", "v234", "v235", "v236", "v237", "v238", "v239", "v240", "v241", "v242", "v243", "v244", "v245", "v246", "v247", "v248", "v249");
#endif
    Frame F;
    F.lds = (LAS unsigned char*)lds; F.MISC = (volatile LAS unsigned*)(F.lds + MISC_OFF);
    F.wave = __builtin_amdgcn_readfirstlane((int)threadIdx.x >> 6);
    F.G = gridDim.x; { const int bx = blockIdx.x; F.vcu = (F.G % 8 == 0) ? (bx % 8) * (F.G / 8) + bx / 8 : bx; }
    Ptrs P;
    P.x = args.in[0]; P.p = args.in[1]; P.g_mix = args.in[2]; P.w_in = args.in[3]; P.w_conv_qkv = args.in[4]; P.a_log = args.in[5]; P.dt_bias = args.in[6]; P.g_gdn_out = args.in[7];
    P.b_glu = args.in[8]; P.w_conv_dw = args.in[9]; P.b_conv_dw = args.in[10]; P.ln_g = args.in[11]; P.ln_b = args.in[12]; P.w_out = args.in[13]; P.g_moe = args.in[14]; P.w_gr = args.in[15];
    P.w_er = args.in[16]; P.w_up = args.in[17]; P.w_down = args.in[18]; P.g_ple = args.in[19]; P.w_pg = args.in[20]; P.w_pp = args.in[21]; P.g_final = args.in[22];
    P.out = args.out; P.ws = args.ws;
    F.ctl = (gu32*)(P.ws + WS_CTL);
    for (int u = (int)threadIdx.x; u < (LDS_BYTES - LDSCTL_OFF) / 4; u += NWAVES * 64) ((LAS unsigned*)(F.lds + LDSCTL_OFF))[u] = 0u;
    __syncthreads();
    XcdBarrier bar; bar.bar = (unsigned*)(F.ctl + CW_BAR) + args.bar_region * XCD_BAR_WORDS; bar.x = 0; bar.st = nullptr;
    if (args.use_bar) bar = xcd_barrier_post((unsigned*)(F.ctl + CW_BAR) + args.bar_region * XCD_BAR_WORDS, F.MISC + 8, threadIdx.x == 0);
    const int lo = args.ph_lo, hi = args.ph_hi;
#ifndef VINIT
#define VINIT 0
#endif
#ifndef REP_PH
#define REP_PH -1
#define REP_N 1
#endif
#ifndef TPROBE_A
#define TPROBE_A -1
#define TPROBE_B -1
#endif
#ifndef TPROBE_MULT
#define TPROBE_MULT 8
#endif
#define TP(k) do { if (TPROBE_A == (k) || TPROBE_B == (k)) { if (blockIdx.x == 0 && F.wave == 0 && lane_now() == 0) __hip_atomic_store((unsigned*)(P.ws + WS_CTL) + 2304 + (TPROBE_B == (k) ? 1 : 0), (unsigned)rt(), __ATOMIC_RELAXED, __HIP_MEMORY_SCOPE_AGENT); } } while (0)
#define TPX(k) do { if (TPROBE_A == (k) || TPROBE_B == (k)) { if ((int)blockIdx.x == (int)gridDim.x - 1 && F.wave == 0 && lane_now() == 0) __hip_atomic_store((unsigned*)(P.ws + WS_CTL) + 2304 + (TPROBE_B == (k) ? 1 : 0), (unsigned)rt(), __ATOMIC_RELAXED, __HIP_MEMORY_SCOPE_AGENT); } } while (0)
#define IN(k) (lo <= (k) && (k) < hi)
#define REPS(k) for (int rep_ = 0; rep_ < ((k) == REP_PH ? REP_N : 1); ++rep_)
#define REPBAR() do { if (rep_) xcd_barrier(bar, F.wave == 0 && lane_now() == 0); } while (0)
#define SEAM(k) do { if (IN(k) && IN((k) + 1)) xcd_barrier(bar, F.wave == 0 && lane_now() == 0); } while (0)
    TP(0);

    if (IN(0)) { REPS(0) { REPBAR(); p0_prologue(F, P); } SEAM(0); TP(1); }
    if (IN(1)) { REPS(1) { REPBAR();
        pg8::Gemm g{(const pg8::bf16_t*)(P.ws + WS_N1), (const pg8::bf16_t*)(P.ws + WS_WIN), M, NIN_T, DM, 0};
        pg8::StaticOrder S; S.init(M, NIN_T, F.G, (int)blockIdx.x);
        EpiIn E{(pg8::bf16_t*)(P.ws + WS_QKVZ), (pg8::bf16_t*)(P.ws + WS_U), P.b_glu};
        pg8::gemm_phase<EpiIn, pg8::StaticOrder, true, true>(F.lds + RING_OFF, g, S, E, F.wave); }
        SEAM(1); TP(2);
    }
#ifndef SKIP_P2
    if (IN(2)) { REPS(2) { REPBAR();
#if P2_DUAL
        p2_gdn_prep_dual(F, P);
#else
        p2_gdn_prep(F, P);
#endif
#if CONV_IN_P2
        p3_convert_late(F, P, F.vcu, F.G);
#endif
#if DTEST
        p2_dtest(F, P);
#endif
#if XCHK
        xchk_sum(F, P, P.ws + WS_QKVZ, (size_t)64 * MiB + 16 * MiB, CK_P1);
        asm volatile("s_waitcnt vmcnt(0)" ::: "memory"); __syncthreads();
        for (int it = F.vcu; it < 1024; it += F.G) {
            const int lane = lane_now(); unsigned acc = 0; const GAS v4u* p4 = (const GAS v4u*)(P.ws + WS_GDN + (size_t)it * GDN_ITEM);
            for (int i = F.wave * 64 + lane; i < (int)(GDN_ITEM / 16); i += NWAVES * 64) { const v4u v = p4[i]; acc = v.x * 3u + v.y * 5u + v.z * 7u + v.w * 11u + (unsigned)(i + it * 131);
                const int reg = i < 1024 ? 0 : (i < 2048 ? 1 : (i < 3072 ? 2 : (i < 4096 ? 3 : 4)));
                __hip_atomic_fetch_add((unsigned*)(P.ws + WS_CTL) + CK_P2 + reg, acc, __ATOMIC_RELAXED, __HIP_MEMORY_SCOPE_AGENT); }
            if (F.wave == 0 && lane == 0) __hip_atomic_fetch_add((unsigned*)(P.ws + WS_CTL) + CK_P2 + 5, __float_as_uint(((const float*)(P.ws + WS_GT))[it]) * 13u + (unsigned)it, __ATOMIC_RELAXED, __HIP_MEMORY_SCOPE_AGENT); }
#endif
        } SEAM(2); TP(3); }
#endif
    if (IN(3)) { REPS(3) { REPBAR();
#ifndef SKIP_SCAN
        if ((int)blockIdx.x < NSCAN) { for (int r3 = 0; r3 < (REP_PH == 31 ? REP_N : 1); ++r3) p3_scan(F, P, (int)blockIdx.x); TP(25); }
        else
#endif
        if ((int)blockIdx.x < NSCAN + NWARM) p3_scan_warm(F, P, (int)blockIdx.x - NSCAN);
        else {
            const int idx = (int)blockIdx.x - NSCAN - NWARM, cnt = F.G - NSCAN - NWARM;
            TPX(20);
#if defined(SCAN_ALONE) && SCAN_ALONE
            { if (F.wave == 0) { for (int j = 0; j < 32; ++j) { while (__builtin_amdgcn_readfirstlane(__hip_atomic_load((unsigned*)(P.ws + WS_CTL) + CW_PROG + (j >> 2) * 64 + (j & 3), __ATOMIC_RELAXED, __HIP_MEMORY_SCOPE_AGENT)) < 128u) __builtin_amdgcn_s_sleep(32); } }
              __syncthreads(); }
#endif
#ifndef SKIP_CONF
            { ConfTaps T; p3_conf_load_taps(P, F.wave * 64 + lane_now(), T);
              for (int r3 = 0; r3 < (REP_PH == 32 ? REP_N : 1); ++r3) for (int t = idx; t < M / 32; t += cnt) p3_conf_tile(F, P, t, T); }
#endif
            TPX(21);
            pg8::Gemm g{(const pg8::bf16_t*)(P.ws + WS_PBF), (const pg8::bf16_t*)(P.ws + WS_WPROJ), M, DM, PLE, 0};
            pg8::StaticOrder S; S.init(M, DM, cnt, idx);
            pg8::EpiBf16<0> E{(pg8::bf16_t*)(P.ws + WS_PROJ), DM, nullptr, 0, 0, 1.f};
            for (int r3 = 0; r3 < (REP_PH == 33 ? REP_N : 1); ++r3) pg8::gemm_phase<pg8::EpiBf16<0>, pg8::StaticOrder, true, true>(F.lds + RING_OFF, g, S, E, F.wave);
            TPX(22);
#if !CONV_IN_P2
            for (int r3 = 0; r3 < (REP_PH == 34 ? REP_N : 1); ++r3) p3_convert_late(F, P, idx, cnt);
#endif
            TPX(23);
#ifndef SKIP_P4
            p4_gdn_out(F, P, idx, cnt);
#endif
            TPX(24);
        } }
        SEAM(3); TP(4);
    }
    if (IN(5)) { REPS(5) { REPBAR();
        pg8::Gemm g{(const pg8::bf16_t*)(P.ws + WS_MIX), (const pg8::bf16_t*)(P.ws + WS_WOUT), M, DM, DM, 0};
        pg8::StaticOrder S; S.init(M, DM, F.G, (int)blockIdx.x);
        EpiRes E{P.x, (pg8::bf16_t*)(P.ws + WS_H1)};
        pg8::gemm_phase<EpiRes, pg8::StaticOrder, true, true>(F.lds + RING_OFF, g, S, E, F.wave); }
        SEAM(5); TP(5);
    }
    if (IN(6)) { REPS(6) { REPBAR(); p6_router(F, P); } SEAM(6); TP(6); }
    if (IN(7)) { REPS(7) { REPBAR(); p7_dispatch(F, P); } SEAM(7); TP(7); }
    if (IN(8)) { REPS(8) { REPBAR();
        { pg8::Gemm g{(const pg8::bf16_t*)(P.ws + WS_XG), (const pg8::bf16_t*)(P.ws + WS_WUP), PSLOTS, 512, DM, (size_t)512 * DM * 2};
          MoeUpOrder S{P.ws, F.G, F.vcu};
          EpiSwiGLU E{(pg8::bf16_t*)(P.ws + WS_ACT)};
          pg8::gemm_phase<EpiSwiGLU, MoeUpOrder, true, true>(F.lds + RING_OFF, g, S, E, F.wave); }
        { pg8::Gemm g{(const pg8::bf16_t*)(P.ws + WS_ACT), (const pg8::bf16_t*)(P.ws + WS_WDOWN), PSLOTS, DM, DEXP, (size_t)DM * DEXP * 2};
          MoeDownOrder S{P.ws, F.G, F.vcu, F.wave};
          EpiGate E{(pg8::bf16_t*)(P.ws + WS_Y), (const float*)(P.ws + WS_GATEW)};
          for (int i = 0; ; ++i) { OneUnit S1; if (!S.next(i, S1.u0)) break; S.wait_ready(S1.u0);
              pg8::gemm_phase<EpiGate, OneUnit, true, true>(F.lds + RING_OFF, g, S1, E, F.wave); } } }
        SEAM(8); TP(8);
    }
    if (IN(10)) { REPS(10) { REPBAR(); p10_combine(F, P); } SEAM(10); TP(9); }
    if (IN(11)) { REPS(11) { REPBAR();
        pg8::Gemm g{(const pg8::bf16_t*)(P.ws + WS_XN3), (const pg8::bf16_t*)(P.ws + WS_WGATE), M, DM, DM, 0};
        pg8::StaticOrder S; S.init(M, DM, F.G, (int)blockIdx.x);
        EpiPle E{(const pg8::bf16_t*)(P.ws + WS_H2), (const pg8::bf16_t*)(P.ws + WS_PROJ), (pg8::bf16_t*)(P.ws + WS_H3)};
        pg8::gemm_phase<EpiPle, pg8::StaticOrder, true, true>(F.lds + RING_OFF, g, S, E, F.wave); }
        SEAM(11); TP(10);
    }
    if (IN(12)) { REPS(12) { REPBAR(); p12_final(F, P); } }
    TP(11);
#if TPROBE_A >= 0
    if (blockIdx.x == 0 && F.wave == 0 && lane_now() == 0) {
        const unsigned ta = __hip_atomic_load((unsigned*)(P.ws + WS_CTL) + 2304, __ATOMIC_RELAXED, __HIP_MEMORY_SCOPE_AGENT), tb = __hip_atomic_load((unsigned*)(P.ws + WS_CTL) + 2305, __ATOMIC_RELAXED, __HIP_MEMORY_SCOPE_AGENT);
        const unsigned want = (tb - ta) * (unsigned)TPROBE_MULT; const unsigned t0 = (unsigned)rt();
        while ((unsigned)rt() - t0 < want) __builtin_amdgcn_s_sleep(4);
    }
#endif
#undef IN
#undef SEAM
}

#ifndef HYB
#define HYB 1
#endif
static int launch_fast(void* const* d_in, float* out, void* d_ws, const int* seg, int nseg, hipStream_t stream) {
    static int grid = 0;
    if (grid == 0) {
        int dev = 0, cus = 0;
        if (hipGetDevice(&dev) != hipSuccess || hipDeviceGetAttribute(&cus, hipDeviceAttributeMultiprocessorCount, dev) != hipSuccess) { fprintf(stderr, "device query failed\n"); grid = -1; return -1; }
        if (hipFuncSetAttribute((const void*)mk_fwd, hipFuncAttributeMaxDynamicSharedMemorySize, LDS_BYTES) != hipSuccess) { fprintf(stderr, "hipFuncSetAttribute failed\n"); grid = -1; return -1; }
        int per_cu = 0;
        if (hipOccupancyMaxActiveBlocksPerMultiprocessor(&per_cu, (const void*)mk_fwd, NWAVES * 64, LDS_BYTES) != hipSuccess || per_cu < 1) fprintf(stderr, "note: occupancy query says %d\n", per_cu);
        (void)hipGetLastError();
        grid = cus;
        if (grid != 256) { fprintf(stderr, "kernel_launch: built for a 256-CU device (router tiles = workgroups); got %d\n", cus); grid = -1; return -1; }
    }
    if (grid < 0) return -1;
    Args a{};
    for (int i = 0; i < 23; ++i) a.in[i] = (const float*)d_in[i];
    a.out = out; a.ws = (unsigned char*)d_ws;
    for (int i = 0; i < nseg; ++i) { a.ph_lo = seg[2 * i]; a.ph_hi = seg[2 * i + 1]; a.use_bar = (a.ph_hi - a.ph_lo > 1) ? 1 : 0; a.bar_region = i;
        hipLaunchKernelGGL(mk_fwd, dim3(grid), dim3(NWAVES * 64), LDS_BYTES, stream, a); }
    return 0;
}

extern "C" void kernel_launch(void* const* d_in, const int* in_sizes, int n_in, void* d_out, int out_size, void* d_ws, size_t ws_size, hipStream_t stream) {
    char* ws = (char*)d_ws; float* out = (float*)d_out;
#if HYB == 0
    run_naive(d_in, out, nv_default_map(ws), 0, stream);
#elif HYB == 1
    (void)hipMemsetAsync(ws + WS_CTL, 0, CTL_ZERO_BYTES, stream);
    { const int seg[] = {0, 1, 1, 2}; if (launch_fast(d_in, out, d_ws, seg, 2, stream) != 0) return; }
    NvMap m = nv_default_map(ws);
    m.proj = (float*)(ws + 226 * MiB); m.ldp = 2056; m.qkv = (float*)(ws + 4 * MiB); m.o = (float*)(ws + 100 * MiB); m.mix = (float*)(ws + 132 * MiB); m.u = (float*)(ws + 392 * MiB); m.h = (float*)(ws + 424 * MiB);
    m.xn = m.mix; m.logits = m.o; m.UP = (float*)(ws + 4 * MiB); m.ACT = (float*)(ws + 356 * MiB); m.Y = (float*)(ws + 196 * MiB); m.G = (float*)(ws + 4 * MiB); m.PP = (float*)(ws + 196 * MiB);
    k_shimA<<<(int)(((size_t)M * 2048 + 255) / 256), 256, 0, stream>>>((const unsigned short*)(ws + WS_QKVZ), (const float*)(ws + WS_AB), (const unsigned short*)(ws + WS_U), m.proj, m.ldp, m.u);
    run_naive(d_in, out, m, 1, stream);
#elif HYB == 2
    (void)hipMemsetAsync(ws + WS_CTL, 0, CTL_ZERO_BYTES, stream);
    { const int seg[] = {0, 1, 1, 2, 2, 3, 3, 4, 4, 5}; if (launch_fast(d_in, out, d_ws, seg, 5, stream) != 0) return; }
    NvMap m = nv_default_map(ws);
    k_shimB<<<(int)(((size_t)M * DM + 255) / 256), 256, 0, stream>>>((const unsigned short*)(ws + WS_MIX), m.mix);
    run_naive(d_in, out, m, 2, stream);
#elif HYB == 3
    (void)hipMemsetAsync(ws + WS_CTL, 0, CTL_ZERO_BYTES, stream);
    { const int seg[] = {0, 1, 1, 2, 2, 3, 3, 4, 4, 5, 5, 6}; if (launch_fast(d_in, out, d_ws, seg, 6, stream) != 0) return; }
    NvMap m = nv_default_map(ws); m.h = (float*)(ws + WS_H1);
    run_naive(d_in, out, m, 3, stream);
#elif HYB == 4
    (void)hipMemsetAsync(ws + WS_CTL, 0, CTL_ZERO_BYTES, stream);
    { const int seg[] = {0, 1, 1, 2, 2, 3, 3, 4, 4, 5, 5, 6, 6, 8, 8, 9, 9, 10, 10, 11}; if (launch_fast(d_in, out, d_ws, seg, 10, stream) != 0) return; }
    NvMap m = nv_default_map(ws); m.h = (float*)(ws + WS_H1);
    run_naive(d_in, out, m, 4, stream);
#elif HYB == 5
    (void)hipMemsetAsync(ws + WS_CTL, 0, CTL_ZERO_BYTES, stream);
    { const int seg[] = {0, 1, 1, 2, 2, 3, 3, 4, 4, 5, 5, 6, 6, 8, 8, 9, 9, 10, 10, 11, 11, 12, 12, 13}; if (launch_fast(d_in, out, d_ws, seg, 12, stream) != 0) return; }
#elif HYB == 6
    (void)hipMemsetAsync(ws + WS_CTL, 0, CTL_ZERO_BYTES, stream);
    { const int seg[] = {0, 13}; if (launch_fast(d_in, out, d_ws, seg, 1, stream) != 0) return; }
#endif
}
```

```cpp
#include <hip/hip_runtime.h>
#include <cstdio>
#include <cstdint>

constexpr int DM = 1024, NB = 2, SEQ = 8192, M = NB * SEQ, PLE = 256;
constexpr int NH = 4, DK = 128, DV = 128, QKW = 512, VW = 512, CCH = 512, CWID = 31;
constexpr int NGRP = 8, EPG = 8, NEXP = 64, DEXP = 256, INC = 3080;
constexpr int O1 = 1536, O2 = 2048, O3 = 2052, O4 = 2056;
constexpr float EPS = 1e-6f;

#define HYB 6
namespace pg8 {
#define PG8_LAS __attribute__((address_space(3)))
typedef unsigned short bf16_t;
typedef short bf16x8 __attribute__((ext_vector_type(8)));
typedef float f32x4 __attribute__((ext_vector_type(4)));
typedef unsigned u32x4 __attribute__((ext_vector_type(4)));
constexpr int BM = 256, BK = 64, HALF = 128, HTB = HALF * BK * 2  , STAGE_BYTES = 8 * HTB, NXCD = 8, WGM = 8;

__host__ __device__ __forceinline__ int lds_byte(int r, int c) { const int st = (r >> 4) * 2 + (c >> 5), rr = r & 15, cc = c & 31, ob = rr * 64 + cc * 2; return st * 1024 + (ob ^ (((ob >> 9) & 1) << 5)); }
__host__ __device__ __forceinline__ void stage_rc(int b, int& R, int& C) { const int st = b / 1024, sb = b % 1024, swz = sb ^ (((sb >> 9) & 1) << 5); R = (st >> 1) * 16 + swz / 64; C = (st & 1) * 32 + (swz % 64) / 2; }
__host__ __device__ __forceinline__ int perm32(int rho) { const int n = rho >> 4, i = rho & 15; return 8 * (i >> 2) + 4 * n + (i & 3); }

struct Unit { int pm, pn, be; };
struct Gemm { const bf16_t* A; const bf16_t* Bt; int M, N, K; size_t bstride; };

struct StaticOrder {
    int nM, nN, nwg, G, c;
    __host__ __device__ void init(int M, int N, int G_, int c_) { nM = M / BM; nN = N / BM; nwg = nM * nN; G = G_; c = c_; }
    __host__ __device__ bool next(int i, Unit& u) const {
        const long L = (long)i * G + c; if (L >= nwg) return false;
        int wgid = (int)L; { const int q = nwg / NXCD, r = nwg % NXCD, xcd = wgid % NXCD, off = wgid / NXCD; wgid = (xcd < r ? xcd * (q + 1) : r * (q + 1) + (xcd - r) * q) + off; }
        const int nig = WGM * nN, gid = wgid / nig, fm = gid * WGM, gsz = (nM - fm) < WGM ? (nM - fm) : WGM;
        u.pm = fm + ((wgid % nig) % gsz); u.pn = (wgid % nig) / gsz; u.be = 0; return true;
    }
    __device__ __forceinline__ void a_ready(const Unit&) const {}
    __device__ __forceinline__ void done(const Unit&) const {}
};

__device__ __forceinline__ unsigned cvt_pk_bf16(float lo, float hi) { unsigned r; asm volatile("v_cvt_pk_bf16_f32 %0, %1, %2" : "=v"(r) : "v"(lo), "v"(hi)); return r; }
typedef float f32x2 __attribute__((ext_vector_type(2)));
__device__ __forceinline__ f32x2 gelu_pk(f32x2 v) {
    const f32x2 av = __builtin_elementwise_abs(v), d = av * 0.2316418882f + 1.0f;
    f32x2 t; t.x = __builtin_amdgcn_rcpf(d.x); t.y = __builtin_amdgcn_rcpf(d.y);
    f32x2 q = t * 0.5307027145f + (-0.7265760135f); q = q * t + 0.7107068705f; q = q * t + (-0.142248368f); q = q * t + 0.127414796f; q = q * t;
    const f32x2 s = (v * v) * (-0.72134752044f);
    f32x2 e; e.x = __builtin_amdgcn_exp2f(s.x); e.y = __builtin_amdgcn_exp2f(s.y);
    const f32x2 m = v * (q * e), r = v - m;
    f32x2 o; o.x = v.x < 0.f ? m.x : r.x; o.y = v.y < 0.f ? m.y : r.y; return o;
}

template <int ACT  > struct EpiBf16 {
    static constexpr bool PERM = true, AFTER_DRAIN = false; static_assert(ACT == 0 || ACT == 1, "EpiBf16: ACT is 0 (none) or 1 (gelu_pk)");
    bf16_t* O; int ldc; const float* bias; int split_cols; size_t split_stride; float scale0;
    __device__ __forceinline__ void operator()(const f32x4 (&acc)[2][2][4][2], const Unit& u, int wr, int wc, int fr, int fq) const {
        const int row0 = u.pm * BM + wr * 64 + fr; int colt = u.pn * BM; bf16_t* base = O;
        float sc = 1.f; if (split_cols) { const int t = colt / split_cols; base += (size_t)t * split_stride; colt -= t * split_cols; if (t == 0) sc = scale0; }
        const int col0 = colt + wc * 32 + 8 * fq, bcol0 = u.pn * BM + wc * 32 + 8 * fq;
        f32x4 bv[2][2];
#pragma unroll
        for (int bj = 0; bj < 2; ++bj)
#pragma unroll
            for (int n = 0; n < 2; ++n) bv[bj][n] = bias ? *(const f32x4*)(bias + bcol0 + bj * HALF + 4 * n) : (f32x4){0.f, 0.f, 0.f, 0.f};
#pragma unroll
        for (int ai = 0; ai < 2; ++ai)
#pragma unroll
            for (int m = 0; m < 4; ++m) { bf16_t* rowp = base + (size_t)(row0 + ai * HALF + m * 16) * ldc + col0;
#pragma unroll
                for (int bj = 0; bj < 2; ++bj) { f32x4 v0 = acc[ai][bj][m][0] + bv[bj][0], v1 = acc[ai][bj][m][1] + bv[bj][1];
                    if (ACT == 1) { f32x2 a = gelu_pk((f32x2){v0[0], v0[1]}), b = gelu_pk((f32x2){v0[2], v0[3]}), c = gelu_pk((f32x2){v1[0], v1[1]}), d = gelu_pk((f32x2){v1[2], v1[3]});
                        v0 = (f32x4){a.x, a.y, b.x, b.y}; v1 = (f32x4){c.x, c.y, d.x, d.y}; }
                    v0 = v0 * sc; v1 = v1 * sc; u32x4 w; w.x = cvt_pk_bf16(v0[0], v0[1]); w.y = cvt_pk_bf16(v0[2], v0[3]); w.z = cvt_pk_bf16(v1[0], v1[1]); w.w = cvt_pk_bf16(v1[2], v1[3]);
                    *(u32x4*)(rowp + bj * HALF) = w; } }
    }
};

struct PanelStats {
    unsigned* xbuf;
    unsigned* cnt;
    unsigned* tmo;
    int ntn; float eps;
    unsigned code;
    __device__ __forceinline__ bool run(const f32x4 (&v)[2][2][4][2], const Unit& u, int wr, int wc, int fr, int fq, PG8_LAS unsigned char* lds, int wid, int lane) const {
        typedef float f32x2v __attribute__((ext_vector_type(2)));
        PG8_LAS f32x2v* P = (PG8_LAS f32x2v*)lds;
        PG8_LAS f32x2v* S = (PG8_LAS f32x2v*)(lds + 8192);
        PG8_LAS unsigned* flag = (PG8_LAS unsigned*)(lds + 8192 + 2048);
#pragma unroll
        for (int ai = 0; ai < 2; ++ai)
#pragma unroll
            for (int m = 0; m < 4; ++m) {
                float s = 0.f;
#pragma unroll
                for (int bj = 0; bj < 2; ++bj)
#pragma unroll
                    for (int n = 0; n < 2; ++n) { const f32x4 x = v[ai][bj][m][n]; s += (x[0] + x[1]) + (x[2] + x[3]); }
                s += __shfl_xor(s, 16); s += __shfl_xor(s, 32);
                const float mw = s * (1.0f / 64.0f); float q = 0.f;
#pragma unroll
                for (int bj = 0; bj < 2; ++bj)
#pragma unroll
                    for (int n = 0; n < 2; ++n) { const f32x4 d = v[ai][bj][m][n] - mw; q += (d[0] * d[0] + d[1] * d[1]) + (d[2] * d[2] + d[3] * d[3]); }
                q += __shfl_xor(q, 16); q += __shfl_xor(q, 32);
                if (fq == 0) P[(ai * HALF + wr * 64 + m * 16 + fr) * 4 + wc] = (f32x2v){mw, q};
            }
        asm volatile("s_waitcnt lgkmcnt(0)" ::: "memory"); __builtin_amdgcn_s_barrier(); asm volatile("" ::: "memory");
#if defined(BROKEN_EXCHANGE_NO_WAIT)
#warning BROKEN CONTROL BUILD: the row-statistics exchange does not wait; results are wrong by design
        if (blockIdx.x >= 64) { const long long t0_ = clock64(); while (clock64() - t0_ < 60000) __builtin_amdgcn_s_sleep(8); }
#endif
        const int row = wid * 32 + (lane & 31);
        if (lane < 32) {
            const f32x2v a = P[row * 4 + 0], b = P[row * 4 + 1], c = P[row * 4 + 2], d = P[row * 4 + 3];
            const float mt = (a.x + b.x + c.x + d.x) * 0.25f;
            const float da = a.x - mt, db = b.x - mt, dc = c.x - mt, dd = d.x - mt;
            const float m2 = (a.y + b.y) + (c.y + d.y) + 64.0f * ((da * da + db * db) + (dc * dc + dd * dd));
            unsigned long long* slot = (unsigned long long*)xbuf + ((size_t)(u.pm * BM + row) * 4 + u.pn);
            __hip_atomic_store(slot, ((unsigned long long)__float_as_uint(m2) << 32) | __float_as_uint(mt), __ATOMIC_RELAXED, __HIP_MEMORY_SCOPE_AGENT);
        }
        asm volatile("s_waitcnt vmcnt(0)" ::: "memory");
        if (lane == 0) __hip_atomic_fetch_add(cnt + 64 * u.pm, 1u, __ATOMIC_RELAXED, __HIP_MEMORY_SCOPE_AGENT);
        if (wid == 0) {
            bool dead = false; const unsigned long long t0 = __builtin_amdgcn_s_memrealtime(); const unsigned want = 8u * (unsigned)ntn;
            for (;;) {
#if defined(BROKEN_EXCHANGE_NO_WAIT)
                break;
#endif
                if ((unsigned)__builtin_amdgcn_readfirstlane(__hip_atomic_load(cnt + 64 * u.pm, __ATOMIC_RELAXED, __HIP_MEMORY_SCOPE_AGENT)) >= want) break;
                if (__builtin_amdgcn_s_memrealtime() - t0 > 2000000ull) {
                    if (lane == 0) { unsigned expect = 0u; __hip_atomic_compare_exchange_strong(tmo + 1, &expect, code | (unsigned)(u.pm & 0xff), __ATOMIC_RELAXED, __ATOMIC_RELAXED, __HIP_MEMORY_SCOPE_AGENT);
                                     __hip_atomic_store(tmo, 1u, __ATOMIC_RELAXED, __HIP_MEMORY_SCOPE_AGENT); }
                    dead = true; break; }
                __builtin_amdgcn_s_sleep(2);
            }
            __builtin_amdgcn_fence(__ATOMIC_ACQUIRE, "agent");
            if (lane == 0) flag[0] = dead ? 1u : 0u;
        }
        asm volatile("s_waitcnt vmcnt(0) lgkmcnt(0)" ::: "memory"); __builtin_amdgcn_s_barrier(); asm volatile("" ::: "memory");
        const bool bad = flag[0] != 0u;
        if (lane < 32) {
            const unsigned long long* slot = (const unsigned long long*)xbuf + (size_t)(u.pm * BM + row) * 4; float mt[4], m2[4]; float ms = 0.f;
#pragma unroll
            for (int t = 0; t < 4; ++t) { if (t < ntn) { const unsigned long long w = __hip_atomic_load(slot + t, __ATOMIC_RELAXED, __HIP_MEMORY_SCOPE_AGENT); mt[t] = __uint_as_float((unsigned)w); m2[t] = __uint_as_float((unsigned)(w >> 32)); } else { mt[t] = 0.f; m2[t] = 0.f; } ms += mt[t]; }
            const float mean = ms / (float)ntn; float q = 0.f;
#pragma unroll
            for (int t = 0; t < 4; ++t) if (t < ntn) { const float dm = mt[t] - mean; q += m2[t] + 256.0f * dm * dm; }
            S[row] = (f32x2v){mean, 1.0f / sqrtf(q / (256.0f * (float)ntn) + eps)};
        }
        asm volatile("s_waitcnt lgkmcnt(0)" ::: "memory"); __builtin_amdgcn_s_barrier(); asm volatile("" ::: "memory");
        return bad;
    }
};
struct EpiLnRes {
    static constexpr bool PERM = false, AFTER_DRAIN = true;
    const float* base; float* out; int ldc; const float* bias; PanelStats st; unsigned poison;
    __device__ __forceinline__ void fused(f32x4 (&acc)[2][2][4][2], const Unit& u, int wr, int wc, int fr, int fq, PG8_LAS unsigned char* lds, int wid, int lane) const {
        typedef float f32x2v __attribute__((ext_vector_type(2)));
        const PG8_LAS f32x2v* S = (const PG8_LAS f32x2v*)(lds + 8192);
        const int col0 = u.pn * BM + wc * 32 + 4 * fq;
#pragma unroll
        for (int bj = 0; bj < 2; ++bj)
#pragma unroll
            for (int n = 0; n < 2; ++n) { const f32x4 bv = bias ? *(const f32x4*)(bias + col0 + bj * HALF + n * 16) : (f32x4){0.f, 0.f, 0.f, 0.f};
#pragma unroll
                for (int ai = 0; ai < 2; ++ai)
#pragma unroll
                    for (int m = 0; m < 4; ++m) acc[ai][bj][m][n] += bv; }
        f32x4 pre[4][2][2];
#pragma unroll
        for (int m = 0; m < 4; ++m) { const size_t off = (size_t)(u.pm * BM + wr * 64 + m * 16 + fr) * ldc + col0;
#pragma unroll
            for (int bj = 0; bj < 2; ++bj)
#pragma unroll
                for (int n = 0; n < 2; ++n) pre[m][bj][n] = *(const f32x4*)(base + off + bj * HALF + n * 16); }
        const bool bad = st.run(acc, u, wr, wc, fr, fq, lds, wid, lane) || poison != 0u;
        const float qnan = __builtin_nanf("");
#pragma unroll
        for (int ai = 0; ai < 2; ++ai)
#pragma unroll
            for (int m = 0; m < 4; ++m) { const int r = ai * HALF + wr * 64 + m * 16 + fr; const f32x2v sr = S[r]; const size_t off = (size_t)(u.pm * BM + r) * ldc + col0;
#pragma unroll
                for (int bj = 0; bj < 2; ++bj)
#pragma unroll
                    for (int n = 0; n < 2; ++n) { const f32x4 bs = ai == 0 ? pre[m][bj][n] : *(const f32x4*)(base + off + bj * HALF + n * 16); f32x4 o = bs + (acc[ai][bj][m][n] - sr.x) * sr.y;
                        if (bad) o = (f32x4){qnan, qnan, qnan, qnan}; *(f32x4*)(out + off + bj * HALF + n * 16) = o; }
                if (m & 1) asm volatile("" ::: "memory"); }
    }
};
struct EpiLnResLn {
    static constexpr bool PERM = false, AFTER_DRAIN = true;
    const float* base; float* out; bf16_t* xn; int ldc; const float* bias; PanelStats st1, st2; unsigned poison;
    __device__ __forceinline__ void fused(f32x4 (&acc)[2][2][4][2], const Unit& u, int wr, int wc, int fr, int fq, PG8_LAS unsigned char* lds, int wid, int lane) const {
        typedef float f32x2v __attribute__((ext_vector_type(2))); typedef unsigned u32x2v __attribute__((ext_vector_type(2)));
        const PG8_LAS f32x2v* S = (const PG8_LAS f32x2v*)(lds + 8192);
        const int col0 = u.pn * BM + wc * 32 + 4 * fq;
#pragma unroll
        for (int bj = 0; bj < 2; ++bj)
#pragma unroll
            for (int n = 0; n < 2; ++n) { const f32x4 bv = bias ? *(const f32x4*)(bias + col0 + bj * HALF + n * 16) : (f32x4){0.f, 0.f, 0.f, 0.f};
#pragma unroll
                for (int ai = 0; ai < 2; ++ai)
#pragma unroll
                    for (int m = 0; m < 4; ++m) acc[ai][bj][m][n] += bv; }
        bool bad = st1.run(acc, u, wr, wc, fr, fq, lds, wid, lane) || poison != 0u;
        const float qnan = __builtin_nanf("");
#pragma unroll
        for (int ai = 0; ai < 2; ++ai)
#pragma unroll
            for (int m = 0; m < 4; ++m) { const int r = ai * HALF + wr * 64 + m * 16 + fr; const f32x2v sr = S[r]; const size_t off = (size_t)(u.pm * BM + r) * ldc + col0;
#pragma unroll
                for (int bj = 0; bj < 2; ++bj)
#pragma unroll
                    for (int n = 0; n < 2; ++n) { const f32x4 bs = *(const f32x4*)(base + off + bj * HALF + n * 16); acc[ai][bj][m][n] = bs + (acc[ai][bj][m][n] - sr.x) * sr.y; }
                asm volatile("" : "+v"(acc[ai][0][m][0]), "+v"(acc[ai][0][m][1]), "+v"(acc[ai][1][m][0]), "+v"(acc[ai][1][m][1]));
                if (m & 1) asm volatile("" ::: "memory"); }
        const bool bad1 = bad;
        bad = st2.run(acc, u, wr, wc, fr, fq, lds, wid, lane) || bad;
#pragma unroll
        for (int ai = 0; ai < 2; ++ai)
#pragma unroll
            for (int m = 0; m < 4; ++m) { const int r = ai * HALF + wr * 64 + m * 16 + fr; const f32x2v sr = S[r]; const size_t off = (size_t)(u.pm * BM + r) * ldc + col0;
#pragma unroll
                for (int bj = 0; bj < 2; ++bj)
#pragma unroll
                    for (int n = 0; n < 2; ++n) { const f32x4 x1 = acc[ai][bj][m][n]; *(f32x4*)(out + off + bj * HALF + n * 16) = bad1 ? (f32x4){qnan, qnan, qnan, qnan} : x1;
                        const f32x4 o = (x1 - sr.x) * sr.y; u32x2v w; w.x = cvt_pk_bf16(o[0], o[1]); w.y = cvt_pk_bf16(o[2], o[3]);
                        if (bad) { w.x = 0x7fc07fc0u; w.y = 0x7fc07fc0u; } *(u32x2v*)(xn + off + bj * HALF + n * 16) = w; }
                asm volatile("" ::: "memory"); }
    }
};

template <class Epi, class Sched, bool ALIGN_EPI = false, bool SP2 = false>
__device__ __forceinline__ void gemm_phase(PG8_LAS unsigned char* lds, const Gemm g, const Sched& S, const Epi& E, const int wid  ) {
    int lane; asm volatile("v_mbcnt_lo_u32_b32 %0, -1, 0\n\tv_mbcnt_hi_u32_b32 %0, -1, %0" : "=v"(lane));
    const int tid = wid * 64 + lane, wr = wid >> 2, wc = wid & 3, fr = lane & 15, fq = lane >> 4;
    const int K = g.K, nt = K / BK;
    unsigned voffA[2], voffB[2];
#pragma unroll
    for (int i = 0; i < 2; ++i) { int R, C; stage_rc(tid * 16 + i * 8192, R, C); const int Rb = Epi::PERM ? ((R & ~31) + perm32(R & 31)) : R;
        voffA[i] = (unsigned)(R * K + C) * 2u; voffB[i] = (unsigned)(Rb * K + C) * 2u; }
    const size_t kstep = (size_t)(BK * 2);
    const size_t hstep = (size_t)HALF * K * 2;
    const size_t tstep = 2 * hstep;
    const unsigned ldsw = (unsigned)wid * 1024u;
    const int aoff = lds_byte(wr * 64 + fr, fq * 8), boff = lds_byte(wc * 32 + fr, fq * 8);
#define PG8_SA(b, h) (((b) * 2 + (h)) * HTB)
#define PG8_SB(b, h) ((4 + (b) * 2 + (h)) * HTB)
#define PG8_STAGE(bufoff, gbase, voff) do { _Pragma("unroll") for (int _i = 0; _i < 2; ++_i) \
        __builtin_amdgcn_global_load_lds((const unsigned*)((const char*)(gbase) + (voff)[_i]), (PG8_LAS unsigned*)(lds + (bufoff) + ldsw + _i * 8192), 16, 0, 0); } while (0)
#define PG8_LDA(dst, b, h) do { _Pragma("unroll") for (int m = 0; m < 4; ++m) _Pragma("unroll") for (int k = 0; k < 2; ++k) dst[m][k] = *(const PG8_LAS bf16x8*)(lds + PG8_SA(b, h) + aoff + m * 2048 + k * 1024); } while (0)
#define PG8_LDB(dst, b, h) do { _Pragma("unroll") for (int n = 0; n < 2; ++n) _Pragma("unroll") for (int k = 0; k < 2; ++k) dst[n][k] = *(const PG8_LAS bf16x8*)(lds + PG8_SB(b, h) + boff + n * 2048 + k * 1024); } while (0)
#define PG8_MMA(ai, bj, At, Bt) do { __builtin_amdgcn_s_setprio(1); _Pragma("unroll") for (int m = 0; m < 4; ++m) _Pragma("unroll") for (int n = 0; n < 2; ++n) _Pragma("unroll") for (int k = 0; k < 2; ++k) \
        acc[ai][bj][m][n] = __builtin_amdgcn_mfma_f32_16x16x32_bf16(Bt[n][k], At[m][k], acc[ai][bj][m][n], 0, 0, 0); __builtin_amdgcn_s_setprio(0); } while (0)
#define PG8_WAIT_V(n) asm volatile("s_waitcnt vmcnt(" #n ")" ::: "memory")
#define PG8_WAIT_L(n) asm volatile("s_waitcnt lgkmcnt(" #n ")" ::: "memory")
#define PG8_BAR __builtin_amdgcn_s_barrier()
#define PG8_SCHED __builtin_amdgcn_sched_barrier(0)
    Unit cur, nxt; int ui = 0;
    if (!S.next(0, cur)) return;
    f32x4 acc[2][2][4][2];
#pragma unroll
    for (int a = 0; a < 2; ++a)
#pragma unroll
        for (int b = 0; b < 2; ++b)
#pragma unroll
            for (int m = 0; m < 4; ++m)
#pragma unroll
                for (int n = 0; n < 2; ++n) acc[a][b][m][n] = (f32x4){0.f, 0.f, 0.f, 0.f};
    bf16x8 At[4][2], B0[2][2], B1[2][2];
    const char* cA = (const char*)g.A + (size_t)cur.pm * tstep; const char* cB = (const char*)g.Bt + (size_t)cur.pn * tstep + (size_t)cur.be * g.bstride;
    S.a_ready(cur);
    if constexpr (SP2) {
        PG8_STAGE(PG8_SB(0, 0), cB, voffB); PG8_STAGE(PG8_SB(0, 1), cB + hstep, voffB); PG8_STAGE(PG8_SA(0, 0), cA, voffA); PG8_STAGE(PG8_SA(0, 1), cA + hstep, voffA);
        if (wr == 1) PG8_BAR;
        PG8_WAIT_V(2); PG8_BAR;
        PG8_STAGE(PG8_SB(1, 0), cB + kstep, voffB); PG8_STAGE(PG8_SA(1, 0), cA + kstep, voffA); PG8_STAGE(PG8_SB(1, 1), cB + hstep + kstep, voffB);
        PG8_WAIT_V(6); PG8_BAR;
    } else {
        PG8_STAGE(PG8_SB(0, 0), cB, voffB); PG8_STAGE(PG8_SA(0, 0), cA, voffA); PG8_STAGE(PG8_SB(0, 1), cB + hstep, voffB); PG8_STAGE(PG8_SA(0, 1), cA + hstep, voffA);
        if (wr == 1) PG8_BAR;
        PG8_WAIT_V(4); PG8_BAR;
        PG8_STAGE(PG8_SB(1, 0), cB + kstep, voffB); PG8_STAGE(PG8_SA(1, 0), cA + kstep, voffA); PG8_STAGE(PG8_SB(1, 1), cB + hstep + kstep, voffB);
        PG8_WAIT_V(6); PG8_BAR;
    }
    for (;;) {
        const bool has_next = S.next(ui + 1, nxt);
        const char* nA = has_next ? (const char*)g.A + (size_t)nxt.pm * tstep : cA; const char* nB = has_next ? (const char*)g.Bt + (size_t)nxt.pn * tstep + (size_t)nxt.be * g.bstride : cB;
        for (int t = 0; t < nt; t += 2) {
            const bool last = (t == nt - 2);
            const char* a1 = cA + (size_t)(t + 1) * kstep;
            const char* a2 = last ? nA : cA + (size_t)(t + 2) * kstep; const char* b2 = last ? nB : cB + (size_t)(t + 2) * kstep;
            const char* a3 = a2 + kstep; const char* b3 = b2 + kstep;
            if (last && has_next) S.a_ready(nxt);
            if constexpr (SP2) {
            PG8_LDB(B0, 0, 0); PG8_LDB(B1, 0, 1); PG8_SCHED; PG8_LDA(At, 0, 0); PG8_STAGE(PG8_SA(1, 1), a1 + hstep, voffA);
            PG8_WAIT_V(8); PG8_WAIT_L(0); PG8_BAR; PG8_MMA(0, 0, At, B0); PG8_MMA(0, 1, At, B1); PG8_BAR; PG8_SCHED;
            PG8_LDA(At, 0, 1); PG8_STAGE(PG8_SB(0, 0), b2, voffB); PG8_STAGE(PG8_SB(0, 1), b2 + hstep, voffB); PG8_STAGE(PG8_SA(0, 0), a2, voffA);
            PG8_WAIT_V(8); PG8_WAIT_L(0); PG8_BAR; PG8_MMA(1, 0, At, B0); PG8_MMA(1, 1, At, B1); PG8_BAR; PG8_SCHED;
            PG8_LDB(B0, 1, 0); PG8_LDB(B1, 1, 1); PG8_SCHED; PG8_LDA(At, 1, 0); PG8_STAGE(PG8_SA(0, 1), a2 + hstep, voffA);
            PG8_WAIT_V(8); PG8_WAIT_L(0); PG8_BAR; PG8_MMA(0, 0, At, B0); PG8_MMA(0, 1, At, B1); PG8_BAR; PG8_SCHED;
            PG8_LDA(At, 1, 1); PG8_STAGE(PG8_SB(1, 0), b3, voffB); PG8_STAGE(PG8_SB(1, 1), b3 + hstep, voffB); PG8_STAGE(PG8_SA(1, 0), a3, voffA);
            PG8_WAIT_V(8); PG8_WAIT_L(0); PG8_BAR; PG8_MMA(1, 0, At, B0); PG8_MMA(1, 1, At, B1); PG8_BAR; PG8_SCHED;
            } else {
            PG8_LDB(B0, 0, 0); PG8_SCHED; PG8_LDA(At, 0, 0); PG8_STAGE(PG8_SA(1, 1), a1 + hstep, voffA);
            PG8_WAIT_L(8); PG8_BAR; PG8_WAIT_L(0); PG8_MMA(0, 0, At, B0); PG8_BAR; PG8_SCHED;
            PG8_LDB(B1, 0, 1); PG8_STAGE(PG8_SB(0, 0), b2, voffB);
            PG8_BAR; PG8_WAIT_L(0); PG8_MMA(0, 1, At, B1); PG8_BAR;
            PG8_LDA(At, 0, 1); PG8_STAGE(PG8_SA(0, 0), a2, voffA);
            PG8_BAR; PG8_WAIT_L(0); PG8_MMA(1, 0, At, B0); PG8_BAR; PG8_SCHED;
            PG8_STAGE(PG8_SB(0, 1), b2 + hstep, voffB);
            PG8_WAIT_V(6); PG8_BAR; PG8_MMA(1, 1, At, B1); PG8_BAR;
            PG8_LDB(B0, 1, 0); PG8_SCHED; PG8_LDA(At, 1, 0); PG8_STAGE(PG8_SA(0, 1), a2 + hstep, voffA);
            PG8_WAIT_L(8); PG8_BAR; PG8_WAIT_L(0); PG8_MMA(0, 0, At, B0); PG8_BAR; PG8_SCHED;
            PG8_LDB(B1, 1, 1); PG8_STAGE(PG8_SB(1, 0), b3, voffB);
            PG8_BAR; PG8_WAIT_L(0); PG8_MMA(0, 1, At, B1); PG8_BAR;
            PG8_LDA(At, 1, 1); PG8_STAGE(PG8_SA(1, 0), a3, voffA);
            PG8_BAR; PG8_WAIT_L(0); PG8_MMA(1, 0, At, B0); PG8_BAR; PG8_SCHED;
            PG8_STAGE(PG8_SB(1, 1), b3 + hstep, voffB);
            PG8_WAIT_V(6); PG8_BAR; PG8_MMA(1, 1, At, B1); PG8_BAR;
            }
        }
        if constexpr (ALIGN_EPI) { if (wr == 0) PG8_BAR; }
        if constexpr (!Epi::AFTER_DRAIN) { E(acc, cur, wr, wc, fr, fq); S.done(cur); }
        if (!has_next) break;
#pragma unroll
        for (int a = 0; a < 2; ++a)
#pragma unroll
            for (int b = 0; b < 2; ++b)
#pragma unroll
                for (int m = 0; m < 4; ++m)
#pragma unroll
                    for (int n = 0; n < 2; ++n) acc[a][b][m][n] = (f32x4){0.f, 0.f, 0.f, 0.f};
        cur = nxt; cA = nA; cB = nB; ++ui;
        if constexpr (ALIGN_EPI) { if (wr == 1) PG8_BAR; }
    }
    PG8_WAIT_V(0);
    if constexpr (!ALIGN_EPI) { if (wr == 0) PG8_BAR; }
    PG8_BAR;
    if constexpr (Epi::AFTER_DRAIN) { E.fused(acc, cur, wr, wc, fr, fq, lds, wid, lane); S.done(cur); }
#undef PG8_SA
#undef PG8_SB
#undef PG8_STAGE
#undef PG8_LDA
#undef PG8_LDB
#undef PG8_MMA
#undef PG8_WAIT_V
#undef PG8_WAIT_L
#undef PG8_BAR
#undef PG8_SCHED
}
}
#define GAS __attribute__((address_space(1)))
#define LAS __attribute__((address_space(3)))
typedef unsigned short bf16;
typedef unsigned v4u __attribute__((ext_vector_type(4)));
typedef float f32x4 __attribute__((ext_vector_type(4)));
typedef short bf16x8 __attribute__((ext_vector_type(8)));
typedef GAS unsigned gu32;
typedef GAS unsigned long long gu64;
#define RLX_AGENT __ATOMIC_RELAXED, __HIP_MEMORY_SCOPE_AGENT
#define LDS_WAIT() asm volatile("s_waitcnt lgkmcnt(0)" ::: "memory")
#define VM_WAIT() asm volatile("s_waitcnt vmcnt(0)" ::: "memory")
__device__ __forceinline__ unsigned long long rt() { return __builtin_amdgcn_s_memrealtime(); }
__device__ __forceinline__ unsigned f2bf(float f) { unsigned u = __builtin_bit_cast(unsigned, f); return (u + 0x7fffu + ((u >> 16) & 1u)) >> 16; }
__device__ __forceinline__ unsigned pk2(float lo, float hi) { return f2bf(lo) | (f2bf(hi) << 16); }

#define XB_TMO      128
#define XB_XCNT(j)  (256  + 64 * (j))
#define XB_XSUB(j)  (1280 + 64 * (j))
#define XB_XGEN(j)  (2304 + 64 * (j))
#define XB_TOP      3328
#define XB_TOPGEN   3392
#define XCD_BAR_WORDS 3456
#define XB_SPIN_CAP (1u << 18)

__device__ __forceinline__ unsigned xb_ld(unsigned* p)              { return __hip_atomic_load(p, __ATOMIC_RELAXED, __HIP_MEMORY_SCOPE_AGENT); }
__device__ __forceinline__ unsigned xb_add(unsigned* p, unsigned v) { return __hip_atomic_fetch_add(p, v, __ATOMIC_RELAXED, __HIP_MEMORY_SCOPE_AGENT); }
__device__ __forceinline__ unsigned xb_xcc_id() { return (unsigned)__builtin_amdgcn_s_getreg((3 << 11) | 20) & 0xFu; }
#define XB_SPIN(cond, bar) do { unsigned _sp = 0; while (cond) { __builtin_amdgcn_s_sleep(1); \
    if ((++_sp & 255u) == 0u) { if (xb_ld(&(bar)[XB_TMO])) break; if (_sp > XB_SPIN_CAP) { atomicAdd(&(bar)[XB_TMO], 1u); break; } } } } while (0)

struct XcdBarrier {
    unsigned* bar; unsigned x;
    volatile LAS unsigned* st;
};

__device__ __forceinline__ XcdBarrier xcd_barrier_post(unsigned* bar, volatile LAS unsigned* st, bool leader) {
    XcdBarrier b; b.bar = bar; b.x = xb_xcc_id(); b.st = st;
    if (leader) (void)xb_add(&bar[XB_XCNT(b.x)], 1u);
    return b;
}
__device__ __forceinline__ void xcd_barrier_complete(unsigned* bar, unsigned x, unsigned& nloc, unsigned& nx) {
    const unsigned G = gridDim.x * gridDim.y * gridDim.z;
    unsigned sum, cnt, mine, sp = 0u;
    for (;;) {
        sum = 0u; cnt = 0u; mine = 0u;
#pragma unroll
        for (unsigned j = 0; j < 16; ++j) { const unsigned c = xb_ld(&bar[XB_XCNT(j)]); sum += c; cnt += (c > 0u) ? 1u : 0u; mine = (j == x) ? c : mine; }
        if (sum == G) break;
        __builtin_amdgcn_s_sleep(1);
        if ((++sp & 255u) == 0u) { if (xb_ld(&bar[XB_TMO])) break; if (sp > XB_SPIN_CAP) { atomicAdd(&bar[XB_TMO], 1u); break; } }
    }
    nloc = mine > 0u ? mine : 1u; nx = cnt > 0u ? cnt : 1u;
}

__device__ __forceinline__ void xcd_barrier(const XcdBarrier& b, bool leader) {
    asm volatile("s_waitcnt vmcnt(0)" ::: "memory");
    __syncthreads();
    if (leader) {
        unsigned* bar = b.bar;
        __builtin_amdgcn_s_waitcnt(0);
        unsigned nloc = b.st[0], nx = b.st[1];
        if (nloc == 0u) { xcd_barrier_complete(bar, b.x, nloc, nx); b.st[0] = nloc; b.st[1] = nx; }
        const unsigned old = xb_add(&bar[XB_XSUB(b.x)], 1u);
        const unsigned gen = old / nloc;
        if (old + 1u == (gen + 1u) * nloc) {
            __builtin_amdgcn_fence(__ATOMIC_RELEASE, "agent");
            asm volatile("s_waitcnt vmcnt(0)" ::: "memory");
            const unsigned og = xb_add(&bar[XB_TOP], 1u);
            const unsigned tg = og / nx;
            if (og + 1u == (tg + 1u) * nx) xb_add(&bar[XB_TOPGEN], 1u);
            else XB_SPIN(xb_ld(&bar[XB_TOPGEN]) == tg, bar);
            __builtin_amdgcn_fence(__ATOMIC_ACQUIRE, "agent");
            xb_add(&bar[XB_XGEN(b.x)], 1u);
            asm volatile("s_waitcnt vmcnt(0)" ::: "memory");
        } else {
            XB_SPIN(xb_ld(&bar[XB_XGEN(b.x)]) == gen, bar);
            __builtin_amdgcn_fence(__ATOMIC_ACQUIRE, "agent");
            asm volatile("s_waitcnt vmcnt(0)" ::: "memory");
        }
    }
    __syncthreads();
}
constexpr int NWAVES = 8;
constexpr size_t MiB = 1u << 20;
constexpr size_t WS_CTL = 0, CTL_ZERO_BYTES = 1 * MiB;
constexpr size_t WS_TAB = 1 * MiB;
constexpr size_t WS_WIN = 4 * MiB, WS_WOUT = 10 * MiB, WS_WGATE = 12 * MiB, WS_WPROJ = 14 * MiB, WS_WUP = 16 * MiB, WS_WDOWN = 80 * MiB;
constexpr size_t WS_N1 = 112 * MiB;
constexpr size_t WS_QKVZ = 144 * MiB;
constexpr size_t WS_U = 208 * MiB;
constexpr size_t WS_AB = 224 * MiB;
constexpr size_t WS_PBF = 226 * MiB;
constexpr int NIN_T = 3072;
constexpr int CW_TMO = 0, CW_CODE = 1, CW_BAR = 4096, CW_READY = 65536, CW_PROG = 131072;
constexpr int RING_OFF = 0, RING_BYTES = 131072, LDSCTL_OFF = RING_BYTES, MISC_OFF = LDSCTL_OFF + 320, LDS_BYTES = 163840;

struct Frame {
    LAS unsigned char* lds; volatile LAS unsigned* MISC; gu32* ctl;
    int wave, vcu, G;
};
__device__ __forceinline__ int lane_now() { int l; asm volatile("v_mbcnt_lo_u32_b32 %0, -1, 0\n\tv_mbcnt_hi_u32_b32 %0, -1, %0" : "=v"(l)); return l; }
template <int CTRL, int ROW_MASK> __device__ __forceinline__ float dpp_add(float v) {
    return v + __builtin_bit_cast(float, __builtin_amdgcn_update_dpp(0, __builtin_bit_cast(int, v), CTRL, ROW_MASK, 0xF, true));
}
__device__ __forceinline__ float wave_sum_f(float v) {
    v = dpp_add<0xB1, 0xF>(v);
    v = dpp_add<0x4E, 0xF>(v);
    v = dpp_add<0x141, 0xF>(v);
    v = dpp_add<0x140, 0xF>(v);
    v = dpp_add<0x142, 0xA>(v);
    v = dpp_add<0x143, 0xC>(v);
    return __builtin_bit_cast(float, __builtin_amdgcn_readlane(__builtin_bit_cast(int, v), 63));
}
__device__ __forceinline__ float fsigmoid(float x) { return __builtin_amdgcn_rcpf(1.f + __expf(-x)); }
__device__ __forceinline__ float fsilu(float x) { return x * __builtin_amdgcn_rcpf(1.f + __expf(-x)); }

struct MapId  { __device__ __forceinline__ int operator()(int n) const { return n; } };
struct MapWin { __device__ __forceinline__ int operator()(int n) const { if (n < 2048) return n; const int j = n - 2048; return O4 + (j >> 3) * 4 + (j & 3) + ((j >> 2) & 1) * CCH; } };
struct MapWup { __device__ __forceinline__ int operator()(int n) const { return (n >> 3) * 4 + (n & 3) + ((n >> 2) & 1) * DEXP; } };

template <class Map>
__device__ __forceinline__ void p0_transpose_item(const float* W, int K, int Nsrc, int Ndst, bf16* WT, LAS float* scr, int item, int lane, Map map) {
    const int nblk = Ndst / 32, kb = item / nblk, nb = item % nblk, k0 = 64 * kb, n0 = 32 * nb;
    const int sc = map(n0 + (lane & 31));
#pragma unroll 8
    for (int i = 0; i < 32; ++i) { const int kk = 2 * i + (lane >> 5); scr[kk * 33 + (lane & 31)] = W[(size_t)(k0 + kk) * Nsrc + sc]; }
    LDS_WAIT(); asm volatile("" ::: "memory");
    const int c = lane & 7;
#pragma unroll
    for (int j = 0; j < 4; ++j) { const int n = (lane >> 3) + 8 * j; const LAS float* s = scr + (8 * c) * 33 + n;
        v4u o; o.x = pk2(s[0 * 33], s[1 * 33]); o.y = pk2(s[2 * 33], s[3 * 33]); o.z = pk2(s[4 * 33], s[5 * 33]); o.w = pk2(s[6 * 33], s[7 * 33]);
        *(GAS v4u*)(WT + (size_t)(n0 + n) * K + k0 + 8 * c) = o; }
    LDS_WAIT(); asm volatile("" ::: "memory");
}

struct Ptrs {
    const float *x, *p, *g_mix, *w_in, *w_conv_qkv, *a_log, *dt_bias, *g_gdn_out, *b_glu, *w_conv_dw, *b_conv_dw, *ln_g, *ln_b, *w_out, *g_moe, *w_gr, *w_er, *w_up, *w_down, *g_ple, *w_pg, *w_pp, *g_final;
    float* out; unsigned char* ws;
};

__device__ __forceinline__ void p0_prologue(Frame& F, const Ptrs& P) {
    const int lane = lane_now(), tid = F.wave * 64 + lane;
    LAS float* scr = (LAS float*)(F.lds + RING_OFF + F.wave * 16384);
    const int gw = F.vcu * NWAVES + F.wave, NGW = F.G * NWAVES;
    bf16* Win_t = (bf16*)(P.ws + WS_WIN); bf16* Wout_t = (bf16*)(P.ws + WS_WOUT); bf16* Wgate_t = (bf16*)(P.ws + WS_WGATE); bf16* Wproj_t = (bf16*)(P.ws + WS_WPROJ);
    bf16* Wup_t = (bf16*)(P.ws + WS_WUP); bf16* Wdown_t = (bf16*)(P.ws + WS_WDOWN);
    constexpr int I_IN = 16 * (NIN_T / 32), I_SQ = 16 * 32, I_PR = 4 * 32, I_UP1 = 16 * 16, I_UP = NEXP * I_UP1, I_DN1 = 4 * 32, I_DN = NEXP * I_DN1;
    constexpr int NITEMS = I_IN + I_SQ + I_PR;
    (void)Wgate_t; (void)Wup_t; (void)Wdown_t; (void)I_UP; (void)I_DN;
    for (int it = gw; it < NITEMS; it += NGW) {
        int r = it;
        if (r < I_IN) { p0_transpose_item(P.w_in, DM, INC, NIN_T, Win_t, scr, r, lane, MapWin()); continue; } r -= I_IN;
        if (r < I_SQ) { p0_transpose_item(P.w_out, DM, DM, DM, Wout_t, scr, r, lane, MapId()); continue; } r -= I_SQ;
        p0_transpose_item(P.w_pp, PLE, DM, DM, Wproj_t, scr, r, lane, MapId());
    }
    __syncthreads();
    LAS float* wabT = (LAS float*)(F.lds + RING_OFF);
    for (int idx = tid; idx < 8 * DM; idx += NWAVES * 64) { const int k = idx >> 3, c = idx & 7; wabT[c * DM + k] = P.w_in[(size_t)k * INC + O2 + c]; }
    __syncthreads();
    bf16* N1 = (bf16*)(P.ws + WS_N1); float* AB = (float*)(P.ws + WS_AB);
    for (int m = gw; m < M; m += NGW) {
        const GAS f32x4* xr = (const GAS f32x4*)(P.x + (size_t)m * DM) + lane;
        f32x4 v[4]; float s = 0.f;
#pragma unroll
        for (int j = 0; j < 4; ++j) { v[j] = xr[64 * j]; s += (v[j].x * v[j].x + v[j].y * v[j].y) + (v[j].z * v[j].z + v[j].w * v[j].w); }
        const float r = rsqrtf(wave_sum_f(s) * (1.f / DM) + EPS);
        float ab[8];
#pragma unroll
        for (int c = 0; c < 8; ++c) ab[c] = 0.f;
#pragma unroll
        for (int j = 0; j < 4; ++j) { const f32x4 g = ((const GAS f32x4*)P.g_mix)[64 * j + lane]; v[j] = v[j] * r * g;
#pragma unroll
            for (int c = 0; c < 8; ++c) { const f32x4 w = *(const LAS f32x4*)(wabT + c * DM + 256 * j + 4 * lane); ab[c] += (v[j].x * w.x + v[j].y * w.y) + (v[j].z * w.z + v[j].w * w.w); } }
        GAS unsigned long long* o8 = (GAS unsigned long long*)(N1 + (size_t)m * DM) + lane;
#pragma unroll
        for (int j = 0; j < 4; ++j) o8[64 * j] = (unsigned long long)pk2(v[j].x, v[j].y) | ((unsigned long long)pk2(v[j].z, v[j].w) << 32);
#pragma unroll
        for (int c = 0; c < 8; ++c) ab[c] = wave_sum_f(ab[c]);
        if (lane == 0) { *(GAS f32x4*)(AB + (size_t)m * 8) = (f32x4){ab[0], ab[1], ab[2], ab[3]}; *(GAS f32x4*)(AB + (size_t)m * 8 + 4) = (f32x4){ab[4], ab[5], ab[6], ab[7]}; }
    }
    { bf16* Wr = (bf16*)(P.ws + 15 * MiB);
      for (int i = F.vcu * (NWAVES * 64) + tid; i < 80 * DM; i += F.G * NWAVES * 64) { const int n = i >> 10, k = i & 1023;
          const float v = n < NGRP ? P.w_gr[k * NGRP + n] : (n < NGRP + NEXP ? P.w_er[k * NEXP + n - NGRP] : 0.f); Wr[i] = (bf16)f2bf(v); } }
    bf16* PB = (bf16*)(P.ws + WS_PBF);
    for (size_t i = (size_t)F.vcu * (NWAVES * 64) + tid; i < (size_t)M * PLE / 8; i += (size_t)F.G * NWAVES * 64) {
        const f32x4 a = ((const GAS f32x4*)P.p)[2 * i], b = ((const GAS f32x4*)P.p)[2 * i + 1];
        v4u o; o.x = pk2(a.x, a.y); o.y = pk2(a.z, a.w); o.z = pk2(b.x, b.y); o.w = pk2(b.z, b.w);
        ((GAS v4u*)PB)[i] = o;
    }
}

__device__ __forceinline__ void p3_convert_late(Frame& F, const Ptrs& P, int idx, int cnt) {
    const int lane = lane_now();
    LAS float* scr = (LAS float*)(F.lds + RING_OFF + F.wave * 16384);
    const int gw = idx * NWAVES + F.wave, NGW = cnt * NWAVES;
    bf16* Wgate_t = (bf16*)(P.ws + WS_WGATE); bf16* Wup_t = (bf16*)(P.ws + WS_WUP); bf16* Wdown_t = (bf16*)(P.ws + WS_WDOWN);
    constexpr int I_SQ = 16 * 32, I_UP1 = 16 * 16, I_UP = NEXP * I_UP1, I_DN1 = 4 * 32, I_DN = NEXP * I_DN1;
    constexpr int NITEMS = I_SQ + I_UP + I_DN;
    for (int it = gw; it < NITEMS; it += NGW) {
        int r = it;
        if (r < I_SQ) { p0_transpose_item(P.w_pg, DM, DM, DM, Wgate_t, scr, r, lane, MapId()); continue; } r -= I_SQ;
        if (r < I_UP) { const int e = r / I_UP1; p0_transpose_item(P.w_up + (size_t)e * DM * 512, DM, 512, 512, Wup_t + (size_t)e * 512 * DM, scr, r % I_UP1, lane, MapWup()); continue; } r -= I_UP;
        { const int e = r / I_DN1; p0_transpose_item(P.w_down + (size_t)e * DEXP * DM, DEXP, DM, DM, Wdown_t + (size_t)e * DM * DEXP, scr, r % I_DN1, lane, MapId()); }
    }
    asm volatile("s_waitcnt lgkmcnt(0)" ::: "memory"); __builtin_amdgcn_s_barrier(); asm volatile("" ::: "memory");
}

struct EpiIn {
    static constexpr bool PERM = true, AFTER_DRAIN = false;
    pg8::bf16_t* QKVZ; pg8::bf16_t* U; const float* b_glu;
    __device__ __forceinline__ void operator()(const pg8::f32x4 (&acc)[2][2][4][2], const pg8::Unit& u, int wr, int wc, int fr, int fq) const {
        using namespace pg8;
        const int row0 = u.pm * BM + wr * 64 + fr;
        if (u.pn < 8) {
            const int col0 = u.pn * BM + wc * 32 + 8 * fq;
#pragma unroll
            for (int ai = 0; ai < 2; ++ai)
#pragma unroll
                for (int m = 0; m < 4; ++m) { bf16_t* rowp = QKVZ + (size_t)(row0 + ai * HALF + m * 16) * 2048 + col0;
#pragma unroll
                    for (int bj = 0; bj < 2; ++bj) { const f32x4 v0 = acc[ai][bj][m][0], v1 = acc[ai][bj][m][1];
                        u32x4 w; w.x = cvt_pk_bf16(v0[0], v0[1]); w.y = cvt_pk_bf16(v0[2], v0[3]); w.z = cvt_pk_bf16(v1[0], v1[1]); w.w = cvt_pk_bf16(v1[2], v1[3]);
                        *(u32x4*)(rowp + bj * HALF) = w; } }
        } else {
            const int hid0 = (u.pn - 8) * 128 + wc * 16 + 4 * fq;
            f32x4 ba[2], bg[2];
#pragma unroll
            for (int bj = 0; bj < 2; ++bj) { ba[bj] = *(const f32x4*)(b_glu + hid0 + bj * 64); bg[bj] = *(const f32x4*)(b_glu + CCH + hid0 + bj * 64); }
#pragma unroll
            for (int ai = 0; ai < 2; ++ai)
#pragma unroll
                for (int m = 0; m < 4; ++m) { bf16_t* rowp = U + (size_t)(row0 + ai * HALF + m * 16) * CCH + hid0;
#pragma unroll
                    for (int bj = 0; bj < 2; ++bj) { const f32x4 a = acc[ai][bj][m][0] + ba[bj], g = acc[ai][bj][m][1] + bg[bj];
                        typedef unsigned u32x2v __attribute__((ext_vector_type(2)));
                        u32x2v w; w.x = cvt_pk_bf16(a[0] * fsigmoid(g[0]), a[1] * fsigmoid(g[1])); w.y = cvt_pk_bf16(a[2] * fsigmoid(g[2]), a[3] * fsigmoid(g[3]));
                        *(u32x2v*)(rowp + bj * 64) = w; } }
        }
    }
};

constexpr size_t WS_GT = 225 * MiB;
constexpr size_t WS_GDN = 234 * MiB, GDN_ITEM = 73728;
constexpr size_t GI_WNEG = 0, GI_KDT = 16384, GI_UFR = 32768, GI_QD = 49152, GI_QK = 65536;
constexpr size_t WS_SN = 306 * MiB;
constexpr size_t WS_VN = 338 * MiB;
constexpr size_t WS_MIX = 354 * MiB;
constexpr size_t WS_H1 = 386 * MiB;
constexpr size_t WS_PROJ = 450 * MiB;
constexpr int NSCAN = 32;
typedef float f32x16 __attribute__((ext_vector_type(16)));
typedef unsigned u32x2 __attribute__((ext_vector_type(2)));
#define LBAR() do { asm volatile("s_waitcnt lgkmcnt(0)" ::: "memory"); __builtin_amdgcn_s_barrier(); asm volatile("" ::: "memory"); } while (0)
__device__ __forceinline__ float bf2f(unsigned short b) { return __uint_as_float((unsigned)b << 16); }
__device__ __forceinline__ __amdgpu_buffer_rsrc_t mk_rsrc(const void* p, unsigned bytes) { return __builtin_amdgcn_make_buffer_rsrc((void*)p, (short)0, (int)bytes, 0x00020000); }
__device__ __forceinline__ float buf_ld_bf16(__amdgpu_buffer_rsrc_t r, unsigned voff, unsigned soff) { return bf2f((unsigned short)__builtin_amdgcn_raw_buffer_load_b16(r, (int)voff, (int)soff, 0)); }
__device__ __forceinline__ void buf_st_b64(__amdgpu_buffer_rsrc_t r, unsigned voff, unsigned soff, u32x2 v) { __builtin_amdgcn_raw_buffer_store_b64(v, r, (int)voff, (int)soff, 0); }
__device__ __forceinline__ void buf_st_b128(__amdgpu_buffer_rsrc_t r, unsigned voff, unsigned soff, v4u v) { __builtin_amdgcn_raw_buffer_store_b128(v, r, (int)(voff + soff), 0, 0); }
__device__ __forceinline__ void buf_st_bf16(__amdgpu_buffer_rsrc_t r, unsigned voff, unsigned soff, float v) { __builtin_amdgcn_raw_buffer_store_b16((short)f2bf(v), r, (int)voff, (int)soff, 0); }

#ifndef XCHK
#define XCHK 0
#endif
#ifndef S5BAR
#define S5BAR 0
#endif
constexpr int CK_P1 = 2112, CK_P2 = 2176;
#define FMAC1(acc, a, b) asm("v_fmac_f32 %0, %1, %2" : "+v"(acc) : "v"(a), "v"(b))
template <int I>
struct SolveRow {
    static __device__ __forceinline__ void run(float (&X)[64], const LAS float* LS, const LAS float* SC) {
        int one; asm volatile("s_mov_b32 %0, 1" : "=s"(one));
        if (one) {
            constexpr int NQ = (I + 3) / 4;
            f32x4 lc[NQ > 0 ? NQ : 1];
#pragma unroll
            for (int q = 0; q < NQ; ++q) lc[q] = *(const volatile LAS f32x4*)(LS + I * 64 + 4 * q);
            float x0 = X[I] * SC[I], x1 = 0.f, x2 = 0.f, x3 = 0.f;
#pragma unroll
            for (int q = 0; q < NQ; ++q) {
                const f32x4 l = lc[q];
                if (4 * q + 0 < I) FMAC1(x0, l.x, X[4 * q + 0]);
                if (4 * q + 1 < I) FMAC1(x1, l.y, X[4 * q + 1]);
                if (4 * q + 2 < I) FMAC1(x2, l.z, X[4 * q + 2]);
                if (4 * q + 3 < I) FMAC1(x3, l.w, X[4 * q + 3]);
            }
            X[I] = (x0 + x1) + (x2 + x3);
        }
        if constexpr (I < 63) SolveRow<I + 1>::run(X, LS, SC);
    }
};

#ifndef SOLVE_PF
#define SOLVE_PF 0
#endif
#ifndef SOLVE_D
#define SOLVE_D 1
#endif
#ifndef SOLVE_ROWBR
#define SOLVE_ROWBR 0
#endif
#ifndef SOLVE2
#define SOLVE2 0
#endif
typedef float f32x2 __attribute__((ext_vector_type(2)));
#define PKFMA_LO(acc, l2, x) asm("v_pk_fma_f32 %0, %1, %2, %0 op_sel_hi:[0,1,1]" : "+v"(acc) : "v"(l2), "v"(x))
#define PKFMA_HI(acc, l2, x) asm("v_pk_fma_f32 %0, %1, %2, %0 op_sel:[1,0,0] op_sel_hi:[1,1,1]" : "+v"(acc) : "v"(l2), "v"(x))
template <int I>
struct SolveRow2 {
    static __device__ __forceinline__ void run(f32x2 (&X)[64], const LAS float* LS, const LAS float* SCW, const LAS float* BET) {
        int one; asm volatile("s_mov_b32 %0, 1" : "=s"(one));
        if (one) {
            constexpr int NQ = (I + 3) / 4, NG = (NQ + 3) / 4;
            f32x4 buf[2][4];
#pragma unroll
            for (int g = 0; g < 2; ++g)
#pragma unroll
                for (int u = 0; u < 4; ++u) if (g < NG && 4 * g + u < NQ) buf[g][u] = *(const volatile LAS f32x4*)(LS + I * 64 + 4 * (4 * g + u));
            const f32x2 sc = {SCW[I], BET[I]};
            f32x2 x0 = X[I] * sc, x1 = {0.f, 0.f}, x2 = {0.f, 0.f}, x3 = {0.f, 0.f};
#pragma unroll
            for (int g = 0; g < NG; ++g) {
#pragma unroll
                for (int u = 0; u < 4; ++u) { const int q = 4 * g + u; if (q < NQ) { const f32x4 l = buf[g & 1][u]; const f32x2 lxy = {l.x, l.y}, lzw = {l.z, l.w};
                    if (4 * q + 0 < I) PKFMA_LO(x0, lxy, X[4 * q + 0]);
                    if (4 * q + 1 < I) PKFMA_HI(x1, lxy, X[4 * q + 1]);
                    if (4 * q + 2 < I) PKFMA_LO(x2, lzw, X[4 * q + 2]);
                    if (4 * q + 3 < I) PKFMA_HI(x3, lzw, X[4 * q + 3]); } }
                if (g + 2 < NG) {
#pragma unroll
                    for (int u = 0; u < 4; ++u) if (4 * (g + 2) + u < NQ) buf[g & 1][u] = *(const volatile LAS f32x4*)(LS + I * 64 + 4 * (4 * (g + 2) + u)); }
            }
            X[I] = (x0 + x1) + (x2 + x3);
        }
        if constexpr (I < 63) SolveRow2<I + 1>::run(X, LS, SCW, BET);
    }
};
#if SOLVE_PF
template <int I>
struct SolveRowPF {
    static constexpr int NQ = (I + 3) / 4, NP = NQ < 8 ? NQ : 8;
    static __device__ __forceinline__ void run(float (&X)[64], const LAS float* LS, const LAS float* SC, const f32x4 (&pre)[8]) {
        int one; asm volatile("s_mov_b32 %0, 1" : "=s"(one));
        f32x4 nxt[8];
        if (one) {
            constexpr int NQ1 = (I + 4) / 4, NP1 = NQ1 < 8 ? NQ1 : 8, NR = NQ > 8 ? NQ - 8 : 0;
            f32x4 rest[NR > 0 ? NR : 1];
#pragma unroll
            for (int q = 0; q < NR; ++q) rest[q] = *(const volatile LAS f32x4*)(LS + I * 64 + 4 * (8 + q));
            if constexpr (I < 63) {
#pragma unroll
                for (int q = 0; q < NP1; ++q) nxt[q] = *(const volatile LAS f32x4*)(LS + (I + 1) * 64 + 4 * q);
            }
            float x0 = X[I] * SC[I], x1 = 0.f, x2 = 0.f, x3 = 0.f;
#pragma unroll
            for (int q = 0; q < NQ; ++q) {
                const f32x4 l = q < NP ? pre[q] : rest[q < 8 ? 0 : q - 8];
                if (4 * q + 0 < I) FMAC1(x0, l.x, X[4 * q + 0]);
                if (4 * q + 1 < I) FMAC1(x1, l.y, X[4 * q + 1]);
                if (4 * q + 2 < I) FMAC1(x2, l.z, X[4 * q + 2]);
                if (4 * q + 3 < I) FMAC1(x3, l.w, X[4 * q + 3]);
            }
            X[I] = (x0 + x1) + (x2 + x3);
        }
        if constexpr (I < 63) SolveRowPF<I + 1>::run(X, LS, SC, nxt);
    }
};
#endif
template <int B> __device__ __forceinline__ void fmac_bc(float& acc, float l, float x) { asm("v_fmac_f32_dpp %0, %1, %2 row_newbcast:%3 row_mask:0xf bank_mask:0xf" : "+v"(acc) : "v"(l), "v"(x), "n"(B)); }
template <int J, int I>
__device__ __forceinline__ void solve_terms(const float (&X)[64], const f32x4& l, float& x0, float& x1, float& x2, float& x3) {
    if constexpr (J < I) {
        constexpr int k = J >> 4, b = J & 15;
        const float lk = k == 0 ? l.x : (k == 1 ? l.y : (k == 2 ? l.z : l.w));
        if constexpr ((J & 3) == 0) fmac_bc<b>(x0, lk, X[J]); else if constexpr ((J & 3) == 1) fmac_bc<b>(x1, lk, X[J]); else if constexpr ((J & 3) == 2) fmac_bc<b>(x2, lk, X[J]); else fmac_bc<b>(x3, lk, X[J]);
        solve_terms<J + 1, I>(X, l, x0, x1, x2, x3);
    }
}
template <int I>
struct SolveRowD {
    static __device__ __forceinline__ void run(float (&X)[64], const LAS float* LSl  , const f32x4 l, const f32x4 l1  ) {
#if SOLVE_ROWBR
        int one; asm volatile("s_mov_b32 %0, 1" : "=s"(one));
#else
        constexpr bool one = true;
#endif
        f32x4 l2 = l1;
        if (one) {
            if constexpr (I < 62) l2 = *(const volatile LAS f32x4*)(LSl + (I + 2) * 64);
            float x0 = X[I], x1 = 0.f, x2 = 0.f, x3 = 0.f;
            solve_terms<0, I>(X, l, x0, x1, x2, x3);
            X[I] = (x0 + x1) + (x2 + x3);
        }
        if constexpr (I < 63) SolveRowD<I + 1>::run(X, LSl, l1, l2);
    }
};
__device__ __forceinline__ void solve64(float (&X)[64], const LAS float* LS, const LAS float* SC) {
#if SOLVE_D
    const LAS float* LSl = LS + (lane_now() & 15) * 4;
    const f32x4 l0 = *(const volatile LAS f32x4*)LSl, l1 = *(const volatile LAS f32x4*)(LSl + 64);
#pragma unroll
    for (int q = 0; q < 16; ++q) { const f32x4 sc = *(const volatile LAS f32x4*)(SC + 4 * q); X[4 * q + 0] *= sc.x; X[4 * q + 1] *= sc.y; X[4 * q + 2] *= sc.z; X[4 * q + 3] *= sc.w; }
    SolveRowD<0>::run(X, LSl, l0, l1);
    return;
#endif
#if SOLVE_PF
    f32x4 pre[8]; SolveRowPF<0>::run(X, LS, SC, pre);
#else
    SolveRow<0>::run(X, LS, SC);
#endif
}

#if defined(P2_TSTAGE)
#define P2T(k) do { if (P2_TSTAGE == (k)) p2t_s = (unsigned)rt(); if (P2_TSTAGE + 1 == (k)) p2t_a += (unsigned)rt() - p2t_s; } while (0)
#else
#define P2T(k) do { } while (0)
#endif
__device__ __forceinline__ void p2_gdn_prep(Frame& F, const Ptrs& P, const size_t gdn_off = WS_GDN, const size_t gt_off = WS_GT) {
    LAS unsigned char* QT = F.lds; LAS unsigned char* KT = F.lds + 17408; LAS float* LS = (LAS float*)(F.lds + 34816);
    LAS unsigned char* XS = F.lds + 53248;
    LAS unsigned char* QDT = F.lds + 53248;
    LAS unsigned char* QKT = F.lds + 53248 + 17408;
    LAS float* gcs = (LAS float*)(F.lds + 51200); LAS float* betas = gcs + 64; LAS float* nk2 = gcs + 128; LAS float* nq2 = gcs + 192; LAS float* sc_w = gcs + 256; LAS float* sc_kd = gcs + 320; LAS float* sc_qd = gcs + 384;
    const bf16* QKVZ = (const bf16*)(P.ws + WS_QKVZ); const float* AB = (const float*)(P.ws + WS_AB);
    const int wave = F.wave;
    const int grp = wave >> 1;
    v4u pre[7];
#define P2_PREFETCH(it_) do { const int lane_ = lane_now(), tid_ = wave * 64 + lane_; const int bh_ = (it_) >> 7, n_ = (it_) & 127; \
        const unsigned char* src_ = (const unsigned char*)(QKVZ + ((size_t)(bh_ >> 2) * SEQ + (size_t)n_ * 64 - 3) * 2048 + (bh_ & 3) * 128); \
        _Pragma("unroll") for (int u = 0; u < 7; ++u) { const int cid = tid_ + 512 * u; pre[u] = (v4u){0u, 0u, 0u, 0u}; if (cid < 67 * 48) { const int row = cid / 48, cc = cid - row * 48, seg3 = cc >> 4; \
            if (n_ * 64 + row - 3 >= 0) pre[u] = *(const GAS v4u*)(src_ + (size_t)row * 4096 + seg3 * 1024 + (cc & 15) * 16); } } } while (0)
    if (F.vcu < 1024) P2_PREFETCH(F.vcu);
    unsigned p2t_s = 0, p2t_a = 0; (void)p2t_s; (void)p2t_a;
    for (int it = F.vcu; it < 1024; it += F.G) {
        P2T(0);
        const int lane = lane_now();
        const int c = ((wave & 1) << 6) | lane, tid = wave * 64 + lane;
        const int bh = it >> 7, n = it & 127, b = bh >> 2, h = bh & 3;
        const size_t m0 = (size_t)b * SEQ + (size_t)n * 64;
        unsigned char* item = P.ws + gdn_off + (size_t)it * GDN_ITEM;
        float y[64];
#pragma unroll
        for (int u = 0; u < 7; ++u) { const int cid = tid + 512 * u; if (cid < 67 * 48) *(LAS v4u*)(XS + cid * 16) = pre[u]; }
        LBAR();
        P2T(1);
        if (grp < 3) {
            const int col = grp * 512 + h * 128 + c;
            const float w0 = P.w_conv_qkv[0 * 1536 + col], w1 = P.w_conv_qkv[1 * 1536 + col], w2 = P.w_conv_qkv[2 * 1536 + col], w3 = P.w_conv_qkv[3 * 1536 + col];
            float xr[67];
#pragma unroll
            for (int j = 0; j < 67; ++j) xr[j] = bf2f(*(const LAS unsigned short*)(XS + j * 768 + grp * 256 + c * 2));
#pragma unroll
            for (int i = 0; i < 64; ++i) { const float s = fmaf(w3, xr[i + 3], fmaf(w2, xr[i + 2], fmaf(w1, xr[i + 1], w0 * xr[i]))); y[i] = fsilu(s); }
            if (grp < 2) { LAS unsigned char* tile = grp == 0 ? QT : KT;
#pragma unroll
                for (int i = 0; i < 64; ++i) *(LAS unsigned short*)(tile + i * 272 + c * 2) = (unsigned short)f2bf(y[i]); }
        }
        if (wave == 7) {
            const float araw = AB[(m0 + lane) * 8 + 4 + h], braw = AB[(m0 + lane) * 8 + h];
            const float xx = araw + P.dt_bias[h];
            const float sp = (xx > 20.f) ? xx : log1pf(expf(xx));
            float g = -expf(P.a_log[h]) * sp;
#pragma unroll
            for (int off = 1; off < 64; off <<= 1) { const float t = __shfl_up(g, off); if (lane >= off) g += t; }
            gcs[lane] = g; betas[lane] = 1.f / (1.f + expf(-braw));
        }
        LBAR();
        P2T(2);
        const int kind = wave < 3 ? 0 : (wave < 6 ? 1 : 2);
        const int tsel = wave < 6 ? wave % 3 : (wave - 6) * 2;
        const int ib = tsel >= 1 ? 1 : 0, jb = tsel == 2 ? 1 : 0;
        const int r32 = lane & 31, hh = lane >> 5;
        f32x16 acc;
#pragma unroll
        for (int i = 0; i < 16; ++i) acc[i] = 0.f;
        {
            const LAS unsigned char* At = (kind == 0 ? KT : QT) + (32 * ib + r32) * 272 + hh * 16;
            const LAS unsigned char* Bt = (kind == 2 ? QT : KT) + (32 * jb + r32) * 272 + hh * 16;
#pragma unroll
            for (int s = 0; s < 8; ++s) { const bf16x8 a = *(const LAS bf16x8*)(At + s * 32), bb = *(const LAS bf16x8*)(Bt + s * 32); acc = __builtin_amdgcn_mfma_f32_32x32x16_bf16(a, bb, acc, 0, 0, 0); }
        }
        if ((kind == 0 || kind == 2) && ib == jb) {
            if (((r32 >> 2) & 1) == hh) {
                const int rsel = (r32 & 3) + 4 * (r32 >> 3); float v = 0.f;
#pragma unroll
                for (int i = 0; i < 16; ++i) v = (i == rsel) ? acc[i] : v;
                (kind == 0 ? nk2 : nq2)[32 * ib + r32] = v;
            }
        }
        LBAR();
        P2T(3);
        {
            const int j = 32 * jb + r32; const float gj = gcs[j], rkj = rsqrtf(nk2[j] + EPS);
#pragma unroll
            for (int reg = 0; reg < 16; ++reg) {
                const int iu = 32 * ib + (reg & 3) + 8 * (reg >> 2), i = iu + 4 * hh;
                const float dec = __expf(fminf(gcs[i] - gj, 0.f));
                if (kind == 0) { const float v = (j < i) ? acc[reg] * betas[i] * rsqrtf(nk2[i] + EPS) * rkj * dec : 0.f; LS[i * 64 + (j & 15) * 4 + (j >> 4)] = -v; }
                else if (kind == 1) { const float v = (j <= i) ? acc[reg] * rsqrtf(nq2[i] + EPS) * 0.08838834764831845f * rkj * dec : 0.f; *(LAS unsigned short*)(QKT + i * 144 + j * 2) = (unsigned short)f2bf(v); }
            }
            if (wave == 7) {
                const float rk = rsqrtf(nk2[lane] + EPS), rq = rsqrtf(nq2[lane] + EPS), gi = gcs[lane], eg = __expf(gi);
                sc_w[lane] = betas[lane] * rk * eg; sc_kd[lane] = rk * __expf(gcs[63] - gi); sc_qd[lane] = rq * 0.08838834764831845f * eg;
            }
            if (kind == 2 && tsel == 0) {
#pragma unroll
                for (int reg = 0; reg < 16; ++reg) { const int i = (reg & 3) + 8 * (reg >> 2) + 4 * hh; *(LAS unsigned short*)(QKT + i * 144 + (32 + r32) * 2) = 0; }
            }
        }
        LBAR();
        P2T(4);
        const float gl = gcs[63];
#if SOLVE2
        if (grp == 2) {
            f32x2 X[64];
#pragma unroll
            for (int i = 0; i < 64; ++i) { X[i].x = bf2f(*(const LAS unsigned short*)(KT + i * 272 + c * 2)); X[i].y = y[i]; }
            SolveRow2<0>::run(X, LS, sc_w, betas);
#pragma unroll
            for (int i = 0; i < 64; ++i) *(LAS unsigned short*)(QT + i * 272 + c * 2) = (unsigned short)f2bf(-X[i].x);
            const __amdgpu_buffer_rsrc_t rit = mk_rsrc(item, (unsigned)GDN_ITEM);
            const int et = c >> 4, r = c & 15;
#pragma unroll
            for (int i4 = 0; i4 < 16; ++i4) { const int ct = i4 >> 2, q = i4 & 3;
                u32x2 o; o.x = pk2(X[4 * i4 + 0].y, X[4 * i4 + 1].y); o.y = pk2(X[4 * i4 + 2].y, X[4 * i4 + 3].y);
                buf_st_b64(rit, (unsigned)((((et >> 1) * 64 + r) * 2 + (et & 1)) * 8), (unsigned)(GI_UFR + (ct * 4 * 64 + q * 16) * 16), o); }
#else
        if (grp == 1 || grp == 2) solve64(y, LS, grp == 1 ? sc_w : betas);
        if (grp == 1) {
#pragma unroll
            for (int i = 0; i < 64; ++i) *(LAS unsigned short*)(QT + i * 272 + c * 2) = (unsigned short)f2bf(-y[i]);
        } else if (grp == 2) {
            const __amdgpu_buffer_rsrc_t rit = mk_rsrc(item, (unsigned)GDN_ITEM);
            const int et = c >> 4, r = c & 15;
#pragma unroll
            for (int i4 = 0; i4 < 16; ++i4) { const int ct = i4 >> 2, q = i4 & 3;
                u32x2 o; o.x = pk2(y[4 * i4 + 0], y[4 * i4 + 1]); o.y = pk2(y[4 * i4 + 2], y[4 * i4 + 3]);
                buf_st_b64(rit, (unsigned)((((et >> 1) * 64 + r) * 2 + (et & 1)) * 8), (unsigned)(GI_UFR + (ct * 4 * 64 + q * 16) * 16), o); }
#endif
        } else if (grp == 0) {
#pragma unroll
            for (int i = 0; i < 64; ++i) *(LAS unsigned short*)(QDT + i * 272 + c * 2) = (unsigned short)f2bf(y[i] * sc_qd[i]);
        }
        LBAR();
        P2T(5);
        if (it + F.G < 1024) P2_PREFETCH(it + F.G);
        {
            const __amdgpu_buffer_rsrc_t rit = mk_rsrc(item, (unsigned)GDN_ITEM);
#pragma unroll
            for (int u = 0; u < 2; ++u) { const int cid = tid + 512 * u, ln = cid & 63, r = ln & 15, q = ln >> 4;
                { const int ct = cid >> 8, sx = (cid >> 6) & 3;
                  const v4u v = *(const LAS v4u*)(QT + (16 * ct + r) * 272 + (32 * sx + 8 * q) * 2);
                  buf_st_b128(rit, (unsigned)cid * 16u, (unsigned)GI_WNEG, v); }
                { const int dt = cid >> 7, sx = (cid >> 6) & 1; float kd[8];
#pragma unroll
                  for (int j = 0; j < 8; ++j) { const int cc = 32 * sx + 8 * q + j; kd[j] = bf2f(*(const LAS unsigned short*)(KT + cc * 272 + (16 * dt + r) * 2)) * sc_kd[cc]; }
                  v4u o; o.x = pk2(kd[0], kd[1]); o.y = pk2(kd[2], kd[3]); o.z = pk2(kd[4], kd[5]); o.w = pk2(kd[6], kd[7]);
                  buf_st_b128(rit, (unsigned)cid * 16u, (unsigned)GI_KDT, o); }
                { const int r32c = ln & 31, hhc = ln >> 5, ct2 = cid >> 9, sx = (cid >> 6) & 7;
                  const v4u v = *(const LAS v4u*)(QDT + (32 * ct2 + r32c) * 272 + (16 * sx + 8 * hhc) * 2);
                  buf_st_b128(rit, (unsigned)cid * 16u, (unsigned)GI_QD, v); }
                if (u == 0) { const int r32c = ln & 31, hhc = ln >> 5, ct2 = cid >> 8, sx = (cid >> 6) & 3;
                  const v4u v = *(const LAS v4u*)(QKT + (32 * ct2 + r32c) * 144 + (16 * sx + 8 * hhc) * 2);
                  buf_st_b128(rit, (unsigned)cid * 16u, (unsigned)GI_QK, v); }
            }
        }
        if (tid == 0) ((float*)(P.ws + gt_off))[it] = __expf(gl);
        LBAR();
        P2T(6);
    }
#if defined(P2_TSTAGE)
    if (blockIdx.x == 0 && wave == 0 && lane_now() == 0) { __hip_atomic_store((unsigned*)(P.ws + WS_CTL) + 2304, 0u, __ATOMIC_RELAXED, __HIP_MEMORY_SCOPE_AGENT); __hip_atomic_store((unsigned*)(P.ws + WS_CTL) + 2305, p2t_a, __ATOMIC_RELAXED, __HIP_MEMORY_SCOPE_AGENT); }
#endif
}
#undef P2_PREFETCH

template <int ROT, int LS_OFF, int AR_OFF, int QT_OFF, int KT_OFF> struct P2S {
    static __device__ __forceinline__ int wv(const Frame& F) { return (F.wave + ROT) & 7; }
    static __device__ __forceinline__ LAS unsigned char* QT(const Frame& F) { unsigned o = QT_OFF; asm volatile("" : "+v"(o)); return F.lds + o; }
    static __device__ __forceinline__ LAS unsigned char* KT(const Frame& F) { unsigned o = KT_OFF; asm volatile("" : "+v"(o)); return F.lds + o; }
    static __device__ __forceinline__ LAS float* LS(const Frame& F) { return (LAS float*)(F.lds + LS_OFF); }
    static __device__ __forceinline__ LAS float* AR(const Frame& F) { return (LAS float*)(F.lds + AR_OFF); }

    static __device__ __forceinline__ void s1(Frame& F, const Ptrs& P, int it, float (&ys)[64]) {
        const int w = wv(F), grp = w >> 1, lane = lane_now(), c = ((w & 1) << 6) | lane;
        const int bh = it >> 7, n = it & 127, b = bh >> 2, h = bh & 3; const size_t m0 = (size_t)b * SEQ + (size_t)n * 64;
        const bf16* QKVZ = (const bf16*)(P.ws + WS_QKVZ); const float* AB = (const float*)(P.ws + WS_AB);
        if (grp < 3) {
            const int col = grp * 512 + h * 128 + c;
            const float w0 = P.w_conv_qkv[0 * 1536 + col], w1 = P.w_conv_qkv[1 * 1536 + col], w2 = P.w_conv_qkv[2 * 1536 + col], w3 = P.w_conv_qkv[3 * 1536 + col];
            const __amdgpu_buffer_rsrc_t rs = mk_rsrc(QKVZ + (size_t)b * SEQ * 2048, (unsigned)SEQ * 2048u * 2u);
            LAS unsigned char* tile = grp == 0 ? QT(F) : KT(F);
#pragma unroll
            for (int hf = 0; hf < 2; ++hf) {
                float xr[35];
#pragma unroll
                for (int j = 0; j < 35; ++j) { const int t = n * 64 + 32 * hf + j - 3; xr[j] = (hf > 0 || j >= 3 || t >= 0) ? buf_ld_bf16(rs, (unsigned)col * 2u, (unsigned)t * 4096u) : 0.f; }
#pragma unroll
                for (int i = 0; i < 32; ++i) { const float sv = fsilu(fmaf(w3, xr[i + 3], fmaf(w2, xr[i + 2], fmaf(w1, xr[i + 1], w0 * xr[i]))));
                    if (grp < 2) *(LAS unsigned short*)(tile + (32 * hf + i) * 272 + c * 2) = (unsigned short)f2bf(sv); else ys[32 * hf + i] = sv; }
            }
        }
        if (w == 7) {
            LAS float* gcs = AR(F); LAS float* betas = gcs + 64;
            const float araw = AB[(m0 + lane) * 8 + 4 + h], braw = AB[(m0 + lane) * 8 + h];
            const float xx = araw + P.dt_bias[h];
            const float sp = (xx > 20.f) ? xx : log1pf(expf(xx));
            float g = -expf(P.a_log[h]) * sp;
#pragma unroll
            for (int off = 1; off < 64; off <<= 1) { const float t = __shfl_up(g, off); if (lane >= off) g += t; }
            gcs[lane] = g; betas[lane] = 1.f / (1.f + expf(-braw));
        }
    }
    static __device__ __forceinline__ void s2(Frame& F, f32x16& acc) {
        const int w = wv(F), lane = lane_now(), r32 = lane & 31, hh = lane >> 5;
        const int kind = w < 3 ? 0 : (w < 6 ? 1 : 2), tsel = w < 6 ? w % 3 : (w - 6) * 2, ib = tsel >= 1 ? 1 : 0, jb = tsel == 2 ? 1 : 0;
        LAS float* nk2 = AR(F) + 128; LAS float* nq2 = AR(F) + 192;
#pragma unroll
        for (int i = 0; i < 16; ++i) acc[i] = 0.f;
        const LAS unsigned char* At = (kind == 0 ? KT(F) : QT(F)) + (32 * ib + r32) * 272 + hh * 16;
        const LAS unsigned char* Bt = (kind == 2 ? QT(F) : KT(F)) + (32 * jb + r32) * 272 + hh * 16;
#pragma unroll
        for (int s = 0; s < 8; ++s) { const bf16x8 a = *(const LAS bf16x8*)(At + s * 32), bb = *(const LAS bf16x8*)(Bt + s * 32); acc = __builtin_amdgcn_mfma_f32_32x32x16_bf16(a, bb, acc, 0, 0, 0); }
        if ((kind == 0 || kind == 2) && ib == jb) {
            if (((r32 >> 2) & 1) == hh) {
                const int rsel = (r32 & 3) + 4 * (r32 >> 3); float v = 0.f;
#pragma unroll
                for (int i = 0; i < 16; ++i) v = (i == rsel) ? acc[i] : v;
                (kind == 0 ? nk2 : nq2)[32 * ib + r32] = v;
            }
        }
    }
    static __device__ __forceinline__ void s3(Frame& F, const Ptrs& P, int it, const f32x16& acc, const size_t gdn_off) {
        const int w = wv(F), lane = lane_now(), r32 = lane & 31, hh = lane >> 5;
        const int kind = w < 3 ? 0 : (w < 6 ? 1 : 2), tsel = w < 6 ? w % 3 : (w - 6) * 2, ib = tsel >= 1 ? 1 : 0, jb = tsel == 2 ? 1 : 0;
        LAS float* gcs = AR(F); LAS float* betas = gcs + 64; LAS float* nk2 = gcs + 128; LAS float* nq2 = gcs + 192; LAS float* sc_w = gcs + 256; LAS float* sc_kd = gcs + 320; LAS float* sc_qd = gcs + 384;
        LAS float* Ls = LS(F);
        unsigned char* item = P.ws + gdn_off + (size_t)it * GDN_ITEM;
        const int j = 32 * jb + r32; const float gj = gcs[j], rkj = rsqrtf(nk2[j] + EPS);
        const __amdgpu_buffer_rsrc_t rqk = mk_rsrc(item + GI_QK, 8192u);
        const unsigned vqk = (unsigned)(((j >> 4) * 64 + 32 * ((j >> 3) & 1)) * 16 + (j & 7) * 2 + 64 * hh);
#pragma unroll
        for (int reg = 0; reg < 16; ++reg) {
            const int iu = 32 * ib + (reg & 3) + 8 * (reg >> 2), i = iu + 4 * hh;
            const float dec = __expf(fminf(gcs[i] - gj, 0.f));
            if (kind == 0) { const float v = (j < i) ? acc[reg] * betas[i] * rsqrtf(nk2[i] + EPS) * rkj * dec : 0.f; Ls[i * 64 + j] = -v; }
            else if (kind == 1) { const float v = (j <= i) ? acc[reg] * rsqrtf(nq2[i] + EPS) * 0.08838834764831845f * rkj * dec : 0.f; buf_st_bf16(rqk, vqk, (unsigned)((iu >> 5) * 4096 + (iu & 31) * 16), v); }
        }
        if (w == 7) {
            const float rk = rsqrtf(nk2[lane] + EPS), rq = rsqrtf(nq2[lane] + EPS), gi = gcs[lane], eg = __expf(gi);
            sc_w[lane] = betas[lane] * rk * eg; sc_kd[lane] = rk * __expf(gcs[63] - gi); sc_qd[lane] = rq * 0.08838834764831845f * eg;
        }
        if (kind == 2 && tsel == 0) {
#pragma unroll
            for (int reg = 0; reg < 16; ++reg) { const int iu = (reg & 3) + 8 * (reg >> 2); const int jz = 32 + r32;
                buf_st_bf16(rqk, (unsigned)(((jz >> 4) * 64 + 32 * ((jz >> 3) & 1)) * 16 + (jz & 7) * 2 + 64 * hh), (unsigned)(iu * 16), 0.f); }
        }
        if ((w >> 1) == 0) {
            const int c = ((w & 1) << 6) | lane;
            const __amdgpu_buffer_rsrc_t rit = mk_rsrc(item, (unsigned)GDN_ITEM);
            const unsigned vqd = (unsigned)(((c >> 4) * 64 + 32 * ((c >> 3) & 1)) * 16 + (c & 7) * 2);
#pragma unroll
            for (int i = 0; i < 64; ++i) { const float q = bf2f(*(const LAS unsigned short*)(QT(F) + i * 272 + c * 2));
                buf_st_bf16(rit, vqd, (unsigned)(GI_QD + (i >> 5) * 8192 + (i & 31) * 16), q * rsqrtf(nq2[i] + EPS) * 0.08838834764831845f * __expf(gcs[i])); }
        }
    }
    static __device__ __forceinline__ void s4v(Frame& F, const Ptrs& P, int it, float (&ys)[64], const size_t gdn_off) {
        const int w = wv(F), grp = w >> 1, lane = lane_now(), c = ((w & 1) << 6) | lane;
        if (grp == 2) {
            LAS float* betas = AR(F) + 64;
            unsigned char* item = P.ws + gdn_off + (size_t)it * GDN_ITEM;
            SolveRow<0>::run(ys, LS(F), betas);
            const __amdgpu_buffer_rsrc_t rit = mk_rsrc(item, (unsigned)GDN_ITEM);
            const int et = c >> 4, r = c & 15;
#pragma unroll
            for (int i4 = 0; i4 < 16; ++i4) { const int ct = i4 >> 2, q = i4 & 3;
                u32x2 o; o.x = pk2(ys[4 * i4 + 0], ys[4 * i4 + 1]); o.y = pk2(ys[4 * i4 + 2], ys[4 * i4 + 3]);
                buf_st_b64(rit, (unsigned)((((et >> 1) * 64 + r) * 2 + (et & 1)) * 8), (unsigned)(GI_UFR + (ct * 4 * 64 + q * 16) * 16), o); }
        }
    }
    static __device__ __forceinline__ void s4k(Frame& F) {
        const int w = wv(F), grp = w >> 1, lane = lane_now(), c = ((w & 1) << 6) | lane;
        if (grp == 1) {
            LAS float* sc_w = AR(F) + 256;
            float yk[64];
#pragma unroll
            for (int i = 0; i < 64; ++i) yk[i] = bf2f(*(const LAS unsigned short*)(KT(F) + i * 272 + c * 2));
            SolveRow<0>::run(yk, LS(F), sc_w);
#pragma unroll
            for (int i = 0; i < 64; ++i) *(LAS unsigned short*)(QT(F) + i * 272 + c * 2) = (unsigned short)f2bf(-yk[i]);
        }
    }
    static __device__ __forceinline__ void s5(Frame& F, const Ptrs& P, int it, const size_t gdn_off, const size_t gt_off) {
        const int lane = lane_now(), tid = F.wave * 64 + lane;
        LAS float* gcs = AR(F); LAS float* sc_kd = gcs + 320;
        unsigned char* item = P.ws + gdn_off + (size_t)it * GDN_ITEM;
        const __amdgpu_buffer_rsrc_t rit = mk_rsrc(item, (unsigned)GDN_ITEM);
#if XCHK
        v4u okeep[2];
#endif
#pragma unroll
        for (int u = 0; u < 2; ++u) { const int cid = tid + 512 * u, ln = cid & 63, r = ln & 15, q = ln >> 4;
            { const int ct = cid >> 8, sx = (cid >> 6) & 3;
              const v4u v = *(const LAS v4u*)(QT(F) + (16 * ct + r) * 272 + (32 * sx + 8 * q) * 2);
              buf_st_b128(rit, (unsigned)cid * 16u, (unsigned)GI_WNEG, v); }
            { const int dt = cid >> 7, sx = (cid >> 6) & 1; float kd[8];
#pragma unroll
              for (int j = 0; j < 8; ++j) { const int cc = 32 * sx + 8 * q + j; kd[j] = bf2f(*(const LAS unsigned short*)(KT(F) + cc * 272 + (16 * dt + r) * 2)) * sc_kd[cc]; }
              v4u o; o.x = pk2(kd[0], kd[1]); o.y = pk2(kd[2], kd[3]); o.z = pk2(kd[4], kd[5]); o.w = pk2(kd[6], kd[7]);
              buf_st_b128(rit, (unsigned)cid * 16u, (unsigned)GI_KDT, o);
#if XCHK
              okeep[u] = o;
#endif
            }
        }
#if XCHK
        LBAR();
        {
            unsigned bad = 0;
#pragma unroll
            for (int u = 0; u < 2; ++u) { const int cid = tid + 512 * u, ln = cid & 63, r = ln & 15, q = ln >> 4; const int dt = cid >> 7, sx = (cid >> 6) & 1; float kd[8];
#pragma unroll
              for (int j = 0; j < 8; ++j) { const int cc = 32 * sx + 8 * q + j; kd[j] = bf2f(*(const LAS unsigned short*)(KT(F) + cc * 272 + (16 * dt + r) * 2)) * sc_kd[cc]; }
              v4u o; o.x = pk2(kd[0], kd[1]); o.y = pk2(kd[2], kd[3]); o.z = pk2(kd[4], kd[5]); o.w = pk2(kd[6], kd[7]);
              bad |= (o.x != okeep[u].x) | (o.y != okeep[u].y) | (o.z != okeep[u].z) | (o.w != okeep[u].w); }
            if (bad) __hip_atomic_fetch_add((unsigned*)(P.ws + WS_CTL) + CK_P2 + 8, 1u, __ATOMIC_RELAXED, __HIP_MEMORY_SCOPE_AGENT);
        }
#endif
        if (tid == 0) ((float*)(P.ws + gt_off))[it] = __expf(gcs[63]);
#if XCHK
        if (gt_off == WS_GT) {
            if (tid < 64) __hip_atomic_fetch_add((unsigned*)(P.ws + WS_CTL) + CK_P2 + 6, __float_as_uint(sc_kd[tid]) * 17u + (unsigned)(tid + it * 7), __ATOMIC_RELAXED, __HIP_MEMORY_SCOPE_AGENT);
            unsigned acc = 0; for (int i = tid; i < 64 * 64; i += 512) { const int rr = i >> 6, cw = i & 63; acc += *(const LAS unsigned*)(KT(F) + rr * 272 + cw * 4) * 19u + (unsigned)(i + it * 3); }
            __hip_atomic_fetch_add((unsigned*)(P.ws + WS_CTL) + CK_P2 + 7, acc, __ATOMIC_RELAXED, __HIP_MEMORY_SCOPE_AGENT);
        }
#endif
    }
};
__device__ __forceinline__ void p2_gdn_prep_dual(Frame& F, const Ptrs& P, const size_t gdn_off = WS_GDN, const size_t gt_off = WS_GT) {
    typedef P2S<0, 0, 32768, 36864, 54272> A; typedef P2S<4, 16384, 34816, 71680, 89088> B;
    for (int it = F.vcu; it < 1024; it += 2 * F.G) {
        const int itB = it + F.G;
        float ys[64]; f32x16 accA, accB;
        A::s1(F, P, it, ys); B::s1(F, P, itB, ys);
        LBAR();
        A::s2(F, accA); B::s2(F, accB);
        LBAR();
        A::s3(F, P, it, accA, gdn_off); B::s3(F, P, itB, accB, gdn_off);
        LBAR();
        A::s4v(F, P, it, ys, gdn_off); B::s4v(F, P, itB, ys, gdn_off);
        A::s4k(F); B::s4k(F);
        LBAR();
        A::s5(F, P, it, gdn_off, gt_off);
#if S5BAR
        LBAR();
#endif
        B::s5(F, P, itB, gdn_off, gt_off);
        LBAR();
    }
}

#ifndef P2_DUAL
#define P2_DUAL 0
#endif
#ifndef DTEST
#define DTEST 0
#endif
constexpr int CW_DT = 2048;
__device__ __forceinline__ void p2_dtest(Frame& F, const Ptrs& P) {
    const int lane = lane_now(), tid = F.wave * 64 + lane;
    for (int i = tid; i < 131072 / 4; i += NWAVES * 64) ((LAS unsigned*)F.lds)[i] = 0x7fc12345u ^ (unsigned)(i * 2654435761u);
    __syncthreads();
    const size_t off2 = 354 * MiB, gt2 = 434 * MiB;
#if P2_DUAL
    p2_gdn_prep_dual(F, P, off2, gt2);
#else
    p2_gdn_prep(F, P, off2, gt2);
#endif
    asm volatile("s_waitcnt vmcnt(0)" ::: "memory"); __syncthreads();
    unsigned bad = 0;
    for (int it = F.vcu; it < 1024; it += F.G) {
        const GAS v4u* a = (const GAS v4u*)(P.ws + WS_GDN + (size_t)it * GDN_ITEM); const GAS v4u* b = (const GAS v4u*)(P.ws + off2 + (size_t)it * GDN_ITEM);
        for (int c = tid; c < (int)(GDN_ITEM / 16); c += NWAVES * 64) { const v4u x = a[c], y = b[c]; const bool ne = (x.x != y.x) | (x.y != y.y) | (x.z != y.z) | (x.w != y.w);
            const int reg = c < 1024 ? 0 : (c < 2048 ? 1 : (c < 3072 ? 2 : (c < 4096 ? 3 : 4)));
            if (ne) bad |= 1u << reg; }
        if (tid == 0 && __float_as_uint(((const float*)(P.ws + WS_GT))[it]) != __float_as_uint(((const float*)(P.ws + gt2))[it])) bad |= 1u << 5;
    }
    if (bad) __hip_atomic_fetch_or((unsigned*)(P.ws + WS_CTL) + CW_DT, bad, __ATOMIC_RELAXED, __HIP_MEMORY_SCOPE_AGENT);
}

__device__ __forceinline__ void xchk_sum(Frame& F, const Ptrs& P, const unsigned char* base, size_t bytes, int ckword) {
    const int lane = lane_now(); const size_t nthr = (size_t)F.G * NWAVES * 64, t0 = (size_t)F.vcu * NWAVES * 64 + F.wave * 64 + lane;
    unsigned acc = 0; const GAS v4u* p4 = (const GAS v4u*)base;
    for (size_t i = t0; i < bytes / 16; i += nthr) { const v4u v = p4[i]; acc += v.x * 3u + v.y * 5u + v.z * 7u + v.w * 11u + (unsigned)i; }
    acc = (unsigned)wave_sum_f(0.f) + acc;
    __hip_atomic_fetch_add((unsigned*)(P.ws + WS_CTL) + ckword, acc, __ATOMIC_RELAXED, __HIP_MEMORY_SCOPE_AGENT);
}
constexpr int SCAN_DIST = 6;
#ifndef SCAN_WARM_AHEAD
#define SCAN_WARM_AHEAD 18
#endif
#ifndef SCAN_WARM
#define SCAN_WARM 0
#endif
constexpr int NWARM = SCAN_WARM ? 8 : 0;
template <int ROLE>
__device__ __forceinline__ void p3_scan_role(Frame& F, const Ptrs& P, int blk) {
    LAS unsigned char* ST = F.lds; LAS unsigned char* VT = F.lds + 8704;
    const int bh = blk & 7, es = blk >> 3;
    const int lane = lane_now(), wave = F.wave, r = lane & 15, q = lane >> 4, tid = wave * 64 + lane;
    const int dt = wave;
    for (int i = tid; i < 8704 / 4; i += NWAVES * 64) ((LAS unsigned*)ST)[i] = 0u;
    f32x4 sacc[2] = {(f32x4){0.f, 0.f, 0.f, 0.f}, (f32x4){0.f, 0.f, 0.f, 0.f}};
    const float* GT = (const float*)(P.ws + WS_GT);
    const unsigned char* item0 = P.ws + WS_GDN + (size_t)(bh * 128) * GDN_ITEM;
#define SCAN_LOAD(n_, wA_, kA_, uC_, gt_) do { const unsigned char* itp = item0 + (size_t)(n_) * GDN_ITEM; \
        if constexpr (ROLE < 2) { _Pragma("unroll") for (int s = 0; s < 4; ++s) wA_[s] = *(const GAS bf16x8*)(itp + GI_WNEG + ((wave * 4 + s) * 64 + lane) * 16); \
            uC_ = *(const GAS v4u*)(itp + GI_UFR + ((size_t)((wave * 4 + es) * 64 + lane)) * 16); } \
        _Pragma("unroll") for (int s = 0; s < 2; ++s) kA_[s] = *(const GAS bf16x8*)(itp + GI_KDT + ((dt * 2 + s) * 64 + lane) * 16); \
        } while (0)
#define SCAN_STEP(n_, wA_, kA_, uC_, unused_) do { __builtin_amdgcn_sched_barrier(0);   \
        if constexpr (ROLE < 2) { v4u o4; \
            _Pragma("unroll") for (int t = 0; t < 2; ++t) { const unsigned u0 = t ? uC_.z : uC_.x, u1 = t ? uC_.w : uC_.y; \
                f32x4 acc; acc.x = __uint_as_float(u0 << 16); acc.y = __uint_as_float(u0 & 0xffff0000u); acc.z = __uint_as_float(u1 << 16); acc.w = __uint_as_float(u1 & 0xffff0000u); \
                _Pragma("unroll") for (int s = 0; s < 4; ++s) { const bf16x8 sf = *(const LAS bf16x8*)(ST + (16 * t + r) * 272 + (32 * s + 8 * q) * 2); acc = __builtin_amdgcn_mfma_f32_16x16x32_bf16(wA_[s], sf, acc, 0, 0, 0); } \
                u32x2 o; o.x = pk2(acc.x, acc.y); o.y = pk2(acc.z, acc.w); \
                *(LAS u32x2*)(VT + (16 * t + r) * 144 + (16 * wave + 4 * q) * 2) = o; \
                if (t == 0) { o4.x = o.x; o4.y = o.y; } else { o4.z = o.x; o4.w = o.y; } } \
            __builtin_amdgcn_raw_buffer_store_b128(o4, rvn, (int)(((wave * 4 + es) * 64 + lane) * 16 + (bh * 128 + (n_)) * 16384), 0, 16  ); } \
        LBAR(); \
        const float gt_ = GTL[n_]; \
        _Pragma("unroll") for (int t = 0; t < 2; ++t) { sacc[t] = sacc[t] * gt_; \
            _Pragma("unroll") for (int s = 0; s < 2; ++s) { const bf16x8 vf = *(const LAS bf16x8*)(VT + (16 * t + r) * 144 + (32 * s + 8 * q) * 2); sacc[t] = __builtin_amdgcn_mfma_f32_16x16x32_bf16(kA_[s], vf, sacc[t], 0, 0, 0); } } \
        { v4u o4; \
        _Pragma("unroll") for (int t = 0; t < 2; ++t) { u32x2 o; o.x = pk2(sacc[t].x, sacc[t].y); o.y = pk2(sacc[t].z, sacc[t].w); \
            *(LAS u32x2*)(ST + (16 * t + r) * 272 + (16 * dt + 4 * q) * 2) = o; \
            if (t == 0) { o4.x = o.x; o4.y = o.y; } else { o4.z = o.x; o4.w = o.y; } } \
        __builtin_amdgcn_raw_buffer_store_b128(o4, rsn, (int)(((dt * 4 + es) * 64 + lane) * 16 + (bh * 128 + (((n_) + 1) & 127)) * 32768), 0, 16  ); }   \
        SCAN_LOAD(((n_) + SCAN_DIST) & 127, wA_, kA_, uC_, 0);   \
        LBAR(); \
          \
        if constexpr (ROLE == 0) __builtin_amdgcn_raw_buffer_store_b32((unsigned)((n_) - SCAN_DIST), rprog, (lane == 0 && (n_) >= SCAN_DIST + 1) ? 0 : 64, 0, 16  );   } while (0)
    const __amdgpu_buffer_rsrc_t rsn = mk_rsrc(P.ws + WS_SN, 32u * 1024u * 1024u), rvn = mk_rsrc(P.ws + WS_VN, 16u * 1024u * 1024u);
    unsigned* prog = (unsigned*)(P.ws + WS_CTL) + CW_PROG + bh * 64 + es;
    const __amdgpu_buffer_rsrc_t rprog = mk_rsrc(prog, 4u);
    LAS float* GTL = (LAS float*)(F.lds + 13312);
    if (tid < 128) GTL[tid] = GT[bh * 128 + tid];
    bf16x8 wA0[4], kA0[2]; v4u uC0;
    bf16x8 wA1[4], kA1[2]; v4u uC1;
    bf16x8 wA2[4], kA2[2]; v4u uC2;
    bf16x8 wA3[4], kA3[2]; v4u uC3;
    bf16x8 wA4[4], kA4[2]; v4u uC4;
    bf16x8 wA5[4], kA5[2]; v4u uC5;
    SCAN_LOAD(0, wA0, kA0, uC0, 0);
    SCAN_LOAD(1, wA1, kA1, uC1, 0);
    SCAN_LOAD(2, wA2, kA2, uC2, 0);
    SCAN_LOAD(3, wA3, kA3, uC3, 0);
    SCAN_LOAD(4, wA4, kA4, uC4, 0);
    SCAN_LOAD(5, wA5, kA5, uC5, 0);
    LBAR();
    SCAN_STEP(0, wA0, kA0, uC0, 0);
    SCAN_STEP(1, wA1, kA1, uC1, 0);
    SCAN_STEP(2, wA2, kA2, uC2, 0);
    SCAN_STEP(3, wA3, kA3, uC3, 0);
    SCAN_STEP(4, wA4, kA4, uC4, 0);
    SCAN_STEP(5, wA5, kA5, uC5, 0);
    for (int n = 6; n < 126; n += 6) {
#if defined(TPROBE_B) && TPROBE_B == 26
        if constexpr (ROLE == 0) { if (n == 60 && blockIdx.x == 0 && lane == 0) __hip_atomic_store((unsigned*)(P.ws + WS_CTL) + 2305, (unsigned)rt(), __ATOMIC_RELAXED, __HIP_MEMORY_SCOPE_AGENT); }
#endif
        SCAN_STEP(n, wA0, kA0, uC0, 0);
        SCAN_STEP(n + 1, wA1, kA1, uC1, 0);
        SCAN_STEP(n + 2, wA2, kA2, uC2, 0);
        SCAN_STEP(n + 3, wA3, kA3, uC3, 0);
        SCAN_STEP(n + 4, wA4, kA4, uC4, 0);
        SCAN_STEP(n + 5, wA5, kA5, uC5, 0);
    }
    SCAN_STEP(126, wA0, kA0, uC0, 0);
    SCAN_STEP(127, wA1, kA1, uC1, 0);
#undef SCAN_LOAD
#undef SCAN_STEP
    asm volatile("s_waitcnt vmcnt(0)" ::: "memory");
    LBAR();
    if (tid == 0) __hip_atomic_store(prog, 128u, __ATOMIC_RELAXED, __HIP_MEMORY_SCOPE_AGENT);
}
__device__ __forceinline__ void p3_scan(Frame& F, const Ptrs& P, int blk) {
    if (F.wave == 0) p3_scan_role<0>(F, P, blk); else if (F.wave < 4) p3_scan_role<1>(F, P, blk); else p3_scan_role<2>(F, P, blk);
}

#ifndef P4_POLL_SLEEP
#define P4_POLL_SLEEP 24
#endif
__device__ __forceinline__ unsigned scan_poll4(const unsigned* pg) {
    const v4u w = __builtin_amdgcn_raw_buffer_load_b128(mk_rsrc(pg, 16u), 0, 0, 16  );
    const unsigned a = w.x < w.y ? w.x : w.y, b = w.z < w.w ? w.z : w.w;
    return (unsigned)__builtin_amdgcn_readfirstlane(a < b ? a : b);
}
__device__ __forceinline__ void p3_scan_warm(Frame& F, const Ptrs& P, int bh) {
    const unsigned* pg = (const unsigned*)(P.ws + WS_CTL) + CW_PROG + bh * 64;
    const unsigned char* item0 = P.ws + WS_GDN + (size_t)(bh * 128) * GDN_ITEM;
    const int tid = F.wave * 64 + lane_now();
    int nx = 2 * SCAN_DIST;
    unsigned acc = 0, t0 = 0, t1 = 0, t2 = 0, t3 = 0;
    const bool act = tid < 384;
    for (unsigned spins = 0; nx < 128 && spins < (1u << 22); ++spins) {
        unsigned mn = scan_poll4(pg);
        acc += t0 + t1 + t2 + t3;
        int tgt = (int)mn + SCAN_WARM_AHEAD; tgt = tgt > 128 ? 128 : tgt;
        if (nx < (int)mn + 2 * SCAN_DIST) nx = (int)mn + 2 * SCAN_DIST;
        if (nx >= tgt) { __builtin_amdgcn_s_sleep(8); continue; }
        const unsigned char* ip = item0 + (size_t)nx * GDN_ITEM + tid * 128;
        const int k = tgt - nx;
        if (act) { t0 = *(const volatile unsigned*)ip;
            if (k > 1) t1 = *(const volatile unsigned*)(ip + GDN_ITEM);
            if (k > 2) t2 = *(const volatile unsigned*)(ip + 2 * GDN_ITEM);
            if (k > 3) t3 = *(const volatile unsigned*)(ip + 3 * GDN_ITEM); }
        nx += k > 4 ? 4 : k;
    }
    acc += t0 + t1 + t2 + t3;
    if (acc == 0x9E3779B9u) F.MISC[15] = acc;
}

struct ConfTaps { float w[CWID]; float bias, lg, lb; };
__device__ __forceinline__ void p3_conf_load_taps(const Ptrs& P, int ch, ConfTaps& T) {
#pragma unroll
    for (int k = 0; k < CWID; ++k) T.w[k] = P.w_conv_dw[k * CCH + ch];
    T.bias = P.b_conv_dw[ch]; T.lg = P.ln_g[ch]; T.lb = P.ln_b[ch];
}
__device__ __forceinline__ void p3_conf_tile(Frame& F, const Ptrs& P, int tile, const ConfTaps& T) {
    LAS float* part = (LAS float*)F.lds; LAS float* stat = (LAS float*)(F.lds + 2048);
    LAS unsigned char* UT = F.lds + 4096; LAS unsigned char* OT = F.lds + 67584;
    const unsigned char* U = P.ws + WS_U; unsigned char* MIX = P.ws + WS_MIX;
    const int lane = lane_now(), ch = F.wave * 64 + lane; const size_t m0 = (size_t)tile * 32; const int t0 = (int)(m0 % SEQ);
#pragma unroll
    for (int u = 0; u < 8; ++u) { const int cid = ch + 512 * u; if (cid < 62 * 64) { const int row = cid >> 6, t = t0 - 30 + row;
        v4u v = {0u, 0u, 0u, 0u}; if (t >= 0) v = *(const GAS v4u*)(U + ((m0 + row) - 30) * (CCH * 2) + (cid & 63) * 16);
        *(LAS v4u*)(UT + cid * 16) = v; } }
    LBAR();
    float cv[32];
#pragma unroll
    for (int i = 0; i < 32; ++i) cv[i] = T.bias;
    {
        float uu[62];
#pragma unroll
        for (int j = 0; j < 62; ++j) uu[j] = bf2f(*(const LAS unsigned short*)(UT + j * (CCH * 2) + ch * 2));
#pragma unroll
        for (int k = 0; k < CWID; ++k)
#pragma unroll
            for (int i = 0; i < 32; ++i) cv[i] = fmaf(T.w[k], uu[i + k], cv[i]);
    }
#pragma unroll
    for (int i = 0; i < 32; ++i) { const float s1 = wave_sum_f(cv[i]), s2 = wave_sum_f(cv[i] * cv[i]); if (lane == 0) { part[(F.wave * 32 + i) * 2] = s1; part[(F.wave * 32 + i) * 2 + 1] = s2; } }
    LBAR();
    if (ch < 32) { float s1 = 0.f, s2 = 0.f;
#pragma unroll
        for (int w = 0; w < 8; ++w) { s1 += part[(w * 32 + ch) * 2]; s2 += part[(w * 32 + ch) * 2 + 1]; }
        const float mu = s1 * (1.f / CCH); const float var = fmaxf(s2 * (1.f / CCH) - mu * mu, 0.f);
        stat[ch * 2] = mu; stat[ch * 2 + 1] = rsqrtf(var + EPS); }
    LBAR();
#pragma unroll
    for (int i = 0; i < 32; ++i) { const float yv = (cv[i] - stat[i * 2]) * stat[i * 2 + 1] * T.lg + T.lb; *(LAS unsigned short*)(OT + i * (CCH * 2) + ch * 2) = (unsigned short)f2bf(fsilu(yv)); }
    LBAR();
#pragma unroll
    for (int u = 0; u < 4; ++u) { const int cid = ch + 512 * u, row = cid >> 6;
        *(GAS v4u*)(MIX + (m0 + row) * (DM * 2) + 1024 + (cid & 63) * 16) = *(const LAS v4u*)(OT + cid * 16); }
    LBAR();
}

__device__ __forceinline__ void p4_gdn_out(Frame& F, const Ptrs& P, int idx, int cnt) {
    LAS float* ssq = (LAS float*)F.lds;
    const bf16* QKVZ = (const bf16*)(P.ws + WS_QKVZ); bf16* MIX = (bf16*)(P.ws + WS_MIX);
    const int wave = F.wave;
    const int ct2 = wave >> 2, et4 = wave & 3;
    for (int itc = idx; itc < 1024; itc += cnt) {
        const int lane = lane_now();
        const int r32 = lane & 31, hh = lane >> 5;
        const int bh = itc & 7, n = itc >> 3, b = bh >> 2, h = bh & 3, it = bh * 128 + n;
        const size_t m0 = (size_t)b * SEQ + (size_t)n * 64;
        const unsigned char* item = P.ws + WS_GDN + (size_t)it * GDN_ITEM;
        if (wave == 0) {
            const unsigned* pg = (const unsigned*)(P.ws + WS_CTL) + CW_PROG + bh * 64; unsigned spins = 0;
            for (;;) { const unsigned mn = scan_poll4(pg);
                if (mn >= (unsigned)(n + 1) || ++spins > (1u << 22)) break;
                __builtin_amdgcn_s_sleep(P4_POLL_SLEEP); }
            asm volatile("s_waitcnt vmcnt(0)" ::: "memory");
        }
        asm volatile("" ::: "memory"); __builtin_amdgcn_s_barrier(); asm volatile("" ::: "memory");
        f32x16 acc;
#pragma unroll
        for (int i = 0; i < 16; ++i) acc[i] = 0.f;
        const int e = 32 * et4 + r32;
        LAS unsigned char* ZT = F.lds + 4096; LAS unsigned char* OT = F.lds + 4096 + 16384;
        {
            bf16x8 a1[8], b1[8], a2[4], b2[4];
            v4u zc[2];
#pragma unroll
            for (int u = 0; u < 2; ++u) { const int cid = wave * 64 + lane + 512 * u; zc[u] = *(const GAS v4u*)((const unsigned char*)QKVZ + (m0 + (cid >> 4)) * 4096 + (1536 + h * 128) * 2 + (cid & 15) * 16); }
            const unsigned char* Ap = item + GI_QD + ((ct2 * 8) * 64 + lane) * 16;
            const __amdgpu_buffer_rsrc_t rsn4 = mk_rsrc(P.ws + WS_SN + (size_t)it * 32768, 32768u), rvn4 = mk_rsrc(P.ws + WS_VN + (size_t)it * 16384, 16384u);
            const int boff = (((et4 * 64) + (r32 & 15) + 32 * hh) * 2 + (r32 >> 4)) * 8;
            const unsigned char* Ap2 = item + GI_QK + ((ct2 * 4) * 64 + lane) * 16;
            constexpr int BSTEP = 4096, BHI = 256;
            if (n > 0) {
#pragma unroll
                for (int s = 0; s < 8; ++s) { a1[s] = *(const GAS bf16x8*)(Ap + s * 1024);
                    const u32x2 lo = __builtin_amdgcn_raw_buffer_load_b64(rsn4, boff + s * BSTEP, 0, 16  ), hi = __builtin_amdgcn_raw_buffer_load_b64(rsn4, boff + s * BSTEP + BHI, 0, 16); const v4u w = {lo.x, lo.y, hi.x, hi.y}; b1[s] = __builtin_bit_cast(bf16x8, w); }
            }
#pragma unroll
            for (int s = 0; s < 4; ++s) { a2[s] = *(const GAS bf16x8*)(Ap2 + s * 1024);
                const u32x2 lo = __builtin_amdgcn_raw_buffer_load_b64(rvn4, boff + s * BSTEP, 0, 16  ), hi = __builtin_amdgcn_raw_buffer_load_b64(rvn4, boff + s * BSTEP + BHI, 0, 16); const v4u w = {lo.x, lo.y, hi.x, hi.y}; b2[s] = __builtin_bit_cast(bf16x8, w); }
#pragma unroll
            for (int u = 0; u < 2; ++u) *(LAS v4u*)(ZT + (wave * 64 + lane + 512 * u) * 16) = zc[u];
            if (n > 0) {
#pragma unroll
                for (int s = 0; s < 8; ++s) acc = __builtin_amdgcn_mfma_f32_32x32x16_bf16(a1[s], b1[s], acc, 0, 0, 0);
            }
#pragma unroll
            for (int s = 0; s < 4; ++s) acc = __builtin_amdgcn_mfma_f32_32x32x16_bf16(a2[s], b2[s], acc, 0, 0, 0);
            float sq[16];
#pragma unroll
            for (int reg = 0; reg < 16; ++reg) sq[reg] = acc[reg] * acc[reg];
#pragma unroll
            for (int st = 1; st < 32; st <<= 1) { float t[16];
#pragma unroll
                for (int reg = 0; reg < 16; ++reg) t[reg] = __shfl_xor(sq[reg], st);
#pragma unroll
                for (int reg = 0; reg < 16; ++reg) sq[reg] += t[reg]; }
            if (r32 == 0) {
#pragma unroll
                for (int reg = 0; reg < 16; ++reg) ssq[(32 * ct2 + (reg & 3) + 8 * (reg >> 2) + 4 * hh) * 4 + et4] = sq[reg]; }
            LBAR();
            const float gg = P.g_gdn_out[e];
#pragma unroll
            for (int reg = 0; reg < 16; ++reg) { const int row = 32 * ct2 + (reg & 3) + 8 * (reg >> 2) + 4 * hh;
                const f32x4 sv = *(const LAS f32x4*)(ssq + row * 4);
                const float rs = rsqrtf(((sv.x + sv.y) + (sv.z + sv.w)) * (1.f / DV) + EPS);
                const float z = bf2f(*(const LAS unsigned short*)(ZT + row * 256 + e * 2));
                *(LAS unsigned short*)(OT + row * 256 + e * 2) = (unsigned short)f2bf(acc[reg] * rs * gg * fsilu(z)); }
            LBAR();
#pragma unroll
            for (int u = 0; u < 2; ++u) { const int cid = wave * 64 + lane + 512 * u;
                *(GAS v4u*)((unsigned char*)MIX + (m0 + (cid >> 4)) * 2048 + h * 256 + (cid & 15) * 16) = *(const LAS v4u*)(OT + cid * 16); }
        }
        LBAR();
    }
}

constexpr size_t WS_WR = 15 * MiB;
constexpr size_t WS_CNT = 1 * MiB;
constexpr size_t WS_TPOS = 1 * MiB + 256 * 1024;
constexpr size_t WS_GATEW = 1 * MiB + 512 * 1024;
constexpr size_t WS_TEX = 2 * MiB;
constexpr size_t WS_XG = 144 * MiB;
constexpr size_t WS_Y = 240 * MiB;
constexpr size_t WS_ACT = 336 * MiB;
constexpr int PSLOTS = 49152;
constexpr size_t WS_XN3 = WS_N1;
constexpr size_t WS_H2 = 144 * MiB;
constexpr size_t WS_H3 = 240 * MiB;
constexpr int LDS_LG = 131584, LDS_TE = LDS_LG + 64 * 80 * 4, LDS_TW = LDS_TE + 512, LDS_CNT = LDS_TW + 512, LDS_POS = LDS_CNT + 256, LDS_BASE = LDS_POS + 512, LDS_PART = LDS_BASE + 256;

__device__ __forceinline__ void unpack8(const v4u w, float (&f)[8]) {
    f[0] = __uint_as_float(w.x << 16); f[1] = __uint_as_float(w.x & 0xffff0000u); f[2] = __uint_as_float(w.y << 16); f[3] = __uint_as_float(w.y & 0xffff0000u);
    f[4] = __uint_as_float(w.z << 16); f[5] = __uint_as_float(w.z & 0xffff0000u); f[6] = __uint_as_float(w.w << 16); f[7] = __uint_as_float(w.w & 0xffff0000u);
}
__device__ __forceinline__ v4u pack8(const float (&f)[8]) { v4u w; w.x = pk2(f[0], f[1]); w.y = pk2(f[2], f[3]); w.z = pk2(f[4], f[5]); w.w = pk2(f[6], f[7]); return w; }
struct EpiRes {
    static constexpr bool PERM = true, AFTER_DRAIN = false;
    const float* base; pg8::bf16_t* out;
    __device__ __forceinline__ void operator()(const pg8::f32x4 (&acc)[2][2][4][2], const pg8::Unit& u, int wr, int wc, int fr, int fq) const {
        using namespace pg8;
        const int row0 = u.pm * BM + wr * 64 + fr, col0 = u.pn * BM + wc * 32 + 8 * fq;
#pragma unroll
        for (int ai = 0; ai < 2; ++ai)
#pragma unroll
            for (int m = 0; m < 4; ++m) { const size_t off = (size_t)(row0 + ai * HALF + m * 16) * DM + col0;
#pragma unroll
                for (int bj = 0; bj < 2; ++bj) { const size_t o = off + bj * HALF;
                    const f32x4 v0 = *(const f32x4*)(base + o) + acc[ai][bj][m][0], v1 = *(const f32x4*)(base + o + 4) + acc[ai][bj][m][1];
                    u32x4 w; w.x = cvt_pk_bf16(v0[0], v0[1]); w.y = cvt_pk_bf16(v0[2], v0[3]); w.z = cvt_pk_bf16(v1[0], v1[1]); w.w = cvt_pk_bf16(v1[2], v1[3]);
                    *(u32x4*)(out + o) = w; } }
    }
};
struct EpiSwiGLU {
    static constexpr bool PERM = true, AFTER_DRAIN = false;
    pg8::bf16_t* ACT;
    __device__ __forceinline__ void operator()(const pg8::f32x4 (&acc)[2][2][4][2], const pg8::Unit& u, int wr, int wc, int fr, int fq) const {
        using namespace pg8;
        const int row0 = u.pm * BM + wr * 64 + fr, hid0 = u.pn * 128 + wc * 16 + 4 * fq;
#pragma unroll
        for (int ai = 0; ai < 2; ++ai)
#pragma unroll
            for (int m = 0; m < 4; ++m) { bf16_t* rowp = ACT + (size_t)(row0 + ai * HALF + m * 16) * DEXP + hid0;
#pragma unroll
                for (int bj = 0; bj < 2; ++bj) { const f32x4 a = acc[ai][bj][m][0], g = acc[ai][bj][m][1];
                    const unsigned lo = cvt_pk_bf16(fsilu(a[0]) * g[0], fsilu(a[1]) * g[1]), hi = cvt_pk_bf16(fsilu(a[2]) * g[2], fsilu(a[3]) * g[3]);
                    __hip_atomic_store((unsigned long long*)(rowp + bj * 64), (unsigned long long)lo | ((unsigned long long)hi << 32), __ATOMIC_RELAXED, __HIP_MEMORY_SCOPE_AGENT); } }
    }
};
struct EpiGate {
    static constexpr bool PERM = true, AFTER_DRAIN = false;
    pg8::bf16_t* Y; const float* gatew;
    __device__ __forceinline__ void operator()(const pg8::f32x4 (&acc)[2][2][4][2], const pg8::Unit& u, int wr, int wc, int fr, int fq) const {
        using namespace pg8;
        const int row0 = u.pm * BM + wr * 64 + fr, col0 = u.pn * BM + wc * 32 + 8 * fq;
#pragma unroll
        for (int ai = 0; ai < 2; ++ai)
#pragma unroll
            for (int m = 0; m < 4; ++m) { const int row = row0 + ai * HALF + m * 16; const float gw = gatew[row]; bf16_t* rowp = Y + (size_t)row * DM + col0;
#pragma unroll
                for (int bj = 0; bj < 2; ++bj) { const f32x4 v0 = acc[ai][bj][m][0] * gw, v1 = acc[ai][bj][m][1] * gw;
                    u32x4 w; w.x = cvt_pk_bf16(v0[0], v0[1]); w.y = cvt_pk_bf16(v0[2], v0[3]); w.z = cvt_pk_bf16(v1[0], v1[1]); w.w = cvt_pk_bf16(v1[2], v1[3]);
                    *(u32x4*)(rowp + bj * HALF) = w; } }
    }
};
struct EpiPle {
    static constexpr bool PERM = true, AFTER_DRAIN = false;
    const pg8::bf16_t* h2; const pg8::bf16_t* proj; pg8::bf16_t* out;
    __device__ __forceinline__ void operator()(const pg8::f32x4 (&acc)[2][2][4][2], const pg8::Unit& u, int wr, int wc, int fr, int fq) const {
        using namespace pg8;
        const int row0 = u.pm * BM + wr * 64 + fr, col0 = u.pn * BM + wc * 32 + 8 * fq;
#pragma unroll
        for (int ai = 0; ai < 2; ++ai)
#pragma unroll
            for (int m = 0; m < 4; ++m) { const size_t off = (size_t)(row0 + ai * HALF + m * 16) * DM + col0;
#pragma unroll
                for (int bj = 0; bj < 2; ++bj) { const size_t o = off + bj * HALF; float hh_[8], pp_[8], r_[8];
                    unpack8(*(const v4u*)(h2 + o), hh_); unpack8(*(const v4u*)(proj + o), pp_);
#pragma unroll
                    for (int i = 0; i < 4; ++i) { r_[i] = hh_[i] + fsigmoid(acc[ai][bj][m][0][i]) * pp_[i]; r_[4 + i] = hh_[4 + i] + fsigmoid(acc[ai][bj][m][1][i]) * pp_[4 + i]; }
                    *(v4u*)(out + o) = pack8(r_); } }
    }
};
struct MoeOrder {
    const int* tex; int nN, G, c;
    __device__ __forceinline__ bool next(int i, pg8::Unit& u) const {
        const int nt = __builtin_amdgcn_readfirstlane(__hip_atomic_load(tex, __ATOMIC_RELAXED, __HIP_MEMORY_SCOPE_AGENT)); const long L = (long)i * G + c; if (L >= (long)nt * nN) return false;
        const int rt = (int)(L / nN); u.pm = rt; u.pn = (int)(L % nN); u.be = __builtin_amdgcn_readfirstlane(__hip_atomic_load(tex + 64 + rt, __ATOMIC_RELAXED, __HIP_MEMORY_SCOPE_AGENT)); return true;
    }
    __device__ __forceinline__ void a_ready(const pg8::Unit&) const {}
    __device__ __forceinline__ void done(const pg8::Unit&) const {}
};

struct MoeUpOrder {
    unsigned char* ws; int G, c;
    __device__ __forceinline__ bool next(int i, pg8::Unit& u) const {
        const int nt = __builtin_amdgcn_readfirstlane(__hip_atomic_load((const int*)(ws + WS_TEX), __ATOMIC_RELAXED, __HIP_MEMORY_SCOPE_AGENT)); const int L = i * G + c; if (L >= 2 * nt) return false;
        const int rt = L >> 1; u.pm = rt; u.pn = L & 1; u.be = __builtin_amdgcn_readfirstlane(__hip_atomic_load((const int*)(ws + WS_TEX) + 64 + rt, __ATOMIC_RELAXED, __HIP_MEMORY_SCOPE_AGENT)); return true;
    }
    __device__ __forceinline__ void a_ready(const pg8::Unit&) const {}
    __device__ __forceinline__ void done(const pg8::Unit& u) const {
        asm volatile("s_waitcnt vmcnt(0)" ::: "memory");
        if (lane_now() == 0) __hip_atomic_fetch_add((unsigned*)(ws + WS_CTL) + CW_READY + 64 * u.pm, 1u, __ATOMIC_RELAXED, __HIP_MEMORY_SCOPE_AGENT);
    }
};
struct MoeDownOrder {
    unsigned char* ws; int G, c, wave;
    __device__ __forceinline__ bool next(int i, pg8::Unit& u) const {
        const int nt = __builtin_amdgcn_readfirstlane(__hip_atomic_load((const int*)(ws + WS_TEX), __ATOMIC_RELAXED, __HIP_MEMORY_SCOPE_AGENT)); const int H = (2 * nt > G) ? 2 * nt - G : 0;
        int L;
        if (i == 0) L = c; else { if (c < H) return false; L = G + (i - 1) * (G - H) + (c - H); }
        if (L >= 4 * nt) return false;
        const int rt = L >> 2; u.pm = rt; u.pn = L & 3; u.be = __builtin_amdgcn_readfirstlane(__hip_atomic_load((const int*)(ws + WS_TEX) + 64 + rt, __ATOMIC_RELAXED, __HIP_MEMORY_SCOPE_AGENT)); return true;
    }
    __device__ __forceinline__ void wait_ready(const pg8::Unit& u) const {
        if (wave == 0) {
            unsigned spins = 0;
            while ((unsigned)__builtin_amdgcn_readfirstlane(__hip_atomic_load((unsigned*)(ws + WS_CTL) + CW_READY + 64 * u.pm, __ATOMIC_RELAXED, __HIP_MEMORY_SCOPE_AGENT)) < 16u && ++spins < (1u << 22)) __builtin_amdgcn_s_sleep(2);
            __builtin_amdgcn_fence(__ATOMIC_ACQUIRE, "agent");
            asm volatile("s_waitcnt vmcnt(0)" ::: "memory");
        }
        asm volatile("" ::: "memory"); __builtin_amdgcn_s_barrier(); asm volatile("" ::: "memory");
    }
};
struct OneUnit {
    pg8::Unit u0;
    __device__ __forceinline__ bool next(int i, pg8::Unit& u) const { if (i != 0) return false; u = u0; return true; }
    __device__ __forceinline__ void a_ready(const pg8::Unit&) const {}
    __device__ __forceinline__ void done(const pg8::Unit&) const {}
};

__device__ __forceinline__ void p6_router(Frame& F, const Ptrs& P) {
    const int lane = lane_now(), wave = F.wave, tid = wave * 64 + lane;
    const int tile = F.vcu; const size_t m0 = (size_t)tile * 64;
    const bf16* H1 = (const bf16*)(P.ws + WS_H1);
    LAS unsigned char* XT = F.lds;
    LAS float* LG = (LAS float*)(F.lds + LDS_LG); LAS int* te_l = (LAS int*)(F.lds + LDS_TE); LAS float* tw_l = (LAS float*)(F.lds + LDS_TW); LAS int* cnt_l = (LAS int*)(F.lds + LDS_CNT);
    if (tid < 64) cnt_l[tid] = 0;
    const int r = lane & 15, q = lane >> 4, mt = wave & 3, nt0 = wave < 4 ? 0 : 3, nnt = wave < 4 ? 3 : 2;
    const unsigned char* Wr = P.ws + WS_WR + ((size_t)(16 * nt0 + r) * DM + 8 * q) * 2;
    bf16x8 bA[8][3], bB[8][3];
#define P6_LOADB(dst, s8) _Pragma("unroll") for (int u = 0; u < 8; ++u) _Pragma("unroll") for (int t = 0; t < 3; ++t) if (t < nnt) dst[u][t] = *(const GAS bf16x8*)(Wr + (size_t)t * (16 * DM * 2) + 64 * ((s8) + u))
#define P6_MFMA(src, s8) _Pragma("unroll") for (int u = 0; u < 8; ++u) { const bf16x8 a = *(const LAS bf16x8*)(XT + (16 * mt + r) * 2048 + (32 * ((s8) + u) + 8 * q) * 2); \
        _Pragma("unroll") for (int t = 0; t < 3; ++t) if (t < nnt) acc[t] = __builtin_amdgcn_mfma_f32_16x16x32_bf16(a, src[u][t], acc[t], 0, 0, 0); }
    P6_LOADB(bA, 0);
    {
        v4u raw[8][2];
#pragma unroll
        for (int rr = 0; rr < 8; ++rr) { const GAS v4u* xr = (const GAS v4u*)(H1 + (m0 + wave * 8 + rr) * DM) + lane; raw[rr][0] = xr[0]; raw[rr][1] = xr[64]; }
        f32x4 gm[2][2];
#pragma unroll
        for (int j = 0; j < 2; ++j) { gm[j][0] = ((const GAS f32x4*)P.g_moe)[2 * (64 * j + lane)]; gm[j][1] = ((const GAS f32x4*)P.g_moe)[2 * (64 * j + lane) + 1]; }
#pragma unroll
        for (int rr = 0; rr < 8; ++rr) { const int row = wave * 8 + rr;
            float v[2][8]; float s = 0.f;
#pragma unroll
            for (int j = 0; j < 2; ++j) { unpack8(raw[rr][j], v[j]);
#pragma unroll
                for (int i = 0; i < 8; ++i) s += v[j][i] * v[j][i]; }
            const float rs = rsqrtf(wave_sum_f(s) * (1.f / DM) + EPS);
#pragma unroll
            for (int j = 0; j < 2; ++j) {
#pragma unroll
                for (int i = 0; i < 4; ++i) { v[j][i] *= rs * gm[j][0][i]; v[j][4 + i] *= rs * gm[j][1][i]; }
                *(LAS v4u*)(XT + row * 2048 + (64 * j + lane) * 16) = pack8(v[j]); } }
    }
    LBAR();
    {
        f32x4 acc[3];
#pragma unroll
        for (int t = 0; t < 3; ++t) acc[t] = (f32x4){0.f, 0.f, 0.f, 0.f};
        P6_LOADB(bB, 8);  P6_MFMA(bA, 0);
        P6_LOADB(bA, 16); P6_MFMA(bB, 8);
        P6_LOADB(bB, 24); P6_MFMA(bA, 16);
        P6_MFMA(bB, 24);
#pragma unroll
        for (int t = 0; t < 3; ++t) if (t < nnt) {
#pragma unroll
            for (int reg = 0; reg < 4; ++reg) LG[(16 * mt + 4 * q + reg) * 80 + 16 * (nt0 + t) + r] = acc[t][reg]; }
    }
#undef P6_LOADB
#undef P6_MFMA
    LBAR();
    if (tid < 64) {
        const LAS float* lg = LG + tid * 80;
        float mx = lg[0]; int gi = 0;
#pragma unroll
        for (int j = 1; j < NGRP; ++j) { const float v = lg[j]; if (v > mx) { mx = v; gi = j; } }
        float den = 0.f;
#pragma unroll
        for (int j = 0; j < NGRP; ++j) den += __expf(lg[j] - mx);
        const float gw = 1.f / den;
        float m1 = -INFINITY, m2 = -INFINITY; int i1 = 0, i2 = 0;
#pragma unroll
        for (int j = 0; j < EPG; ++j) { const float v = lg[8 + gi * EPG + j]; if (v > m1) { m2 = m1; i2 = i1; m1 = v; i1 = j; } else if (v > m2) { m2 = v; i2 = j; } }
        const float p2 = __expf(m2 - m1);
        const int e1 = gi * EPG + i1, e2 = gi * EPG + i2;
        te_l[tid * 2] = e1; te_l[tid * 2 + 1] = e2; tw_l[tid * 2] = gw / (1.f + p2); tw_l[tid * 2 + 1] = gw * p2 / (1.f + p2);
        __hip_atomic_fetch_add(cnt_l + e1, 1, __ATOMIC_RELAXED, __HIP_MEMORY_SCOPE_WORKGROUP); __hip_atomic_fetch_add(cnt_l + e2, 1, __ATOMIC_RELAXED, __HIP_MEMORY_SCOPE_WORKGROUP);
    }
    LBAR();
    if (tid < 64) ((int*)(P.ws + WS_CNT))[tile * 64 + tid] = cnt_l[tid];
}
__device__ __forceinline__ void p7_dispatch(Frame& F, const Ptrs& P) {
    const int lane = lane_now(), wave = F.wave, tid = wave * 64 + lane;
    const int tile = F.vcu; const size_t m0 = (size_t)tile * 64;
    LAS unsigned char* XT = F.lds;
    LAS int* te_l = (LAS int*)(F.lds + LDS_TE); LAS float* tw_l = (LAS float*)(F.lds + LDS_TW); LAS int* pos_l = (LAS int*)(F.lds + LDS_POS); LAS int* base_l = (LAS int*)(F.lds + LDS_BASE);
    LAS int* part = (LAS int*)(F.lds + LDS_PART);
    const int* CNT = (const int*)(P.ws + WS_CNT);
    { const int e = lane, pt = wave; int tot = 0, bef = 0;
      int cv[32];
#pragma unroll
      for (int t = 0; t < 32; ++t) cv[t] = CNT[(32 * pt + t) * 64 + e];
#pragma unroll
      for (int t = 0; t < 32; ++t) { tot += cv[t]; bef += (32 * pt + t < tile) ? cv[t] : 0; }
      part[(pt * 64 + e) * 2] = tot; part[(pt * 64 + e) * 2 + 1] = bef; }
    LBAR();
    if (wave == 0) { int tot = 0, bef = 0;
#pragma unroll
        for (int pt = 0; pt < 8; ++pt) { tot += part[(pt * 64 + lane) * 2]; bef += part[(pt * 64 + lane) * 2 + 1]; }
        const int pc = (tot + 255) & ~255; int incl = pc;
#pragma unroll
        for (int off = 1; off < 64; off <<= 1) { const int t = __shfl_up(incl, off); if (lane >= off) incl += t; }
        const int pstart = incl - pc;
        base_l[lane] = pstart + bef;
        if (tile == 0) { int* TEX = (int*)(P.ws + WS_TEX); for (int r = pstart >> 8; r < (pstart + pc) >> 8; ++r) TEX[64 + r] = lane; if (lane == 63) TEX[0] = (pstart + pc) >> 8; }
    }
    LBAR();
    if (wave < 2) { const int e = te_l[tid]; int rank = 0;
#pragma unroll
        for (int j4 = 0; j4 < 32; ++j4) { const v4u t4 = *(const LAS v4u*)(te_l + 4 * j4);
            rank += ((4 * j4 + 0 < tid && (int)t4.x == e) ? 1 : 0) + ((4 * j4 + 1 < tid && (int)t4.y == e) ? 1 : 0) + ((4 * j4 + 2 < tid && (int)t4.z == e) ? 1 : 0) + ((4 * j4 + 3 < tid && (int)t4.w == e) ? 1 : 0); }
        const int pos = base_l[e] + rank; pos_l[tid] = pos;
        ((int*)(P.ws + WS_TPOS))[m0 * 2 + tid] = pos; ((float*)(P.ws + WS_GATEW))[pos] = tw_l[tid]; }
    LBAR();
    for (int rr = 0; rr < 8; ++rr) { const int row = wave * 8 + rr; const int p0 = pos_l[row * 2], p1 = pos_l[row * 2 + 1];
#pragma unroll
        for (int c = 0; c < 2; ++c) { const v4u v = *(const LAS v4u*)(XT + row * 2048 + (lane + 64 * c) * 16);
            *(GAS v4u*)(P.ws + WS_XG + (size_t)p0 * 2048 + (lane + 64 * c) * 16) = v; *(GAS v4u*)(P.ws + WS_XG + (size_t)p1 * 2048 + (lane + 64 * c) * 16) = v; } }
}
__device__ __forceinline__ void p10_combine(Frame& F, const Ptrs& P) {
    const int lane = lane_now(); const int gw = F.vcu * NWAVES + F.wave, NGW = F.G * NWAVES;
    const bf16* H = (const bf16*)(P.ws + WS_H1); bf16* H2 = (bf16*)(P.ws + WS_H2); const int* TPOS = (const int*)(P.ws + WS_TPOS); bf16* XN3 = (bf16*)(P.ws + WS_XN3);
    for (int m = gw; m < M; m += NGW) {
        const int p0 = TPOS[m * 2], p1 = TPOS[m * 2 + 1];
        const GAS v4u* hr = (const GAS v4u*)(H + (size_t)m * DM) + lane; GAS v4u* ho = (GAS v4u*)(H2 + (size_t)m * DM) + lane;
        const GAS v4u* y0 = (const GAS v4u*)(P.ws + WS_Y + (size_t)p0 * 2048) + lane; const GAS v4u* y1 = (const GAS v4u*)(P.ws + WS_Y + (size_t)p1 * 2048) + lane;
        float v[2][8]; float s = 0.f;
#pragma unroll
        for (int j = 0; j < 2; ++j) { float a[8], b[8]; unpack8(hr[64 * j], v[j]); unpack8(y0[64 * j], a); unpack8(y1[64 * j], b);
#pragma unroll
            for (int i = 0; i < 8; ++i) { v[j][i] += a[i] + b[i]; s += v[j][i] * v[j][i]; }
            ho[64 * j] = pack8(v[j]); }
        const float r = rsqrtf(wave_sum_f(s) * (1.f / DM) + EPS);
        GAS v4u* o8 = (GAS v4u*)(XN3 + (size_t)m * DM) + lane;
#pragma unroll
        for (int j = 0; j < 2; ++j) { const f32x4 g0 = ((const GAS f32x4*)P.g_ple)[2 * (64 * j + lane)], g1 = ((const GAS f32x4*)P.g_ple)[2 * (64 * j + lane) + 1];
#pragma unroll
            for (int i = 0; i < 4; ++i) { v[j][i] *= r * g0[i]; v[j][4 + i] *= r * g1[i]; }
            o8[64 * j] = pack8(v[j]); }
    }
}
__device__ __forceinline__ void p12_final(Frame& F, const Ptrs& P) {
    const int lane = lane_now(); const int gw = F.vcu * NWAVES + F.wave, NGW = F.G * NWAVES;
    for (int m = gw; m < M; m += NGW) {
        const GAS v4u* hr = (const GAS v4u*)((const bf16*)(P.ws + WS_H3) + (size_t)m * DM) + lane; GAS f32x4* ho = (GAS f32x4*)(P.out + (size_t)m * DM);
        float v[2][8]; float s = 0.f;
#pragma unroll
        for (int j = 0; j < 2; ++j) { unpack8(hr[64 * j], v[j]);
#pragma unroll
            for (int i = 0; i < 8; ++i) s += v[j][i] * v[j][i]; }
        float r = rsqrtf(wave_sum_f(s) * (1.f / DM) + EPS);
#if XCHK
        { const unsigned c1 = __hip_atomic_load((const unsigned*)(P.ws + WS_CTL) + CK_P1, __ATOMIC_RELAXED, __HIP_MEMORY_SCOPE_AGENT), c2 = __hip_atomic_load((const unsigned*)(P.ws + WS_CTL) + CK_P2, __ATOMIC_RELAXED, __HIP_MEMORY_SCOPE_AGENT);
          const unsigned p1 = ((const unsigned*)(P.ws + 3 * MiB))[0]; (void)c2;
          if (__hip_atomic_load((const unsigned*)(P.ws + WS_CTL) + CK_P2 + 8, __ATOMIC_RELAXED, __HIP_MEMORY_SCOPE_AGENT) != 0u) r *= 3.0f;
          if (p1 != 0xAAAAAAAAu && p1 != c1) r *= 1.1f;
          else {
#pragma unroll
            for (int g = 7; g >= 0; --g) { const unsigned cg = __hip_atomic_load((const unsigned*)(P.ws + WS_CTL) + CK_P2 + g, __ATOMIC_RELAXED, __HIP_MEMORY_SCOPE_AGENT), pg = ((const unsigned*)(P.ws + 3 * MiB))[1 + g];
                if (pg != 0xAAAAAAAAu && pg != cg) r *= 1.2f + 0.1f * (float)g; } } }
#endif
#if DTEST
        { const unsigned dtm = __hip_atomic_load((const unsigned*)(P.ws + WS_CTL) + CW_DT, __ATOMIC_RELAXED, __HIP_MEMORY_SCOPE_AGENT);
          if (dtm != 0u) r *= 1.0f + 0.05f * (float)(__builtin_ctz(dtm) + 1) + 0.5f * (float)(__builtin_popcount(dtm) - 1); }
#endif
#pragma unroll
        for (int j = 0; j < 2; ++j) { const int c4 = 2 * (64 * j + lane); const f32x4 g0 = ((const GAS f32x4*)P.g_final)[c4], g1 = ((const GAS f32x4*)P.g_final)[c4 + 1];
            ho[c4] = (f32x4){v[j][0] * r * g0[0], v[j][1] * r * g0[1], v[j][2] * r * g0[2], v[j][3] * r * g0[3]};
            ho[c4 + 1] = (f32x4){v[j][4] * r * g1[0], v[j][5] * r * g1[1], v[j][6] * r * g1[2], v[j][7] * r * g1[3]}; }
    }
#if XCHK
    if (F.vcu == F.G - 1 && F.wave == 7 && lane == 0) { __builtin_amdgcn_s_sleep(127); __builtin_amdgcn_s_sleep(127); __builtin_amdgcn_s_sleep(127);
        ((unsigned*)(P.ws + 3 * MiB))[0] = __hip_atomic_load((const unsigned*)(P.ws + WS_CTL) + CK_P1, __ATOMIC_RELAXED, __HIP_MEMORY_SCOPE_AGENT);
        for (int g = 0; g < 8; ++g) ((unsigned*)(P.ws + 3 * MiB))[1 + g] = __hip_atomic_load((const unsigned*)(P.ws + WS_CTL) + CK_P2 + g, __ATOMIC_RELAXED, __HIP_MEMORY_SCOPE_AGENT); }
#endif
}
struct Args { const float* in[23]; float* out; unsigned char* ws; int ph_lo, ph_hi, use_bar, bar_region; };
constexpr int N_PHASES = 13;
__global__ void __launch_bounds__(NWAVES * 64, 2) mk_fwd(Args args) {
    extern __shared__ __attribute__((aligned(16))) unsigned char lds[];
#if defined(VINIT) && VINIT
    asm volatile("v_mov_b32 v8, 0\n\tv_mov_b32 v9, 0\n\tv_mov_b32 v10, 0\n\tv_mov_b32 v11, 0\n\tv_mov_b32 v12, 0\n\tv_mov_b32 v13, 0\n\tv_mov_b32 v14, 0\n\tv_mov_b32 v15, 0\n\tv_mov_b32 v16, 0\n\tv_mov_b32 v17, 0\n\tv_mov_b32 v18, 0\n\tv_mov_b32 v19, 0\n\tv_mov_b32 v20, 0\n\tv_mov_b32 v21, 0\n\tv_mov_b32 v22, 0\n\tv_mov_b32 v23, 0\n\tv_mov_b32 v24, 0\n\tv_mov_b32 v25, 0\n\tv_mov_b32 v26, 0\n\tv_mov_b32 v27, 0\n\tv_mov_b32 v28, 0\n\tv_mov_b32 v29, 0\n\tv_mov_b32 v30, 0\n\tv_mov_b32 v31, 0\n\tv_mov_b32 v32, 0\n\tv_mov_b32 v33, 0\n\tv_mov_b32 v34, 0\n\tv_mov_b32 v35, 0\n\tv_mov_b32 v36, 0\n\tv_mov_b32 v37, 0\n\tv_mov_b32 v38, 0\n\tv_mov_b32 v39, 0\n\tv_mov_b32 v40, 0\n\tv_mov_b32 v41, 0\n\tv_mov_b32 v42, 0\n\tv_mov_b32 v43, 0\n\tv_mov_b32 v44, 0\n\tv_mov_b32 v45, 0\n\tv_mov_b32 v46, 0\n\tv_mov_b32 v47, 0\n\tv_mov_b32 v48, 0\n\tv_mov_b32 v49, 0\n\tv_mov_b32 v50, 0\n\tv_mov_b32 v51, 0\n\tv_mov_b32 v52, 0\n\tv_mov_b32 v53, 0\n\tv_mov_b32 v54, 0\n\tv_mov_b32 v55, 0\n\tv_mov_b32 v56, 0\n\tv_mov_b32 v57, 0\n\tv_mov_b32 v58, 0\n\tv_mov_b32 v59, 0\n\tv_mov_b32 v60, 0\n\tv_mov_b32 v61, 0\n\tv_mov_b32 v62, 0\n\tv_mov_b32 v63, 0" ::: "v8", "v9", "v10", "v11", "v12", "v13", "v14", "v15", "v16", "v17", "v18", "v19", "v20", "v21", "v22", "v23", "v24", "v25", "v26", "v27", "v28", "v29", "v30", "v31", "v32", "v33", "v34", "v35", "v36", "v37", "v38", "v39", "v40", "v41", "v42", "v43", "v44", "v45", "v46", "v47", "v48", "v49", "v50", "v51", "v52", "v53", "v54", "v55", "v56", "v57", "v58", "v59", "v60", "v61", "v62", "v63");
    asm volatile("v_mov_b32 v64, 0\n\tv_mov_b32 v65, 0\n\tv_mov_b32 v66, 0\n\tv_mov_b32 v67, 0\n\tv_mov_b32 v68, 0\n\tv_mov_b32 v69, 0\n\tv_mov_b32 v70, 0\n\tv_mov_b32 v71, 0\n\tv_mov_b32 v72, 0\n\tv_mov_b32 v73, 0\n\tv_mov_b32 v74, 0\n\tv_mov_b32 v75, 0\n\tv_mov_b32 v76, 0\n\tv_mov_b32 v77, 0\n\tv_mov_b32 v78, 0\n\tv_mov_b32 v79, 0\n\tv_mov_b32 v80, 0\n\tv_mov_b32 v81, 0\n\tv_mov_b32 v82, 0\n\tv_mov_b32 v83, 0\n\tv_mov_b32 v84, 0\n\tv_mov_b32 v85, 0\n\tv_mov_b32 v86, 0\n\tv_mov_b32 v87, 0\n\tv_mov_b32 v88, 0\n\tv_mov_b32 v89, 0\n\tv_mov_b32 v90, 0\n\tv_mov_b32 v91, 0\n\tv_mov_b32 v92, 0\n\tv_mov_b32 v93, 0\n\tv_mov_b32 v94, 0\n\tv_mov_b32 v95, 0\n\tv_mov_b32 v96, 0\n\tv_mov_b32 v97, 0\n\tv_mov_b32 v98, 0\n\tv_mov_b32 v99, 0\n\tv_mov_b32 v100, 0\n\tv_mov_b32 v101, 0\n\tv_mov_b32 v102, 0\n\tv_mov_b32 v103, 0\n\tv_mov_b32 v104, 0\n\tv_mov_b32 v105, 0\n\tv_mov_b32 v106, 0\n\tv_mov_b32 v107, 0\n\tv_mov_b32 v108, 0\n\tv_mov_b32 v109, 0\n\tv_mov_b32 v110, 0\n\tv_mov_b32 v111, 0\n\tv_mov_b32 v112, 0\n\tv_mov_b32 v113, 0\n\tv_mov_b32 v114, 0\n\tv_mov_b32 v115, 0\n\tv_mov_b32 v116, 0\n\tv_mov_b32 v117, 0\n\tv_mov_b32 v118, 0\n\tv_mov_b32 v119, 0\n\tv_mov_b32 v120, 0\n\tv_mov_b32 v121, 0\n\tv_mov_b32 v122, 0\n\tv_mov_b32 v123, 0\n\tv_mov_b32 v124, 0\n\tv_mov_b32 v125, 0\n\tv_mov_b32 v126, 0\n\tv_mov_b32 v127, 0" ::: "v64", "v65", "v66", "v67", "v68", "v69", "v70", "v71", "v72", "v73", "v74", "v75", "v76", "v77", "v78", "v79", "v80", "v81", "v82", "v83", "v84", "v85", "v86", "v87", "v88", "v89", "v90", "v91", "v92", "v93", "v94", "v95", "v96", "v97", "v98", "v99", "v100", "v101", "v102", "v103", "v104", "v105", "v106", "v107", "v108", "v109", "v110", "v111", "v112", "v113", "v114", "v115", "v116", "v117", "v118", "v119", "v120", "v121", "v122", "v123", "v124", "v125", "v126", "v127");
    asm volatile("v_mov_b32 v128, 0\n\tv_mov_b32 v129, 0\n\tv_mov_b32 v130, 0\n\tv_mov_b32 v131, 0\n\tv_mov_b32 v132, 0\n\tv_mov_b32 v133, 0\n\tv_mov_b32 v134, 0\n\tv_mov_b32 v135, 0\n\tv_mov_b32 v136, 0\n\tv_mov_b32 v137, 0\n\tv_mov_b32 v138, 0\n\tv_mov_b32 v139, 0\n\tv_mov_b32 v140, 0\n\tv_mov_b32 v141, 0\n\tv_mov_b32 v142, 0\n\tv_mov_b32 v143, 0\n\tv_mov_b32 v144, 0\n\tv_mov_b32 v145, 0\n\tv_mov_b32 v146, 0\n\tv_mov_b32 v147, 0\n\tv_mov_b32 v148, 0\n\tv_mov_b32 v149, 0\n\tv_mov_b32 v150, 0\n\tv_mov_b32 v151, 0\n\tv_mov_b32 v152, 0\n\tv_mov_b32 v153, 0\n\tv_mov_b32 v154, 0\n\tv_mov_b32 v155, 0\n\tv_mov_b32 v156, 0\n\tv_mov_b32 v157, 0\n\tv_mov_b32 v158, 0\n\tv_mov_b32 v159, 0\n\tv_mov_b32 v160, 0\n\tv_mov_b32 v161, 0\n\tv_mov_b32 v162, 0\n\tv_mov_b32 v163, 0\n\tv_mov_b32 v164, 0\n\tv_mov_b32 v165, 0\n\tv_mov_b32 v166, 0\n\tv_mov_b32 v167, 0\n\tv_mov_b32 v168, 0\n\tv_mov_b32 v169, 0\n\tv_mov_b32 v170, 0\n\tv_mov_b32 v171, 0\n\tv_mov_b32 v172, 0\n\tv_mov_b32 v173, 0\n\tv_mov_b32 v174, 0\n\tv_mov_b32 v175, 0\n\tv_mov_b32 v176, 0\n\tv_mov_b32 v177, 0\n\tv_mov_b32 v178, 0\n\tv_mov_b32 v179, 0\n\tv_mov_b32 v180, 0\n\tv_mov_b32 v181, 0\n\tv_mov_b32 v182, 0\n\tv_mov_b32 v183, 0\n\tv_mov_b32 v184, 0\n\tv_mov_b32 v185, 0\n\tv_mov_b32 v186, 0\n\tv_mov_b32 v187, 0\n\tv_mov_b32 v188, 0\n\tv_mov_b32 v189, 0\n\tv_mov_b32 v190, 0\n\tv_mov_b32 v191, 0" ::: "v128", "v129", "v130", "v131", "v132", "v133", "v134", "v135", "v136", "v137", "v138", "v139", "v140", "v141", "v142", "v143", "v144", "v145", "v146", "v147", "v148", "v149", "v150", "v151", "v152", "v153", "v154", "v155", "v156", "v157", "v158", "v159", "v160", "v161", "v162", "v163", "v164", "v165", "v166", "v167", "v168", "v169", "v170", "v171", "v172", "v173", "v174", "v175", "v176", "v177", "v178", "v179", "v180", "v181", "v182", "v183", "v184", "v185", "v186", "v187", "v188", "v189", "v190", "v191");
    asm volatile("v_mov_b32 v192, 0\n\tv_mov_b32 v193, 0\n\tv_mov_b32 v194, 0\n\tv_mov_b32 v195, 0\n\tv_mov_b32 v196, 0\n\tv_mov_b32 v197, 0\n\tv_mov_b32 v198, 0\n\tv_mov_b32 v199, 0\n\tv_mov_b32 v200, 0\n\tv_mov_b32 v201, 0\n\tv_mov_b32 v202, 0\n\tv_mov_b32 v203, 0\n\tv_mov_b32 v204, 0\n\tv_mov_b32 v205, 0\n\tv_mov_b32 v206, 0\n\tv_mov_b32 v207, 0\n\tv_mov_b32 v208, 0\n\tv_mov_b32 v209, 0\n\tv_mov_b32 v210, 0\n\tv_mov_b32 v211, 0\n\tv_mov_b32 v212, 0\n\tv_mov_b32 v213, 0\n\tv_mov_b32 v214, 0\n\tv_mov_b32 v215, 0\n\tv_mov_b32 v216, 0\n\tv_mov_b32 v217, 0\n\tv_mov_b32 v218, 0\n\tv_mov_b32 v219, 0\n\tv_mov_b32 v220, 0\n\tv_mov_b32 v221, 0\n\tv_mov_b32 v222, 0\n\tv_mov_b32 v223, 0\n\tv_mov_b32 v224, 0\n\tv_mov_b32 v225, 0\n\tv_mov_b32 v226, 0\n\tv_mov_b32 v227, 0\n\tv_mov_b32 v228, 0\n\tv_mov_b32 v229, 0\n\tv_mov_b32 v230, 0\n\tv_mov_b32 v231, 0\n\tv_mov_b32 v232, 0\n\tv_mov_b32 v233, 0\n\tv_mov_b32 v234, 0\n\tv_mov_b32 v235, 0\n\tv_mov_b32 v236, 0\n\tv_mov_b32 v237, 0\n\tv_mov_b32 v238, 0\n\tv_mov_b32 v239, 0\n\tv_mov_b32 v240, 0\n\tv_mov_b32 v241, 0\n\tv_mov_b32 v242, 0\n\tv_mov_b32 v243, 0\n\tv_mov_b32 v244, 0\n\tv_mov_b32 v245, 0\n\tv_mov_b32 v246, 0\n\tv_mov_b32 v247, 0\n\tv_mov_b32 v248, 0\n\tv_mov_b32 v249, 0" ::: "v192", "v193", "v194", "v195", "v196", "v197", "v198", "v199", "v200", "v201", "v202", "v203", "v204", "v205", "v206", "v207", "v208", "v209", "v210", "v211", "v212", "v213", "v214", "v215", "v216", "v217", "v218", "v219", "v220", "v221", "v222", "v223", "v224", "v225", "v226", "v227", "v228", "v229", "v230", "v231", "v232", "v233", "v234", "v235", "v236", "v237", "v238", "v239", "v240", "v241", "v242", "v243", "v244", "v245", "v246", "v247", "v248", "v249");
#endif
    Frame F;
    F.lds = (LAS unsigned char*)lds; F.MISC = (volatile LAS unsigned*)(F.lds + MISC_OFF);
    F.wave = __builtin_amdgcn_readfirstlane((int)threadIdx.x >> 6);
    F.G = gridDim.x; { const int bx = blockIdx.x; F.vcu = (F.G % 8 == 0) ? (bx % 8) * (F.G / 8) + bx / 8 : bx; }
    Ptrs P;
    P.x = args.in[0]; P.p = args.in[1]; P.g_mix = args.in[2]; P.w_in = args.in[3]; P.w_conv_qkv = args.in[4]; P.a_log = args.in[5]; P.dt_bias = args.in[6]; P.g_gdn_out = args.in[7];
    P.b_glu = args.in[8]; P.w_conv_dw = args.in[9]; P.b_conv_dw = args.in[10]; P.ln_g = args.in[11]; P.ln_b = args.in[12]; P.w_out = args.in[13]; P.g_moe = args.in[14]; P.w_gr = args.in[15];
    P.w_er = args.in[16]; P.w_up = args.in[17]; P.w_down = args.in[18]; P.g_ple = args.in[19]; P.w_pg = args.in[20]; P.w_pp = args.in[21]; P.g_final = args.in[22];
    P.out = args.out; P.ws = args.ws;
    F.ctl = (gu32*)(P.ws + WS_CTL);
    for (int u = (int)threadIdx.x; u < (LDS_BYTES - LDSCTL_OFF) / 4; u += NWAVES * 64) ((LAS unsigned*)(F.lds + LDSCTL_OFF))[u] = 0u;
    __syncthreads();
    XcdBarrier bar; bar.bar = (unsigned*)(F.ctl + CW_BAR) + args.bar_region * XCD_BAR_WORDS; bar.x = 0; bar.st = nullptr;
    if (args.use_bar) bar = xcd_barrier_post((unsigned*)(F.ctl + CW_BAR) + args.bar_region * XCD_BAR_WORDS, F.MISC + 8, threadIdx.x == 0);
    const int lo = args.ph_lo, hi = args.ph_hi;
#ifndef VINIT
#define VINIT 0
#endif
#ifndef REP_PH
#define REP_PH -1
#define REP_N 1
#endif
#ifndef TPROBE_A
#define TPROBE_A -1
#define TPROBE_B -1
#endif
#ifndef TPROBE_MULT
#define TPROBE_MULT 8
#endif
#define TP(k) do { if (TPROBE_A == (k) || TPROBE_B == (k)) { if (blockIdx.x == 0 && F.wave == 0 && lane_now() == 0) __hip_atomic_store((unsigned*)(P.ws + WS_CTL) + 2304 + (TPROBE_B == (k) ? 1 : 0), (unsigned)rt(), __ATOMIC_RELAXED, __HIP_MEMORY_SCOPE_AGENT); } } while (0)
#define TPX(k) do { if (TPROBE_A == (k) || TPROBE_B == (k)) { if ((int)blockIdx.x == (int)gridDim.x - 1 && F.wave == 0 && lane_now() == 0) __hip_atomic_store((unsigned*)(P.ws + WS_CTL) + 2304 + (TPROBE_B == (k) ? 1 : 0), (unsigned)rt(), __ATOMIC_RELAXED, __HIP_MEMORY_SCOPE_AGENT); } } while (0)
#define IN(k) (lo <= (k) && (k) < hi)
#define REPS(k) for (int rep_ = 0; rep_ < ((k) == REP_PH ? REP_N : 1); ++rep_)
#define REPBAR() do { if (rep_) xcd_barrier(bar, F.wave == 0 && lane_now() == 0); } while (0)
#define SEAM(k) do { if (IN(k) && IN((k) + 1)) xcd_barrier(bar, F.wave == 0 && lane_now() == 0); } while (0)
    TP(0);

    if (IN(0)) { REPS(0) { REPBAR(); p0_prologue(F, P); } SEAM(0); TP(1); }
    if (IN(1)) { REPS(1) { REPBAR();
        pg8::Gemm g{(const pg8::bf16_t*)(P.ws + WS_N1), (const pg8::bf16_t*)(P.ws + WS_WIN), M, NIN_T, DM, 0};
        pg8::StaticOrder S; S.init(M, NIN_T, F.G, (int)blockIdx.x);
        EpiIn E{(pg8::bf16_t*)(P.ws + WS_QKVZ), (pg8::bf16_t*)(P.ws + WS_U), P.b_glu};
        pg8::gemm_phase<EpiIn, pg8::StaticOrder, true, true>(F.lds + RING_OFF, g, S, E, F.wave); }
        SEAM(1); TP(2);
    }
#ifndef SKIP_P2
    if (IN(2)) { REPS(2) { REPBAR();
#if P2_DUAL
        p2_gdn_prep_dual(F, P);
#else
        p2_gdn_prep(F, P);
#endif
#if CONV_IN_P2
        p3_convert_late(F, P, F.vcu, F.G);
#endif
#if DTEST
        p2_dtest(F, P);
#endif
#if XCHK
        xchk_sum(F, P, P.ws + WS_QKVZ, (size_t)64 * MiB + 16 * MiB, CK_P1);
        asm volatile("s_waitcnt vmcnt(0)" ::: "memory"); __syncthreads();
        for (int it = F.vcu; it < 1024; it += F.G) {
            const int lane = lane_now(); unsigned acc = 0; const GAS v4u* p4 = (const GAS v4u*)(P.ws + WS_GDN + (size_t)it * GDN_ITEM);
            for (int i = F.wave * 64 + lane; i < (int)(GDN_ITEM / 16); i += NWAVES * 64) { const v4u v = p4[i]; acc = v.x * 3u + v.y * 5u + v.z * 7u + v.w * 11u + (unsigned)(i + it * 131);
                const int reg = i < 1024 ? 0 : (i < 2048 ? 1 : (i < 3072 ? 2 : (i < 4096 ? 3 : 4)));
                __hip_atomic_fetch_add((unsigned*)(P.ws + WS_CTL) + CK_P2 + reg, acc, __ATOMIC_RELAXED, __HIP_MEMORY_SCOPE_AGENT); }
            if (F.wave == 0 && lane == 0) __hip_atomic_fetch_add((unsigned*)(P.ws + WS_CTL) + CK_P2 + 5, __float_as_uint(((const float*)(P.ws + WS_GT))[it]) * 13u + (unsigned)it, __ATOMIC_RELAXED, __HIP_MEMORY_SCOPE_AGENT); }
#endif
        } SEAM(2); TP(3); }
#endif
    if (IN(3)) { REPS(3) { REPBAR();
#ifndef SKIP_SCAN
        if ((int)blockIdx.x < NSCAN) { for (int r3 = 0; r3 < (REP_PH == 31 ? REP_N : 1); ++r3) p3_scan(F, P, (int)blockIdx.x); TP(25); }
        else
#endif
        if ((int)blockIdx.x < NSCAN + NWARM) p3_scan_warm(F, P, (int)blockIdx.x - NSCAN);
        else {
            const int idx = (int)blockIdx.x - NSCAN - NWARM, cnt = F.G - NSCAN - NWARM;
            TPX(20);
#if defined(SCAN_ALONE) && SCAN_ALONE
            { if (F.wave == 0) { for (int j = 0; j < 32; ++j) { while (__builtin_amdgcn_readfirstlane(__hip_atomic_load((unsigned*)(P.ws + WS_CTL) + CW_PROG + (j >> 2) * 64 + (j & 3), __ATOMIC_RELAXED, __HIP_MEMORY_SCOPE_AGENT)) < 128u) __builtin_amdgcn_s_sleep(32); } }
              __syncthreads(); }
#endif
#ifndef SKIP_CONF
            { ConfTaps T; p3_conf_load_taps(P, F.wave * 64 + lane_now(), T);
              for (int r3 = 0; r3 < (REP_PH == 32 ? REP_N : 1); ++r3) for (int t = idx; t < M / 32; t += cnt) p3_conf_tile(F, P, t, T); }
#endif
            TPX(21);
            pg8::Gemm g{(const pg8::bf16_t*)(P.ws + WS_PBF), (const pg8::bf16_t*)(P.ws + WS_WPROJ), M, DM, PLE, 0};
            pg8::StaticOrder S; S.init(M, DM, cnt, idx);
            pg8::EpiBf16<0> E{(pg8::bf16_t*)(P.ws + WS_PROJ), DM, nullptr, 0, 0, 1.f};
            for (int r3 = 0; r3 < (REP_PH == 33 ? REP_N : 1); ++r3) pg8::gemm_phase<pg8::EpiBf16<0>, pg8::StaticOrder, true, true>(F.lds + RING_OFF, g, S, E, F.wave);
            TPX(22);
#if !CONV_IN_P2
            for (int r3 = 0; r3 < (REP_PH == 34 ? REP_N : 1); ++r3) p3_convert_late(F, P, idx, cnt);
#endif
            TPX(23);
#ifndef SKIP_P4
            p4_gdn_out(F, P, idx, cnt);
#endif
            TPX(24);
        } }
        SEAM(3); TP(4);
    }
    if (IN(5)) { REPS(5) { REPBAR();
        pg8::Gemm g{(const pg8::bf16_t*)(P.ws + WS_MIX), (const pg8::bf16_t*)(P.ws + WS_WOUT), M, DM, DM, 0};
        pg8::StaticOrder S; S.init(M, DM, F.G, (int)blockIdx.x);
        EpiRes E{P.x, (pg8::bf16_t*)(P.ws + WS_H1)};
        pg8::gemm_phase<EpiRes, pg8::StaticOrder, true, true>(F.lds + RING_OFF, g, S, E, F.wave); }
        SEAM(5); TP(5);
    }
    if (IN(6)) { REPS(6) { REPBAR(); p6_router(F, P); } SEAM(6); TP(6); }
    if (IN(7)) { REPS(7) { REPBAR(); p7_dispatch(F, P); } SEAM(7); TP(7); }
    if (IN(8)) { REPS(8) { REPBAR();
        { pg8::Gemm g{(const pg8::bf16_t*)(P.ws + WS_XG), (const pg8::bf16_t*)(P.ws + WS_WUP), PSLOTS, 512, DM, (size_t)512 * DM * 2};
          MoeUpOrder S{P.ws, F.G, F.vcu};
          EpiSwiGLU E{(pg8::bf16_t*)(P.ws + WS_ACT)};
          pg8::gemm_phase<EpiSwiGLU, MoeUpOrder, true, true>(F.lds + RING_OFF, g, S, E, F.wave); }
        { pg8::Gemm g{(const pg8::bf16_t*)(P.ws + WS_ACT), (const pg8::bf16_t*)(P.ws + WS_WDOWN), PSLOTS, DM, DEXP, (size_t)DM * DEXP * 2};
          MoeDownOrder S{P.ws, F.G, F.vcu, F.wave};
          EpiGate E{(pg8::bf16_t*)(P.ws + WS_Y), (const float*)(P.ws + WS_GATEW)};
          for (int i = 0; ; ++i) { OneUnit S1; if (!S.next(i, S1.u0)) break; S.wait_ready(S1.u0);
              pg8::gemm_phase<EpiGate, OneUnit, true, true>(F.lds + RING_OFF, g, S1, E, F.wave); } } }
        SEAM(8); TP(8);
    }
    if (IN(10)) { REPS(10) { REPBAR(); p10_combine(F, P); } SEAM(10); TP(9); }
    if (IN(11)) { REPS(11) { REPBAR();
        pg8::Gemm g{(const pg8::bf16_t*)(P.ws + WS_XN3), (const pg8::bf16_t*)(P.ws + WS_WGATE), M, DM, DM, 0};
        pg8::StaticOrder S; S.init(M, DM, F.G, (int)blockIdx.x);
        EpiPle E{(const pg8::bf16_t*)(P.ws + WS_H2), (const pg8::bf16_t*)(P.ws + WS_PROJ), (pg8::bf16_t*)(P.ws + WS_H3)};
        pg8::gemm_phase<EpiPle, pg8::StaticOrder, true, true>(F.lds + RING_OFF, g, S, E, F.wave); }
        SEAM(11); TP(10);
    }
    if (IN(12)) { REPS(12) { REPBAR(); p12_final(F, P); } }
    TP(11);
#if TPROBE_A >= 0
    if (blockIdx.x == 0 && F.wave == 0 && lane_now() == 0) {
        const unsigned ta = __hip_atomic_load((unsigned*)(P.ws + WS_CTL) + 2304, __ATOMIC_RELAXED, __HIP_MEMORY_SCOPE_AGENT), tb = __hip_atomic_load((unsigned*)(P.ws + WS_CTL) + 2305, __ATOMIC_RELAXED, __HIP_MEMORY_SCOPE_AGENT);
        const unsigned want = (tb - ta) * (unsigned)TPROBE_MULT; const unsigned t0 = (unsigned)rt();
        while ((unsigned)rt() - t0 < want) __builtin_amdgcn_s_sleep(4);
    }
#endif
#undef IN
#undef SEAM
}

#ifndef HYB
#define HYB 1
#endif
static int launch_fast(void* const* d_in, float* out, void* d_ws, const int* seg, int nseg, hipStream_t stream) {
    static int grid = 0;
    if (grid == 0) {
        int dev = 0, cus = 0;
        if (hipGetDevice(&dev) != hipSuccess || hipDeviceGetAttribute(&cus, hipDeviceAttributeMultiprocessorCount, dev) != hipSuccess) { fprintf(stderr, "device query failed\n"); grid = -1; return -1; }
        if (hipFuncSetAttribute((const void*)mk_fwd, hipFuncAttributeMaxDynamicSharedMemorySize, LDS_BYTES) != hipSuccess) { fprintf(stderr, "hipFuncSetAttribute failed\n"); grid = -1; return -1; }
        int per_cu = 0;
        if (hipOccupancyMaxActiveBlocksPerMultiprocessor(&per_cu, (const void*)mk_fwd, NWAVES * 64, LDS_BYTES) != hipSuccess || per_cu < 1) fprintf(stderr, "note: occupancy query says %d\n", per_cu);
        (void)hipGetLastError();
        grid = cus;
        if (grid != 256) { fprintf(stderr, "kernel_launch: built for a 256-CU device (router tiles = workgroups); got %d\n", cus); grid = -1; return -1; }
    }
    if (grid < 0) return -1;
    Args a{};
    for (int i = 0; i < 23; ++i) a.in[i] = (const float*)d_in[i];
    a.out = out; a.ws = (unsigned char*)d_ws;
    for (int i = 0; i < nseg; ++i) { a.ph_lo = seg[2 * i]; a.ph_hi = seg[2 * i + 1]; a.use_bar = (a.ph_hi - a.ph_lo > 1) ? 1 : 0; a.bar_region = i;
        hipLaunchKernelGGL(mk_fwd, dim3(grid), dim3(NWAVES * 64), LDS_BYTES, stream, a); }
    return 0;
}

extern "C" void kernel_launch(void* const* d_in, const int* in_sizes, int n_in, void* d_out, int out_size, void* d_ws, size_t ws_size, hipStream_t stream) {
    char* ws = (char*)d_ws; float* out = (float*)d_out;
#if HYB == 0
    run_naive(d_in, out, nv_default_map(ws), 0, stream);
#elif HYB == 1
    (void)hipMemsetAsync(ws + WS_CTL, 0, CTL_ZERO_BYTES, stream);
    { const int seg[] = {0, 1, 1, 2}; if (launch_fast(d_in, out, d_ws, seg, 2, stream) != 0) return; }
    NvMap m = nv_default_map(ws);
    m.proj = (float*)(ws + 226 * MiB); m.ldp = 2056; m.qkv = (float*)(ws + 4 * MiB); m.o = (float*)(ws + 100 * MiB); m.mix = (float*)(ws + 132 * MiB); m.u = (float*)(ws + 392 * MiB); m.h = (float*)(ws + 424 * MiB);
    m.xn = m.mix; m.logits = m.o; m.UP = (float*)(ws + 4 * MiB); m.ACT = (float*)(ws + 356 * MiB); m.Y = (float*)(ws + 196 * MiB); m.G = (float*)(ws + 4 * MiB); m.PP = (float*)(ws + 196 * MiB);
    k_shimA<<<(int)(((size_t)M * 2048 + 255) / 256), 256, 0, stream>>>((const unsigned short*)(ws + WS_QKVZ), (const float*)(ws + WS_AB), (const unsigned short*)(ws + WS_U), m.proj, m.ldp, m.u);
    run_naive(d_in, out, m, 1, stream);
#elif HYB == 2
    (void)hipMemsetAsync(ws + WS_CTL, 0, CTL_ZERO_BYTES, stream);
    { const int seg[] = {0, 1, 1, 2, 2, 3, 3, 4, 4, 5}; if (launch_fast(d_in, out, d_ws, seg, 5, stream) != 0) return; }
    NvMap m = nv_default_map(ws);
    k_shimB<<<(int)(((size_t)M * DM + 255) / 256), 256, 0, stream>>>((const unsigned short*)(ws + WS_MIX), m.mix);
    run_naive(d_in, out, m, 2, stream);
#elif HYB == 3
    (void)hipMemsetAsync(ws + WS_CTL, 0, CTL_ZERO_BYTES, stream);
    { const int seg[] = {0, 1, 1, 2, 2, 3, 3, 4, 4, 5, 5, 6}; if (launch_fast(d_in, out, d_ws, seg, 6, stream) != 0) return; }
    NvMap m = nv_default_map(ws); m.h = (float*)(ws + WS_H1);
    run_naive(d_in, out, m, 3, stream);
#elif HYB == 4
    (void)hipMemsetAsync(ws + WS_CTL, 0, CTL_ZERO_BYTES, stream);
    { const int seg[] = {0, 1, 1, 2, 2, 3, 3, 4, 4, 5, 5, 6, 6, 8, 8, 9, 9, 10, 10, 11}; if (launch_fast(d_in, out, d_ws, seg, 10, stream) != 0) return; }
    NvMap m = nv_default_map(ws); m.h = (float*)(ws + WS_H1);
    run_naive(d_in, out, m, 4, stream);
#elif HYB == 5
    (void)hipMemsetAsync(ws + WS_CTL, 0, CTL_ZERO_BYTES, stream);
    { const int seg[] = {0, 1, 1, 2, 2, 3, 3, 4, 4, 5, 5, 6, 6, 8, 8, 9, 9, 10, 10, 11, 11, 12, 12, 13}; if (launch_fast(d_in, out, d_ws, seg, 12, stream) != 0) return; }
#elif HYB == 6
    (void)hipMemsetAsync(ws + WS_CTL, 0, CTL_ZERO_BYTES, stream);
    { const int seg[] = {0, 13}; if (launch_fast(d_in, out, d_ws, seg, 1, stream) != 0) return; }
#endif
}
```

```cpp
#include <hip/hip_runtime.h>
#include <cstdio>
#include <cstdint>

constexpr int DM = 1024, NB = 2, SEQ = 8192, M = NB * SEQ, PLE = 256;
constexpr int NH = 4, DK = 128, DV = 128, QKW = 512, VW = 512, CCH = 512, CWID = 31;
constexpr int NGRP = 8, EPG = 8, NEXP = 64, DEXP = 256, INC = 3080;
constexpr int O1 = 1536, O2 = 2048, O3 = 2052, O4 = 2056;
constexpr float EPS = 1e-6f;

#define HYB 6
namespace pg8 {
#define PG8_LAS __attribute__((address_space(3)))
typedef unsigned short bf16_t;
typedef short bf16x8 __attribute__((ext_vector_type(8)));
typedef float f32x4 __attribute__((ext_vector_type(4)));
typedef unsigned u32x4 __attribute__((ext_vector_type(4)));
constexpr int BM = 256, BK = 64, HALF = 128, HTB = HALF * BK * 2  , STAGE_BYTES = 8 * HTB, NXCD = 8, WGM = 8;

__host__ __device__ __forceinline__ int lds_byte(int r, int c) { const int st = (r >> 4) * 2 + (c >> 5), rr = r & 15, cc = c & 31, ob = rr * 64 + cc * 2; return st * 1024 + (ob ^ (((ob >> 9) & 1) << 5)); }
__host__ __device__ __forceinline__ void stage_rc(int b, int& R, int& C) { const int st = b / 1024, sb = b % 1024, swz = sb ^ (((sb >> 9) & 1) << 5); R = (st >> 1) * 16 + swz / 64; C = (st & 1) * 32 + (swz % 64) / 2; }
__host__ __device__ __forceinline__ int perm32(int rho) { const int n = rho >> 4, i = rho & 15; return 8 * (i >> 2) + 4 * n + (i & 3); }

struct Unit { int pm, pn, be; };
struct Gemm { const bf16_t* A; const bf16_t* Bt; int M, N, K; size_t bstride; };

struct StaticOrder {
    int nM, nN, nwg, G, c;
    __host__ __device__ void init(int M, int N, int G_, int c_) { nM = M / BM; nN = N / BM; nwg = nM * nN; G = G_; c = c_; }
    __host__ __device__ bool next(int i, Unit& u) const {
        const long L = (long)i * G + c; if (L >= nwg) return false;
        int wgid = (int)L; { const int q = nwg / NXCD, r = nwg % NXCD, xcd = wgid % NXCD, off = wgid / NXCD; wgid = (xcd < r ? xcd * (q + 1) : r * (q + 1) + (xcd - r) * q) + off; }
        const int nig = WGM * nN, gid = wgid / nig, fm = gid * WGM, gsz = (nM - fm) < WGM ? (nM - fm) : WGM;
        u.pm = fm + ((wgid % nig) % gsz); u.pn = (wgid % nig) / gsz; u.be = 0; return true;
    }
    __device__ __forceinline__ void a_ready(const Unit&) const {}
    __device__ __forceinline__ void done(const Unit&) const {}
};

__device__ __forceinline__ unsigned cvt_pk_bf16(float lo, float hi) { unsigned r; asm volatile("v_cvt_pk_bf16_f32 %0, %1, %2" : "=v"(r) : "v"(lo), "v"(hi)); return r; }
typedef float f32x2 __attribute__((ext_vector_type(2)));
__device__ __forceinline__ f32x2 gelu_pk(f32x2 v) {
    const f32x2 av = __builtin_elementwise_abs(v), d = av * 0.2316418882f + 1.0f;
    f32x2 t; t.x = __builtin_amdgcn_rcpf(d.x); t.y = __builtin_amdgcn_rcpf(d.y);
    f32x2 q = t * 0.5307027145f + (-0.7265760135f); q = q * t + 0.7107068705f; q = q * t + (-0.142248368f); q = q * t + 0.127414796f; q = q * t;
    const f32x2 s = (v * v) * (-0.72134752044f);
    f32x2 e; e.x = __builtin_amdgcn_exp2f(s.x); e.y = __builtin_amdgcn_exp2f(s.y);
    const f32x2 m = v * (q * e), r = v - m;
    f32x2 o; o.x = v.x < 0.f ? m.x : r.x; o.y = v.y < 0.f ? m.y : r.y; return o;
}

template <int ACT  > struct EpiBf16 {
    static constexpr bool PERM = true, AFTER_DRAIN = false; static_assert(ACT == 0 || ACT == 1, "EpiBf16: ACT is 0 (none) or 1 (gelu_pk)");
    bf16_t* O; int ldc; const float* bias; int split_cols; size_t split_stride; float scale0;
    __device__ __forceinline__ void operator()(const f32x4 (&acc)[2][2][4][2], const Unit& u, int wr, int wc, int fr, int fq) const {
        const int row0 = u.pm * BM + wr * 64 + fr; int colt = u.pn * BM; bf16_t* base = O;
        float sc = 1.f; if (split_cols) { const int t = colt / split_cols; base += (size_t)t * split_stride; colt -= t * split_cols; if (t == 0) sc = scale0; }
        const int col0 = colt + wc * 32 + 8 * fq, bcol0 = u.pn * BM + wc * 32 + 8 * fq;
        f32x4 bv[2][2];
#pragma unroll
        for (int bj = 0; bj < 2; ++bj)
#pragma unroll
            for (int n = 0; n < 2; ++n) bv[bj][n] = bias ? *(const f32x4*)(bias + bcol0 + bj * HALF + 4 * n) : (f32x4){0.f, 0.f, 0.f, 0.f};
#pragma unroll
        for (int ai = 0; ai < 2; ++ai)
#pragma unroll
            for (int m = 0; m < 4; ++m) { bf16_t* rowp = base + (size_t)(row0 + ai * HALF + m * 16) * ldc + col0;
#pragma unroll
                for (int bj = 0; bj < 2; ++bj) { f32x4 v0 = acc[ai][bj][m][0] + bv[bj][0], v1 = acc[ai][bj][m][1] + bv[bj][1];
                    if (ACT == 1) { f32x2 a = gelu_pk((f32x2){v0[0], v0[1]}), b = gelu_pk((f32x2){v0[2], v0[3]}), c = gelu_pk((f32x2){v1[0], v1[1]}), d = gelu_pk((f32x2){v1[2], v1[3]});
                        v0 = (f32x4){a.x, a.y, b.x, b.y}; v1 = (f32x4){c.x, c.y, d.x, d.y}; }
                    v0 = v0 * sc; v1 = v1 * sc; u32x4 w; w.x = cvt_pk_bf16(v0[0], v0[1]); w.y = cvt_pk_bf16(v0[2], v0[3]); w.z = cvt_pk_bf16(v1[0], v1[1]); w.w = cvt_pk_bf16(v1[2], v1[3]);
                    *(u32x4*)(rowp + bj * HALF) = w; } }
    }
};

struct PanelStats {
    unsigned* xbuf;
    unsigned* cnt;
    unsigned* tmo;
    int ntn; float eps;
    unsigned code;
    __device__ __forceinline__ bool run(const f32x4 (&v)[2][2][4][2], const Unit& u, int wr, int wc, int fr, int fq, PG8_LAS unsigned char* lds, int wid, int lane) const {
        typedef float f32x2v __attribute__((ext_vector_type(2)));
        PG8_LAS f32x2v* P = (PG8_LAS f32x2v*)lds;
        PG8_LAS f32x2v* S = (PG8_LAS f32x2v*)(lds + 8192);
        PG8_LAS unsigned* flag = (PG8_LAS unsigned*)(lds + 8192 + 2048);
#pragma unroll
        for (int ai = 0; ai < 2; ++ai)
#pragma unroll
            for (int m = 0; m < 4; ++m) {
                float s = 0.f;
#pragma unroll
                for (int bj = 0; bj < 2; ++bj)
#pragma unroll
                    for (int n = 0; n < 2; ++n) { const f32x4 x = v[ai][bj][m][n]; s += (x[0] + x[1]) + (x[2] + x[3]); }
                s += __shfl_xor(s, 16); s += __shfl_xor(s, 32);
                const float mw = s * (1.0f / 64.0f); float q = 0.f;
#pragma unroll
                for (int bj = 0; bj < 2; ++bj)
#pragma unroll
                    for (int n = 0; n < 2; ++n) { const f32x4 d = v[ai][bj][m][n] - mw; q += (d[0] * d[0] + d[1] * d[1]) + (d[2] * d[2] + d[3] * d[3]); }
                q += __shfl_xor(q, 16); q += __shfl_xor(q, 32);
                if (fq == 0) P[(ai * HALF + wr * 64 + m * 16 + fr) * 4 + wc] = (f32x2v){mw, q};
            }
        asm volatile("s_waitcnt lgkmcnt(0)" ::: "memory"); __builtin_amdgcn_s_barrier(); asm volatile("" ::: "memory");
#if defined(BROKEN_EXCHANGE_NO_WAIT)
#warning BROKEN CONTROL BUILD: the row-statistics exchange does not wait; results are wrong by design
        if (blockIdx.x >= 64) { const long long t0_ = clock64(); while (clock64() - t0_ < 60000) __builtin_amdgcn_s_sleep(8); }
#endif
        const int row = wid * 32 + (lane & 31);
        if (lane < 32) {
            const f32x2v a = P[row * 4 + 0], b = P[row * 4 + 1], c = P[row * 4 + 2], d = P[row * 4 + 3];
            const float mt = (a.x + b.x + c.x + d.x) * 0.25f;
            const float da = a.x - mt, db = b.x - mt, dc = c.x - mt, dd = d.x - mt;
            const float m2 = (a.y + b.y) + (c.y + d.y) + 64.0f * ((da * da + db * db) + (dc * dc + dd * dd));
            unsigned long long* slot = (unsigned long long*)xbuf + ((size_t)(u.pm * BM + row) * 4 + u.pn);
            __hip_atomic_store(slot, ((unsigned long long)__float_as_uint(m2) << 32) | __float_as_uint(mt), __ATOMIC_RELAXED, __HIP_MEMORY_SCOPE_AGENT);
        }
        asm volatile("s_waitcnt vmcnt(0)" ::: "memory");
        if (lane == 0) __hip_atomic_fetch_add(cnt + 64 * u.pm, 1u, __ATOMIC_RELAXED, __HIP_MEMORY_SCOPE_AGENT);
        if (wid == 0) {
            bool dead = false; const unsigned long long t0 = __builtin_amdgcn_s_memrealtime(); const unsigned want = 8u * (unsigned)ntn;
            for (;;) {
#if defined(BROKEN_EXCHANGE_NO_WAIT)
                break;
#endif
                if ((unsigned)__builtin_amdgcn_readfirstlane(__hip_atomic_load(cnt + 64 * u.pm, __ATOMIC_RELAXED, __HIP_MEMORY_SCOPE_AGENT)) >= want) break;
                if (__builtin_amdgcn_s_memrealtime() - t0 > 2000000ull) {
                    if (lane == 0) { unsigned expect = 0u; __hip_atomic_compare_exchange_strong(tmo + 1, &expect, code | (unsigned)(u.pm & 0xff), __ATOMIC_RELAXED, __ATOMIC_RELAXED, __HIP_MEMORY_SCOPE_AGENT);
                                     __hip_atomic_store(tmo, 1u, __ATOMIC_RELAXED, __HIP_MEMORY_SCOPE_AGENT); }
                    dead = true; break; }
                __builtin_amdgcn_s_sleep(2);
            }
            __builtin_amdgcn_fence(__ATOMIC_ACQUIRE, "agent");
            if (lane == 0) flag[0] = dead ? 1u : 0u;
        }
        asm volatile("s_waitcnt vmcnt(0) lgkmcnt(0)" ::: "memory"); __builtin_amdgcn_s_barrier(); asm volatile("" ::: "memory");
        const bool bad = flag[0] != 0u;
        if (lane < 32) {
            const unsigned long long* slot = (const unsigned long long*)xbuf + (size_t)(u.pm * BM + row) * 4; float mt[4], m2[4]; float ms = 0.f;
#pragma unroll
            for (int t = 0; t < 4; ++t) { if (t < ntn) { const unsigned long long w = __hip_atomic_load(slot + t, __ATOMIC_RELAXED, __HIP_MEMORY_SCOPE_AGENT); mt[t] = __uint_as_float((unsigned)w); m2[t] = __uint_as_float((unsigned)(w >> 32)); } else { mt[t] = 0.f; m2[t] = 0.f; } ms += mt[t]; }
            const float mean = ms / (float)ntn; float q = 0.f;
#pragma unroll
            for (int t = 0; t < 4; ++t) if (t < ntn) { const float dm = mt[t] - mean; q += m2[t] + 256.0f * dm * dm; }
            S[row] = (f32x2v){mean, 1.0f / sqrtf(q / (256.0f * (float)ntn) + eps)};
        }
        asm volatile("s_waitcnt lgkmcnt(0)" ::: "memory"); __builtin_amdgcn_s_barrier(); asm volatile("" ::: "memory");
        return bad;
    }
};
struct EpiLnRes {
    static constexpr bool PERM = false, AFTER_DRAIN = true;
    const float* base; float* out; int ldc; const float* bias; PanelStats st; unsigned poison;
    __device__ __forceinline__ void fused(f32x4 (&acc)[2][2][4][2], const Unit& u, int wr, int wc, int fr, int fq, PG8_LAS unsigned char* lds, int wid, int lane) const {
        typedef float f32x2v __attribute__((ext_vector_type(2)));
        const PG8_LAS f32x2v* S = (const PG8_LAS f32x2v*)(lds + 8192);
        const int col0 = u.pn * BM + wc * 32 + 4 * fq;
#pragma unroll
        for (int bj = 0; bj < 2; ++bj)
#pragma unroll
            for (int n = 0; n < 2; ++n) { const f32x4 bv = bias ? *(const f32x4*)(bias + col0 + bj * HALF + n * 16) : (f32x4){0.f, 0.f, 0.f, 0.f};
#pragma unroll
                for (int ai = 0; ai < 2; ++ai)
#pragma unroll
                    for (int m = 0; m < 4; ++m) acc[ai][bj][m][n] += bv; }
        f32x4 pre[4][2][2];
#pragma unroll
        for (int m = 0; m < 4; ++m) { const size_t off = (size_t)(u.pm * BM + wr * 64 + m * 16 + fr) * ldc + col0;
#pragma unroll
            for (int bj = 0; bj < 2; ++bj)
#pragma unroll
                for (int n = 0; n < 2; ++n) pre[m][bj][n] = *(const f32x4*)(base + off + bj * HALF + n * 16); }
        const bool bad = st.run(acc, u, wr, wc, fr, fq, lds, wid, lane) || poison != 0u;
        const float qnan = __builtin_nanf("");
#pragma unroll
        for (int ai = 0; ai < 2; ++ai)
#pragma unroll
            for (int m = 0; m < 4; ++m) { const int r = ai * HALF + wr * 64 + m * 16 + fr; const f32x2v sr = S[r]; const size_t off = (size_t)(u.pm * BM + r) * ldc + col0;
#pragma unroll
                for (int bj = 0; bj < 2; ++bj)
#pragma unroll
                    for (int n = 0; n < 2; ++n) { const f32x4 bs = ai == 0 ? pre[m][bj][n] : *(const f32x4*)(base + off + bj * HALF + n * 16); f32x4 o = bs + (acc[ai][bj][m][n] - sr.x) * sr.y;
                        if (bad) o = (f32x4){qnan, qnan, qnan, qnan}; *(f32x4*)(out + off + bj * HALF + n * 16) = o; }
                if (m & 1) asm volatile("" ::: "memory"); }
    }
};
struct EpiLnResLn {
    static constexpr bool PERM = false, AFTER_DRAIN = true;
    const float* base; float* out; bf16_t* xn; int ldc; const float* bias; PanelStats st1, st2; unsigned poison;
    __device__ __forceinline__ void fused(f32x4 (&acc)[2][2][4][2], const Unit& u, int wr, int wc, int fr, int fq, PG8_LAS unsigned char* lds, int wid, int lane) const {
        typedef float f32x2v __attribute__((ext_vector_type(2))); typedef unsigned u32x2v __attribute__((ext_vector_type(2)));
        const PG8_LAS f32x2v* S = (const PG8_LAS f32x2v*)(lds + 8192);
        const int col0 = u.pn * BM + wc * 32 + 4 * fq;
#pragma unroll
        for (int bj = 0; bj < 2; ++bj)
#pragma unroll
            for (int n = 0; n < 2; ++n) { const f32x4 bv = bias ? *(const f32x4*)(bias + col0 + bj * HALF + n * 16) : (f32x4){0.f, 0.f, 0.f, 0.f};
#pragma unroll
                for (int ai = 0; ai < 2; ++ai)
#pragma unroll
                    for (int m = 0; m < 4; ++m) acc[ai][bj][m][n] += bv; }
        bool bad = st1.run(acc, u, wr, wc, fr, fq, lds, wid, lane) || poison != 0u;
        const float qnan = __builtin_nanf("");
#pragma unroll
        for (int ai = 0; ai < 2; ++ai)
#pragma unroll
            for (int m = 0; m < 4; ++m) { const int r = ai * HALF + wr * 64 + m * 16 + fr; const f32x2v sr = S[r]; const size_t off = (size_t)(u.pm * BM + r) * ldc + col0;
#pragma unroll
                for (int bj = 0; bj < 2; ++bj)
#pragma unroll
                    for (int n = 0; n < 2; ++n) { const f32x4 bs = *(const f32x4*)(base + off + bj * HALF + n * 16); acc[ai][bj][m][n] = bs + (acc[ai][bj][m][n] - sr.x) * sr.y; }
                asm volatile("" : "+v"(acc[ai][0][m][0]), "+v"(acc[ai][0][m][1]), "+v"(acc[ai][1][m][0]), "+v"(acc[ai][1][m][1]));
                if (m & 1) asm volatile("" ::: "memory"); }
        const bool bad1 = bad;
        bad = st2.run(acc, u, wr, wc, fr, fq, lds, wid, lane) || bad;
#pragma unroll
        for (int ai = 0; ai < 2; ++ai)
#pragma unroll
            for (int m = 0; m < 4; ++m) { const int r = ai * HALF + wr * 64 + m * 16 + fr; const f32x2v sr = S[r]; const size_t off = (size_t)(u.pm * BM + r) * ldc + col0;
#pragma unroll
                for (int bj = 0; bj < 2; ++bj)
#pragma unroll
                    for (int n = 0; n < 2; ++n) { const f32x4 x1 = acc[ai][bj][m][n]; *(f32x4*)(out + off + bj * HALF + n * 16) = bad1 ? (f32x4){qnan, qnan, qnan, qnan} : x1;
                        const f32x4 o = (x1 - sr.x) * sr.y; u32x2v w; w.x = cvt_pk_bf16(o[0], o[1]); w.y = cvt_pk_bf16(o[2], o[3]);
                        if (bad) { w.x = 0x7fc07fc0u; w.y = 0x7fc07fc0u; } *(u32x2v*)(xn + off + bj * HALF + n * 16) = w; }
                asm volatile("" ::: "memory"); }
    }
};

template <class Epi, class Sched, bool ALIGN_EPI = false, bool SP2 = false>
__device__ __forceinline__ void gemm_phase(PG8_LAS unsigned char* lds, const Gemm g, const Sched& S, const Epi& E, const int wid  ) {
    int lane; asm volatile("v_mbcnt_lo_u32_b32 %0, -1, 0\n\tv_mbcnt_hi_u32_b32 %0, -1, %0" : "=v"(lane));
    const int tid = wid * 64 + lane, wr = wid >> 2, wc = wid & 3, fr = lane & 15, fq = lane >> 4;
    const int K = g.K, nt = K / BK;
    unsigned voffA[2], voffB[2];
#pragma unroll
    for (int i = 0; i < 2; ++i) { int R, C; stage_rc(tid * 16 + i * 8192, R, C); const int Rb = Epi::PERM ? ((R & ~31) + perm32(R & 31)) : R;
        voffA[i] = (unsigned)(R * K + C) * 2u; voffB[i] = (unsigned)(Rb * K + C) * 2u; }
    const size_t kstep = (size_t)(BK * 2);
    const size_t hstep = (size_t)HALF * K * 2;
    const size_t tstep = 2 * hstep;
    const unsigned ldsw = (unsigned)wid * 1024u;
    const int aoff = lds_byte(wr * 64 + fr, fq * 8), boff = lds_byte(wc * 32 + fr, fq * 8);
#define PG8_SA(b, h) (((b) * 2 + (h)) * HTB)
#define PG8_SB(b, h) ((4 + (b) * 2 + (h)) * HTB)
#define PG8_STAGE(bufoff, gbase, voff) do { _Pragma("unroll") for (int _i = 0; _i < 2; ++_i) \
        __builtin_amdgcn_global_load_lds((const unsigned*)((const char*)(gbase) + (voff)[_i]), (PG8_LAS unsigned*)(lds + (bufoff) + ldsw + _i * 8192), 16, 0, 0); } while (0)
#define PG8_LDA(dst, b, h) do { _Pragma("unroll") for (int m = 0; m < 4; ++m) _Pragma("unroll") for (int k = 0; k < 2; ++k) dst[m][k] = *(const PG8_LAS bf16x8*)(lds + PG8_SA(b, h) + aoff + m * 2048 + k * 1024); } while (0)
#define PG8_LDB(dst, b, h) do { _Pragma("unroll") for (int n = 0; n < 2; ++n) _Pragma("unroll") for (int k = 0; k < 2; ++k) dst[n][k] = *(const PG8_LAS bf16x8*)(lds + PG8_SB(b, h) + boff + n * 2048 + k * 1024); } while (0)
#define PG8_MMA(ai, bj, At, Bt) do { __builtin_amdgcn_s_setprio(1); _Pragma("unroll") for (int m = 0; m < 4; ++m) _Pragma("unroll") for (int n = 0; n < 2; ++n) _Pragma("unroll") for (int k = 0; k < 2; ++k) \
        acc[ai][bj][m][n] = __builtin_amdgcn_mfma_f32_16x16x32_bf16(Bt[n][k], At[m][k], acc[ai][bj][m][n], 0, 0, 0); __builtin_amdgcn_s_setprio(0); } while (0)
#define PG8_WAIT_V(n) asm volatile("s_waitcnt vmcnt(" #n ")" ::: "memory")
#define PG8_WAIT_L(n) asm volatile("s_waitcnt lgkmcnt(" #n ")" ::: "memory")
#define PG8_BAR __builtin_amdgcn_s_barrier()
#define PG8_SCHED __builtin_amdgcn_sched_barrier(0)
    Unit cur, nxt; int ui = 0;
    if (!S.next(0, cur)) return;
    f32x4 acc[2][2][4][2];
#pragma unroll
    for (int a = 0; a < 2; ++a)
#pragma unroll
        for (int b = 0; b < 2; ++b)
#pragma unroll
            for (int m = 0; m < 4; ++m)
#pragma unroll
                for (int n = 0; n < 2; ++n) acc[a][b][m][n] = (f32x4){0.f, 0.f, 0.f, 0.f};
    bf16x8 At[4][2], B0[2][2], B1[2][2];
    const char* cA = (const char*)g.A + (size_t)cur.pm * tstep; const char* cB = (const char*)g.Bt + (size_t)cur.pn * tstep + (size_t)cur.be * g.bstride;
    S.a_ready(cur);
    if constexpr (SP2) {
        PG8_STAGE(PG8_SB(0, 0), cB, voffB); PG8_STAGE(PG8_SB(0, 1), cB + hstep, voffB); PG8_STAGE(PG8_SA(0, 0), cA, voffA); PG8_STAGE(PG8_SA(0, 1), cA + hstep, voffA);
        if (wr == 1) PG8_BAR;
        PG8_WAIT_V(2); PG8_BAR;
        PG8_STAGE(PG8_SB(1, 0), cB + kstep, voffB); PG8_STAGE(PG8_SA(1, 0), cA + kstep, voffA); PG8_STAGE(PG8_SB(1, 1), cB + hstep + kstep, voffB);
        PG8_WAIT_V(6); PG8_BAR;
    } else {
        PG8_STAGE(PG8_SB(0, 0), cB, voffB); PG8_STAGE(PG8_SA(0, 0), cA, voffA); PG8_STAGE(PG8_SB(0, 1), cB + hstep, voffB); PG8_STAGE(PG8_SA(0, 1), cA + hstep, voffA);
        if (wr == 1) PG8_BAR;
        PG8_WAIT_V(4); PG8_BAR;
        PG8_STAGE(PG8_SB(1, 0), cB + kstep, voffB); PG8_STAGE(PG8_SA(1, 0), cA + kstep, voffA); PG8_STAGE(PG8_SB(1, 1), cB + hstep + kstep, voffB);
        PG8_WAIT_V(6); PG8_BAR;
    }
    for (;;) {
        const bool has_next = S.next(ui + 1, nxt);
        const char* nA = has_next ? (const char*)g.A + (size_t)nxt.pm * tstep : cA; const char* nB = has_next ? (const char*)g.Bt + (size_t)nxt.pn * tstep + (size_t)nxt.be * g.bstride : cB;
        for (int t = 0; t < nt; t += 2) {
            const bool last = (t == nt - 2);
            const char* a1 = cA + (size_t)(t + 1) * kstep;
            const char* a2 = last ? nA : cA + (size_t)(t + 2) * kstep; const char* b2 = last ? nB : cB + (size_t)(t + 2) * kstep;
            const char* a3 = a2 + kstep; const char* b3 = b2 + kstep;
            if (last && has_next) S.a_ready(nxt);
            if constexpr (SP2) {
            PG8_LDB(B0, 0, 0); PG8_LDB(B1, 0, 1); PG8_SCHED; PG8_LDA(At, 0, 0); PG8_STAGE(PG8_SA(1, 1), a1 + hstep, voffA);
            PG8_WAIT_V(8); PG8_WAIT_L(0); PG8_BAR; PG8_MMA(0, 0, At, B0); PG8_MMA(0, 1, At, B1); PG8_BAR; PG8_SCHED;
            PG8_LDA(At, 0, 1); PG8_STAGE(PG8_SB(0, 0), b2, voffB); PG8_STAGE(PG8_SB(0, 1), b2 + hstep, voffB); PG8_STAGE(PG8_SA(0, 0), a2, voffA);
            PG8_WAIT_V(8); PG8_WAIT_L(0); PG8_BAR; PG8_MMA(1, 0, At, B0); PG8_MMA(1, 1, At, B1); PG8_BAR; PG8_SCHED;
            PG8_LDB(B0, 1, 0); PG8_LDB(B1, 1, 1); PG8_SCHED; PG8_LDA(At, 1, 0); PG8_STAGE(PG8_SA(0, 1), a2 + hstep, voffA);
            PG8_WAIT_V(8); PG8_WAIT_L(0); PG8_BAR; PG8_MMA(0, 0, At, B0); PG8_MMA(0, 1, At, B1); PG8_BAR; PG8_SCHED;
            PG8_LDA(At, 1, 1); PG8_STAGE(PG8_SB(1, 0), b3, voffB); PG8_STAGE(PG8_SB(1, 1), b3 + hstep, voffB); PG8_STAGE(PG8_SA(1, 0), a3, voffA);
            PG8_WAIT_V(8); PG8_WAIT_L(0); PG8_BAR; PG8_MMA(1, 0, At, B0); PG8_MMA(1, 1, At, B1); PG8_BAR; PG8_SCHED;
            } else {
            PG8_LDB(B0, 0, 0); PG8_SCHED; PG8_LDA(At, 0, 0); PG8_STAGE(PG8_SA(1, 1), a1 + hstep, voffA);
            PG8_WAIT_L(8); PG8_BAR; PG8_WAIT_L(0); PG8_MMA(0, 0, At, B0); PG8_BAR; PG8_SCHED;
            PG8_LDB(B1, 0, 1); PG8_STAGE(PG8_SB(0, 0), b2, voffB);
            PG8_BAR; PG8_WAIT_L(0); PG8_MMA(0, 1, At, B1); PG8_BAR;
            PG8_LDA(At, 0, 1); PG8_STAGE(PG8_SA(0, 0), a2, voffA);
            PG8_BAR; PG8_WAIT_L(0); PG8_MMA(1, 0, At, B0); PG8_BAR; PG8_SCHED;
            PG8_STAGE(PG8_SB(0, 1), b2 + hstep, voffB);
            PG8_WAIT_V(6); PG8_BAR; PG8_MMA(1, 1, At, B1); PG8_BAR;
            PG8_LDB(B0, 1, 0); PG8_SCHED; PG8_LDA(At, 1, 0); PG8_STAGE(PG8_SA(0, 1), a2 + hstep, voffA);
            PG8_WAIT_L(8); PG8_BAR; PG8_WAIT_L(0); PG8_MMA(0, 0, At, B0); PG8_BAR; PG8_SCHED;
            PG8_LDB(B1, 1, 1); PG8_STAGE(PG8_SB(1, 0), b3, voffB);
            PG8_BAR; PG8_WAIT_L(0); PG8_MMA(0, 1, At, B1); PG8_BAR;
            PG8_LDA(At, 1, 1); PG8_STAGE(PG8_SA(1, 0), a3, voffA);
            PG8_BAR; PG8_WAIT_L(0); PG8_MMA(1, 0, At, B0); PG8_BAR; PG8_SCHED;
            PG8_STAGE(PG8_SB(1, 1), b3 + hstep, voffB);
            PG8_WAIT_V(6); PG8_BAR; PG8_MMA(1, 1, At, B1); PG8_BAR;
            }
        }
        if constexpr (ALIGN_EPI) { if (wr == 0) PG8_BAR; }
        if constexpr (!Epi::AFTER_DRAIN) { E(acc, cur, wr, wc, fr, fq); S.done(cur); }
        if (!has_next) break;
#pragma unroll
        for (int a = 0; a < 2; ++a)
#pragma unroll
            for (int b = 0; b < 2; ++b)
#pragma unroll
                for (int m = 0; m < 4; ++m)
#pragma unroll
                    for (int n = 0; n < 2; ++n) acc[a][b][m][n] = (f32x4){0.f, 0.f, 0.f, 0.f};
        cur = nxt; cA = nA; cB = nB; ++ui;
        if constexpr (ALIGN_EPI) { if (wr == 1) PG8_BAR; }
    }
    PG8_WAIT_V(0);
    if constexpr (!ALIGN_EPI) { if (wr == 0) PG8_BAR; }
    PG8_BAR;
    if constexpr (Epi::AFTER_DRAIN) { E.fused(acc, cur, wr, wc, fr, fq, lds, wid, lane); S.done(cur); }
#undef PG8_SA
#undef PG8_SB
#undef PG8_STAGE
#undef PG8_LDA
#undef PG8_LDB
#undef PG8_MMA
#undef PG8_WAIT_V
#undef PG8_WAIT_L
#undef PG8_BAR
#undef PG8_SCHED
}
}
#define GAS __attribute__((address_space(1)))
#define LAS __attribute__((address_space(3)))
typedef unsigned short bf16;
typedef unsigned v4u __attribute__((ext_vector_type(4)));
typedef float f32x4 __attribute__((ext_vector_type(4)));
typedef short bf16x8 __attribute__((ext_vector_type(8)));
typedef GAS unsigned gu32;
typedef GAS unsigned long long gu64;
#define RLX_AGENT __ATOMIC_RELAXED, __HIP_MEMORY_SCOPE_AGENT
#define LDS_WAIT() asm volatile("s_waitcnt lgkmcnt(0)" ::: "memory")
#define VM_WAIT() asm volatile("s_waitcnt vmcnt(0)" ::: "memory")
__device__ __forceinline__ unsigned long long rt() { return __builtin_amdgcn_s_memrealtime(); }
__device__ __forceinline__ unsigned f2bf(float f) { unsigned u = __builtin_bit_cast(unsigned, f); return (u + 0x7fffu + ((u >> 16) & 1u)) >> 16; }
__device__ __forceinline__ unsigned pk2(float lo, float hi) { return f2bf(lo) | (f2bf(hi) << 16); }

#define XB_TMO      128
#define XB_XCNT(j)  (256  + 64 * (j))
#define XB_XSUB(j)  (1280 + 64 * (j))
#define XB_XGEN(j)  (2304 + 64 * (j))
#define XB_TOP      3328
#define XB_TOPGEN   3392
#define XCD_BAR_WORDS 3456
#define XB_SPIN_CAP (1u << 18)

__device__ __forceinline__ unsigned xb_ld(unsigned* p)              { return __hip_atomic_load(p, __ATOMIC_RELAXED, __HIP_MEMORY_SCOPE_AGENT); }
__device__ __forceinline__ unsigned xb_add(unsigned* p, unsigned v) { return __hip_atomic_fetch_add(p, v, __ATOMIC_RELAXED, __HIP_MEMORY_SCOPE_AGENT); }
__device__ __forceinline__ unsigned xb_xcc_id() { return (unsigned)__builtin_amdgcn_s_getreg((3 << 11) | 20) & 0xFu; }
#define XB_SPIN(cond, bar) do { unsigned _sp = 0; while (cond) { __builtin_amdgcn_s_sleep(1); \
    if ((++_sp & 255u) == 0u) { if (xb_ld(&(bar)[XB_TMO])) break; if (_sp > XB_SPIN_CAP) { atomicAdd(&(bar)[XB_TMO], 1u); break; } } } } while (0)

struct XcdBarrier {
    unsigned* bar; unsigned x;
    volatile LAS unsigned* st;
};

__device__ __forceinline__ XcdBarrier xcd_barrier_post(unsigned* bar, volatile LAS unsigned* st, bool leader) {
    XcdBarrier b; b.bar = bar; b.x = xb_xcc_id(); b.st = st;
    if (leader) (void)xb_add(&bar[XB_XCNT(b.x)], 1u);
    return b;
}
__device__ __forceinline__ void xcd_barrier_complete(unsigned* bar, unsigned x, unsigned& nloc, unsigned& nx) {
    const unsigned G = gridDim.x * gridDim.y * gridDim.z;
    unsigned sum, cnt, mine, sp = 0u;
    for (;;) {
        sum = 0u; cnt = 0u; mine = 0u;
#pragma unroll
        for (unsigned j = 0; j < 16; ++j) { const unsigned c = xb_ld(&bar[XB_XCNT(j)]); sum += c; cnt += (c > 0u) ? 1u : 0u; mine = (j == x) ? c : mine; }
        if (sum == G) break;
        __builtin_amdgcn_s_sleep(1);
        if ((++sp & 255u) == 0u) { if (xb_ld(&bar[XB_TMO])) break; if (sp > XB_SPIN_CAP) { atomicAdd(&bar[XB_TMO], 1u); break; } }
    }
    nloc = mine > 0u ? mine : 1u; nx = cnt > 0u ? cnt : 1u;
}

__device__ __forceinline__ void xcd_barrier(const XcdBarrier& b, bool leader) {
    asm volatile("s_waitcnt vmcnt(0)" ::: "memory");
    __syncthreads();
    if (leader) {
        unsigned* bar = b.bar;
        __builtin_amdgcn_s_waitcnt(0);
        unsigned nloc = b.st[0], nx = b.st[1];
        if (nloc == 0u) { xcd_barrier_complete(bar, b.x, nloc, nx); b.st[0] = nloc; b.st[1] = nx; }
        const unsigned old = xb_add(&bar[XB_XSUB(b.x)], 1u);
        const unsigned gen = old / nloc;
        if (old + 1u == (gen + 1u) * nloc) {
            __builtin_amdgcn_fence(__ATOMIC_RELEASE, "agent");
            asm volatile("s_waitcnt vmcnt(0)" ::: "memory");
            const unsigned og = xb_add(&bar[XB_TOP], 1u);
            const unsigned tg = og / nx;
            if (og + 1u == (tg + 1u) * nx) xb_add(&bar[XB_TOPGEN], 1u);
            else XB_SPIN(xb_ld(&bar[XB_TOPGEN]) == tg, bar);
            __builtin_amdgcn_fence(__ATOMIC_ACQUIRE, "agent");
            xb_add(&bar[XB_XGEN(b.x)], 1u);
            asm volatile("s_waitcnt vmcnt(0)" ::: "memory");
        } else {
            XB_SPIN(xb_ld(&bar[XB_XGEN(b.x)]) == gen, bar);
            __builtin_amdgcn_fence(__ATOMIC_ACQUIRE, "agent");
            asm volatile("s_waitcnt vmcnt(0)" ::: "memory");
        }
    }
    __syncthreads();
}
constexpr int NWAVES = 8;
constexpr size_t MiB = 1u << 20;
constexpr size_t WS_CTL = 0, CTL_ZERO_BYTES = 1 * MiB;
constexpr size_t WS_TAB = 1 * MiB;
constexpr size_t WS_WIN = 4 * MiB, WS_WOUT = 10 * MiB, WS_WGATE = 12 * MiB, WS_WPROJ = 14 * MiB, WS_WUP = 16 * MiB, WS_WDOWN = 80 * MiB;
constexpr size_t WS_N1 = 112 * MiB;
constexpr size_t WS_QKVZ = 144 * MiB;
constexpr size_t WS_U = 208 * MiB;
constexpr size_t WS_AB = 224 * MiB;
constexpr size_t WS_PBF = 226 * MiB;
constexpr int NIN_T = 3072;
constexpr int CW_TMO = 0, CW_CODE = 1, CW_BAR = 4096, CW_READY = 65536, CW_PROG = 131072;
constexpr int RING_OFF = 0, RING_BYTES = 131072, LDSCTL_OFF = RING_BYTES, MISC_OFF = LDSCTL_OFF + 320, LDS_BYTES = 163840;

struct Frame {
    LAS unsigned char* lds; volatile LAS unsigned* MISC; gu32* ctl;
    int wave, vcu, G;
};
__device__ __forceinline__ int lane_now() { int l; asm volatile("v_mbcnt_lo_u32_b32 %0, -1, 0\n\tv_mbcnt_hi_u32_b32 %0, -1, %0" : "=v"(l)); return l; }
template <int CTRL, int ROW_MASK> __device__ __forceinline__ float dpp_add(float v) {
    return v + __builtin_bit_cast(float, __builtin_amdgcn_update_dpp(0, __builtin_bit_cast(int, v), CTRL, ROW_MASK, 0xF, true));
}
__device__ __forceinline__ float wave_sum_f(float v) {
    v = dpp_add<0xB1, 0xF>(v);
    v = dpp_add<0x4E, 0xF>(v);
    v = dpp_add<0x141, 0xF>(v);
    v = dpp_add<0x140, 0xF>(v);
    v = dpp_add<0x142, 0xA>(v);
    v = dpp_add<0x143, 0xC>(v);
    return __builtin_bit_cast(float, __builtin_amdgcn_readlane(__builtin_bit_cast(int, v), 63));
}
__device__ __forceinline__ float fsigmoid(float x) { return __builtin_amdgcn_rcpf(1.f + __expf(-x)); }
__device__ __forceinline__ float fsilu(float x) { return x * __builtin_amdgcn_rcpf(1.f + __expf(-x)); }

struct MapId  { __device__ __forceinline__ int operator()(int n) const { return n; } };
struct MapWin { __device__ __forceinline__ int operator()(int n) const { if (n < 2048) return n; const int j = n - 2048; return O4 + (j >> 3) * 4 + (j & 3) + ((j >> 2) & 1) * CCH; } };
struct MapWup { __device__ __forceinline__ int operator()(int n) const { return (n >> 3) * 4 + (n & 3) + ((n >> 2) & 1) * DEXP; } };

template <class Map>
__device__ __forceinline__ void p0_transpose_item(const float* W, int K, int Nsrc, int Ndst, bf16* WT, LAS float* scr, int item, int lane, Map map) {
    const int nblk = Ndst / 32, kb = item / nblk, nb = item % nblk, k0 = 64 * kb, n0 = 32 * nb;
    const int sc = map(n0 + (lane & 31));
#pragma unroll 8
    for (int i = 0; i < 32; ++i) { const int kk = 2 * i + (lane >> 5); scr[kk * 33 + (lane & 31)] = W[(size_t)(k0 + kk) * Nsrc + sc]; }
    LDS_WAIT(); asm volatile("" ::: "memory");
    const int c = lane & 7;
#pragma unroll
    for (int j = 0; j < 4; ++j) { const int n = (lane >> 3) + 8 * j; const LAS float* s = scr + (8 * c) * 33 + n;
        v4u o; o.x = pk2(s[0 * 33], s[1 * 33]); o.y = pk2(s[2 * 33], s[3 * 33]); o.z = pk2(s[4 * 33], s[5 * 33]); o.w = pk2(s[6 * 33], s[7 * 33]);
        *(GAS v4u*)(WT + (size_t)(n0 + n) * K + k0 + 8 * c) = o; }
    LDS_WAIT(); asm volatile("" ::: "memory");
}

struct Ptrs {
    const float *x, *p, *g_mix, *w_in, *w_conv_qkv, *a_log, *dt_bias, *g_gdn_out, *b_glu, *w_conv_dw, *b_conv_dw, *ln_g, *ln_b, *w_out, *g_moe, *w_gr, *w_er, *w_up, *w_down, *g_ple, *w_pg, *w_pp, *g_final;
    float* out; unsigned char* ws;
};

__device__ __forceinline__ void p0_prologue(Frame& F, const Ptrs& P) {
    const int lane = lane_now(), tid = F.wave * 64 + lane;
    LAS float* scr = (LAS float*)(F.lds + RING_OFF + F.wave * 16384);
    const int gw = F.vcu * NWAVES + F.wave, NGW = F.G * NWAVES;
    bf16* Win_t = (bf16*)(P.ws + WS_WIN); bf16* Wout_t = (bf16*)(P.ws + WS_WOUT); bf16* Wgate_t = (bf16*)(P.ws + WS_WGATE); bf16* Wproj_t = (bf16*)(P.ws + WS_WPROJ);
    bf16* Wup_t = (bf16*)(P.ws + WS_WUP); bf16* Wdown_t = (bf16*)(P.ws + WS_WDOWN);
    constexpr int I_IN = 16 * (NIN_T / 32), I_SQ = 16 * 32, I_PR = 4 * 32, I_UP1 = 16 * 16, I_UP = NEXP * I_UP1, I_DN1 = 4 * 32, I_DN = NEXP * I_DN1;
    constexpr int NITEMS = I_IN + I_SQ + I_PR;
    (void)Wgate_t; (void)Wup_t; (void)Wdown_t; (void)I_UP; (void)I_DN;
    for (int it = gw; it < NITEMS; it += NGW) {
        int r = it;
        if (r < I_IN) { p0_transpose_item(P.w_in, DM, INC, NIN_T, Win_t, scr, r, lane, MapWin()); continue; } r -= I_IN;
        if (r < I_SQ) { p0_transpose_item(P.w_out, DM, DM, DM, Wout_t, scr, r, lane, MapId()); continue; } r -= I_SQ;
        p0_transpose_item(P.w_pp, PLE, DM, DM, Wproj_t, scr, r, lane, MapId());
    }
    __syncthreads();
    LAS float* wabT = (LAS float*)(F.lds + RING_OFF);
    for (int idx = tid; idx < 8 * DM; idx += NWAVES * 64) { const int k = idx >> 3, c = idx & 7; wabT[c * DM + k] = P.w_in[(size_t)k * INC + O2 + c]; }
    __syncthreads();
    bf16* N1 = (bf16*)(P.ws + WS_N1); float* AB = (float*)(P.ws + WS_AB);
    for (int m = gw; m < M; m += NGW) {
        const GAS f32x4* xr = (const GAS f32x4*)(P.x + (size_t)m * DM) + lane;
        f32x4 v[4]; float s = 0.f;
#pragma unroll
        for (int j = 0; j < 4; ++j) { v[j] = xr[64 * j]; s += (v[j].x * v[j].x + v[j].y * v[j].y) + (v[j].z * v[j].z + v[j].w * v[j].w); }
        const float r = rsqrtf(wave_sum_f(s) * (1.f / DM) + EPS);
        float ab[8];
#pragma unroll
        for (int c = 0; c < 8; ++c) ab[c] = 0.f;
#pragma unroll
        for (int j = 0; j < 4; ++j) { const f32x4 g = ((const GAS f32x4*)P.g_mix)[64 * j + lane]; v[j] = v[j] * r * g;
#pragma unroll
            for (int c = 0; c < 8; ++c) { const f32x4 w = *(const LAS f32x4*)(wabT + c * DM + 256 * j + 4 * lane); ab[c] += (v[j].x * w.x + v[j].y * w.y) + (v[j].z * w.z + v[j].w * w.w); } }
        GAS unsigned long long* o8 = (GAS unsigned long long*)(N1 + (size_t)m * DM) + lane;
#pragma unroll
        for (int j = 0; j < 4; ++j) o8[64 * j] = (unsigned long long)pk2(v[j].x, v[j].y) | ((unsigned long long)pk2(v[j].z, v[j].w) << 32);
#pragma unroll
        for (int c = 0; c < 8; ++c) ab[c] = wave_sum_f(ab[c]);
        if (lane == 0) { *(GAS f32x4*)(AB + (size_t)m * 8) = (f32x4){ab[0], ab[1], ab[2], ab[3]}; *(GAS f32x4*)(AB + (size_t)m * 8 + 4) = (f32x4){ab[4], ab[5], ab[6], ab[7]}; }
    }
    { bf16* Wr = (bf16*)(P.ws + 15 * MiB);
      for (int i = F.vcu * (NWAVES * 64) + tid; i < 80 * DM; i += F.G * NWAVES * 64) { const int n = i >> 10, k = i & 1023;
          const float v = n < NGRP ? P.w_gr[k * NGRP + n] : (n < NGRP + NEXP ? P.w_er[k * NEXP + n - NGRP] : 0.f); Wr[i] = (bf16)f2bf(v); } }
    bf16* PB = (bf16*)(P.ws + WS_PBF);
    for (size_t i = (size_t)F.vcu * (NWAVES * 64) + tid; i < (size_t)M * PLE / 8; i += (size_t)F.G * NWAVES * 64) {
        const f32x4 a = ((const GAS f32x4*)P.p)[2 * i], b = ((const GAS f32x4*)P.p)[2 * i + 1];
        v4u o; o.x = pk2(a.x, a.y); o.y = pk2(a.z, a.w); o.z = pk2(b.x, b.y); o.w = pk2(b.z, b.w);
        ((GAS v4u*)PB)[i] = o;
    }
}

__device__ __forceinline__ void p3_convert_late(Frame& F, const Ptrs& P, int idx, int cnt) {
    const int lane = lane_now();
    LAS float* scr = (LAS float*)(F.lds + RING_OFF + F.wave * 16384);
    const int gw = idx * NWAVES + F.wave, NGW = cnt * NWAVES;
    bf16* Wgate_t = (bf16*)(P.ws + WS_WGATE); bf16* Wup_t = (bf16*)(P.ws + WS_WUP); bf16* Wdown_t = (bf16*)(P.ws + WS_WDOWN);
    constexpr int I_SQ = 16 * 32, I_UP1 = 16 * 16, I_UP = NEXP * I_UP1, I_DN1 = 4 * 32, I_DN = NEXP * I_DN1;
    constexpr int NITEMS = I_SQ + I_UP + I_DN;
    for (int it = gw; it < NITEMS; it += NGW) {
        int r = it;
        if (r < I_SQ) { p0_transpose_item(P.w_pg, DM, DM, DM, Wgate_t, scr, r, lane, MapId()); continue; } r -= I_SQ;
        if (r < I_UP) { const int e = r / I_UP1; p0_transpose_item(P.w_up + (size_t)e * DM * 512, DM, 512, 512, Wup_t + (size_t)e * 512 * DM, scr, r % I_UP1, lane, MapWup()); continue; } r -= I_UP;
        { const int e = r / I_DN1; p0_transpose_item(P.w_down + (size_t)e * DEXP * DM, DEXP, DM, DM, Wdown_t + (size_t)e * DM * DEXP, scr, r % I_DN1, lane, MapId()); }
    }
    asm volatile("s_waitcnt lgkmcnt(0)" ::: "memory"); __builtin_amdgcn_s_barrier(); asm volatile("" ::: "memory");
}

struct EpiIn {
    static constexpr bool PERM = true, AFTER_DRAIN = false;
    pg8::bf16_t* QKVZ; pg8::bf16_t* U; const float* b_glu;
    __device__ __forceinline__ void operator()(const pg8::f32x4 (&acc)[2][2][4][2], const pg8::Unit& u, int wr, int wc, int fr, int fq) const {
        using namespace pg8;
        const int row0 = u.pm * BM + wr * 64 + fr;
        if (u.pn < 8) {
            const int col0 = u.pn * BM + wc * 32 + 8 * fq;
#pragma unroll
            for (int ai = 0; ai < 2; ++ai)
#pragma unroll
                for (int m = 0; m < 4; ++m) { bf16_t* rowp = QKVZ + (size_t)(row0 + ai * HALF + m * 16) * 2048 + col0;
#pragma unroll
                    for (int bj = 0; bj < 2; ++bj) { const f32x4 v0 = acc[ai][bj][m][0], v1 = acc[ai][bj][m][1];
                        u32x4 w; w.x = cvt_pk_bf16(v0[0], v0[1]); w.y = cvt_pk_bf16(v0[2], v0[3]); w.z = cvt_pk_bf16(v1[0], v1[1]); w.w = cvt_pk_bf16(v1[2], v1[3]);
                        *(u32x4*)(rowp + bj * HALF) = w; } }
        } else {
            const int hid0 = (u.pn - 8) * 128 + wc * 16 + 4 * fq;
            f32x4 ba[2], bg[2];
#pragma unroll
            for (int bj = 0; bj < 2; ++bj) { ba[bj] = *(const f32x4*)(b_glu + hid0 + bj * 64); bg[bj] = *(const f32x4*)(b_glu + CCH + hid0 + bj * 64); }
#pragma unroll
            for (int ai = 0; ai < 2; ++ai)
#pragma unroll
                for (int m = 0; m < 4; ++m) { bf16_t* rowp = U + (size_t)(row0 + ai * HALF + m * 16) * CCH + hid0;
#pragma unroll
                    for (int bj = 0; bj < 2; ++bj) { const f32x4 a = acc[ai][bj][m][0] + ba[bj], g = acc[ai][bj][m][1] + bg[bj];
                        typedef unsigned u32x2v __attribute__((ext_vector_type(2)));
                        u32x2v w; w.x = cvt_pk_bf16(a[0] * fsigmoid(g[0]), a[1] * fsigmoid(g[1])); w.y = cvt_pk_bf16(a[2] * fsigmoid(g[2]), a[3] * fsigmoid(g[3]));
                        *(u32x2v*)(rowp + bj * 64) = w; } }
        }
    }
};

constexpr size_t WS_GT = 225 * MiB;
constexpr size_t WS_GDN = 234 * MiB, GDN_ITEM = 73728;
constexpr size_t GI_WNEG = 0, GI_KDT = 16384, GI_UFR = 32768, GI_QD = 49152, GI_QK = 65536;
constexpr size_t WS_SN = 306 * MiB;
constexpr size_t WS_VN = 338 * MiB;
constexpr size_t WS_MIX = 354 * MiB;
constexpr size_t WS_H1 = 386 * MiB;
constexpr size_t WS_PROJ = 450 * MiB;
constexpr int NSCAN = 32;
typedef float f32x16 __attribute__((ext_vector_type(16)));
typedef unsigned u32x2 __attribute__((ext_vector_type(2)));
#define LBAR() do { asm volatile("s_waitcnt lgkmcnt(0)" ::: "memory"); __builtin_amdgcn_s_barrier(); asm volatile("" ::: "memory"); } while (0)
__device__ __forceinline__ float bf2f(unsigned short b) { return __uint_as_float((unsigned)b << 16); }
__device__ __forceinline__ __amdgpu_buffer_rsrc_t mk_rsrc(const void* p, unsigned bytes) { return __builtin_amdgcn_make_buffer_rsrc((void*)p, (short)0, (int)bytes, 0x00020000); }
__device__ __forceinline__ float buf_ld_bf16(__amdgpu_buffer_rsrc_t r, unsigned voff, unsigned soff) { return bf2f((unsigned short)__builtin_amdgcn_raw_buffer_load_b16(r, (int)voff, (int)soff, 0)); }
__device__ __forceinline__ void buf_st_b64(__amdgpu_buffer_rsrc_t r, unsigned voff, unsigned soff, u32x2 v) { __builtin_amdgcn_raw_buffer_store_b64(v, r, (int)voff, (int)soff, 0); }
__device__ __forceinline__ void buf_st_b128(__amdgpu_buffer_rsrc_t r, unsigned voff, unsigned soff, v4u v) { __builtin_amdgcn_raw_buffer_store_b128(v, r, (int)(voff + soff), 0, 0); }
__device__ __forceinline__ void buf_st_bf16(__amdgpu_buffer_rsrc_t r, unsigned voff, unsigned soff, float v) { __builtin_amdgcn_raw_buffer_store_b16((short)f2bf(v), r, (int)voff, (int)soff, 0); }

#ifndef XCHK
#define XCHK 0
#endif
#ifndef S5BAR
#define S5BAR 0
#endif
constexpr int CK_P1 = 2112, CK_P2 = 2176;
#define FMAC1(acc, a, b) asm("v_fmac_f32 %0, %1, %2" : "+v"(acc) : "v"(a), "v"(b))
template <int I>
struct SolveRow {
    static __device__ __forceinline__ void run(float (&X)[64], const LAS float* LS, const LAS float* SC) {
        int one; asm volatile("s_mov_b32 %0, 1" : "=s"(one));
        if (one) {
            constexpr int NQ = (I + 3) / 4;
            f32x4 lc[NQ > 0 ? NQ : 1];
#pragma unroll
            for (int q = 0; q < NQ; ++q) lc[q] = *(const volatile LAS f32x4*)(LS + I * 64 + 4 * q);
            float x0 = X[I] * SC[I], x1 = 0.f, x2 = 0.f, x3 = 0.f;
#pragma unroll
            for (int q = 0; q < NQ; ++q) {
                const f32x4 l = lc[q];
                if (4 * q + 0 < I) FMAC1(x0, l.x, X[4 * q + 0]);
                if (4 * q + 1 < I) FMAC1(x1, l.y, X[4 * q + 1]);
                if (4 * q + 2 < I) FMAC1(x2, l.z, X[4 * q + 2]);
                if (4 * q + 3 < I) FMAC1(x3, l.w, X[4 * q + 3]);
            }
            X[I] = (x0 + x1) + (x2 + x3);
        }
        if constexpr (I < 63) SolveRow<I + 1>::run(X, LS, SC);
    }
};

#ifndef SOLVE_PF
#define SOLVE_PF 0
#endif
#ifndef SOLVE_D
#define SOLVE_D 1
#endif
#ifndef SOLVE_ROWBR
#define SOLVE_ROWBR 0
#endif
#ifndef SOLVE2
#define SOLVE2 0
#endif
typedef float f32x2 __attribute__((ext_vector_type(2)));
#define PKFMA_LO(acc, l2, x) asm("v_pk_fma_f32 %0, %1, %2, %0 op_sel_hi:[0,1,1]" : "+v"(acc) : "v"(l2), "v"(x))
#define PKFMA_HI(acc, l2, x) asm("v_pk_fma_f32 %0, %1, %2, %0 op_sel:[1,0,0] op_sel_hi:[1,1,1]" : "+v"(acc) : "v"(l2), "v"(x))
template <int I>
struct SolveRow2 {
    static __device__ __forceinline__ void run(f32x2 (&X)[64], const LAS float* LS, const LAS float* SCW, const LAS float* BET) {
        int one; asm volatile("s_mov_b32 %0, 1" : "=s"(one));
        if (one) {
            constexpr int NQ = (I + 3) / 4, NG = (NQ + 3) / 4;
            f32x4 buf[2][4];
#pragma unroll
            for (int g = 0; g < 2; ++g)
#pragma unroll
                for (int u = 0; u < 4; ++u) if (g < NG && 4 * g + u < NQ) buf[g][u] = *(const volatile LAS f32x4*)(LS + I * 64 + 4 * (4 * g + u));
            const f32x2 sc = {SCW[I], BET[I]};
            f32x2 x0 = X[I] * sc, x1 = {0.f, 0.f}, x2 = {0.f, 0.f}, x3 = {0.f, 0.f};
#pragma unroll
            for (int g = 0; g < NG; ++g) {
#pragma unroll
                for (int u = 0; u < 4; ++u) { const int q = 4 * g + u; if (q < NQ) { const f32x4 l = buf[g & 1][u]; const f32x2 lxy = {l.x, l.y}, lzw = {l.z, l.w};
                    if (4 * q + 0 < I) PKFMA_LO(x0, lxy, X[4 * q + 0]);
                    if (4 * q + 1 < I) PKFMA_HI(x1, lxy, X[4 * q + 1]);
                    if (4 * q + 2 < I) PKFMA_LO(x2, lzw, X[4 * q + 2]);
                    if (4 * q + 3 < I) PKFMA_HI(x3, lzw, X[4 * q + 3]); } }
                if (g + 2 < NG) {
#pragma unroll
                    for (int u = 0; u < 4; ++u) if (4 * (g + 2) + u < NQ) buf[g & 1][u] = *(const volatile LAS f32x4*)(LS + I * 64 + 4 * (4 * (g + 2) + u)); }
            }
            X[I] = (x0 + x1) + (x2 + x3);
        }
        if constexpr (I < 63) SolveRow2<I + 1>::run(X, LS, SCW, BET);
    }
};
#if SOLVE_PF
template <int I>
struct SolveRowPF {
    static constexpr int NQ = (I + 3) / 4, NP = NQ < 8 ? NQ : 8;
    static __device__ __forceinline__ void run(float (&X)[64], const LAS float* LS, const LAS float* SC, const f32x4 (&pre)[8]) {
        int one; asm volatile("s_mov_b32 %0, 1" : "=s"(one));
        f32x4 nxt[8];
        if (one) {
            constexpr int NQ1 = (I + 4) / 4, NP1 = NQ1 < 8 ? NQ1 : 8, NR = NQ > 8 ? NQ - 8 : 0;
            f32x4 rest[NR > 0 ? NR : 1];
#pragma unroll
            for (int q = 0; q < NR; ++q) rest[q] = *(const volatile LAS f32x4*)(LS + I * 64 + 4 * (8 + q));
            if constexpr (I < 63) {
#pragma unroll
                for (int q = 0; q < NP1; ++q) nxt[q] = *(const volatile LAS f32x4*)(LS + (I + 1) * 64 + 4 * q);
            }
            float x0 = X[I] * SC[I], x1 = 0.f, x2 = 0.f, x3 = 0.f;
#pragma unroll
            for (int q = 0; q < NQ; ++q) {
                const f32x4 l = q < NP ? pre[q] : rest[q < 8 ? 0 : q - 8];
                if (4 * q + 0 < I) FMAC1(x0, l.x, X[4 * q + 0]);
                if (4 * q + 1 < I) FMAC1(x1, l.y, X[4 * q + 1]);
                if (4 * q + 2 < I) FMAC1(x2, l.z, X[4 * q + 2]);
                if (4 * q + 3 < I) FMAC1(x3, l.w, X[4 * q + 3]);
            }
            X[I] = (x0 + x1) + (x2 + x3);
        }
        if constexpr (I < 63) SolveRowPF<I + 1>::run(X, LS, SC, nxt);
    }
};
#endif
template <int B> __device__ __forceinline__ void fmac_bc(float& acc, float l, float x) { asm("v_fmac_f32_dpp %0, %1, %2 row_newbcast:%3 row_mask:0xf bank_mask:0xf" : "+v"(acc) : "v"(l), "v"(x), "n"(B)); }
template <int J, int I>
__device__ __forceinline__ void solve_terms(const float (&X)[64], const f32x4& l, float& x0, float& x1, float& x2, float& x3) {
    if constexpr (J < I) {
        constexpr int k = J >> 4, b = J & 15;
        const float lk = k == 0 ? l.x : (k == 1 ? l.y : (k == 2 ? l.z : l.w));
        if constexpr ((J & 3) == 0) fmac_bc<b>(x0, lk, X[J]); else if constexpr ((J & 3) == 1) fmac_bc<b>(x1, lk, X[J]); else if constexpr ((J & 3) == 2) fmac_bc<b>(x2, lk, X[J]); else fmac_bc<b>(x3, lk, X[J]);
        solve_terms<J + 1, I>(X, l, x0, x1, x2, x3);
    }
}
template <int I>
struct SolveRowD {
    static __device__ __forceinline__ void run(float (&X)[64], const LAS float* LSl  , const f32x4 l, const f32x4 l1  ) {
#if SOLVE_ROWBR
        int one; asm volatile("s_mov_b32 %0, 1" : "=s"(one));
#else
        constexpr bool one = true;
#endif
        f32x4 l2 = l1;
        if (one) {
            if constexpr (I < 62) l2 = *(const volatile LAS f32x4*)(LSl + (I + 2) * 64);
            float x0 = X[I], x1 = 0.f, x2 = 0.f, x3 = 0.f;
            solve_terms<0, I>(X, l, x0, x1, x2, x3);
            X[I] = (x0 + x1) + (x2 + x3);
        }
        if constexpr (I < 63) SolveRowD<I + 1>::run(X, LSl, l1, l2);
    }
};
__device__ __forceinline__ void solve64(float (&X)[64], const LAS float* LS, const LAS float* SC) {
#if SOLVE_D
    const LAS float* LSl = LS + (lane_now() & 15) * 4;
    const f32x4 l0 = *(const volatile LAS f32x4*)LSl, l1 = *(const volatile LAS f32x4*)(LSl + 64);
#pragma unroll
    for (int q = 0; q < 16; ++q) { const f32x4 sc = *(const volatile LAS f32x4*)(SC + 4 * q); X[4 * q + 0] *= sc.x; X[4 * q + 1] *= sc.y; X[4 * q + 2] *= sc.z; X[4 * q + 3] *= sc.w; }
    SolveRowD<0>::run(X, LSl, l0, l1);
    return;
#endif
#if SOLVE_PF
    f32x4 pre[8]; SolveRowPF<0>::run(X, LS, SC, pre);
#else
    SolveRow<0>::run(X, LS, SC);
#endif
}

#if defined(P2_TSTAGE)
#define P2T(k) do { if (P2_TSTAGE == (k)) p2t_s = (unsigned)rt(); if (P2_TSTAGE + 1 == (k)) p2t_a += (unsigned)rt() - p2t_s; } while (0)
#else
#define P2T(k) do { } while (0)
#endif
__device__ __forceinline__ void p2_gdn_prep(Frame& F, const Ptrs& P, const size_t gdn_off = WS_GDN, const size_t gt_off = WS_GT) {
    LAS unsigned char* QT = F.lds; LAS unsigned char* KT = F.lds + 17408; LAS float* LS = (LAS float*)(F.lds + 34816);
    LAS unsigned char* XS = F.lds + 53248;
    LAS unsigned char* QDT = F.lds + 53248;
    LAS unsigned char* QKT = F.lds + 53248 + 17408;
    LAS float* gcs = (LAS float*)(F.lds + 51200); LAS float* betas = gcs + 64; LAS float* nk2 = gcs + 128; LAS float* nq2 = gcs + 192; LAS float* sc_w = gcs + 256; LAS float* sc_kd = gcs + 320; LAS float* sc_qd = gcs + 384;
    const bf16* QKVZ = (const bf16*)(P.ws + WS_QKVZ); const float* AB = (const float*)(P.ws + WS_AB);
    const int wave = F.wave;
    const int grp = wave >> 1;
    v4u pre[7];
#define P2_PREFETCH(it_) do { const int lane_ = lane_now(), tid_ = wave * 64 + lane_; const int bh_ = (it_) >> 7, n_ = (it_) & 127; \
        const unsigned char* src_ = (const unsigned char*)(QKVZ + ((size_t)(bh_ >> 2) * SEQ + (size_t)n_ * 64 - 3) * 2048 + (bh_ & 3) * 128); \
        _Pragma("unroll") for (int u = 0; u < 7; ++u) { const int cid = tid_ + 512 * u; pre[u] = (v4u){0u, 0u, 0u, 0u}; if (cid < 67 * 48) { const int row = cid / 48, cc = cid - row * 48, seg3 = cc >> 4; \
            if (n_ * 64 + row - 3 >= 0) pre[u] = *(const GAS v4u*)(src_ + (size_t)row * 4096 + seg3 * 1024 + (cc & 15) * 16); } } } while (0)
    if (F.vcu < 1024) P2_PREFETCH(F.vcu);
    unsigned p2t_s = 0, p2t_a = 0; (void)p2t_s; (void)p2t_a;
    for (int it = F.vcu; it < 1024; it += F.G) {
        P2T(0);
        const int lane = lane_now();
        const int c = ((wave & 1) << 6) | lane, tid = wave * 64 + lane;
        const int bh = it >> 7, n = it & 127, b = bh >> 2, h = bh & 3;
        const size_t m0 = (size_t)b * SEQ + (size_t)n * 64;
        unsigned char* item = P.ws + gdn_off + (size_t)it * GDN_ITEM;
        float y[64];
#pragma unroll
        for (int u = 0; u < 7; ++u) { const int cid = tid + 512 * u; if (cid < 67 * 48) *(LAS v4u*)(XS + cid * 16) = pre[u]; }
        LBAR();
        P2T(1);
        if (grp < 3) {
            const int col = grp * 512 + h * 128 + c;
            const float w0 = P.w_conv_qkv[0 * 1536 + col], w1 = P.w_conv_qkv[1 * 1536 + col], w2 = P.w_conv_qkv[2 * 1536 + col], w3 = P.w_conv_qkv[3 * 1536 + col];
            float xr[67];
#pragma unroll
            for (int j = 0; j < 67; ++j) xr[j] = bf2f(*(const LAS unsigned short*)(XS + j * 768 + grp * 256 + c * 2));
#pragma unroll
            for (int i = 0; i < 64; ++i) { const float s = fmaf(w3, xr[i + 3], fmaf(w2, xr[i + 2], fmaf(w1, xr[i + 1], w0 * xr[i]))); y[i] = fsilu(s); }
            if (grp < 2) { LAS unsigned char* tile = grp == 0 ? QT : KT;
#pragma unroll
                for (int i = 0; i < 64; ++i) *(LAS unsigned short*)(tile + i * 272 + c * 2) = (unsigned short)f2bf(y[i]); }
        }
        if (wave == 7) {
            const float araw = AB[(m0 + lane) * 8 + 4 + h], braw = AB[(m0 + lane) * 8 + h];
            const float xx = araw + P.dt_bias[h];
            const float sp = (xx > 20.f) ? xx : log1pf(expf(xx));
            float g = -expf(P.a_log[h]) * sp;
#pragma unroll
            for (int off = 1; off < 64; off <<= 1) { const float t = __shfl_up(g, off); if (lane >= off) g += t; }
            gcs[lane] = g; betas[lane] = 1.f / (1.f + expf(-braw));
        }
        LBAR();
        P2T(2);
        const int kind = wave < 3 ? 0 : (wave < 6 ? 1 : 2);
        const int tsel = wave < 6 ? wave % 3 : (wave - 6) * 2;
        const int ib = tsel >= 1 ? 1 : 0, jb = tsel == 2 ? 1 : 0;
        const int r32 = lane & 31, hh = lane >> 5;
        f32x16 acc;
#pragma unroll
        for (int i = 0; i < 16; ++i) acc[i] = 0.f;
        {
            const LAS unsigned char* At = (kind == 0 ? KT : QT) + (32 * ib + r32) * 272 + hh * 16;
            const LAS unsigned char* Bt = (kind == 2 ? QT : KT) + (32 * jb + r32) * 272 + hh * 16;
#pragma unroll
            for (int s = 0; s < 8; ++s) { const bf16x8 a = *(const LAS bf16x8*)(At + s * 32), bb = *(const LAS bf16x8*)(Bt + s * 32); acc = __builtin_amdgcn_mfma_f32_32x32x16_bf16(a, bb, acc, 0, 0, 0); }
        }
        if ((kind == 0 || kind == 2) && ib == jb) {
            if (((r32 >> 2) & 1) == hh) {
                const int rsel = (r32 & 3) + 4 * (r32 >> 3); float v = 0.f;
#pragma unroll
                for (int i = 0; i < 16; ++i) v = (i == rsel) ? acc[i] : v;
                (kind == 0 ? nk2 : nq2)[32 * ib + r32] = v;
            }
        }
        LBAR();
        P2T(3);
        {
            const int j = 32 * jb + r32; const float gj = gcs[j], rkj = rsqrtf(nk2[j] + EPS);
#pragma unroll
            for (int reg = 0; reg < 16; ++reg) {
                const int iu = 32 * ib + (reg & 3) + 8 * (reg >> 2), i = iu + 4 * hh;
                const float dec = __expf(fminf(gcs[i] - gj, 0.f));
                if (kind == 0) { const float v = (j < i) ? acc[reg] * betas[i] * rsqrtf(nk2[i] + EPS) * rkj * dec : 0.f; LS[i * 64 + (j & 15) * 4 + (j >> 4)] = -v; }
                else if (kind == 1) { const float v = (j <= i) ? acc[reg] * rsqrtf(nq2[i] + EPS) * 0.08838834764831845f * rkj * dec : 0.f; *(LAS unsigned short*)(QKT + i * 144 + j * 2) = (unsigned short)f2bf(v); }
            }
            if (wave == 7) {
                const float rk = rsqrtf(nk2[lane] + EPS), rq = rsqrtf(nq2[lane] + EPS), gi = gcs[lane], eg = __expf(gi);
                sc_w[lane] = betas[lane] * rk * eg; sc_kd[lane] = rk * __expf(gcs[63] - gi); sc_qd[lane] = rq * 0.08838834764831845f * eg;
            }
            if (kind == 2 && tsel == 0) {
#pragma unroll
                for (int reg = 0; reg < 16; ++reg) { const int i = (reg & 3) + 8 * (reg >> 2) + 4 * hh; *(LAS unsigned short*)(QKT + i * 144 + (32 + r32) * 2) = 0; }
            }
        }
        LBAR();
        P2T(4);
        const float gl = gcs[63];
#if SOLVE2
        if (grp == 2) {
            f32x2 X[64];
#pragma unroll
            for (int i = 0; i < 64; ++i) { X[i].x = bf2f(*(const LAS unsigned short*)(KT + i * 272 + c * 2)); X[i].y = y[i]; }
            SolveRow2<0>::run(X, LS, sc_w, betas);
#pragma unroll
            for (int i = 0; i < 64; ++i) *(LAS unsigned short*)(QT + i * 272 + c * 2) = (unsigned short)f2bf(-X[i].x);
            const __amdgpu_buffer_rsrc_t rit = mk_rsrc(item, (unsigned)GDN_ITEM);
            const int et = c >> 4, r = c & 15;
#pragma unroll
            for (int i4 = 0; i4 < 16; ++i4) { const int ct = i4 >> 2, q = i4 & 3;
                u32x2 o; o.x = pk2(X[4 * i4 + 0].y, X[4 * i4 + 1].y); o.y = pk2(X[4 * i4 + 2].y, X[4 * i4 + 3].y);
                buf_st_b64(rit, (unsigned)((((et >> 1) * 64 + r) * 2 + (et & 1)) * 8), (unsigned)(GI_UFR + (ct * 4 * 64 + q * 16) * 16), o); }
#else
        if (grp == 1 || grp == 2) solve64(y, LS, grp == 1 ? sc_w : betas);
        if (grp == 1) {
#pragma unroll
            for (int i = 0; i < 64; ++i) *(LAS unsigned short*)(QT + i * 272 + c * 2) = (unsigned short)f2bf(-y[i]);
        } else if (grp == 2) {
            const __amdgpu_buffer_rsrc_t rit = mk_rsrc(item, (unsigned)GDN_ITEM);
            const int et = c >> 4, r = c & 15;
#pragma unroll
            for (int i4 = 0; i4 < 16; ++i4) { const int ct = i4 >> 2, q = i4 & 3;
                u32x2 o; o.x = pk2(y[4 * i4 + 0], y[4 * i4 + 1]); o.y = pk2(y[4 * i4 + 2], y[4 * i4 + 3]);
                buf_st_b64(rit, (unsigned)((((et >> 1) * 64 + r) * 2 + (et & 1)) * 8), (unsigned)(GI_UFR + (ct * 4 * 64 + q * 16) * 16), o); }
#endif
        } else if (grp == 0) {
#pragma unroll
            for (int i = 0; i < 64; ++i) *(LAS unsigned short*)(QDT + i * 272 + c * 2) = (unsigned short)f2bf(y[i] * sc_qd[i]);
        }
        LBAR();
        P2T(5);
        if (it + F.G < 1024) P2_PREFETCH(it + F.G);
        {
            const __amdgpu_buffer_rsrc_t rit = mk_rsrc(item, (unsigned)GDN_ITEM);
#pragma unroll
            for (int u = 0; u < 2; ++u) { const int cid = tid + 512 * u, ln = cid & 63, r = ln & 15, q = ln >> 4;
                { const int ct = cid >> 8, sx = (cid >> 6) & 3;
                  const v4u v = *(const LAS v4u*)(QT + (16 * ct + r) * 272 + (32 * sx + 8 * q) * 2);
                  buf_st_b128(rit, (unsigned)cid * 16u, (unsigned)GI_WNEG, v); }
                { const int dt = cid >> 7, sx = (cid >> 6) & 1; float kd[8];
#pragma unroll
                  for (int j = 0; j < 8; ++j) { const int cc = 32 * sx + 8 * q + j; kd[j] = bf2f(*(const LAS unsigned short*)(KT + cc * 272 + (16 * dt + r) * 2)) * sc_kd[cc]; }
                  v4u o; o.x = pk2(kd[0], kd[1]); o.y = pk2(kd[2], kd[3]); o.z = pk2(kd[4], kd[5]); o.w = pk2(kd[6], kd[7]);
                  buf_st_b128(rit, (unsigned)cid * 16u, (unsigned)GI_KDT, o); }
                { const int r32c = ln & 31, hhc = ln >> 5, ct2 = cid >> 9, sx = (cid >> 6) & 7;
                  const v4u v = *(const LAS v4u*)(QDT + (32 * ct2 + r32c) * 272 + (16 * sx + 8 * hhc) * 2);
                  buf_st_b128(rit, (unsigned)cid * 16u, (unsigned)GI_QD, v); }
                if (u == 0) { const int r32c = ln & 31, hhc = ln >> 5, ct2 = cid >> 8, sx = (cid >> 6) & 3;
                  const v4u v = *(const LAS v4u*)(QKT + (32 * ct2 + r32c) * 144 + (16 * sx + 8 * hhc) * 2);
                  buf_st_b128(rit, (unsigned)cid * 16u, (unsigned)GI_QK, v); }
            }
        }
        if (tid == 0) ((float*)(P.ws + gt_off))[it] = __expf(gl);
        LBAR();
        P2T(6);
    }
#if defined(P2_TSTAGE)
    if (blockIdx.x == 0 && wave == 0 && lane_now() == 0) { __hip_atomic_store((unsigned*)(P.ws + WS_CTL) + 2304, 0u, __ATOMIC_RELAXED, __HIP_MEMORY_SCOPE_AGENT); __hip_atomic_store((unsigned*)(P.ws + WS_CTL) + 2305, p2t_a, __ATOMIC_RELAXED, __HIP_MEMORY_SCOPE_AGENT); }
#endif
}
#undef P2_PREFETCH

template <int ROT, int LS_OFF, int AR_OFF, int QT_OFF, int KT_OFF> struct P2S {
    static __device__ __forceinline__ int wv(const Frame& F) { return (F.wave + ROT) & 7; }
    static __device__ __forceinline__ LAS unsigned char* QT(const Frame& F) { unsigned o = QT_OFF; asm volatile("" : "+v"(o)); return F.lds + o; }
    static __device__ __forceinline__ LAS unsigned char* KT(const Frame& F) { unsigned o = KT_OFF; asm volatile("" : "+v"(o)); return F.lds + o; }
    static __device__ __forceinline__ LAS float* LS(const Frame& F) { return (LAS float*)(F.lds + LS_OFF); }
    static __device__ __forceinline__ LAS float* AR(const Frame& F) { return (LAS float*)(F.lds + AR_OFF); }

    static __device__ __forceinline__ void s1(Frame& F, const Ptrs& P, int it, float (&ys)[64]) {
        const int w = wv(F), grp = w >> 1, lane = lane_now(), c = ((w & 1) << 6) | lane;
        const int bh = it >> 7, n = it & 127, b = bh >> 2, h = bh & 3; const size_t m0 = (size_t)b * SEQ + (size_t)n * 64;
        const bf16* QKVZ = (const bf16*)(P.ws + WS_QKVZ); const float* AB = (const float*)(P.ws + WS_AB);
        if (grp < 3) {
            const int col = grp * 512 + h * 128 + c;
            const float w0 = P.w_conv_qkv[0 * 1536 + col], w1 = P.w_conv_qkv[1 * 1536 + col], w2 = P.w_conv_qkv[2 * 1536 + col], w3 = P.w_conv_qkv[3 * 1536 + col];
            const __amdgpu_buffer_rsrc_t rs = mk_rsrc(QKVZ + (size_t)b * SEQ * 2048, (unsigned)SEQ * 2048u * 2u);
            LAS unsigned char* tile = grp == 0 ? QT(F) : KT(F);
#pragma unroll
            for (int hf = 0; hf < 2; ++hf) {
                float xr[35];
#pragma unroll
                for (int j = 0; j < 35; ++j) { const int t = n * 64 + 32 * hf + j - 3; xr[j] = (hf > 0 || j >= 3 || t >= 0) ? buf_ld_bf16(rs, (unsigned)col * 2u, (unsigned)t * 4096u) : 0.f; }
#pragma unroll
                for (int i = 0; i < 32; ++i) { const float sv = fsilu(fmaf(w3, xr[i + 3], fmaf(w2, xr[i + 2], fmaf(w1, xr[i + 1], w0 * xr[i]))));
                    if (grp < 2) *(LAS unsigned short*)(tile + (32 * hf + i) * 272 + c * 2) = (unsigned short)f2bf(sv); else ys[32 * hf + i] = sv; }
            }
        }
        if (w == 7) {
            LAS float* gcs = AR(F); LAS float* betas = gcs + 64;
            const float araw = AB[(m0 + lane) * 8 + 4 + h], braw = AB[(m0 + lane) * 8 + h];
            const float xx = araw + P.dt_bias[h];
            const float sp = (xx > 20.f) ? xx : log1pf(expf(xx));
            float g = -expf(P.a_log[h]) * sp;
#pragma unroll
            for (int off = 1; off < 64; off <<= 1) { const float t = __shfl_up(g, off); if (lane >= off) g += t; }
            gcs[lane] = g; betas[lane] = 1.f / (1.f + expf(-braw));
        }
    }
    static __device__ __forceinline__ void s2(Frame& F, f32x16& acc) {
        const int w = wv(F), lane = lane_now(), r32 = lane & 31, hh = lane >> 5;
        const int kind = w < 3 ? 0 : (w < 6 ? 1 : 2), tsel = w < 6 ? w % 3 : (w - 6) * 2, ib = tsel >= 1 ? 1 : 0, jb = tsel == 2 ? 1 : 0;
        LAS float* nk2 = AR(F) + 128; LAS float* nq2 = AR(F) + 192;
#pragma unroll
        for (int i = 0; i < 16; ++i) acc[i] = 0.f;
        const LAS unsigned char* At = (kind == 0 ? KT(F) : QT(F)) + (32 * ib + r32) * 272 + hh * 16;
        const LAS unsigned char* Bt = (kind == 2 ? QT(F) : KT(F)) + (32 * jb + r32) * 272 + hh * 16;
#pragma unroll
        for (int s = 0; s < 8; ++s) { const bf16x8 a = *(const LAS bf16x8*)(At + s * 32), bb = *(const LAS bf16x8*)(Bt + s * 32); acc = __builtin_amdgcn_mfma_f32_32x32x16_bf16(a, bb, acc, 0, 0, 0); }
        if ((kind == 0 || kind == 2) && ib == jb) {
            if (((r32 >> 2) & 1) == hh) {
                const int rsel = (r32 & 3) + 4 * (r32 >> 3); float v = 0.f;
#pragma unroll
                for (int i = 0; i < 16; ++i) v = (i == rsel) ? acc[i] : v;
                (kind == 0 ? nk2 : nq2)[32 * ib + r32] = v;
            }
        }
    }
    static __device__ __forceinline__ void s3(Frame& F, const Ptrs& P, int it, const f32x16& acc, const size_t gdn_off) {
        const int w = wv(F), lane = lane_now(), r32 = lane & 31, hh = lane >> 5;
        const int kind = w < 3 ? 0 : (w < 6 ? 1 : 2), tsel = w < 6 ? w % 3 : (w - 6) * 2, ib = tsel >= 1 ? 1 : 0, jb = tsel == 2 ? 1 : 0;
        LAS float* gcs = AR(F); LAS float* betas = gcs + 64; LAS float* nk2 = gcs + 128; LAS float* nq2 = gcs + 192; LAS float* sc_w = gcs + 256; LAS float* sc_kd = gcs + 320; LAS float* sc_qd = gcs + 384;
        LAS float* Ls = LS(F);
        unsigned char* item = P.ws + gdn_off + (size_t)it * GDN_ITEM;
        const int j = 32 * jb + r32; const float gj = gcs[j], rkj = rsqrtf(nk2[j] + EPS);
        const __amdgpu_buffer_rsrc_t rqk = mk_rsrc(item + GI_QK, 8192u);
        const unsigned vqk = (unsigned)(((j >> 4) * 64 + 32 * ((j >> 3) & 1)) * 16 + (j & 7) * 2 + 64 * hh);
#pragma unroll
        for (int reg = 0; reg < 16; ++reg) {
            const int iu = 32 * ib + (reg & 3) + 8 * (reg >> 2), i = iu + 4 * hh;
            const float dec = __expf(fminf(gcs[i] - gj, 0.f));
            if (kind == 0) { const float v = (j < i) ? acc[reg] * betas[i] * rsqrtf(nk2[i] + EPS) * rkj * dec : 0.f; Ls[i * 64 + j] = -v; }
            else if (kind == 1) { const float v = (j <= i) ? acc[reg] * rsqrtf(nq2[i] + EPS) * 0.08838834764831845f * rkj * dec : 0.f; buf_st_bf16(rqk, vqk, (unsigned)((iu >> 5) * 4096 + (iu & 31) * 16), v); }
        }
        if (w == 7) {
            const float rk = rsqrtf(nk2[lane] + EPS), rq = rsqrtf(nq2[lane] + EPS), gi = gcs[lane], eg = __expf(gi);
            sc_w[lane] = betas[lane] * rk * eg; sc_kd[lane] = rk * __expf(gcs[63] - gi); sc_qd[lane] = rq * 0.08838834764831845f * eg;
        }
        if (kind == 2 && tsel == 0) {
#pragma unroll
            for (int reg = 0; reg < 16; ++reg) { const int iu = (reg & 3) + 8 * (reg >> 2); const int jz = 32 + r32;
                buf_st_bf16(rqk, (unsigned)(((jz >> 4) * 64 + 32 * ((jz >> 3) & 1)) * 16 + (jz & 7) * 2 + 64 * hh), (unsigned)(iu * 16), 0.f); }
        }
        if ((w >> 1) == 0) {
            const int c = ((w & 1) << 6) | lane;
            const __amdgpu_buffer_rsrc_t rit = mk_rsrc(item, (unsigned)GDN_ITEM);
            const unsigned vqd = (unsigned)(((c >> 4) * 64 + 32 * ((c >> 3) & 1)) * 16 + (c & 7) * 2);
#pragma unroll
            for (int i = 0; i < 64; ++i) { const float q = bf2f(*(const LAS unsigned short*)(QT(F) + i * 272 + c * 2));
                buf_st_bf16(rit, vqd, (unsigned)(GI_QD + (i >> 5) * 8192 + (i & 31) * 16), q * rsqrtf(nq2[i] + EPS) * 0.08838834764831845f * __expf(gcs[i])); }
        }
    }
    static __device__ __forceinline__ void s4v(Frame& F, const Ptrs& P, int it, float (&ys)[64], const size_t gdn_off) {
        const int w = wv(F), grp = w >> 1, lane = lane_now(), c = ((w & 1) << 6) | lane;
        if (grp == 2) {
            LAS float* betas = AR(F) + 64;
            unsigned char* item = P.ws + gdn_off + (size_t)it * GDN_ITEM;
            SolveRow<0>::run(ys, LS(F), betas);
            const __amdgpu_buffer_rsrc_t rit = mk_rsrc(item, (unsigned)GDN_ITEM);
            const int et = c >> 4, r = c & 15;
#pragma unroll
            for (int i4 = 0; i4 < 16; ++i4) { const int ct = i4 >> 2, q = i4 & 3;
                u32x2 o; o.x = pk2(ys[4 * i4 + 0], ys[4 * i4 + 1]); o.y = pk2(ys[4 * i4 + 2], ys[4 * i4 + 3]);
                buf_st_b64(rit, (unsigned)((((et >> 1) * 64 + r) * 2 + (et & 1)) * 8), (unsigned)(GI_UFR + (ct * 4 * 64 + q * 16) * 16), o); }
        }
    }
    static __device__ __forceinline__ void s4k(Frame& F) {
        const int w = wv(F), grp = w >> 1, lane = lane_now(), c = ((w & 1) << 6) | lane;
        if (grp == 1) {
            LAS float* sc_w = AR(F) + 256;
            float yk[64];
#pragma unroll
            for (int i = 0; i < 64; ++i) yk[i] = bf2f(*(const LAS unsigned short*)(KT(F) + i * 272 + c * 2));
            SolveRow<0>::run(yk, LS(F), sc_w);
#pragma unroll
            for (int i = 0; i < 64; ++i) *(LAS unsigned short*)(QT(F) + i * 272 + c * 2) = (unsigned short)f2bf(-yk[i]);
        }
    }
    static __device__ __forceinline__ void s5(Frame& F, const Ptrs& P, int it, const size_t gdn_off, const size_t gt_off) {
        const int lane = lane_now(), tid = F.wave * 64 + lane;
        LAS float* gcs = AR(F); LAS float* sc_kd = gcs + 320;
        unsigned char* item = P.ws + gdn_off + (size_t)it * GDN_ITEM;
        const __amdgpu_buffer_rsrc_t rit = mk_rsrc(item, (unsigned)GDN_ITEM);
#if XCHK
        v4u okeep[2];
#endif
#pragma unroll
        for (int u = 0; u < 2; ++u) { const int cid = tid + 512 * u, ln = cid & 63, r = ln & 15, q = ln >> 4;
            { const int ct = cid >> 8, sx = (cid >> 6) & 3;
              const v4u v = *(const LAS v4u*)(QT(F) + (16 * ct + r) * 272 + (32 * sx + 8 * q) * 2);
              buf_st_b128(rit, (unsigned)cid * 16u, (unsigned)GI_WNEG, v); }
            { const int dt = cid >> 7, sx = (cid >> 6) & 1; float kd[8];
#pragma unroll
              for (int j = 0; j < 8; ++j) { const int cc = 32 * sx + 8 * q + j; kd[j] = bf2f(*(const LAS unsigned short*)(KT(F) + cc * 272 + (16 * dt + r) * 2)) * sc_kd[cc]; }
              v4u o; o.x = pk2(kd[0], kd[1]); o.y = pk2(kd[2], kd[3]); o.z = pk2(kd[4], kd[5]); o.w = pk2(kd[6], kd[7]);
              buf_st_b128(rit, (unsigned)cid * 16u, (unsigned)GI_KDT, o);
#if XCHK
              okeep[u] = o;
#endif
            }
        }
#if XCHK
        LBAR();
        {
            unsigned bad = 0;
#pragma unroll
            for (int u = 0; u < 2; ++u) { const int cid = tid + 512 * u, ln = cid & 63, r = ln & 15, q = ln >> 4; const int dt = cid >> 7, sx = (cid >> 6) & 1; float kd[8];
#pragma unroll
              for (int j = 0; j < 8; ++j) { const int cc = 32 * sx + 8 * q + j; kd[j] = bf2f(*(const LAS unsigned short*)(KT(F) + cc * 272 + (16 * dt + r) * 2)) * sc_kd[cc]; }
              v4u o; o.x = pk2(kd[0], kd[1]); o.y = pk2(kd[2], kd[3]); o.z = pk2(kd[4], kd[5]); o.w = pk2(kd[6], kd[7]);
              bad |= (o.x != okeep[u].x) | (o.y != okeep[u].y) | (o.z != okeep[u].z) | (o.w != okeep[u].w); }
            if (bad) __hip_atomic_fetch_add((unsigned*)(P.ws + WS_CTL) + CK_P2 + 8, 1u, __ATOMIC_RELAXED, __HIP_MEMORY_SCOPE_AGENT);
        }
#endif
        if (tid == 0) ((float*)(P.ws + gt_off))[it] = __expf(gcs[63]);
#if XCHK
        if (gt_off == WS_GT) {
            if (tid < 64) __hip_atomic_fetch_add((unsigned*)(P.ws + WS_CTL) + CK_P2 + 6, __float_as_uint(sc_kd[tid]) * 17u + (unsigned)(tid + it * 7), __ATOMIC_RELAXED, __HIP_MEMORY_SCOPE_AGENT);
            unsigned acc = 0; for (int i = tid; i < 64 * 64; i += 512) { const int rr = i >> 6, cw = i & 63; acc += *(const LAS unsigned*)(KT(F) + rr * 272 + cw * 4) * 19u + (unsigned)(i + it * 3); }
            __hip_atomic_fetch_add((unsigned*)(P.ws + WS_CTL) + CK_P2 + 7, acc, __ATOMIC_RELAXED, __HIP_MEMORY_SCOPE_AGENT);
        }
#endif
    }
};
__device__ __forceinline__ void p2_gdn_prep_dual(Frame& F, const Ptrs& P, const size_t gdn_off = WS_GDN, const size_t gt_off = WS_GT) {
    typedef P2S<0, 0, 32768, 36864, 54272> A; typedef P2S<4, 16384, 34816, 71680, 89088> B;
    for (int it = F.vcu; it < 1024; it += 2 * F.G) {
        const int itB = it + F.G;
        float ys[64]; f32x16 accA, accB;
        A::s1(F, P, it, ys); B::s1(F, P, itB, ys);
        LBAR();
        A::s2(F, accA); B::s2(F, accB);
        LBAR();
        A::s3(F, P, it, accA, gdn_off); B::s3(F, P, itB, accB, gdn_off);
        LBAR();
        A::s4v(F, P, it, ys, gdn_off); B::s4v(F, P, itB, ys, gdn_off);
        A::s4k(F); B::s4k(F);
        LBAR();
        A::s5(F, P, it, gdn_off, gt_off);
#if S5BAR
        LBAR();
#endif
        B::s5(F, P, itB, gdn_off, gt_off);
        LBAR();
    }
}

#ifndef P2_DUAL
#define P2_DUAL 0
#endif
#ifndef DTEST
#define DTEST 0
#endif
constexpr int CW_DT = 2048;
__device__ __forceinline__ void p2_dtest(Frame& F, const Ptrs& P) {
    const int lane = lane_now(), tid = F.wave * 64 + lane;
    for (int i = tid; i < 131072 / 4; i += NWAVES * 64) ((LAS unsigned*)F.lds)[i] = 0x7fc12345u ^ (unsigned)(i * 2654435761u);
    __syncthreads();
    const size_t off2 = 354 * MiB, gt2 = 434 * MiB;
#if P2_DUAL
    p2_gdn_prep_dual(F, P, off2, gt2);
#else
    p2_gdn_prep(F, P, off2, gt2);
#endif
    asm volatile("s_waitcnt vmcnt(0)" ::: "memory"); __syncthreads();
    unsigned bad = 0;
    for (int it = F.vcu; it < 1024; it += F.G) {
        const GAS v4u* a = (const GAS v4u*)(P.ws + WS_GDN + (size_t)it * GDN_ITEM); const GAS v4u* b = (const GAS v4u*)(P.ws + off2 + (size_t)it * GDN_ITEM);
        for (int c = tid; c < (int)(GDN_ITEM / 16); c += NWAVES * 64) { const v4u x = a[c], y = b[c]; const bool ne = (x.x != y.x) | (x.y != y.y) | (x.z != y.z) | (x.w != y.w);
            const int reg = c < 1024 ? 0 : (c < 2048 ? 1 : (c < 3072 ? 2 : (c < 4096 ? 3 : 4)));
            if (ne) bad |= 1u << reg; }
        if (tid == 0 && __float_as_uint(((const float*)(P.ws + WS_GT))[it]) != __float_as_uint(((const float*)(P.ws + gt2))[it])) bad |= 1u << 5;
    }
    if (bad) __hip_atomic_fetch_or((unsigned*)(P.ws + WS_CTL) + CW_DT, bad, __ATOMIC_RELAXED, __HIP_MEMORY_SCOPE_AGENT);
}

__device__ __forceinline__ void xchk_sum(Frame& F, const Ptrs& P, const unsigned char* base, size_t bytes, int ckword) {
    const int lane = lane_now(); const size_t nthr = (size_t)F.G * NWAVES * 64, t0 = (size_t)F.vcu * NWAVES * 64 + F.wave * 64 + lane;
    unsigned acc = 0; const GAS v4u* p4 = (const GAS v4u*)base;
    for (size_t i = t0; i < bytes / 16; i += nthr) { const v4u v = p4[i]; acc += v.x * 3u + v.y * 5u + v.z * 7u + v.w * 11u + (unsigned)i; }
    acc = (unsigned)wave_sum_f(0.f) + acc;
    __hip_atomic_fetch_add((unsigned*)(P.ws + WS_CTL) + ckword, acc, __ATOMIC_RELAXED, __HIP_MEMORY_SCOPE_AGENT);
}
constexpr int SCAN_DIST = 6;
#ifndef SCAN_WARM_AHEAD
#define SCAN_WARM_AHEAD 18
#endif
#ifndef SCAN_WARM
#define SCAN_WARM 0
#endif
constexpr int NWARM = SCAN_WARM ? 8 : 0;
template <int ROLE>
__device__ __forceinline__ void p3_scan_role(Frame& F, const Ptrs& P, int blk) {
    LAS unsigned char* ST = F.lds; LAS unsigned char* VT = F.lds + 8704;
    const int bh = blk & 7, es = blk >> 3;
    const int lane = lane_now(), wave = F.wave, r = lane & 15, q = lane >> 4, tid = wave * 64 + lane;
    const int dt = wave;
    for (int i = tid; i < 8704 / 4; i += NWAVES * 64) ((LAS unsigned*)ST)[i] = 0u;
    f32x4 sacc[2] = {(f32x4){0.f, 0.f, 0.f, 0.f}, (f32x4){0.f, 0.f, 0.f, 0.f}};
    const float* GT = (const float*)(P.ws + WS_GT);
    const unsigned char* item0 = P.ws + WS_GDN + (size_t)(bh * 128) * GDN_ITEM;
#define SCAN_LOAD(n_, wA_, kA_, uC_, gt_) do { const unsigned char* itp = item0 + (size_t)(n_) * GDN_ITEM; \
        if constexpr (ROLE < 2) { _Pragma("unroll") for (int s = 0; s < 4; ++s) wA_[s] = *(const GAS bf16x8*)(itp + GI_WNEG + ((wave * 4 + s) * 64 + lane) * 16); \
            uC_ = *(const GAS v4u*)(itp + GI_UFR + ((size_t)((wave * 4 + es) * 64 + lane)) * 16); } \
        _Pragma("unroll") for (int s = 0; s < 2; ++s) kA_[s] = *(const GAS bf16x8*)(itp + GI_KDT + ((dt * 2 + s) * 64 + lane) * 16); \
        } while (0)
#define SCAN_STEP(n_, wA_, kA_, uC_, RL_, pwA_, pkA_, puC_) do { __builtin_amdgcn_sched_barrier(0);   \
        if constexpr (ROLE == 2) { if constexpr (RL_) SCAN_LOAD(((n_) + SCAN_DIST - 1) & 127, pwA_, pkA_, puC_, 0); } \
        if constexpr (ROLE < 2) { v4u o4; f32x4 accv[2]; \
            _Pragma("unroll") for (int t = 0; t < 2; ++t) { const unsigned u0 = t ? uC_.z : uC_.x, u1 = t ? uC_.w : uC_.y; \
                f32x4 acc; acc.x = __uint_as_float(u0 << 16); acc.y = __uint_as_float(u0 & 0xffff0000u); acc.z = __uint_as_float(u1 << 16); acc.w = __uint_as_float(u1 & 0xffff0000u); \
                _Pragma("unroll") for (int s = 0; s < 4; ++s) { const bf16x8 sf = *(const LAS bf16x8*)(ST + (16 * t + r) * 272 + (32 * s + 8 * q) * 2); acc = __builtin_amdgcn_mfma_f32_16x16x32_bf16(wA_[s], sf, acc, 0, 0, 0); } \
                accv[t] = acc; } \
            __builtin_amdgcn_sched_barrier(0); \
            if constexpr (RL_) SCAN_LOAD(((n_) + SCAN_DIST - 1) & 127, pwA_, pkA_, puC_, 0); \
            __builtin_amdgcn_sched_barrier(0); \
            _Pragma("unroll") for (int t = 0; t < 2; ++t) { u32x2 o; o.x = pk2(accv[t].x, accv[t].y); o.y = pk2(accv[t].z, accv[t].w); \
                *(LAS u32x2*)(VT + (16 * t + r) * 144 + (16 * wave + 4 * q) * 2) = o; \
                if (t == 0) { o4.x = o.x; o4.y = o.y; } else { o4.z = o.x; o4.w = o.y; } } \
            __builtin_amdgcn_raw_buffer_store_b128(o4, rvn, (int)(((wave * 4 + es) * 64 + lane) * 16 + (bh * 128 + (n_)) * 16384), 0, 16  ); } \
        LBAR(); \
        const float gt_ = GTL[n_]; \
        _Pragma("unroll") for (int t = 0; t < 2; ++t) { sacc[t] = sacc[t] * gt_; \
            _Pragma("unroll") for (int s = 0; s < 2; ++s) { const bf16x8 vf = *(const LAS bf16x8*)(VT + (16 * t + r) * 144 + (32 * s + 8 * q) * 2); sacc[t] = __builtin_amdgcn_mfma_f32_16x16x32_bf16(kA_[s], vf, sacc[t], 0, 0, 0); } } \
        { v4u o4; \
        _Pragma("unroll") for (int t = 0; t < 2; ++t) { u32x2 o; o.x = pk2(sacc[t].x, sacc[t].y); o.y = pk2(sacc[t].z, sacc[t].w); \
            *(LAS u32x2*)(ST + (16 * t + r) * 272 + (16 * dt + 4 * q) * 2) = o; \
            if (t == 0) { o4.x = o.x; o4.y = o.y; } else { o4.z = o.x; o4.w = o.y; } } \
        __builtin_amdgcn_raw_buffer_store_b128(o4, rsn, (int)(((dt * 4 + es) * 64 + lane) * 16 + (bh * 128 + (((n_) + 1) & 127)) * 32768), 0, 16  ); }   \
        LBAR(); \
          \
        if constexpr (ROLE == 0) __builtin_amdgcn_raw_buffer_store_b32((unsigned)((n_) - SCAN_DIST), rprog, (lane == 0 && (n_) >= SCAN_DIST + 1) ? 0 : 64, 0, 16  );   } while (0)
    const __amdgpu_buffer_rsrc_t rsn = mk_rsrc(P.ws + WS_SN, 32u * 1024u * 1024u), rvn = mk_rsrc(P.ws + WS_VN, 16u * 1024u * 1024u);
    unsigned* prog = (unsigned*)(P.ws + WS_CTL) + CW_PROG + bh * 64 + es;
    const __amdgpu_buffer_rsrc_t rprog = mk_rsrc(prog, 4u);
    LAS float* GTL = (LAS float*)(F.lds + 13312);
    if (tid < 128) GTL[tid] = GT[bh * 128 + tid];
    bf16x8 wA0[4], kA0[2]; v4u uC0;
    bf16x8 wA1[4], kA1[2]; v4u uC1;
    bf16x8 wA2[4], kA2[2]; v4u uC2;
    bf16x8 wA3[4], kA3[2]; v4u uC3;
    bf16x8 wA4[4], kA4[2]; v4u uC4;
    bf16x8 wA5[4], kA5[2]; v4u uC5;
    SCAN_LOAD(0, wA0, kA0, uC0, 0);
    SCAN_LOAD(1, wA1, kA1, uC1, 0);
    SCAN_LOAD(2, wA2, kA2, uC2, 0);
    SCAN_LOAD(3, wA3, kA3, uC3, 0);
    SCAN_LOAD(4, wA4, kA4, uC4, 0);
    SCAN_LOAD(5, wA5, kA5, uC5, 0);
    LBAR();
    SCAN_STEP(0, wA0, kA0, uC0, 0, wA5, kA5, uC5);
    SCAN_STEP(1, wA1, kA1, uC1, 1, wA0, kA0, uC0);
    SCAN_STEP(2, wA2, kA2, uC2, 1, wA1, kA1, uC1);
    SCAN_STEP(3, wA3, kA3, uC3, 1, wA2, kA2, uC2);
    SCAN_STEP(4, wA4, kA4, uC4, 1, wA3, kA3, uC3);
    SCAN_STEP(5, wA5, kA5, uC5, 1, wA4, kA4, uC4);
    for (int n = 6; n < 126; n += 6) {
        SCAN_STEP(n, wA0, kA0, uC0, 1, wA5, kA5, uC5);
        SCAN_STEP(n + 1, wA1, kA1, uC1, 1, wA0, kA0, uC0);
        SCAN_STEP(n + 2, wA2, kA2, uC2, 1, wA1, kA1, uC1);
        SCAN_STEP(n + 3, wA3, kA3, uC3, 1, wA2, kA2, uC2);
        SCAN_STEP(n + 4, wA4, kA4, uC4, 1, wA3, kA3, uC3);
        SCAN_STEP(n + 5, wA5, kA5, uC5, 1, wA4, kA4, uC4);
    }
    SCAN_STEP(126, wA0, kA0, uC0, 1, wA5, kA5, uC5);
    SCAN_STEP(127, wA1, kA1, uC1, 0, wA0, kA0, uC0);
#undef SCAN_LOAD
#undef SCAN_STEP
    asm volatile("s_waitcnt vmcnt(0)" ::: "memory");
    LBAR();
    if (tid == 0) __hip_atomic_store(prog, 128u, __ATOMIC_RELAXED, __HIP_MEMORY_SCOPE_AGENT);
}
__device__ __forceinline__ void p3_scan(Frame& F, const Ptrs& P, int blk) {
    if (F.wave == 0) p3_scan_role<0>(F, P, blk); else if (F.wave < 4) p3_scan_role<1>(F, P, blk); else p3_scan_role<2>(F, P, blk);
}

#ifndef P4_POLL_SLEEP
#define P4_POLL_SLEEP 24
#endif
__device__ __forceinline__ unsigned scan_poll4(const unsigned* pg) {
    const v4u w = __builtin_amdgcn_raw_buffer_load_b128(mk_rsrc(pg, 16u), 0, 0, 16  );
    const unsigned a = w.x < w.y ? w.x : w.y, b = w.z < w.w ? w.z : w.w;
    return (unsigned)__builtin_amdgcn_readfirstlane(a < b ? a : b);
}
__device__ __forceinline__ void p3_scan_warm(Frame& F, const Ptrs& P, int bh) {
    const unsigned* pg = (const unsigned*)(P.ws + WS_CTL) + CW_PROG + bh * 64;
    const unsigned char* item0 = P.ws + WS_GDN + (size_t)(bh * 128) * GDN_ITEM;
    const int tid = F.wave * 64 + lane_now();
    int nx = 2 * SCAN_DIST;
    unsigned acc = 0, t0 = 0, t1 = 0, t2 = 0, t3 = 0;
    const bool act = tid < 384;
    for (unsigned spins = 0; nx < 128 && spins < (1u << 22); ++spins) {
        unsigned mn = scan_poll4(pg);
        acc += t0 + t1 + t2 + t3;
        int tgt = (int)mn + SCAN_WARM_AHEAD; tgt = tgt > 128 ? 128 : tgt;
        if (nx < (int)mn + 2 * SCAN_DIST) nx = (int)mn + 2 * SCAN_DIST;
        if (nx >= tgt) { __builtin_amdgcn_s_sleep(8); continue; }
        const unsigned char* ip = item0 + (size_t)nx * GDN_ITEM + tid * 128;
        const int k = tgt - nx;
        if (act) { t0 = *(const volatile unsigned*)ip;
            if (k > 1) t1 = *(const volatile unsigned*)(ip + GDN_ITEM);
            if (k > 2) t2 = *(const volatile unsigned*)(ip + 2 * GDN_ITEM);
            if (k > 3) t3 = *(const volatile unsigned*)(ip + 3 * GDN_ITEM); }
        nx += k > 4 ? 4 : k;
    }
    acc += t0 + t1 + t2 + t3;
    if (acc == 0x9E3779B9u) F.MISC[15] = acc;
}

struct ConfTaps { float w[CWID]; float bias, lg, lb; };
__device__ __forceinline__ void p3_conf_load_taps(const Ptrs& P, int ch, ConfTaps& T) {
#pragma unroll
    for (int k = 0; k < CWID; ++k) T.w[k] = P.w_conv_dw[k * CCH + ch];
    T.bias = P.b_conv_dw[ch]; T.lg = P.ln_g[ch]; T.lb = P.ln_b[ch];
}
__device__ __forceinline__ void p3_conf_tile(Frame& F, const Ptrs& P, int tile, const ConfTaps& T) {
    LAS float* part = (LAS float*)F.lds; LAS float* stat = (LAS float*)(F.lds + 2048);
    LAS unsigned char* UT = F.lds + 4096; LAS unsigned char* OT = F.lds + 67584;
    const unsigned char* U = P.ws + WS_U; unsigned char* MIX = P.ws + WS_MIX;
    const int lane = lane_now(), ch = F.wave * 64 + lane; const size_t m0 = (size_t)tile * 32; const int t0 = (int)(m0 % SEQ);
#pragma unroll
    for (int u = 0; u < 8; ++u) { const int cid = ch + 512 * u; if (cid < 62 * 64) { const int row = cid >> 6, t = t0 - 30 + row;
        v4u v = {0u, 0u, 0u, 0u}; if (t >= 0) v = *(const GAS v4u*)(U + ((m0 + row) - 30) * (CCH * 2) + (cid & 63) * 16);
        *(LAS v4u*)(UT + cid * 16) = v; } }
    LBAR();
    float cv[32];
#pragma unroll
    for (int i = 0; i < 32; ++i) cv[i] = T.bias;
    {
        float uu[62];
#pragma unroll
        for (int j = 0; j < 62; ++j) uu[j] = bf2f(*(const LAS unsigned short*)(UT + j * (CCH * 2) + ch * 2));
#pragma unroll
        for (int k = 0; k < CWID; ++k)
#pragma unroll
            for (int i = 0; i < 32; ++i) cv[i] = fmaf(T.w[k], uu[i + k], cv[i]);
    }
#pragma unroll
    for (int i = 0; i < 32; ++i) { const float s1 = wave_sum_f(cv[i]), s2 = wave_sum_f(cv[i] * cv[i]); if (lane == 0) { part[(F.wave * 32 + i) * 2] = s1; part[(F.wave * 32 + i) * 2 + 1] = s2; } }
    LBAR();
    if (ch < 32) { float s1 = 0.f, s2 = 0.f;
#pragma unroll
        for (int w = 0; w < 8; ++w) { s1 += part[(w * 32 + ch) * 2]; s2 += part[(w * 32 + ch) * 2 + 1]; }
        const float mu = s1 * (1.f / CCH); const float var = fmaxf(s2 * (1.f / CCH) - mu * mu, 0.f);
        stat[ch * 2] = mu; stat[ch * 2 + 1] = rsqrtf(var + EPS); }
    LBAR();
#pragma unroll
    for (int i = 0; i < 32; ++i) { const float yv = (cv[i] - stat[i * 2]) * stat[i * 2 + 1] * T.lg + T.lb; *(LAS unsigned short*)(OT + i * (CCH * 2) + ch * 2) = (unsigned short)f2bf(fsilu(yv)); }
    LBAR();
#pragma unroll
    for (int u = 0; u < 4; ++u) { const int cid = ch + 512 * u, row = cid >> 6;
        *(GAS v4u*)(MIX + (m0 + row) * (DM * 2) + 1024 + (cid & 63) * 16) = *(const LAS v4u*)(OT + cid * 16); }
    LBAR();
}

__device__ __forceinline__ void p4_gdn_out(Frame& F, const Ptrs& P, int idx, int cnt) {
    LAS float* ssq = (LAS float*)F.lds;
    const bf16* QKVZ = (const bf16*)(P.ws + WS_QKVZ); bf16* MIX = (bf16*)(P.ws + WS_MIX);
    const int wave = F.wave;
    const int ct2 = wave >> 2, et4 = wave & 3;
    for (int itc = idx; itc < 1024; itc += cnt) {
        const int lane = lane_now();
        const int r32 = lane & 31, hh = lane >> 5;
        const int bh = itc & 7, n = itc >> 3, b = bh >> 2, h = bh & 3, it = bh * 128 + n;
        const size_t m0 = (size_t)b * SEQ + (size_t)n * 64;
        const unsigned char* item = P.ws + WS_GDN + (size_t)it * GDN_ITEM;
        if (wave == 0) {
            const unsigned* pg = (const unsigned*)(P.ws + WS_CTL) + CW_PROG + bh * 64; unsigned spins = 0;
            for (;;) { const unsigned mn = scan_poll4(pg);
                if (mn >= (unsigned)(n + 1) || ++spins > (1u << 22)) break;
                __builtin_amdgcn_s_sleep(P4_POLL_SLEEP); }
            asm volatile("s_waitcnt vmcnt(0)" ::: "memory");
        }
        asm volatile("" ::: "memory"); __builtin_amdgcn_s_barrier(); asm volatile("" ::: "memory");
        f32x16 acc;
#pragma unroll
        for (int i = 0; i < 16; ++i) acc[i] = 0.f;
        const int e = 32 * et4 + r32;
        LAS unsigned char* ZT = F.lds + 4096; LAS unsigned char* OT = F.lds + 4096 + 16384;
        {
            bf16x8 a1[8], b1[8], a2[4], b2[4];
            v4u zc[2];
#pragma unroll
            for (int u = 0; u < 2; ++u) { const int cid = wave * 64 + lane + 512 * u; zc[u] = *(const GAS v4u*)((const unsigned char*)QKVZ + (m0 + (cid >> 4)) * 4096 + (1536 + h * 128) * 2 + (cid & 15) * 16); }
            const unsigned char* Ap = item + GI_QD + ((ct2 * 8) * 64 + lane) * 16;
            const __amdgpu_buffer_rsrc_t rsn4 = mk_rsrc(P.ws + WS_SN + (size_t)it * 32768, 32768u), rvn4 = mk_rsrc(P.ws + WS_VN + (size_t)it * 16384, 16384u);
            const int boff = (((et4 * 64) + (r32 & 15) + 32 * hh) * 2 + (r32 >> 4)) * 8;
            const unsigned char* Ap2 = item + GI_QK + ((ct2 * 4) * 64 + lane) * 16;
            constexpr int BSTEP = 4096, BHI = 256;
            if (n > 0) {
#pragma unroll
                for (int s = 0; s < 8; ++s) { a1[s] = *(const GAS bf16x8*)(Ap + s * 1024);
                    const u32x2 lo = __builtin_amdgcn_raw_buffer_load_b64(rsn4, boff + s * BSTEP, 0, 16  ), hi = __builtin_amdgcn_raw_buffer_load_b64(rsn4, boff + s * BSTEP + BHI, 0, 16); const v4u w = {lo.x, lo.y, hi.x, hi.y}; b1[s] = __builtin_bit_cast(bf16x8, w); }
            }
#pragma unroll
            for (int s = 0; s < 4; ++s) { a2[s] = *(const GAS bf16x8*)(Ap2 + s * 1024);
                const u32x2 lo = __builtin_amdgcn_raw_buffer_load_b64(rvn4, boff + s * BSTEP, 0, 16  ), hi = __builtin_amdgcn_raw_buffer_load_b64(rvn4, boff + s * BSTEP + BHI, 0, 16); const v4u w = {lo.x, lo.y, hi.x, hi.y}; b2[s] = __builtin_bit_cast(bf16x8, w); }
#pragma unroll
            for (int u = 0; u < 2; ++u) *(LAS v4u*)(ZT + (wave * 64 + lane + 512 * u) * 16) = zc[u];
            if (n > 0) {
#pragma unroll
                for (int s = 0; s < 8; ++s) acc = __builtin_amdgcn_mfma_f32_32x32x16_bf16(a1[s], b1[s], acc, 0, 0, 0);
            }
#pragma unroll
            for (int s = 0; s < 4; ++s) acc = __builtin_amdgcn_mfma_f32_32x32x16_bf16(a2[s], b2[s], acc, 0, 0, 0);
            float sq[16];
#pragma unroll
            for (int reg = 0; reg < 16; ++reg) sq[reg] = acc[reg] * acc[reg];
#pragma unroll
            for (int st = 1; st < 32; st <<= 1) { float t[16];
#pragma unroll
                for (int reg = 0; reg < 16; ++reg) t[reg] = __shfl_xor(sq[reg], st);
#pragma unroll
                for (int reg = 0; reg < 16; ++reg) sq[reg] += t[reg]; }
            if (r32 == 0) {
#pragma unroll
                for (int reg = 0; reg < 16; ++reg) ssq[(32 * ct2 + (reg & 3) + 8 * (reg >> 2) + 4 * hh) * 4 + et4] = sq[reg]; }
            LBAR();
            const float gg = P.g_gdn_out[e];
#pragma unroll
            for (int reg = 0; reg < 16; ++reg) { const int row = 32 * ct2 + (reg & 3) + 8 * (reg >> 2) + 4 * hh;
                const f32x4 sv = *(const LAS f32x4*)(ssq + row * 4);
                const float rs = rsqrtf(((sv.x + sv.y) + (sv.z + sv.w)) * (1.f / DV) + EPS);
                const float z = bf2f(*(const LAS unsigned short*)(ZT + row * 256 + e * 2));
                *(LAS unsigned short*)(OT + row * 256 + e * 2) = (unsigned short)f2bf(acc[reg] * rs * gg * fsilu(z)); }
            LBAR();
#pragma unroll
            for (int u = 0; u < 2; ++u) { const int cid = wave * 64 + lane + 512 * u;
                *(GAS v4u*)((unsigned char*)MIX + (m0 + (cid >> 4)) * 2048 + h * 256 + (cid & 15) * 16) = *(const LAS v4u*)(OT + cid * 16); }
        }
        LBAR();
    }
}

constexpr size_t WS_WR = 15 * MiB;
constexpr size_t WS_CNT = 1 * MiB;
constexpr size_t WS_TPOS = 1 * MiB + 256 * 1024;
constexpr size_t WS_GATEW = 1 * MiB + 512 * 1024;
constexpr size_t WS_TEX = 2 * MiB;
constexpr size_t WS_XG = 144 * MiB;
constexpr size_t WS_Y = 240 * MiB;
constexpr size_t WS_ACT = 336 * MiB;
constexpr int PSLOTS = 49152;
constexpr size_t WS_XN3 = WS_N1;
constexpr size_t WS_H2 = 144 * MiB;
constexpr size_t WS_H3 = 240 * MiB;
constexpr int LDS_LG = 131584, LDS_TE = LDS_LG + 64 * 80 * 4, LDS_TW = LDS_TE + 512, LDS_CNT = LDS_TW + 512, LDS_POS = LDS_CNT + 256, LDS_BASE = LDS_POS + 512, LDS_PART = LDS_BASE + 256;

__device__ __forceinline__ void unpack8(const v4u w, float (&f)[8]) {
    f[0] = __uint_as_float(w.x << 16); f[1] = __uint_as_float(w.x & 0xffff0000u); f[2] = __uint_as_float(w.y << 16); f[3] = __uint_as_float(w.y & 0xffff0000u);
    f[4] = __uint_as_float(w.z << 16); f[5] = __uint_as_float(w.z & 0xffff0000u); f[6] = __uint_as_float(w.w << 16); f[7] = __uint_as_float(w.w & 0xffff0000u);
}
__device__ __forceinline__ v4u pack8(const float (&f)[8]) { v4u w; w.x = pk2(f[0], f[1]); w.y = pk2(f[2], f[3]); w.z = pk2(f[4], f[5]); w.w = pk2(f[6], f[7]); return w; }
struct EpiRes {
    static constexpr bool PERM = true, AFTER_DRAIN = false;
    const float* base; pg8::bf16_t* out;
    __device__ __forceinline__ void operator()(const pg8::f32x4 (&acc)[2][2][4][2], const pg8::Unit& u, int wr, int wc, int fr, int fq) const {
        using namespace pg8;
        const int row0 = u.pm * BM + wr * 64 + fr, col0 = u.pn * BM + wc * 32 + 8 * fq;
#pragma unroll
        for (int ai = 0; ai < 2; ++ai)
#pragma unroll
            for (int m = 0; m < 4; ++m) { const size_t off = (size_t)(row0 + ai * HALF + m * 16) * DM + col0;
#pragma unroll
                for (int bj = 0; bj < 2; ++bj) { const size_t o = off + bj * HALF;
                    const f32x4 v0 = *(const f32x4*)(base + o) + acc[ai][bj][m][0], v1 = *(const f32x4*)(base + o + 4) + acc[ai][bj][m][1];
                    u32x4 w; w.x = cvt_pk_bf16(v0[0], v0[1]); w.y = cvt_pk_bf16(v0[2], v0[3]); w.z = cvt_pk_bf16(v1[0], v1[1]); w.w = cvt_pk_bf16(v1[2], v1[3]);
                    *(u32x4*)(out + o) = w; } }
    }
};
struct EpiSwiGLU {
    static constexpr bool PERM = true, AFTER_DRAIN = false;
    pg8::bf16_t* ACT;
    __device__ __forceinline__ void operator()(const pg8::f32x4 (&acc)[2][2][4][2], const pg8::Unit& u, int wr, int wc, int fr, int fq) const {
        using namespace pg8;
        const int row0 = u.pm * BM + wr * 64 + fr, hid0 = u.pn * 128 + wc * 16 + 4 * fq;
#pragma unroll
        for (int ai = 0; ai < 2; ++ai)
#pragma unroll
            for (int m = 0; m < 4; ++m) { bf16_t* rowp = ACT + (size_t)(row0 + ai * HALF + m * 16) * DEXP + hid0;
#pragma unroll
                for (int bj = 0; bj < 2; ++bj) { const f32x4 a = acc[ai][bj][m][0], g = acc[ai][bj][m][1];
                    const unsigned lo = cvt_pk_bf16(fsilu(a[0]) * g[0], fsilu(a[1]) * g[1]), hi = cvt_pk_bf16(fsilu(a[2]) * g[2], fsilu(a[3]) * g[3]);
                    __hip_atomic_store((unsigned long long*)(rowp + bj * 64), (unsigned long long)lo | ((unsigned long long)hi << 32), __ATOMIC_RELAXED, __HIP_MEMORY_SCOPE_AGENT); } }
    }
};
struct EpiGate {
    static constexpr bool PERM = true, AFTER_DRAIN = false;
    pg8::bf16_t* Y; const float* gatew;
    __device__ __forceinline__ void operator()(const pg8::f32x4 (&acc)[2][2][4][2], const pg8::Unit& u, int wr, int wc, int fr, int fq) const {
        using namespace pg8;
        const int row0 = u.pm * BM + wr * 64 + fr, col0 = u.pn * BM + wc * 32 + 8 * fq;
#pragma unroll
        for (int ai = 0; ai < 2; ++ai)
#pragma unroll
            for (int m = 0; m < 4; ++m) { const int row = row0 + ai * HALF + m * 16; const float gw = gatew[row]; bf16_t* rowp = Y + (size_t)row * DM + col0;
#pragma unroll
                for (int bj = 0; bj < 2; ++bj) { const f32x4 v0 = acc[ai][bj][m][0] * gw, v1 = acc[ai][bj][m][1] * gw;
                    u32x4 w; w.x = cvt_pk_bf16(v0[0], v0[1]); w.y = cvt_pk_bf16(v0[2], v0[3]); w.z = cvt_pk_bf16(v1[0], v1[1]); w.w = cvt_pk_bf16(v1[2], v1[3]);
                    *(u32x4*)(rowp + bj * HALF) = w; } }
    }
};
struct EpiPle {
    static constexpr bool PERM = true, AFTER_DRAIN = false;
    const pg8::bf16_t* h2; const pg8::bf16_t* proj; pg8::bf16_t* out;
    __device__ __forceinline__ void operator()(const pg8::f32x4 (&acc)[2][2][4][2], const pg8::Unit& u, int wr, int wc, int fr, int fq) const {
        using namespace pg8;
        const int row0 = u.pm * BM + wr * 64 + fr, col0 = u.pn * BM + wc * 32 + 8 * fq;
#pragma unroll
        for (int ai = 0; ai < 2; ++ai)
#pragma unroll
            for (int m = 0; m < 4; ++m) { const size_t off = (size_t)(row0 + ai * HALF + m * 16) * DM + col0;
#pragma unroll
                for (int bj = 0; bj < 2; ++bj) { const size_t o = off + bj * HALF; float hh_[8], pp_[8], r_[8];
                    unpack8(*(const v4u*)(h2 + o), hh_); unpack8(*(const v4u*)(proj + o), pp_);
#pragma unroll
                    for (int i = 0; i < 4; ++i) { r_[i] = hh_[i] + fsigmoid(acc[ai][bj][m][0][i]) * pp_[i]; r_[4 + i] = hh_[4 + i] + fsigmoid(acc[ai][bj][m][1][i]) * pp_[4 + i]; }
                    *(v4u*)(out + o) = pack8(r_); } }
    }
};
struct MoeOrder {
    const int* tex; int nN, G, c;
    __device__ __forceinline__ bool next(int i, pg8::Unit& u) const {
        const int nt = __builtin_amdgcn_readfirstlane(__hip_atomic_load(tex, __ATOMIC_RELAXED, __HIP_MEMORY_SCOPE_AGENT)); const long L = (long)i * G + c; if (L >= (long)nt * nN) return false;
        const int rt = (int)(L / nN); u.pm = rt; u.pn = (int)(L % nN); u.be = __builtin_amdgcn_readfirstlane(__hip_atomic_load(tex + 64 + rt, __ATOMIC_RELAXED, __HIP_MEMORY_SCOPE_AGENT)); return true;
    }
    __device__ __forceinline__ void a_ready(const pg8::Unit&) const {}
    __device__ __forceinline__ void done(const pg8::Unit&) const {}
};

struct MoeUpOrder {
    unsigned char* ws; int G, c;
    __device__ __forceinline__ bool next(int i, pg8::Unit& u) const {
        const int nt = __builtin_amdgcn_readfirstlane(__hip_atomic_load((const int*)(ws + WS_TEX), __ATOMIC_RELAXED, __HIP_MEMORY_SCOPE_AGENT)); const int L = i * G + c; if (L >= 2 * nt) return false;
        const int rt = L >> 1; u.pm = rt; u.pn = L & 1; u.be = __builtin_amdgcn_readfirstlane(__hip_atomic_load((const int*)(ws + WS_TEX) + 64 + rt, __ATOMIC_RELAXED, __HIP_MEMORY_SCOPE_AGENT)); return true;
    }
    __device__ __forceinline__ void a_ready(const pg8::Unit&) const {}
    __device__ __forceinline__ void done(const pg8::Unit& u) const {
        asm volatile("s_waitcnt vmcnt(0)" ::: "memory");
        if (lane_now() == 0) __hip_atomic_fetch_add((unsigned*)(ws + WS_CTL) + CW_READY + 64 * u.pm, 1u, __ATOMIC_RELAXED, __HIP_MEMORY_SCOPE_AGENT);
    }
};
struct MoeDownOrder {
    unsigned char* ws; int G, c, wave;
    __device__ __forceinline__ bool next(int i, pg8::Unit& u) const {
        const int nt = __builtin_amdgcn_readfirstlane(__hip_atomic_load((const int*)(ws + WS_TEX), __ATOMIC_RELAXED, __HIP_MEMORY_SCOPE_AGENT)); const int H = (2 * nt > G) ? 2 * nt - G : 0;
        int L;
        if (i == 0) L = c; else { if (c < H) return false; L = G + (i - 1) * (G - H) + (c - H); }
        if (L >= 4 * nt) return false;
        const int rt = L >> 2; u.pm = rt; u.pn = L & 3; u.be = __builtin_amdgcn_readfirstlane(__hip_atomic_load((const int*)(ws + WS_TEX) + 64 + rt, __ATOMIC_RELAXED, __HIP_MEMORY_SCOPE_AGENT)); return true;
    }
    __device__ __forceinline__ void wait_ready(const pg8::Unit& u) const {
        if (wave == 0) {
            unsigned spins = 0;
            while ((unsigned)__builtin_amdgcn_readfirstlane(__hip_atomic_load((unsigned*)(ws + WS_CTL) + CW_READY + 64 * u.pm, __ATOMIC_RELAXED, __HIP_MEMORY_SCOPE_AGENT)) < 16u && ++spins < (1u << 22)) __builtin_amdgcn_s_sleep(2);
            __builtin_amdgcn_fence(__ATOMIC_ACQUIRE, "agent");
            asm volatile("s_waitcnt vmcnt(0)" ::: "memory");
        }
        asm volatile("" ::: "memory"); __builtin_amdgcn_s_barrier(); asm volatile("" ::: "memory");
    }
};
struct OneUnit {
    pg8::Unit u0;
    __device__ __forceinline__ bool next(int i, pg8::Unit& u) const { if (i != 0) return false; u = u0; return true; }
    __device__ __forceinline__ void a_ready(const pg8::Unit&) const {}
    __device__ __forceinline__ void done(const pg8::Unit&) const {}
};

__device__ __forceinline__ void p6_router(Frame& F, const Ptrs& P) {
    const int lane = lane_now(), wave = F.wave, tid = wave * 64 + lane;
    const int tile = F.vcu; const size_t m0 = (size_t)tile * 64;
    const bf16* H1 = (const bf16*)(P.ws + WS_H1);
    LAS unsigned char* XT = F.lds;
    LAS float* LG = (LAS float*)(F.lds + LDS_LG); LAS int* te_l = (LAS int*)(F.lds + LDS_TE); LAS float* tw_l = (LAS float*)(F.lds + LDS_TW); LAS int* cnt_l = (LAS int*)(F.lds + LDS_CNT);
    if (tid < 64) cnt_l[tid] = 0;
    const int r = lane & 15, q = lane >> 4, mt = wave & 3, nt0 = wave < 4 ? 0 : 3, nnt = wave < 4 ? 3 : 2;
    const unsigned char* Wr = P.ws + WS_WR + ((size_t)(16 * nt0 + r) * DM + 8 * q) * 2;
    bf16x8 bA[8][3], bB[8][3];
#define P6_LOADB(dst, s8) _Pragma("unroll") for (int u = 0; u < 8; ++u) _Pragma("unroll") for (int t = 0; t < 3; ++t) if (t < nnt) dst[u][t] = *(const GAS bf16x8*)(Wr + (size_t)t * (16 * DM * 2) + 64 * ((s8) + u))
#define P6_MFMA(src, s8) _Pragma("unroll") for (int u = 0; u < 8; ++u) { const bf16x8 a = *(const LAS bf16x8*)(XT + (16 * mt + r) * 2048 + (32 * ((s8) + u) + 8 * q) * 2); \
        _Pragma("unroll") for (int t = 0; t < 3; ++t) if (t < nnt) acc[t] = __builtin_amdgcn_mfma_f32_16x16x32_bf16(a, src[u][t], acc[t], 0, 0, 0); }
    P6_LOADB(bA, 0);
    {
        v4u raw[8][2];
#pragma unroll
        for (int rr = 0; rr < 8; ++rr) { const GAS v4u* xr = (const GAS v4u*)(H1 + (m0 + wave * 8 + rr) * DM) + lane; raw[rr][0] = xr[0]; raw[rr][1] = xr[64]; }
        f32x4 gm[2][2];
#pragma unroll
        for (int j = 0; j < 2; ++j) { gm[j][0] = ((const GAS f32x4*)P.g_moe)[2 * (64 * j + lane)]; gm[j][1] = ((const GAS f32x4*)P.g_moe)[2 * (64 * j + lane) + 1]; }
#pragma unroll
        for (int rr = 0; rr < 8; ++rr) { const int row = wave * 8 + rr;
            float v[2][8]; float s = 0.f;
#pragma unroll
            for (int j = 0; j < 2; ++j) { unpack8(raw[rr][j], v[j]);
#pragma unroll
                for (int i = 0; i < 8; ++i) s += v[j][i] * v[j][i]; }
            const float rs = rsqrtf(wave_sum_f(s) * (1.f / DM) + EPS);
#pragma unroll
            for (int j = 0; j < 2; ++j) {
#pragma unroll
                for (int i = 0; i < 4; ++i) { v[j][i] *= rs * gm[j][0][i]; v[j][4 + i] *= rs * gm[j][1][i]; }
                *(LAS v4u*)(XT + row * 2048 + (64 * j + lane) * 16) = pack8(v[j]); } }
    }
    LBAR();
    {
        f32x4 acc[3];
#pragma unroll
        for (int t = 0; t < 3; ++t) acc[t] = (f32x4){0.f, 0.f, 0.f, 0.f};
        P6_LOADB(bB, 8);  P6_MFMA(bA, 0);
        P6_LOADB(bA, 16); P6_MFMA(bB, 8);
        P6_LOADB(bB, 24); P6_MFMA(bA, 16);
        P6_MFMA(bB, 24);
#pragma unroll
        for (int t = 0; t < 3; ++t) if (t < nnt) {
#pragma unroll
            for (int reg = 0; reg < 4; ++reg) LG[(16 * mt + 4 * q + reg) * 80 + 16 * (nt0 + t) + r] = acc[t][reg]; }
    }
#undef P6_LOADB
#undef P6_MFMA
    LBAR();
    if (tid < 64) {
        const LAS float* lg = LG + tid * 80;
        float mx = lg[0]; int gi = 0;
#pragma unroll
        for (int j = 1; j < NGRP; ++j) { const float v = lg[j]; if (v > mx) { mx = v; gi = j; } }
        float den = 0.f;
#pragma unroll
        for (int j = 0; j < NGRP; ++j) den += __expf(lg[j] - mx);
        const float gw = 1.f / den;
        float m1 = -INFINITY, m2 = -INFINITY; int i1 = 0, i2 = 0;
#pragma unroll
        for (int j = 0; j < EPG; ++j) { const float v = lg[8 + gi * EPG + j]; if (v > m1) { m2 = m1; i2 = i1; m1 = v; i1 = j; } else if (v > m2) { m2 = v; i2 = j; } }
        const float p2 = __expf(m2 - m1);
        const int e1 = gi * EPG + i1, e2 = gi * EPG + i2;
        te_l[tid * 2] = e1; te_l[tid * 2 + 1] = e2; tw_l[tid * 2] = gw / (1.f + p2); tw_l[tid * 2 + 1] = gw * p2 / (1.f + p2);
        __hip_atomic_fetch_add(cnt_l + e1, 1, __ATOMIC_RELAXED, __HIP_MEMORY_SCOPE_WORKGROUP); __hip_atomic_fetch_add(cnt_l + e2, 1, __ATOMIC_RELAXED, __HIP_MEMORY_SCOPE_WORKGROUP);
    }
    LBAR();
    if (tid < 64) ((int*)(P.ws + WS_CNT))[tile * 64 + tid] = cnt_l[tid];
}
__device__ __forceinline__ void p7_dispatch(Frame& F, const Ptrs& P) {
    const int lane = lane_now(), wave = F.wave, tid = wave * 64 + lane;
    const int tile = F.vcu; const size_t m0 = (size_t)tile * 64;
    LAS unsigned char* XT = F.lds;
    LAS int* te_l = (LAS int*)(F.lds + LDS_TE); LAS float* tw_l = (LAS float*)(F.lds + LDS_TW); LAS int* pos_l = (LAS int*)(F.lds + LDS_POS); LAS int* base_l = (LAS int*)(F.lds + LDS_BASE);
    LAS int* part = (LAS int*)(F.lds + LDS_PART);
    const int* CNT = (const int*)(P.ws + WS_CNT);
    { const int e = lane, pt = wave; int tot = 0, bef = 0;
      int cv[32];
#pragma unroll
      for (int t = 0; t < 32; ++t) cv[t] = CNT[(32 * pt + t) * 64 + e];
#pragma unroll
      for (int t = 0; t < 32; ++t) { tot += cv[t]; bef += (32 * pt + t < tile) ? cv[t] : 0; }
      part[(pt * 64 + e) * 2] = tot; part[(pt * 64 + e) * 2 + 1] = bef; }
    LBAR();
    if (wave == 0) { int tot = 0, bef = 0;
#pragma unroll
        for (int pt = 0; pt < 8; ++pt) { tot += part[(pt * 64 + lane) * 2]; bef += part[(pt * 64 + lane) * 2 + 1]; }
        const int pc = (tot + 255) & ~255; int incl = pc;
#pragma unroll
        for (int off = 1; off < 64; off <<= 1) { const int t = __shfl_up(incl, off); if (lane >= off) incl += t; }
        const int pstart = incl - pc;
        base_l[lane] = pstart + bef;
        if (tile == 0) { int* TEX = (int*)(P.ws + WS_TEX); for (int r = pstart >> 8; r < (pstart + pc) >> 8; ++r) TEX[64 + r] = lane; if (lane == 63) TEX[0] = (pstart + pc) >> 8; }
    }
    LBAR();
    if (wave < 2) { const int e = te_l[tid]; int rank = 0;
#pragma unroll
        for (int j4 = 0; j4 < 32; ++j4) { const v4u t4 = *(const LAS v4u*)(te_l + 4 * j4);
            rank += ((4 * j4 + 0 < tid && (int)t4.x == e) ? 1 : 0) + ((4 * j4 + 1 < tid && (int)t4.y == e) ? 1 : 0) + ((4 * j4 + 2 < tid && (int)t4.z == e) ? 1 : 0) + ((4 * j4 + 3 < tid && (int)t4.w == e) ? 1 : 0); }
        const int pos = base_l[e] + rank; pos_l[tid] = pos;
        ((int*)(P.ws + WS_TPOS))[m0 * 2 + tid] = pos; ((float*)(P.ws + WS_GATEW))[pos] = tw_l[tid]; }
    LBAR();
    for (int rr = 0; rr < 8; ++rr) { const int row = wave * 8 + rr; const int p0 = pos_l[row * 2], p1 = pos_l[row * 2 + 1];
#pragma unroll
        for (int c = 0; c < 2; ++c) { const v4u v = *(const LAS v4u*)(XT + row * 2048 + (lane + 64 * c) * 16);
            *(GAS v4u*)(P.ws + WS_XG + (size_t)p0 * 2048 + (lane + 64 * c) * 16) = v; *(GAS v4u*)(P.ws + WS_XG + (size_t)p1 * 2048 + (lane + 64 * c) * 16) = v; } }
}
__device__ __forceinline__ void p10_combine(Frame& F, const Ptrs& P) {
    const int lane = lane_now(); const int gw = F.vcu * NWAVES + F.wave, NGW = F.G * NWAVES;
    const bf16* H = (const bf16*)(P.ws + WS_H1); bf16* H2 = (bf16*)(P.ws + WS_H2); const int* TPOS = (const int*)(P.ws + WS_TPOS); bf16* XN3 = (bf16*)(P.ws + WS_XN3);
    for (int m = gw; m < M; m += NGW) {
        const int p0 = TPOS[m * 2], p1 = TPOS[m * 2 + 1];
        const GAS v4u* hr = (const GAS v4u*)(H + (size_t)m * DM) + lane; GAS v4u* ho = (GAS v4u*)(H2 + (size_t)m * DM) + lane;
        const GAS v4u* y0 = (const GAS v4u*)(P.ws + WS_Y + (size_t)p0 * 2048) + lane; const GAS v4u* y1 = (const GAS v4u*)(P.ws + WS_Y + (size_t)p1 * 2048) + lane;
        float v[2][8]; float s = 0.f;
#pragma unroll
        for (int j = 0; j < 2; ++j) { float a[8], b[8]; unpack8(hr[64 * j], v[j]); unpack8(y0[64 * j], a); unpack8(y1[64 * j], b);
#pragma unroll
            for (int i = 0; i < 8; ++i) { v[j][i] += a[i] + b[i]; s += v[j][i] * v[j][i]; }
            ho[64 * j] = pack8(v[j]); }
        const float r = rsqrtf(wave_sum_f(s) * (1.f / DM) + EPS);
        GAS v4u* o8 = (GAS v4u*)(XN3 + (size_t)m * DM) + lane;
#pragma unroll
        for (int j = 0; j < 2; ++j) { const f32x4 g0 = ((const GAS f32x4*)P.g_ple)[2 * (64 * j + lane)], g1 = ((const GAS f32x4*)P.g_ple)[2 * (64 * j + lane) + 1];
#pragma unroll
            for (int i = 0; i < 4; ++i) { v[j][i] *= r * g0[i]; v[j][4 + i] *= r * g1[i]; }
            o8[64 * j] = pack8(v[j]); }
    }
}
__device__ __forceinline__ void p12_final(Frame& F, const Ptrs& P) {
    const int lane = lane_now(); const int gw = F.vcu * NWAVES + F.wave, NGW = F.G * NWAVES;
    for (int m = gw; m < M; m += NGW) {
        const GAS v4u* hr = (const GAS v4u*)((const bf16*)(P.ws + WS_H3) + (size_t)m * DM) + lane; GAS f32x4* ho = (GAS f32x4*)(P.out + (size_t)m * DM);
        float v[2][8]; float s = 0.f;
#pragma unroll
        for (int j = 0; j < 2; ++j) { unpack8(hr[64 * j], v[j]);
#pragma unroll
            for (int i = 0; i < 8; ++i) s += v[j][i] * v[j][i]; }
        float r = rsqrtf(wave_sum_f(s) * (1.f / DM) + EPS);
#if XCHK
        { const unsigned c1 = __hip_atomic_load((const unsigned*)(P.ws + WS_CTL) + CK_P1, __ATOMIC_RELAXED, __HIP_MEMORY_SCOPE_AGENT), c2 = __hip_atomic_load((const unsigned*)(P.ws + WS_CTL) + CK_P2, __ATOMIC_RELAXED, __HIP_MEMORY_SCOPE_AGENT);
          const unsigned p1 = ((const unsigned*)(P.ws + 3 * MiB))[0]; (void)c2;
          if (__hip_atomic_load((const unsigned*)(P.ws + WS_CTL) + CK_P2 + 8, __ATOMIC_RELAXED, __HIP_MEMORY_SCOPE_AGENT) != 0u) r *= 3.0f;
          if (p1 != 0xAAAAAAAAu && p1 != c1) r *= 1.1f;
          else {
#pragma unroll
            for (int g = 7; g >= 0; --g) { const unsigned cg = __hip_atomic_load((const unsigned*)(P.ws + WS_CTL) + CK_P2 + g, __ATOMIC_RELAXED, __HIP_MEMORY_SCOPE_AGENT), pg = ((const unsigned*)(P.ws + 3 * MiB))[1 + g];
                if (pg != 0xAAAAAAAAu && pg != cg) r *= 1.2f + 0.1f * (float)g; } } }
#endif
#if DTEST
        { const unsigned dtm = __hip_atomic_load((const unsigned*)(P.ws + WS_CTL) + CW_DT, __ATOMIC_RELAXED, __HIP_MEMORY_SCOPE_AGENT);
          if (dtm != 0u) r *= 1.0f + 0.05f * (float)(__builtin_ctz(dtm) + 1) + 0.5f * (float)(__builtin_popcount(dtm) - 1); }
#endif
#pragma unroll
        for (int j = 0; j < 2; ++j) { const int c4 = 2 * (64 * j + lane); const f32x4 g0 = ((const GAS f32x4*)P.g_final)[c4], g1 = ((const GAS f32x4*)P.g_final)[c4 + 1];
            ho[c4] = (f32x4){v[j][0] * r * g0[0], v[j][1] * r * g0[1], v[j][2] * r * g0[2], v[j][3] * r * g0[3]};
            ho[c4 + 1] = (f32x4){v[j][4] * r * g1[0], v[j][5] * r * g1[1], v[j][6] * r * g1[2], v[j][7] * r * g1[3]}; }
    }
#if XCHK
    if (F.vcu == F.G - 1 && F.wave == 7 && lane == 0) { __builtin_amdgcn_s_sleep(127); __builtin_amdgcn_s_sleep(127); __builtin_amdgcn_s_sleep(127);
        ((unsigned*)(P.ws + 3 * MiB))[0] = __hip_atomic_load((const unsigned*)(P.ws + WS_CTL) + CK_P1, __ATOMIC_RELAXED, __HIP_MEMORY_SCOPE_AGENT);
        for (int g = 0; g < 8; ++g) ((unsigned*)(P.ws + 3 * MiB))[1 + g] = __hip_atomic_load((const unsigned*)(P.ws + WS_CTL) + CK_P2 + g, __ATOMIC_RELAXED, __HIP_MEMORY_SCOPE_AGENT); }
#endif
}
struct Args { const float* in[23]; float* out; unsigned char* ws; int ph_lo, ph_hi, use_bar, bar_region; };
constexpr int N_PHASES = 13;
__global__ void __launch_bounds__(NWAVES * 64, 2) mk_fwd(Args args) {
    extern __shared__ __attribute__((aligned(16))) unsigned char lds[];
#if defined(VINIT) && VINIT
    asm volatile("v_mov_b32 v8, 0\n\tv_mov_b32 v9, 0\n\tv_mov_b32 v10, 0\n\tv_mov_b32 v11, 0\n\tv_mov_b32 v12, 0\n\tv_mov_b32 v13, 0\n\tv_mov_b32 v14, 0\n\tv_mov_b32 v15, 0\n\tv_mov_b32 v16, 0\n\tv_mov_b32 v17, 0\n\tv_mov_b32 v18, 0\n\tv_mov_b32 v19, 0\n\tv_mov_b32 v20, 0\n\tv_mov_b32 v21, 0\n\tv_mov_b32 v22, 0\n\tv_mov_b32 v23, 0\n\tv_mov_b32 v24, 0\n\tv_mov_b32 v25, 0\n\tv_mov_b32 v26, 0\n\tv_mov_b32 v27, 0\n\tv_mov_b32 v28, 0\n\tv_mov_b32 v29, 0\n\tv_mov_b32 v30, 0\n\tv_mov_b32 v31, 0\n\tv_mov_b32 v32, 0\n\tv_mov_b32 v33, 0\n\tv_mov_b32 v34, 0\n\tv_mov_b32 v35, 0\n\tv_mov_b32 v36, 0\n\tv_mov_b32 v37, 0\n\tv_mov_b32 v38, 0\n\tv_mov_b32 v39, 0\n\tv_mov_b32 v40, 0\n\tv_mov_b32 v41, 0\n\tv_mov_b32 v42, 0\n\tv_mov_b32 v43, 0\n\tv_mov_b32 v44, 0\n\tv_mov_b32 v45, 0\n\tv_mov_b32 v46, 0\n\tv_mov_b32 v47, 0\n\tv_mov_b32 v48, 0\n\tv_mov_b32 v49, 0\n\tv_mov_b32 v50, 0\n\tv_mov_b32 v51, 0\n\tv_mov_b32 v52, 0\n\tv_mov_b32 v53, 0\n\tv_mov_b32 v54, 0\n\tv_mov_b32 v55, 0\n\tv_mov_b32 v56, 0\n\tv_mov_b32 v57, 0\n\tv_mov_b32 v58, 0\n\tv_mov_b32 v59, 0\n\tv_mov_b32 v60, 0\n\tv_mov_b32 v61, 0\n\tv_mov_b32 v62, 0\n\tv_mov_b32 v63, 0" ::: "v8", "v9", "v10", "v11", "v12", "v13", "v14", "v15", "v16", "v17", "v18", "v19", "v20", "v21", "v22", "v23", "v24", "v25", "v26", "v27", "v28", "v29", "v30", "v31", "v32", "v33", "v34", "v35", "v36", "v37", "v38", "v39", "v40", "v41", "v42", "v43", "v44", "v45", "v46", "v47", "v48", "v49", "v50", "v51", "v52", "v53", "v54", "v55", "v56", "v57", "v58", "v59", "v60", "v61", "v62", "v63");
    asm volatile("v_mov_b32 v64, 0\n\tv_mov_b32 v65, 0\n\tv_mov_b32 v66, 0\n\tv_mov_b32 v67, 0\n\tv_mov_b32 v68, 0\n\tv_mov_b32 v69, 0\n\tv_mov_b32 v70, 0\n\tv_mov_b32 v71, 0\n\tv_mov_b32 v72, 0\n\tv_mov_b32 v73, 0\n\tv_mov_b32 v74, 0\n\tv_mov_b32 v75, 0\n\tv_mov_b32 v76, 0\n\tv_mov_b32 v77, 0\n\tv_mov_b32 v78, 0\n\tv_mov_b32 v79, 0\n\tv_mov_b32 v80, 0\n\tv_mov_b32 v81, 0\n\tv_mov_b32 v82, 0\n\tv_mov_b32 v83, 0\n\tv_mov_b32 v84, 0\n\tv_mov_b32 v85, 0\n\tv_mov_b32 v86, 0\n\tv_mov_b32 v87, 0\n\tv_mov_b32 v88, 0\n\tv_mov_b32 v89, 0\n\tv_mov_b32 v90, 0\n\tv_mov_b32 v91, 0\n\tv_mov_b32 v92, 0\n\tv_mov_b32 v93, 0\n\tv_mov_b32 v94, 0\n\tv_mov_b32 v95, 0\n\tv_mov_b32 v96, 0\n\tv_mov_b32 v97, 0\n\tv_mov_b32 v98, 0\n\tv_mov_b32 v99, 0\n\tv_mov_b32 v100, 0\n\tv_mov_b32 v101, 0\n\tv_mov_b32 v102, 0\n\tv_mov_b32 v103, 0\n\tv_mov_b32 v104, 0\n\tv_mov_b32 v105, 0\n\tv_mov_b32 v106, 0\n\tv_mov_b32 v107, 0\n\tv_mov_b32 v108, 0\n\tv_mov_b32 v109, 0\n\tv_mov_b32 v110, 0\n\tv_mov_b32 v111, 0\n\tv_mov_b32 v112, 0\n\tv_mov_b32 v113, 0\n\tv_mov_b32 v114, 0\n\tv_mov_b32 v115, 0\n\tv_mov_b32 v116, 0\n\tv_mov_b32 v117, 0\n\tv_mov_b32 v118, 0\n\tv_mov_b32 v119, 0\n\tv_mov_b32 v120, 0\n\tv_mov_b32 v121, 0\n\tv_mov_b32 v122, 0\n\tv_mov_b32 v123, 0\n\tv_mov_b32 v124, 0\n\tv_mov_b32 v125, 0\n\tv_mov_b32 v126, 0\n\tv_mov_b32 v127, 0" ::: "v64", "v65", "v66", "v67", "v68", "v69", "v70", "v71", "v72", "v73", "v74", "v75", "v76", "v77", "v78", "v79", "v80", "v81", "v82", "v83", "v84", "v85", "v86", "v87", "v88", "v89", "v90", "v91", "v92", "v93", "v94", "v95", "v96", "v97", "v98", "v99", "v100", "v101", "v102", "v103", "v104", "v105", "v106", "v107", "v108", "v109", "v110", "v111", "v112", "v113", "v114", "v115", "v116", "v117", "v118", "v119", "v120", "v121", "v122", "v123", "v124", "v125", "v126", "v127");
    asm volatile("v_mov_b32 v128, 0\n\tv_mov_b32 v129, 0\n\tv_mov_b32 v130, 0\n\tv_mov_b32 v131, 0\n\tv_mov_b32 v132, 0\n\tv_mov_b32 v133, 0\n\tv_mov_b32 v134, 0\n\tv_mov_b32 v135, 0\n\tv_mov_b32 v136, 0\n\tv_mov_b32 v137, 0\n\tv_mov_b32 v138, 0\n\tv_mov_b32 v139, 0\n\tv_mov_b32 v140, 0\n\tv_mov_b32 v141, 0\n\tv_mov_b32 v142, 0\n\tv_mov_b32 v143, 0\n\tv_mov_b32 v144, 0\n\tv_mov_b32 v145, 0\n\tv_mov_b32 v146, 0\n\tv_mov_b32 v147, 0\n\tv_mov_b32 v148, 0\n\tv_mov_b32 v149, 0\n\tv_mov_b32 v150, 0\n\tv_mov_b32 v151, 0\n\tv_mov_b32 v152, 0\n\tv_mov_b32 v153, 0\n\tv_mov_b32 v154, 0\n\tv_mov_b32 v155, 0\n\tv_mov_b32 v156, 0\n\tv_mov_b32 v157, 0\n\tv_mov_b32 v158, 0\n\tv_mov_b32 v159, 0\n\tv_mov_b32 v160, 0\n\tv_mov_b32 v161, 0\n\tv_mov_b32 v162, 0\n\tv_mov_b32 v163, 0\n\tv_mov_b32 v164, 0\n\tv_mov_b32 v165, 0\n\tv_mov_b32 v166, 0\n\tv_mov_b32 v167, 0\n\tv_mov_b32 v168, 0\n\tv_mov_b32 v169, 0\n\tv_mov_b32 v170, 0\n\tv_mov_b32 v171, 0\n\tv_mov_b32 v172, 0\n\tv_mov_b32 v173, 0\n\tv_mov_b32 v174, 0\n\tv_mov_b32 v175, 0\n\tv_mov_b32 v176, 0\n\tv_mov_b32 v177, 0\n\tv_mov_b32 v178, 0\n\tv_mov_b32 v179, 0\n\tv_mov_b32 v180, 0\n\tv_mov_b32 v181, 0\n\tv_mov_b32 v182, 0\n\tv_mov_b32 v183, 0\n\tv_mov_b32 v184, 0\n\tv_mov_b32 v185, 0\n\tv_mov_b32 v186, 0\n\tv_mov_b32 v187, 0\n\tv_mov_b32 v188, 0\n\tv_mov_b32 v189, 0\n\tv_mov_b32 v190, 0\n\tv_mov_b32 v191, 0" ::: "v128", "v129", "v130", "v131", "v132", "v133", "v134", "v135", "v136", "v137", "v138", "v139", "v140", "v141", "v142", "v143", "v144", "v145", "v146", "v147", "v148", "v149", "v150", "v151", "v152", "v153", "v154", "v155", "v156", "v157", "v158", "v159", "v160", "v161", "v162", "v163", "v164", "v165", "v166", "v167", "v168", "v169", "v170", "v171", "v172", "v173", "v174", "v175", "v176", "v177", "v178", "v179", "v180", "v181", "v182", "v183", "v184", "v185", "v186", "v187", "v188", "v189", "v190", "v191");
    asm volatile("v_mov_b32 v192, 0\n\tv_mov_b32 v193, 0\n\tv_mov_b32 v194, 0\n\tv_mov_b32 v195, 0\n\tv_mov_b32 v196, 0\n\tv_mov_b32 v197, 0\n\tv_mov_b32 v198, 0\n\tv_mov_b32 v199, 0\n\tv_mov_b32 v200, 0\n\tv_mov_b32 v201, 0\n\tv_mov_b32 v202, 0\n\tv_mov_b32 v203, 0\n\tv_mov_b32 v204, 0\n\tv_mov_b32 v205, 0\n\tv_mov_b32 v206, 0\n\tv_mov_b32 v207, 0\n\tv_mov_b32 v208, 0\n\tv_mov_b32 v209, 0\n\tv_mov_b32 v210, 0\n\tv_mov_b32 v211, 0\n\tv_mov_b32 v212, 0\n\tv_mov_b32 v213, 0\n\tv_mov_b32 v214, 0\n\tv_mov_b32 v215, 0\n\tv_mov_b32 v216, 0\n\tv_mov_b32 v217, 0\n\tv_mov_b32 v218, 0\n\tv_mov_b32 v219, 0\n\tv_mov_b32 v220, 0\n\tv_mov_b32 v221, 0\n\tv_mov_b32 v222, 0\n\tv_mov_b32 v223, 0\n\tv_mov_b32 v224, 0\n\tv_mov_b32 v225, 0\n\tv_mov_b32 v226, 0\n\tv_mov_b32 v227, 0\n\tv_mov_b32 v228, 0\n\tv_mov_b32 v229, 0\n\tv_mov_b32 v230, 0\n\tv_mov_b32 v231, 0\n\tv_mov_b32 v232, 0\n\tv_mov_b32 v233, 0\n\tv_mov_b32 v234, 0\n\tv_mov_b32 v235, 0\n\tv_mov_b32 v236, 0\n\tv_mov_b32 v237, 0\n\tv_mov_b32 v238, 0\n\tv_mov_b32 v239, 0\n\tv_mov_b32 v240, 0\n\tv_mov_b32 v241, 0\n\tv_mov_b32 v242, 0\n\tv_mov_b32 v243, 0\n\tv_mov_b32 v244, 0\n\tv_mov_b32 v245, 0\n\tv_mov_b32 v246, 0\n\tv_mov_b32 v247, 0\n\tv_mov_b32 v248, 0\n\tv_mov_b32 v249, 0" ::: "v192", "v193", "v194", "v195", "v196", "v197", "v198", "v199", "v200", "v201", "v202", "v203", "v204", "v205", "v206", "v207", "v208", "v209", "v210", "v211", "v212", "v213", "v214", "v215", "v216", "v217", "v218", "v219", "v220", "v221", "v222", "v223", "v224", "v225", "v226", "v227", "v228", "v229", "v230", "v231", "v232", "v233", "v234", "v235", "v236", "v237", "v238", "v239", "v240", "v241", "v242", "v243", "v244", "v245", "v246", "v247", "v248", "v249");
#endif
    Frame F;
    F.lds = (LAS unsigned char*)lds; F.MISC = (volatile LAS unsigned*)(F.lds + MISC_OFF);
    F.wave = __builtin_amdgcn_readfirstlane((int)threadIdx.x >> 6);
    F.G = gridDim.x; { const int bx = blockIdx.x; F.vcu = (F.G % 8 == 0) ? (bx % 8) * (F.G / 8) + bx / 8 : bx; }
    Ptrs P;
    P.x = args.in[0]; P.p = args.in[1]; P.g_mix = args.in[2]; P.w_in = args.in[3]; P.w_conv_qkv = args.in[4]; P.a_log = args.in[5]; P.dt_bias = args.in[6]; P.g_gdn_out = args.in[7];
    P.b_glu = args.in[8]; P.w_conv_dw = args.in[9]; P.b_conv_dw = args.in[10]; P.ln_g = args.in[11]; P.ln_b = args.in[12]; P.w_out = args.in[13]; P.g_moe = args.in[14]; P.w_gr = args.in[15];
    P.w_er = args.in[16]; P.w_up = args.in[17]; P.w_down = args.in[18]; P.g_ple = args.in[19]; P.w_pg = args.in[20]; P.w_pp = args.in[21]; P.g_final = args.in[22];
    P.out = args.out; P.ws = args.ws;
    F.ctl = (gu32*)(P.ws + WS_CTL);
    for (int u = (int)threadIdx.x; u < (LDS_BYTES - LDSCTL_OFF) / 4; u += NWAVES * 64) ((LAS unsigned*)(F.lds + LDSCTL_OFF))[u] = 0u;
    __syncthreads();
    XcdBarrier bar; bar.bar = (unsigned*)(F.ctl + CW_BAR) + args.bar_region * XCD_BAR_WORDS; bar.x = 0; bar.st = nullptr;
    if (args.use_bar) bar = xcd_barrier_post((unsigned*)(F.ctl + CW_BAR) + args.bar_region * XCD_BAR_WORDS, F.MISC + 8, threadIdx.x == 0);
    const int lo = args.ph_lo, hi = args.ph_hi;
#ifndef VINIT
#define VINIT 0
#endif
#ifndef REP_PH
#define REP_PH -1
#define REP_N 1
#endif
#ifndef TPROBE_A
#define TPROBE_A -1
#define TPROBE_B -1
#endif
#ifndef TPROBE_MULT
#define TPROBE_MULT 8
#endif
#define TP(k) do { if (TPROBE_A == (k) || TPROBE_B == (k)) { if (blockIdx.x == 0 && F.wave == 0 && lane_now() == 0) __hip_atomic_store((unsigned*)(P.ws + WS_CTL) + 2304 + (TPROBE_B == (k) ? 1 : 0), (unsigned)rt(), __ATOMIC_RELAXED, __HIP_MEMORY_SCOPE_AGENT); } } while (0)
#define TPX(k) do { if (TPROBE_A == (k) || TPROBE_B == (k)) { if ((int)blockIdx.x == (int)gridDim.x - 1 && F.wave == 0 && lane_now() == 0) __hip_atomic_store((unsigned*)(P.ws + WS_CTL) + 2304 + (TPROBE_B == (k) ? 1 : 0), (unsigned)rt(), __ATOMIC_RELAXED, __HIP_MEMORY_SCOPE_AGENT); } } while (0)
#define IN(k) (lo <= (k) && (k) < hi)
#define REPS(k) for (int rep_ = 0; rep_ < ((k) == REP_PH ? REP_N : 1); ++rep_)
#define REPBAR() do { if (rep_) xcd_barrier(bar, F.wave == 0 && lane_now() == 0); } while (0)
#define SEAM(k) do { if (IN(k) && IN((k) + 1)) xcd_barrier(bar, F.wave == 0 && lane_now() == 0); } while (0)
    TP(0);

    if (IN(0)) { REPS(0) { REPBAR(); p0_prologue(F, P); } SEAM(0); TP(1); }
    if (IN(1)) { REPS(1) { REPBAR();
        pg8::Gemm g{(const pg8::bf16_t*)(P.ws + WS_N1), (const pg8::bf16_t*)(P.ws + WS_WIN), M, NIN_T, DM, 0};
        pg8::StaticOrder S; S.init(M, NIN_T, F.G, (int)blockIdx.x);
        EpiIn E{(pg8::bf16_t*)(P.ws + WS_QKVZ), (pg8::bf16_t*)(P.ws + WS_U), P.b_glu};
        pg8::gemm_phase<EpiIn, pg8::StaticOrder, true, true>(F.lds + RING_OFF, g, S, E, F.wave); }
        SEAM(1); TP(2);
    }
#ifndef SKIP_P2
    if (IN(2)) { REPS(2) { REPBAR();
#if P2_DUAL
        p2_gdn_prep_dual(F, P);
#else
        p2_gdn_prep(F, P);
#endif
#if CONV_IN_P2
        p3_convert_late(F, P, F.vcu, F.G);
#endif
#if DTEST
        p2_dtest(F, P);
#endif
#if XCHK
        xchk_sum(F, P, P.ws + WS_QKVZ, (size_t)64 * MiB + 16 * MiB, CK_P1);
        asm volatile("s_waitcnt vmcnt(0)" ::: "memory"); __syncthreads();
        for (int it = F.vcu; it < 1024; it += F.G) {
            const int lane = lane_now(); unsigned acc = 0; const GAS v4u* p4 = (const GAS v4u*)(P.ws + WS_GDN + (size_t)it * GDN_ITEM);
            for (int i = F.wave * 64 + lane; i < (int)(GDN_ITEM / 16); i += NWAVES * 64) { const v4u v = p4[i]; acc = v.x * 3u + v.y * 5u + v.z * 7u + v.w * 11u + (unsigned)(i + it * 131);
                const int reg = i < 1024 ? 0 : (i < 2048 ? 1 : (i < 3072 ? 2 : (i < 4096 ? 3 : 4)));
                __hip_atomic_fetch_add((unsigned*)(P.ws + WS_CTL) + CK_P2 + reg, acc, __ATOMIC_RELAXED, __HIP_MEMORY_SCOPE_AGENT); }
            if (F.wave == 0 && lane == 0) __hip_atomic_fetch_add((unsigned*)(P.ws + WS_CTL) + CK_P2 + 5, __float_as_uint(((const float*)(P.ws + WS_GT))[it]) * 13u + (unsigned)it, __ATOMIC_RELAXED, __HIP_MEMORY_SCOPE_AGENT); }
#endif
        } SEAM(2); TP(3); }
#endif
    if (IN(3)) { REPS(3) { REPBAR();
#ifndef SKIP_SCAN
        if ((int)blockIdx.x < NSCAN) { for (int r3 = 0; r3 < (REP_PH == 31 ? REP_N : 1); ++r3) p3_scan(F, P, (int)blockIdx.x); TP(25); }
        else
#endif
        if ((int)blockIdx.x < NSCAN + NWARM) p3_scan_warm(F, P, (int)blockIdx.x - NSCAN);
        else {
            const int idx = (int)blockIdx.x - NSCAN - NWARM, cnt = F.G - NSCAN - NWARM;
            TPX(20);
#if defined(SCAN_ALONE) && SCAN_ALONE
            { if (F.wave == 0) { for (int j = 0; j < 32; ++j) { while (__builtin_amdgcn_readfirstlane(__hip_atomic_load((unsigned*)(P.ws + WS_CTL) + CW_PROG + (j >> 2) * 64 + (j & 3), __ATOMIC_RELAXED, __HIP_MEMORY_SCOPE_AGENT)) < 128u) __builtin_amdgcn_s_sleep(32); } }
              __syncthreads(); }
#endif
#ifndef SKIP_CONF
            { ConfTaps T; p3_conf_load_taps(P, F.wave * 64 + lane_now(), T);
              for (int r3 = 0; r3 < (REP_PH == 32 ? REP_N : 1); ++r3) for (int t = idx; t < M / 32; t += cnt) p3_conf_tile(F, P, t, T); }
#endif
            TPX(21);
            pg8::Gemm g{(const pg8::bf16_t*)(P.ws + WS_PBF), (const pg8::bf16_t*)(P.ws + WS_WPROJ), M, DM, PLE, 0};
            pg8::StaticOrder S; S.init(M, DM, cnt, idx);
            pg8::EpiBf16<0> E{(pg8::bf16_t*)(P.ws + WS_PROJ), DM, nullptr, 0, 0, 1.f};
            for (int r3 = 0; r3 < (REP_PH == 33 ? REP_N : 1); ++r3) pg8::gemm_phase<pg8::EpiBf16<0>, pg8::StaticOrder, true, true>(F.lds + RING_OFF, g, S, E, F.wave);
            TPX(22);
#if !CONV_IN_P2
            for (int r3 = 0; r3 < (REP_PH == 34 ? REP_N : 1); ++r3) p3_convert_late(F, P, idx, cnt);
#endif
            TPX(23);
#ifndef SKIP_P4
            p4_gdn_out(F, P, idx, cnt);
#endif
            TPX(24);
        } }
        SEAM(3); TP(4);
    }
    if (IN(5)) { REPS(5) { REPBAR();
        pg8::Gemm g{(const pg8::bf16_t*)(P.ws + WS_MIX), (const pg8::bf16_t*)(P.ws + WS_WOUT), M, DM, DM, 0};
        pg8::StaticOrder S; S.init(M, DM, F.G, (int)blockIdx.x);
        EpiRes E{P.x, (pg8::bf16_t*)(P.ws + WS_H1)};
        pg8::gemm_phase<EpiRes, pg8::StaticOrder, true, true>(F.lds + RING_OFF, g, S, E, F.wave); }
        SEAM(5); TP(5);
    }
    if (IN(6)) { REPS(6) { REPBAR(); p6_router(F, P); } SEAM(6); TP(6); }
    if (IN(7)) { REPS(7) { REPBAR(); p7_dispatch(F, P); } SEAM(7); TP(7); }
    if (IN(8)) { REPS(8) { REPBAR();
        { pg8::Gemm g{(const pg8::bf16_t*)(P.ws + WS_XG), (const pg8::bf16_t*)(P.ws + WS_WUP), PSLOTS, 512, DM, (size_t)512 * DM * 2};
          MoeUpOrder S{P.ws, F.G, F.vcu};
          EpiSwiGLU E{(pg8::bf16_t*)(P.ws + WS_ACT)};
          pg8::gemm_phase<EpiSwiGLU, MoeUpOrder, true, true>(F.lds + RING_OFF, g, S, E, F.wave); }
        { pg8::Gemm g{(const pg8::bf16_t*)(P.ws + WS_ACT), (const pg8::bf16_t*)(P.ws + WS_WDOWN), PSLOTS, DM, DEXP, (size_t)DM * DEXP * 2};
          MoeDownOrder S{P.ws, F.G, F.vcu, F.wave};
          EpiGate E{(pg8::bf16_t*)(P.ws + WS_Y), (const float*)(P.ws + WS_GATEW)};
          for (int i = 0; ; ++i) { OneUnit S1; if (!S.next(i, S1.u0)) break; S.wait_ready(S1.u0);
              pg8::gemm_phase<EpiGate, OneUnit, true, true>(F.lds + RING_OFF, g, S1, E, F.wave); } } }
        SEAM(8); TP(8);
    }
    if (IN(10)) { REPS(10) { REPBAR(); p10_combine(F, P); } SEAM(10); TP(9); }
    if (IN(11)) { REPS(11) { REPBAR();
        pg8::Gemm g{(const pg8::bf16_t*)(P.ws + WS_XN3), (const pg8::bf16_t*)(P.ws + WS_WGATE), M, DM, DM, 0};
        pg8::StaticOrder S; S.init(M, DM, F.G, (int)blockIdx.x);
        EpiPle E{(const pg8::bf16_t*)(P.ws + WS_H2), (const pg8::bf16_t*)(P.ws + WS_PROJ), (pg8::bf16_t*)(P.ws + WS_H3)};
        pg8::gemm_phase<EpiPle, pg8::StaticOrder, true, true>(F.lds + RING_OFF, g, S, E, F.wave); }
        SEAM(11); TP(10);
    }
    if (IN(12)) { REPS(12) { REPBAR(); p12_final(F, P); } }
    TP(11);
#if defined(DPP_BENCH)
    if (blockIdx.x == 0) {
        float a0 = 1.f, a1 = 2.f, a2 = 3.f, a3 = 4.f; const float lv = (float)lane_now() * 1e-9f, xv = 1e-9f;
        for (int it = 0; it < 4000; ++it) {
#pragma unroll
            for (int j = 0; j < 16; ++j) {
#if DPP_BENCH == 1
                asm volatile("v_fmac_f32_dpp %0, %4, %5 row_newbcast:3 row_mask:0xf bank_mask:0xf\n\tv_fmac_f32_dpp %1, %4, %5 row_newbcast:5 row_mask:0xf bank_mask:0xf\n\tv_fmac_f32_dpp %2, %4, %5 row_newbcast:7 row_mask:0xf bank_mask:0xf\n\tv_fmac_f32_dpp %3, %4, %5 row_newbcast:9 row_mask:0xf bank_mask:0xf" : "+v"(a0), "+v"(a1), "+v"(a2), "+v"(a3) : "v"(lv), "v"(xv));
#else
                asm volatile("v_fmac_f32 %0, %4, %5\n\tv_fmac_f32 %1, %4, %5\n\tv_fmac_f32 %2, %4, %5\n\tv_fmac_f32 %3, %4, %5" : "+v"(a0), "+v"(a1), "+v"(a2), "+v"(a3) : "v"(lv), "v"(xv));
#endif
            } }
        if (a0 + a1 + a2 + a3 == 12345.678f) F.MISC[15] = 1u;
    }
#endif
#if TPROBE_A >= 0
    if (blockIdx.x == 0 && F.wave == 0 && lane_now() == 0) {
        const unsigned ta = __hip_atomic_load((unsigned*)(P.ws + WS_CTL) + 2304, __ATOMIC_RELAXED, __HIP_MEMORY_SCOPE_AGENT), tb = __hip_atomic_load((unsigned*)(P.ws + WS_CTL) + 2305, __ATOMIC_RELAXED, __HIP_MEMORY_SCOPE_AGENT);
        const unsigned want = (tb - ta) * (unsigned)TPROBE_MULT; const unsigned t0 = (unsigned)rt();
        while ((unsigned)rt() - t0 < want) __builtin_amdgcn_s_sleep(4);
    }
#endif
#undef IN
#undef SEAM
}

#ifndef HYB
#define HYB 1
#endif
static int launch_fast(void* const* d_in, float* out, void* d_ws, const int* seg, int nseg, hipStream_t stream) {
    static int grid = 0;
    if (grid == 0) {
        int dev = 0, cus = 0;
        if (hipGetDevice(&dev) != hipSuccess || hipDeviceGetAttribute(&cus, hipDeviceAttributeMultiprocessorCount, dev) != hipSuccess) { fprintf(stderr, "device query failed\n"); grid = -1; return -1; }
        if (hipFuncSetAttribute((const void*)mk_fwd, hipFuncAttributeMaxDynamicSharedMemorySize, LDS_BYTES) != hipSuccess) { fprintf(stderr, "hipFuncSetAttribute failed\n"); grid = -1; return -1; }
        int per_cu = 0;
        if (hipOccupancyMaxActiveBlocksPerMultiprocessor(&per_cu, (const void*)mk_fwd, NWAVES * 64, LDS_BYTES) != hipSuccess || per_cu < 1) fprintf(stderr, "note: occupancy query says %d\n", per_cu);
        (void)hipGetLastError();
        grid = cus;
        if (grid != 256) { fprintf(stderr, "kernel_launch: built for a 256-CU device (router tiles = workgroups); got %d\n", cus); grid = -1; return -1; }
    }
    if (grid < 0) return -1;
    Args a{};
    for (int i = 0; i < 23; ++i) a.in[i] = (const float*)d_in[i];
    a.out = out; a.ws = (unsigned char*)d_ws;
    for (int i = 0; i < nseg; ++i) { a.ph_lo = seg[2 * i]; a.ph_hi = seg[2 * i + 1]; a.use_bar = (a.ph_hi - a.ph_lo > 1) ? 1 : 0; a.bar_region = i;
        hipLaunchKernelGGL(mk_fwd, dim3(grid), dim3(NWAVES * 64), LDS_BYTES, stream, a); }
    return 0;
}

extern "C" void kernel_launch(void* const* d_in, const int* in_sizes, int n_in, void* d_out, int out_size, void* d_ws, size_t ws_size, hipStream_t stream) {
    char* ws = (char*)d_ws; float* out = (float*)d_out;
#if HYB == 0
    run_naive(d_in, out, nv_default_map(ws), 0, stream);
#elif HYB == 1
    (void)hipMemsetAsync(ws + WS_CTL, 0, CTL_ZERO_BYTES, stream);
    { const int seg[] = {0, 1, 1, 2}; if (launch_fast(d_in, out, d_ws, seg, 2, stream) != 0) return; }
    NvMap m = nv_default_map(ws);
    m.proj = (float*)(ws + 226 * MiB); m.ldp = 2056; m.qkv = (float*)(ws + 4 * MiB); m.o = (float*)(ws + 100 * MiB); m.mix = (float*)(ws + 132 * MiB); m.u = (float*)(ws + 392 * MiB); m.h = (float*)(ws + 424 * MiB);
    m.xn = m.mix; m.logits = m.o; m.UP = (float*)(ws + 4 * MiB); m.ACT = (float*)(ws + 356 * MiB); m.Y = (float*)(ws + 196 * MiB); m.G = (float*)(ws + 4 * MiB); m.PP = (float*)(ws + 196 * MiB);
    k_shimA<<<(int)(((size_t)M * 2048 + 255) / 256), 256, 0, stream>>>((const unsigned short*)(ws + WS_QKVZ), (const float*)(ws + WS_AB), (const unsigned short*)(ws + WS_U), m.proj, m.ldp, m.u);
    run_naive(d_in, out, m, 1, stream);
#elif HYB == 2
    (void)hipMemsetAsync(ws + WS_CTL, 0, CTL_ZERO_BYTES, stream);
    { const int seg[] = {0, 1, 1, 2, 2, 3, 3, 4, 4, 5}; if (launch_fast(d_in, out, d_ws, seg, 5, stream) != 0) return; }
    NvMap m = nv_default_map(ws);
    k_shimB<<<(int)(((size_t)M * DM + 255) / 256), 256, 0, stream>>>((const unsigned short*)(ws + WS_MIX), m.mix);
    run_naive(d_in, out, m, 2, stream);
#elif HYB == 3
    (void)hipMemsetAsync(ws + WS_CTL, 0, CTL_ZERO_BYTES, stream);
    { const int seg[] = {0, 1, 1, 2, 2, 3, 3, 4, 4, 5, 5, 6}; if (launch_fast(d_in, out, d_ws, seg, 6, stream) != 0) return; }
    NvMap m = nv_default_map(ws); m.h = (float*)(ws + WS_H1);
    run_naive(d_in, out, m, 3, stream);
#elif HYB == 4
    (void)hipMemsetAsync(ws + WS_CTL, 0, CTL_ZERO_BYTES, stream);
    { const int seg[] = {0, 1, 1, 2, 2, 3, 3, 4, 4, 5, 5, 6, 6, 8, 8, 9, 9, 10, 10, 11}; if (launch_fast(d_in, out, d_ws, seg, 10, stream) != 0) return; }
    NvMap m = nv_default_map(ws); m.h = (float*)(ws + WS_H1);
    run_naive(d_in, out, m, 4, stream);
#elif HYB == 5
    (void)hipMemsetAsync(ws + WS_CTL, 0, CTL_ZERO_BYTES, stream);
    { const int seg[] = {0, 1, 1, 2, 2, 3, 3, 4, 4, 5, 5, 6, 6, 8, 8, 9, 9, 10, 10, 11, 11, 12, 12, 13}; if (launch_fast(d_in, out, d_ws, seg, 12, stream) != 0) return; }
#elif HYB == 6
    (void)hipMemsetAsync(ws + WS_CTL, 0, CTL_ZERO_BYTES, stream);
    { const int seg[] = {0, 13}; if (launch_fast(d_in, out, d_ws, seg, 1, stream) != 0) return; }
#endif
}
```
